# Optimizing an MI355X kernel written in HIP

```python
import math
import jax, jax.numpy as jnp
from jax import lax
import numpy as np


D_MODEL = 1024
BATCH = 8
SEQ = 4096
DEPTH = 1

CHUNK = 64
N_META = 16
Q_BLOCK = 128
MIX_WIDTH = D_MODEL
HG_WIDTH = MIX_WIDTH // 2
HG_HEADS = 4
HG_DK = HG_WIDTH // HG_HEADS
SB_WIDTH = MIX_WIDTH - HG_WIDTH
SB_HEADS = 8
SB_DH = SB_WIDTH // SB_HEADS
N_GROUPS = 4
EXPERTS_PER_GROUP = 4
N_EXPERTS = N_GROUPS * EXPERTS_PER_GROUP
TOP_K_INNER = 2
D_EXPERT = D_MODEL // 2
ALPHA = (2 * DEPTH) ** 0.25
BETA = (8 * DEPTH) ** -0.25
LN_EPS = 1e-5
RMS_EPS = 1e-6
SPLITS = (HG_WIDTH, 2 * HG_WIDTH, 3 * HG_WIDTH, 4 * HG_WIDTH,
          4 * HG_WIDTH + SB_WIDTH, 4 * HG_WIDTH + 2 * SB_WIDTH)
IN_COLS = 4 * HG_WIDTH + 3 * SB_WIDTH

kernel_name = 'hymba_hgrn2_stickbreak_hmoe_deepnorm'


def layer_norm(x, g, b):
    xf = x.astype(jnp.float32)
    mu = jnp.mean(xf, axis=-1, keepdims=True)
    var = jnp.mean(jnp.square(xf - mu), axis=-1, keepdims=True)
    return ((xf - mu) * lax.rsqrt(var + LN_EPS) * g + b).astype(x.dtype)


def head_rms_norm(x, g):
    xf = x.astype(jnp.float32)
    y = xf * lax.rsqrt(jnp.mean(xf * xf, axis=-1, keepdims=True) + RMS_EPS)
    return y.reshape(*x.shape[:-2], -1) * g


def hgrn2_mixer(q_raw, f_raw, i_raw, g_raw, lb, norm_g):
    B, Lp, _ = q_raw.shape
    nc = Lp // CHUNK
    zf = f_raw.astype(jnp.float32)
    log_f = jnp.log(lb + (1.0 - lb) * jax.nn.sigmoid(zf))
    k = (1.0 - lb) * jax.nn.sigmoid(-zf)
    q = jax.nn.silu(q_raw.astype(jnp.float32))
    v = i_raw.astype(jnp.float32)

    def to_chunks(a):
        return a.reshape(B, nc, CHUNK, HG_HEADS, HG_DK).transpose(1, 0, 3, 2, 4)

    qc, kc, vc, lfc = to_chunks(q), to_chunks(k), to_chunks(v), to_chunks(log_f)
    causal = jnp.tril(jnp.ones((CHUNK, CHUNK), dtype=bool))

    def step(S, inp):
        qb, kb, vb, lfb = inp
        bcum = jnp.cumsum(lfb, axis=2)
        diff = bcum[:, :, :, None, :] - bcum[:, :, None, :, :]
        decay = jnp.exp(jnp.where(causal[:, :, None], diff, -jnp.inf))
        scores = jnp.einsum('bhtd,bhsd,bhtsd->bhts', qb, kb, decay)
        o = (jnp.einsum('bhts,bhsv->bhtv', scores, vb)
             + jnp.einsum('bhtd,bhdv->bhtv', qb * jnp.exp(bcum), S))
        b_last = bcum[:, :, -1:, :]
        S_new = (jnp.exp(b_last[:, :, 0, :, None]) * S
                 + jnp.einsum('bhsd,bhsv->bhdv', kb * jnp.exp(b_last - bcum), vb))
        return S_new, o

    S0 = jnp.zeros((B, HG_HEADS, HG_DK, HG_DK), jnp.float32)
    _, oc = lax.scan(step, S0, (qc, kc, vc, lfc))
    o = oc.transpose(1, 0, 3, 2, 4).reshape(B, Lp, HG_HEADS, HG_DK)
    gate = jax.nn.sigmoid(g_raw.astype(jnp.float32))
    return head_rms_norm(o, norm_g) * gate


def stick_breaking_mixer(q, k, v, norm_g):
    B, Lp, _ = q.shape

    def heads(a):
        return a.astype(jnp.float32).reshape(B, Lp, SB_HEADS, SB_DH).transpose(0, 2, 1, 3)

    qh = heads(q) * (SB_DH ** -0.5)
    kh, vh = heads(k), heads(v)
    outs = []
    for blk in range(Lp // Q_BLOCK):
        start = blk * Q_BLOCK
        end = start + Q_BLOCK
        z = jnp.einsum('bhqd,bhkd->bhqk', qh[:, :, start:end], kh[:, :, :end])
        mask = jnp.arange(end)[None, :] < (start + jnp.arange(Q_BLOCK))[:, None]
        log_keep = jnp.where(mask, jax.nn.log_sigmoid(-z), 0.0)
        log_a = jax.nn.log_sigmoid(z) + lax.cumsum(log_keep, axis=3, reverse=True) - log_keep
        a = jnp.where(mask, jnp.exp(log_a), 0.0)
        outs.append(jnp.einsum('bhqk,bhkd->bhqd', a, vh[:, :, :end]))
    o = jnp.concatenate(outs, axis=2).transpose(0, 2, 1, 3)
    return head_rms_norm(o, norm_g)


def hierarchical_moe(h, w_rg, b_rg, w_re, b_re, w1, w3, w2):
    B, L, D = h.shape
    xf = h.reshape(-1, D)
    logits_g = (xf @ w_rg).astype(jnp.float32) + b_rg
    probs_g = jax.nn.softmax(logits_g, axis=-1)
    _, grp = lax.top_k(logits_g, 1)
    grp_oh = jax.nn.one_hot(grp[:, 0], N_GROUPS, dtype=jnp.float32)
    p_grp = jnp.sum(probs_g * grp_oh, axis=-1, keepdims=True)
    logits_e = jnp.einsum('nd,dge->nge', xf, w_re).astype(jnp.float32) + b_re
    logits_in = jnp.einsum('nge,ng->ne', logits_e, grp_oh)
    top_v, top_i = lax.top_k(logits_in, TOP_K_INNER)
    w_inner = jax.nn.softmax(top_v, axis=-1)
    expert_id = grp * EXPERTS_PER_GROUP + top_i
    gates = p_grp * jnp.sum(jax.nn.one_hot(expert_id, N_EXPERTS, dtype=jnp.float32)
                            * w_inner[..., None], axis=1)
    y = jnp.zeros(xf.shape, jnp.float32)
    for e in range(N_EXPERTS):
        hid = jax.nn.silu(xf @ w1[e]) * (xf @ w3[e])
        y = y + gates[:, e:e + 1] * (hid @ w2[e])
    return y.astype(h.dtype).reshape(B, L, D)


def setup_inputs(seed: int = 0) -> dict:
    key = jax.random.key(seed)
    ks = jax.random.split(key, 18)
    f32 = jnp.float32
    col_scale = jnp.concatenate([
        jnp.ones((2 * HG_WIDTH,), f32), jnp.full((HG_WIDTH,), BETA, f32),
        jnp.ones((HG_WIDTH + 2 * SB_WIDTH,), f32),
        jnp.full((SB_WIDTH,), BETA, f32)])
    w_in = jax.random.normal(ks[2], (DEPTH, D_MODEL, IN_COLS), f32) * (D_MODEL ** -0.5) * col_scale
    return {
        'x': jax.random.normal(ks[0], (BATCH, SEQ, D_MODEL), f32),
        'meta_tokens': jax.random.normal(ks[1], (N_META, D_MODEL), f32),
        'w_in': w_in,
        'hg_lower_bound': 0.1 * jax.random.normal(ks[3], (DEPTH + 1, HG_WIDTH), f32),
        'hg_norm_g': 1.0 + 0.02 * jax.random.normal(ks[4], (DEPTH, HG_WIDTH), f32),
        'sb_norm_g': 1.0 + 0.02 * jax.random.normal(ks[5], (DEPTH, SB_WIDTH), f32),
        'w_out': jax.random.normal(ks[6], (DEPTH, MIX_WIDTH, D_MODEL), f32) * (MIX_WIDTH ** -0.5) * BETA,
        'ln1_g': 1.0 + 0.02 * jax.random.normal(ks[7], (DEPTH, D_MODEL), f32),
        'ln1_b': 0.02 * jax.random.normal(ks[8], (DEPTH, D_MODEL), f32),
        'w_router_group': jax.random.normal(ks[9], (DEPTH, D_MODEL, N_GROUPS), f32) * (D_MODEL ** -0.5),
        'b_router_group': 0.01 * jax.random.normal(ks[10], (DEPTH, N_GROUPS), f32),
        'w_router_expert': jax.random.normal(ks[11], (DEPTH, D_MODEL, N_GROUPS, EXPERTS_PER_GROUP), f32) * (D_MODEL ** -0.5),
        'b_router_expert': 0.01 * jax.random.normal(ks[12], (DEPTH, N_GROUPS, EXPERTS_PER_GROUP), f32),
        'w_exp_gate': jax.random.normal(ks[13], (DEPTH, N_EXPERTS, D_MODEL, D_EXPERT), f32) * (D_MODEL ** -0.5) * BETA,
        'w_exp_up': jax.random.normal(ks[14], (DEPTH, N_EXPERTS, D_MODEL, D_EXPERT), f32) * (D_MODEL ** -0.5) * BETA,
        'w_exp_down': jax.random.normal(ks[15], (DEPTH, N_EXPERTS, D_EXPERT, D_MODEL), f32) * (D_EXPERT ** -0.5) * BETA,
        'ln2_g': 1.0 + 0.02 * jax.random.normal(ks[16], (DEPTH, D_MODEL), f32),
        'ln2_b': 0.02 * jax.random.normal(ks[17], (DEPTH, D_MODEL), f32),
    }


def reference(x, meta_tokens, w_in, hg_lower_bound, hg_norm_g, sb_norm_g, w_out, ln1_g, ln1_b,
              w_router_group, b_router_group, w_router_expert, b_router_expert,
              w_exp_gate, w_exp_up, w_exp_down, ln2_g, ln2_b):
    B = x.shape[0]
    meta = jnp.broadcast_to(meta_tokens[None].astype(x.dtype), (B, N_META, D_MODEL))
    h = jnp.concatenate([meta, x], axis=1)
    L = h.shape[1]
    Lp = -(-L // Q_BLOCK) * Q_BLOCK
    lb_all = jnp.cumsum(jax.nn.softmax(hg_lower_bound.astype(jnp.float32), axis=0), axis=0)
    for layer in range(DEPTH):
        proj = jnp.einsum('bld,dp->blp', h, w_in[layer])
        proj = jnp.pad(proj, ((0, 0), (0, Lp - L), (0, 0)))
        hq, hf, hi, hg, sq, sk, sv = jnp.split(proj, SPLITS, axis=-1)
        o_hg = hgrn2_mixer(hq, hf, hi, hg, lb_all[layer], hg_norm_g[layer])
        o_sb = stick_breaking_mixer(sq, sk, sv, sb_norm_g[layer])
        mixed = jnp.concatenate([o_hg, o_sb], axis=-1)[:, :L].astype(h.dtype)
        h = layer_norm(ALPHA * h + mixed @ w_out[layer], ln1_g[layer], ln1_b[layer])
        ffn = hierarchical_moe(h, w_router_group[layer], b_router_group[layer],
                               w_router_expert[layer], b_router_expert[layer],
                               w_exp_gate[layer], w_exp_up[layer], w_exp_down[layer])
        h = layer_norm(ALPHA * h + ffn, ln2_g[layer], ln2_b[layer])
    return h[:, N_META:]
```

```cpp
#include <hip/hip_runtime.h>
#include <hip/hip_cooperative_groups.h>
#include <cstdio>
#include <cstdint>
namespace cg = cooperative_groups;
namespace pg8 {
#define PG8_LAS __attribute__((address_space(3)))
typedef unsigned short bf16_t;
typedef short bf16x8 __attribute__((ext_vector_type(8)));
typedef float f32x4 __attribute__((ext_vector_type(4)));
typedef unsigned u32x4 __attribute__((ext_vector_type(4)));
constexpr int BM = 256, BK = 64, HALF = 128, HTB = HALF * BK * 2  , STAGE_BYTES = 8 * HTB, NXCD = 8, WGM = 8;

__host__ __device__ __forceinline__ int lds_byte(int r, int c) { const int st = (r >> 4) * 2 + (c >> 5), rr = r & 15, cc = c & 31, ob = rr * 64 + cc * 2; return st * 1024 + (ob ^ (((ob >> 9) & 1) << 5)); }
__host__ __device__ __forceinline__ void stage_rc(int b, int& R, int& C) { const int st = b / 1024, sb = b % 1024, swz = sb ^ (((sb >> 9) & 1) << 5); R = (st >> 1) * 16 + swz / 64; C = (st & 1) * 32 + (swz % 64) / 2; }
__host__ __device__ __forceinline__ int perm32(int rho) { const int n = rho >> 4, i = rho & 15; return 8 * (i >> 2) + 4 * n + (i & 3); }

struct Unit { int pm, pn; };
struct Gemm { const bf16_t* A; const bf16_t* Bt; int M, N, K; };

struct StaticOrder {
    int nM, nN, nwg, G, c;
    __host__ __device__ void init(int M, int N, int G_, int c_) { nM = M / BM; nN = N / BM; nwg = nM * nN; G = G_; c = c_; }
    __host__ __device__ bool next(int i, Unit& u) const {
        const long L = (long)i * G + c; if (L >= nwg) return false;
        int wgid = (int)L; { const int q = nwg / NXCD, r = nwg % NXCD, xcd = wgid % NXCD, off = wgid / NXCD; wgid = (xcd < r ? xcd * (q + 1) : r * (q + 1) + (xcd - r) * q) + off; }
        const int nig = WGM * nN, gid = wgid / nig, fm = gid * WGM, gsz = (nM - fm) < WGM ? (nM - fm) : WGM;
        u.pm = fm + ((wgid % nig) % gsz); u.pn = (wgid % nig) / gsz; return true;
    }
    __device__ __forceinline__ void a_ready(const Unit&) const {}
    __device__ __forceinline__ void done(const Unit&) const {}
};

__device__ __forceinline__ unsigned cvt_pk_bf16(float lo, float hi) { unsigned r; asm volatile("v_cvt_pk_bf16_f32 %0, %1, %2" : "=v"(r) : "v"(lo), "v"(hi)); return r; }
template <class Epi, class Sched, bool ALIGN_EPI = false, bool SP2 = false>
__device__ __forceinline__ void gemm_phase(PG8_LAS unsigned char* lds, const Gemm g, const Sched& S, const Epi& E) {
    int tid_ = threadIdx.x; asm volatile("" : "+v"(tid_));
    const int tid = tid_, wid = __builtin_amdgcn_readfirstlane(tid >> 6), lane = tid & 63, wr = wid >> 2, wc = wid & 3, fr = lane & 15, fq = lane >> 4;
    const int K = g.K, nt = K / BK;
    unsigned voffA[2], voffB[2];
#pragma unroll
    for (int i = 0; i < 2; ++i) { int R, C; stage_rc(tid * 16 + i * 8192, R, C); const int Rb = Epi::PERM ? ((R & ~31) + perm32(R & 31)) : R;
        voffA[i] = (unsigned)(R * K + C) * 2u; voffB[i] = (unsigned)(Rb * K + C) * 2u; }
    const size_t kstep = (size_t)(BK * 2);
    const size_t hstep = (size_t)HALF * K * 2;
    const size_t tstep = 2 * hstep;
    const unsigned ldsw = (unsigned)wid * 1024u;
    const int aoff = lds_byte(wr * 64 + fr, fq * 8), boff = lds_byte(wc * 32 + fr, fq * 8);
#define PG8_SA(b, h) (((b) * 2 + (h)) * HTB)
#define PG8_SB(b, h) ((4 + (b) * 2 + (h)) * HTB)
#define PG8_STAGE(bufoff, gbase, voff) do { _Pragma("unroll") for (int _i = 0; _i < 2; ++_i) \
        __builtin_amdgcn_global_load_lds((const unsigned*)((const char*)(gbase) + (voff)[_i]), (PG8_LAS unsigned*)(lds + (bufoff) + ldsw + _i * 8192), 16, 0, 0); } while (0)
#define PG8_LDA(dst, b, h) do { _Pragma("unroll") for (int m = 0; m < 4; ++m) _Pragma("unroll") for (int k = 0; k < 2; ++k) dst[m][k] = *(const PG8_LAS bf16x8*)(lds + PG8_SA(b, h) + aoff + m * 2048 + k * 1024); } while (0)
#define PG8_LDB(dst, b, h) do { _Pragma("unroll") for (int n = 0; n < 2; ++n) _Pragma("unroll") for (int k = 0; k < 2; ++k) dst[n][k] = *(const PG8_LAS bf16x8*)(lds + PG8_SB(b, h) + boff + n * 2048 + k * 1024); } while (0)
#define PG8_MMA(ai, bj, At, Bt) do { __builtin_amdgcn_s_setprio(1); _Pragma("unroll") for (int m = 0; m < 4; ++m) _Pragma("unroll") for (int n = 0; n < 2; ++n) _Pragma("unroll") for (int k = 0; k < 2; ++k) \
        acc[ai][bj][m][n] = __builtin_amdgcn_mfma_f32_16x16x32_bf16(Bt[n][k], At[m][k], acc[ai][bj][m][n], 0, 0, 0); __builtin_amdgcn_s_setprio(0); } while (0)
#define PG8_WAIT_V(n) asm volatile("s_waitcnt vmcnt(" #n ")" ::: "memory")
#define PG8_WAIT_L(n) asm volatile("s_waitcnt lgkmcnt(" #n ")" ::: "memory")
#define PG8_BAR __builtin_amdgcn_s_barrier()
#define PG8_SCHED __builtin_amdgcn_sched_barrier(0)
    Unit cur, nxt; int ui = 0;
    if (!S.next(0, cur)) return;
    f32x4 acc[2][2][4][2];
#pragma unroll
    for (int a = 0; a < 2; ++a)
#pragma unroll
        for (int b = 0; b < 2; ++b)
#pragma unroll
            for (int m = 0; m < 4; ++m)
#pragma unroll
                for (int n = 0; n < 2; ++n) acc[a][b][m][n] = (f32x4){0.f, 0.f, 0.f, 0.f};
    bf16x8 At[4][2], B0[2][2], B1[2][2];
    const char* cA = (const char*)g.A + (size_t)cur.pm * tstep; const char* cB = (const char*)g.Bt + (size_t)cur.pn * tstep;
    S.a_ready(cur);
    if constexpr (SP2) {
        PG8_STAGE(PG8_SB(0, 0), cB, voffB); PG8_STAGE(PG8_SB(0, 1), cB + hstep, voffB); PG8_STAGE(PG8_SA(0, 0), cA, voffA); PG8_STAGE(PG8_SA(0, 1), cA + hstep, voffA);
        if (wr == 1) PG8_BAR;
        PG8_WAIT_V(2); PG8_BAR;
        PG8_STAGE(PG8_SB(1, 0), cB + kstep, voffB); PG8_STAGE(PG8_SA(1, 0), cA + kstep, voffA); PG8_STAGE(PG8_SB(1, 1), cB + hstep + kstep, voffB);
        PG8_WAIT_V(6); PG8_BAR;
    } else {
        PG8_STAGE(PG8_SB(0, 0), cB, voffB); PG8_STAGE(PG8_SA(0, 0), cA, voffA); PG8_STAGE(PG8_SB(0, 1), cB + hstep, voffB); PG8_STAGE(PG8_SA(0, 1), cA + hstep, voffA);
        if (wr == 1) PG8_BAR;
        PG8_WAIT_V(4); PG8_BAR;
        PG8_STAGE(PG8_SB(1, 0), cB + kstep, voffB); PG8_STAGE(PG8_SA(1, 0), cA + kstep, voffA); PG8_STAGE(PG8_SB(1, 1), cB + hstep + kstep, voffB);
        PG8_WAIT_V(6); PG8_BAR;
    }
    for (;;) {
        const bool has_next = S.next(ui + 1, nxt);
        const char* nA = has_next ? (const char*)g.A + (size_t)nxt.pm * tstep : cA; const char* nB = has_next ? (const char*)g.Bt + (size_t)nxt.pn * tstep : cB;
        for (int t = 0; t < nt; t += 2) {
            const bool last = (t == nt - 2);
            const char* a1 = cA + (size_t)(t + 1) * kstep;
            const char* a2 = last ? nA : cA + (size_t)(t + 2) * kstep; const char* b2 = last ? nB : cB + (size_t)(t + 2) * kstep;
            const char* a3 = a2 + kstep; const char* b3 = b2 + kstep;
            if (last && has_next) S.a_ready(nxt);
            if constexpr (SP2) {
            PG8_LDB(B0, 0, 0); PG8_LDB(B1, 0, 1); PG8_SCHED; PG8_LDA(At, 0, 0); PG8_STAGE(PG8_SA(1, 1), a1 + hstep, voffA);
            PG8_WAIT_V(8); PG8_WAIT_L(0); PG8_BAR; PG8_MMA(0, 0, At, B0); PG8_MMA(0, 1, At, B1); PG8_BAR; PG8_SCHED;
            PG8_LDA(At, 0, 1); PG8_STAGE(PG8_SB(0, 0), b2, voffB); PG8_STAGE(PG8_SB(0, 1), b2 + hstep, voffB); PG8_STAGE(PG8_SA(0, 0), a2, voffA);
            PG8_WAIT_V(8); PG8_WAIT_L(0); PG8_BAR; PG8_MMA(1, 0, At, B0); PG8_MMA(1, 1, At, B1); PG8_BAR; PG8_SCHED;
            PG8_LDB(B0, 1, 0); PG8_LDB(B1, 1, 1); PG8_SCHED; PG8_LDA(At, 1, 0); PG8_STAGE(PG8_SA(0, 1), a2 + hstep, voffA);
            PG8_WAIT_V(8); PG8_WAIT_L(0); PG8_BAR; PG8_MMA(0, 0, At, B0); PG8_MMA(0, 1, At, B1); PG8_BAR; PG8_SCHED;
            PG8_LDA(At, 1, 1); PG8_STAGE(PG8_SB(1, 0), b3, voffB); PG8_STAGE(PG8_SB(1, 1), b3 + hstep, voffB); PG8_STAGE(PG8_SA(1, 0), a3, voffA);
            PG8_WAIT_V(8); PG8_WAIT_L(0); PG8_BAR; PG8_MMA(1, 0, At, B0); PG8_MMA(1, 1, At, B1); PG8_BAR; PG8_SCHED;
            } else {
            PG8_LDB(B0, 0, 0); PG8_SCHED; PG8_LDA(At, 0, 0); PG8_STAGE(PG8_SA(1, 1), a1 + hstep, voffA);
            PG8_WAIT_L(8); PG8_BAR; PG8_WAIT_L(0); PG8_MMA(0, 0, At, B0); PG8_BAR; PG8_SCHED;
            PG8_LDB(B1, 0, 1); PG8_STAGE(PG8_SB(0, 0), b2, voffB);
            PG8_BAR; PG8_WAIT_L(0); PG8_MMA(0, 1, At, B1); PG8_BAR;
            PG8_LDA(At, 0, 1); PG8_STAGE(PG8_SA(0, 0), a2, voffA);
            PG8_BAR; PG8_WAIT_L(0); PG8_MMA(1, 0, At, B0); PG8_BAR; PG8_SCHED;
            PG8_STAGE(PG8_SB(0, 1), b2 + hstep, voffB);
            PG8_WAIT_V(6); PG8_BAR; PG8_MMA(1, 1, At, B1); PG8_BAR;
            PG8_LDB(B0, 1, 0); PG8_SCHED; PG8_LDA(At, 1, 0); PG8_STAGE(PG8_SA(0, 1), a2 + hstep, voffA);
            PG8_WAIT_L(8); PG8_BAR; PG8_WAIT_L(0); PG8_MMA(0, 0, At, B0); PG8_BAR; PG8_SCHED;
            PG8_LDB(B1, 1, 1); PG8_STAGE(PG8_SB(1, 0), b3, voffB);
            PG8_BAR; PG8_WAIT_L(0); PG8_MMA(0, 1, At, B1); PG8_BAR;
            PG8_LDA(At, 1, 1); PG8_STAGE(PG8_SA(1, 0), a3, voffA);
            PG8_BAR; PG8_WAIT_L(0); PG8_MMA(1, 0, At, B0); PG8_BAR; PG8_SCHED;
            PG8_STAGE(PG8_SB(1, 1), b3 + hstep, voffB);
            PG8_WAIT_V(6); PG8_BAR; PG8_MMA(1, 1, At, B1); PG8_BAR;
            }
        }
        if constexpr (ALIGN_EPI) { if (wr == 0) PG8_BAR; }
        if constexpr (!Epi::AFTER_DRAIN) { E(acc, cur, wr, wc, fr, fq); S.done(cur); }
        if (!has_next) break;
#pragma unroll
        for (int a = 0; a < 2; ++a)
#pragma unroll
            for (int b = 0; b < 2; ++b)
#pragma unroll
                for (int m = 0; m < 4; ++m)
#pragma unroll
                    for (int n = 0; n < 2; ++n) acc[a][b][m][n] = (f32x4){0.f, 0.f, 0.f, 0.f};
        cur = nxt; cA = nA; cB = nB; ++ui;
        if constexpr (ALIGN_EPI) { if (wr == 1) PG8_BAR; }
    }
    PG8_WAIT_V(0);
    if constexpr (!ALIGN_EPI) { if (wr == 0) PG8_BAR; }
    PG8_BAR;
    if constexpr (Epi::AFTER_DRAIN) { E.fused(acc, cur, wr, wc, fr, fq, lds, wid, lane); S.done(cur); }
#undef PG8_SA
#undef PG8_SB
#undef PG8_STAGE
#undef PG8_LDA
#undef PG8_LDB
#undef PG8_MMA
#undef PG8_WAIT_V
#undef PG8_WAIT_L
#undef PG8_BAR
#undef PG8_SCHED
}
}


#ifndef PG8_SP2
#define PG8_SP2 true
#endif
#ifndef PG8_ALIGN
#define PG8_ALIGN true
#endif
#ifndef MK_LAUNCHES
#define MK_LAUNCHES 1
#endif

#define GAS __attribute__((address_space(1)))
#define LAS __attribute__((address_space(3)))
typedef unsigned short bf16;
typedef float f32x4 __attribute__((ext_vector_type(4)));
typedef unsigned u32x4 __attribute__((ext_vector_type(4)));
typedef unsigned u32x2 __attribute__((ext_vector_type(2)));

constexpr int NB = 8, SEQ = 4096, DM = 1024, NMETA = 16;
constexpr int ROWS = 4160, PADR = 48, TOK0 = 64;
constexpr int MTOK = NB * SEQ;
constexpr int NIN = 3584;
constexpr int BROWS = NB * ROWS;
constexpr size_t ARR = (size_t)BROWS * 512;
constexpr int NCH = 64;
constexpr int NEXP = 16, DEXP = 512;
constexpr int XS_ROWS = 69632;
constexpr float ALPHA = 1.189207115002721f;
constexpr float LN_EPS = 1e-5f, RMS_EPS = 1e-6f;
constexpr float LOG2E = 1.4426950408889634f;
constexpr float C2Q = 0.125f * LOG2E;
constexpr float STICK_THR = 48.0f;

constexpr size_t MiB = 1u << 20;
constexpr size_t WS_CTL = 0, CTL_ZERO_BYTES = 1 * MiB;
constexpr size_t WS_WIN = 1 * MiB;
constexpr size_t WS_WOUT = 8 * MiB;
constexpr size_t WS_LB = 10 * MiB;
constexpr size_t WS_META = 11 * MiB;
constexpr size_t WS_DV = 12 * MiB;
constexpr size_t WS_XB = 16 * MiB;
constexpr size_t WS_S = 16 * MiB;
constexpr size_t WS_PROJ = 80 * MiB;
constexpr size_t WS_U = 308 * MiB;
constexpr size_t WS_MIX = 436 * MiB;
constexpr size_t WS_W13 = 80 * MiB;
constexpr size_t WS_W2 = 112 * MiB;
constexpr size_t WS_XS = 128 * MiB;
constexpr size_t WS_HID = 264 * MiB;
constexpr size_t WS_YS = 332 * MiB;
constexpr size_t WS_END = 500 * MiB;
static_assert(WS_PROJ + 7 * ARR * 2 <= WS_U && WS_U + (size_t)32 * 64 * 16384 * 4 <= WS_MIX && WS_MIX + (size_t)MTOK * DM * 2 <= WS_END, "ws map A");
static_assert(WS_W13 + (size_t)16 * 1024 * 1024 * 2 <= WS_W2 && WS_W2 + (size_t)16 * 1024 * 512 * 2 <= WS_XS && WS_XS + (size_t)XS_ROWS * 1024 * 2 <= WS_HID &&
              WS_HID + (size_t)XS_ROWS * 512 * 2 <= WS_YS && WS_YS + (size_t)XS_ROWS * 1024 * 2 <= WS_END, "ws map B");
constexpr int CW_CNT = 64;

constexpr int RING_BYTES = 131072;
constexpr int MISC_OFF = RING_BYTES;
constexpr int LDS_BYTES = 147456;
constexpr int NWAVES = 8, NTHREADS = 512;

__device__ __forceinline__ unsigned f2bf(float f) { unsigned u = __builtin_bit_cast(unsigned, f); return (u + 0x7fffu + ((u >> 16) & 1u)) >> 16; }
__device__ __forceinline__ unsigned pk2(float lo, float hi) { return f2bf(lo) | (f2bf(hi) << 16); }
__device__ __forceinline__ float bf2f(unsigned h) { return __builtin_bit_cast(float, h << 16); }
__device__ __forceinline__ float bflo(unsigned w) { return __builtin_bit_cast(float, w << 16); }
__device__ __forceinline__ float bfhi(unsigned w) { return __builtin_bit_cast(float, w & 0xffff0000u); }
__device__ __forceinline__ float ex2(float x) { return __builtin_amdgcn_exp2f(x); }
__device__ __forceinline__ float lg2(float x) { return __builtin_amdgcn_logf(x); }
__device__ __forceinline__ float rcpf_(float x) { return __builtin_amdgcn_rcpf(x); }
__device__ __forceinline__ float sigm(float v) { return rcpf_(1.f + ex2(-v * LOG2E)); }
__device__ __forceinline__ float wave_sum(float v) {
#pragma unroll
    for (int o = 1; o < 64; o <<= 1) v += __shfl_xor(v, o);
    return v;
}
template <int XF> __device__ __forceinline__ float xform(float v, float lb) {
    if (XF == 0) return v * sigm(v);
    if (XF == 1) return lg2(lb + (1.f - lb) * sigm(v));
    if (XF == 3) return sigm(v);
    if (XF == 4) return v * C2Q;
    return v;
}
__device__ __forceinline__ float xform_rt(int kind, float v, float lb) {
    switch (kind) { case 0: return xform<0>(v, lb); case 1: return xform<1>(v, lb); case 3: return xform<3>(v, lb); case 4: return xform<4>(v, lb); default: return v; }
}

using pg8::Unit;
struct EpiProj {
    static constexpr bool PERM = true, AFTER_DRAIN = false;
    bf16* proj; const float* lb;
    template <int XF> __device__ __forceinline__ void run(int kind, const f32x4 (&acc)[2][2][4][2], const Unit& u, int wr, int wc, int fr, int fq) const {
        const int b = u.pm >> 4;
        const int r0 = b * ROWS + TOK0 + (u.pm & 15) * 256 + wr * 64 + fr;
        const int c0 = (u.pn & 1) * 256 + wc * 32 + 8 * fq;
        bf16* base = proj + (size_t)kind * ARR;
        f32x4 l0[2], l1[2];
#pragma unroll
        for (int bj = 0; bj < 2; ++bj) {
            if (XF == 1) { l0[bj] = *(const f32x4*)(lb + c0 + bj * 128); l1[bj] = *(const f32x4*)(lb + c0 + bj * 128 + 4); }
            else { l0[bj] = (f32x4){0.f, 0.f, 0.f, 0.f}; l1[bj] = l0[bj]; }
        }
#pragma unroll
        for (int ai = 0; ai < 2; ++ai)
#pragma unroll
            for (int m = 0; m < 4; ++m) {
                bf16* rowp = base + (size_t)(r0 + ai * 128 + m * 16) * 512 + c0;
#pragma unroll
                for (int bj = 0; bj < 2; ++bj) {
                    const f32x4 v0 = acc[ai][bj][m][0], v1 = acc[ai][bj][m][1];
                    u32x4 w;
                    w.x = pk2(xform<XF>(v0[0], l0[bj][0]), xform<XF>(v0[1], l0[bj][1]));
                    w.y = pk2(xform<XF>(v0[2], l0[bj][2]), xform<XF>(v0[3], l0[bj][3]));
                    w.z = pk2(xform<XF>(v1[0], l1[bj][0]), xform<XF>(v1[1], l1[bj][1]));
                    w.w = pk2(xform<XF>(v1[2], l1[bj][2]), xform<XF>(v1[3], l1[bj][3]));
                    *(u32x4*)(rowp + bj * 128) = w;
                }
            }
    }
    __device__ __forceinline__ void operator()(const f32x4 (&acc)[2][2][4][2], const Unit& u, int wr, int wc, int fr, int fq) const {
        const int kind = u.pn >> 1;
        if (kind == 0) run<0>(kind, acc, u, wr, wc, fr, fq);
        else if (kind == 1) run<1>(kind, acc, u, wr, wc, fr, fq);
        else if (kind == 3) run<3>(kind, acc, u, wr, wc, fr, fq);
        else if (kind == 4) run<4>(kind, acc, u, wr, wc, fr, fq);
        else run<2>(kind, acc, u, wr, wc, fr, fq);
    }
};
struct EpiOut {
    static constexpr bool PERM = false, AFTER_DRAIN = false;
    const float* x; float* out;
    __device__ __forceinline__ void operator()(const f32x4 (&acc)[2][2][4][2], const Unit& u, int wr, int wc, int fr, int fq) const {
        const int row0 = u.pm * 256 + wr * 64 + fr, col0 = u.pn * 256 + wc * 32 + 4 * fq;
#pragma unroll
        for (int ai = 0; ai < 2; ++ai)
#pragma unroll
            for (int m = 0; m < 4; ++m) {
                const size_t ro = (size_t)(row0 + ai * 128 + m * 16) * DM + col0;
#pragma unroll
                for (int bj = 0; bj < 2; ++bj)
#pragma unroll
                    for (int n = 0; n < 2; ++n) {
                        const f32x4 xv = *(const f32x4*)(x + ro + bj * 128 + 16 * n);
                        *(f32x4*)(out + ro + bj * 128 + 16 * n) = acc[ai][bj][m][n] + xv * ALPHA;
                    }
            }
    }
};
struct EpiHid {
    static constexpr bool PERM = true, AFTER_DRAIN = false;
    bf16* hid;
    __device__ __forceinline__ void operator()(const f32x4 (&acc)[2][2][4][2], const Unit& u, int wr, int wc, int fr, int fq) const {
        const int row0 = u.pm * 256 + wr * 64 + fr, hc0 = (u.pn & 3) * 128 + wc * 16 + 4 * fq;
#pragma unroll
        for (int ai = 0; ai < 2; ++ai)
#pragma unroll
            for (int m = 0; m < 4; ++m) {
                bf16* rowp = hid + (size_t)(row0 + ai * 128 + m * 16) * DEXP + hc0;
#pragma unroll
                for (int bj = 0; bj < 2; ++bj) {
                    const f32x4 g = acc[ai][bj][m][0], up = acc[ai][bj][m][1];
                    u32x2 w;
                    w.x = pk2(g[0] * sigm(g[0]) * up[0], g[1] * sigm(g[1]) * up[1]);
                    w.y = pk2(g[2] * sigm(g[2]) * up[2], g[3] * sigm(g[3]) * up[3]);
                    *(u32x2*)(rowp + bj * 64) = w;
                }
            }
    }
};
struct EpiYs {
    static constexpr bool PERM = true, AFTER_DRAIN = false;
    bf16* ys;
    __device__ __forceinline__ void operator()(const f32x4 (&acc)[2][2][4][2], const Unit& u, int wr, int wc, int fr, int fq) const {
        const int row0 = u.pm * 256 + wr * 64 + fr, col0 = (u.pn & 3) * 256 + wc * 32 + 8 * fq;
#pragma unroll
        for (int ai = 0; ai < 2; ++ai)
#pragma unroll
            for (int m = 0; m < 4; ++m) {
                bf16* rowp = ys + (size_t)(row0 + ai * 128 + m * 16) * DM + col0;
#pragma unroll
                for (int bj = 0; bj < 2; ++bj) {
                    const f32x4 v0 = acc[ai][bj][m][0], v1 = acc[ai][bj][m][1];
                    u32x4 w; w.x = pk2(v0[0], v0[1]); w.y = pk2(v0[2], v0[3]); w.z = pk2(v1[0], v1[1]); w.w = pk2(v1[2], v1[3]);
                    *(u32x4*)(rowp + bj * 128) = w;
                }
            }
    }
};
struct MoeOrder {
    const LAS int* toff; int G, c, ntot;
    __device__ __forceinline__ bool next(int i, Unit& u) const {
        const long L = (long)i * G + c; if (L >= (long)ntot * 4) return false;
        const int mt = (int)(L >> 2), pl = (int)(L & 3); int e = 0;
#pragma unroll
        for (int j = 1; j < NEXP; ++j) e += (mt >= toff[j]) ? 1 : 0;
        u.pm = mt; u.pn = e * 4 + pl; return true;
    }
    __device__ __forceinline__ void a_ready(const Unit&) const {}
    __device__ __forceinline__ void done(const Unit&) const {}
};

struct Args { const float* in[18]; float* out; unsigned char* ws; int ph_lo, ph_hi; };
struct Frame {
    LAS unsigned char* lds; LAS int* misc;
    int tid, lane, wave, G, gw, ngw;
};

template <int MODE> __device__ __forceinline__ int rowmap(int n) { return MODE == 0 ? n : ((n >> 2) * 8 + (n & 3) + (MODE == 2 ? 4 : 0)); }
template <int MODE> __device__ __forceinline__ void transpose_item(const float* W, int K, int N, bf16* WT, LAS float* scr, int item, int lane) {
    const int nblk = N / 32, kb = item / nblk, nb = item % nblk, k0 = 64 * kb, n0 = 32 * nb;
#pragma unroll 8
    for (int i = 0; i < 32; ++i) { const int kk = 2 * i + (lane >> 5); scr[kk * 33 + (lane & 31)] = W[(size_t)(k0 + kk) * N + n0 + (lane & 31)]; }
    asm volatile("s_waitcnt lgkmcnt(0)" ::: "memory");
    const int c = lane & 7;
#pragma unroll
    for (int j = 0; j < 4; ++j) { const int n = (lane >> 3) + 8 * j; const LAS float* s = scr + (8 * c) * 33 + n;
        u32x4 o; o.x = pk2(s[0 * 33], s[1 * 33]); o.y = pk2(s[2 * 33], s[3 * 33]); o.z = pk2(s[4 * 33], s[5 * 33]); o.w = pk2(s[6 * 33], s[7 * 33]);
        *(u32x4*)(WT + (size_t)rowmap<MODE>(n0 + n) * K + k0 + 8 * c) = o; }
    asm volatile("s_waitcnt lgkmcnt(0)" ::: "memory");
}

__device__ __forceinline__ void p0_prep(Frame& F, const Args& A) {
    LAS float* scr = (LAS float*)(F.lds + F.wave * 16384);
    const int gtid = blockIdx.x * NTHREADS + F.tid, gthreads = F.G * NTHREADS;
    for (int i = gtid; i < 512; i += gthreads) ((float*)(A.ws + WS_LB))[i] = 1.f / (1.f + __expf(A.in[3][512 + i] - A.in[3][i]));
    for (int i = gtid; i < 7 * NB * 3072; i += gthreads) {
        const int a = i / (NB * 3072), r = i % (NB * 3072), b = r / 3072, o = r % 3072;
        *(u32x4*)(((bf16*)(A.ws + WS_PROJ)) + (size_t)a * ARR + (size_t)b * ROWS * 512 + (size_t)o * 8) = (u32x4){0u, 0u, 0u, 0u};
    }
    for (int job = F.gw; job < 56 * 4; job += F.ngw) {
        const int cgp = job >> 2, rq = job & 3, n = cgp * 64 + F.lane, kind = cgp >> 3;
        float acc0 = 0.f, acc1 = 0.f, acc2 = 0.f, acc3 = 0.f;
        const float* mt = A.in[1] + (size_t)(4 * rq) * DM;
#pragma unroll 8
        for (int k = 0; k < DM; ++k) {
            const float w = A.in[2][(size_t)k * NIN + n];
            acc0 += mt[k] * w; acc1 += mt[DM + k] * w; acc2 += mt[2 * DM + k] * w; acc3 += mt[3 * DM + k] * w;
        }
        const int col = n & 511;
        const float lbv = 1.f / (1.f + __expf(A.in[3][512 + col] - A.in[3][col]));
        const unsigned short o0 = (unsigned short)f2bf(xform_rt(kind, acc0, lbv)), o1 = (unsigned short)f2bf(xform_rt(kind, acc1, lbv)),
                             o2 = (unsigned short)f2bf(xform_rt(kind, acc2, lbv)), o3 = (unsigned short)f2bf(xform_rt(kind, acc3, lbv));
        bf16* base = ((bf16*)(A.ws + WS_PROJ)) + (size_t)kind * ARR + col;
        for (int b = 0; b < NB; ++b) {
            bf16* p = base + (size_t)(b * ROWS + PADR + 4 * rq) * 512;
            p[0] = o0; p[512] = o1; p[1024] = o2; p[1536] = o3;
        }
    }
    constexpr int I_IN = (DM / 64) * (NIN / 32), I_OUT = (DM / 64) * (DM / 32);
    for (int it = F.gw; it < I_IN + I_OUT; it += F.ngw) {
        if (it < I_IN) transpose_item<0>(A.in[2], DM, NIN, ((bf16*)(A.ws + WS_WIN)), scr, it, F.lane);
        else transpose_item<0>(A.in[6], DM, DM, ((bf16*)(A.ws + WS_WOUT)), scr, it - I_IN, F.lane);
    }
    for (int m = F.gw; m < MTOK; m += F.ngw) {
        const f32x4* xr = (const f32x4*)(A.in[0] + (size_t)m * DM) + F.lane;
        u32x2* o8 = (u32x2*)(((bf16*)(A.ws + WS_XB)) + (size_t)m * DM) + F.lane;
#pragma unroll
        for (int j = 0; j < 4; ++j) { const f32x4 v = xr[64 * j]; u32x2 w; w.x = pk2(v[0], v[1]); w.y = pk2(v[2], v[3]); o8[64 * j] = w; }
    }
}

__device__ __forceinline__ void ha_unit(Frame& F, const Args& A, int bh, int c) {
    const int b = bh >> 2, h = bh & 3, tid = F.tid;
    LAS float* VV = (LAS float*)F.lds;
    LAS float* KH = VV + 64 * 128;
    LAS float* TOT = KH + 64 * 128;
    const int d = tid & 127, sq = tid >> 7;
    const size_t rb = (size_t)(b * ROWS + 64 * c + 16 * sq) * 512 + 128 * h + d;
    const bf16* LF = ((bf16*)(A.ws + WS_PROJ)) + 1 * ARR; const bf16* HV = ((bf16*)(A.ws + WS_PROJ)) + 2 * ARR;
    float lf[16], pre[16]; float run = 0.f;
#pragma unroll
    for (int i = 0; i < 16; ++i) { lf[i] = bf2f(LF[rb + (size_t)i * 512]); VV[(16 * sq + i) * 128 + d] = bf2f(HV[rb + (size_t)i * 512]); }
#pragma unroll
    for (int i = 0; i < 16; ++i) { run += lf[i]; pre[i] = run; }
    TOT[sq * 128 + d] = run;
    __syncthreads();
    float off = 0.f, blast = 0.f;
#pragma unroll
    for (int q = 0; q < 4; ++q) { const float t = TOT[q * 128 + d]; off += (q < sq) ? t : 0.f; blast += t; }
#pragma unroll
    for (int i = 0; i < 16; ++i) { const float bc = off + pre[i]; KH[(16 * sq + i) * 128 + d] = (1.f - ex2(lf[i])) * ex2(blast - bc); }
    if (sq == 0) ((float*)(A.ws + WS_DV))[(size_t)(bh * 64 + c) * 128 + d] = ex2(blast);
    __syncthreads();
    const int vq = tid >> 4, dq = tid & 15;
    f32x4 a0[4], a1[4];
#pragma unroll
    for (int a = 0; a < 4; ++a) { a0[a] = (f32x4){0.f, 0.f, 0.f, 0.f}; a1[a] = a0[a]; }
#pragma unroll 4
    for (int s = 0; s < 64; ++s) {
        const f32x4 vv = *(const LAS f32x4*)(VV + s * 128 + 4 * vq);
        const f32x4 k0 = *(const LAS f32x4*)(KH + s * 128 + 8 * dq), k1 = *(const LAS f32x4*)(KH + s * 128 + 8 * dq + 4);
#pragma unroll
        for (int a = 0; a < 4; ++a) { a0[a] += k0 * vv[a]; a1[a] += k1 * vv[a]; }
    }
    float* up = ((float*)(A.ws + WS_U)) + (size_t)(bh * 64 + c) * 16384 + (size_t)(4 * vq) * 128 + 8 * dq;
#pragma unroll
    for (int a = 0; a < 4; ++a) { *(f32x4*)(up + a * 128) = a0[a]; *(f32x4*)(up + a * 128 + 4) = a1[a]; }
    __syncthreads();
}

__device__ __forceinline__ void attn_phase(Frame& F, const Args& A) {
    const bf16* SQ = ((bf16*)(A.ws + WS_PROJ)) + 4 * ARR; const bf16* SK = ((bf16*)(A.ws + WS_PROJ)) + 5 * ARR; const bf16* SV = ((bf16*)(A.ws + WS_PROJ)) + 6 * ARR;
    for (int u = blockIdx.x; u < 64 * 8; u += F.G) {
        const int bh = u >> 3, b = bh >> 3, h = bh & 7, t = (u & 7) * 512 + F.tid, r = TOK0 + t;
        float q[64], o[64];
        { const u32x4* qp = (const u32x4*)(SQ + (size_t)(b * ROWS + r) * 512 + 64 * h);
#pragma unroll
          for (int i = 0; i < 8; ++i) { const u32x4 w = qp[i]; q[8 * i] = bflo(w.x); q[8 * i + 1] = bfhi(w.x); q[8 * i + 2] = bflo(w.y); q[8 * i + 3] = bfhi(w.y);
              q[8 * i + 4] = bflo(w.z); q[8 * i + 5] = bfhi(w.z); q[8 * i + 6] = bflo(w.w); q[8 * i + 7] = bfhi(w.w); } }
#pragma unroll
        for (int i = 0; i < 64; ++i) o[i] = 0.f;
        float T = 0.f;
        for (int j = r - 1; j >= PADR; --j) {
            if (T > STICK_THR) break;
            const u32x4* kp = (const u32x4*)(SK + (size_t)(b * ROWS + j) * 512 + 64 * h);
            const u32x4* vp = (const u32x4*)(SV + (size_t)(b * ROWS + j) * 512 + 64 * h);
            float z0 = 0.f, z1 = 0.f;
#pragma unroll
            for (int i = 0; i < 8; ++i) { const u32x4 w = kp[i];
                z0 += q[8 * i] * bflo(w.x) + q[8 * i + 2] * bflo(w.y) + q[8 * i + 4] * bflo(w.z) + q[8 * i + 6] * bflo(w.w);
                z1 += q[8 * i + 1] * bfhi(w.x) + q[8 * i + 3] * bfhi(w.y) + q[8 * i + 5] * bfhi(w.z) + q[8 * i + 7] * bfhi(w.w); }
            const float z = fminf(z0 + z1, 100.f);
            const float sp = lg2(1.f + ex2(z));
            const float a = ex2(z - T - sp);
            T += sp;
#pragma unroll
            for (int i = 0; i < 8; ++i) { const u32x4 w = vp[i];
                o[8 * i] += a * bflo(w.x); o[8 * i + 1] += a * bfhi(w.x); o[8 * i + 2] += a * bflo(w.y); o[8 * i + 3] += a * bfhi(w.y);
                o[8 * i + 4] += a * bflo(w.z); o[8 * i + 5] += a * bfhi(w.z); o[8 * i + 6] += a * bflo(w.w); o[8 * i + 7] += a * bfhi(w.w); }
        }
        float ss = 0.f;
#pragma unroll
        for (int i = 0; i < 64; ++i) ss += o[i] * o[i];
        const float rs = 1.0f / sqrtf(ss * (1.f / 64.f) + RMS_EPS);
        const f32x4* gp = (const f32x4*)(A.in[5] + 64 * h);
        u32x4* op = (u32x4*)(((bf16*)(A.ws + WS_MIX)) + (size_t)(b * SEQ + t) * DM + 512 + 64 * h);
#pragma unroll
        for (int i = 0; i < 8; ++i) { const f32x4 g0 = gp[2 * i], g1 = gp[2 * i + 1]; u32x4 w;
            w.x = pk2(o[8 * i] * rs * g0[0], o[8 * i + 1] * rs * g0[1]); w.y = pk2(o[8 * i + 2] * rs * g0[2], o[8 * i + 3] * rs * g0[3]);
            w.z = pk2(o[8 * i + 4] * rs * g1[0], o[8 * i + 5] * rs * g1[1]); w.w = pk2(o[8 * i + 6] * rs * g1[2], o[8 * i + 7] * rs * g1[3]);
            op[i] = w; }
    }
}

__device__ __forceinline__ void hb_phase(Frame& F, const Args& A) {
    for (int g = blockIdx.x * NTHREADS + F.tid; g < 32 * 4096; g += F.G * NTHREADS) {
        const int bh = g >> 12, r = g & 4095, v = r >> 5, d4 = (r & 31) * 4;
        const float* up = ((float*)(A.ws + WS_U)) + (size_t)bh * 64 * 16384 + v * 128 + d4;
        const float* dp = ((float*)(A.ws + WS_DV)) + (size_t)bh * 64 * 128 + d4;
        bf16* sp = ((bf16*)(A.ws + WS_S)) + (size_t)bh * 64 * 16384 + v * 128 + d4;
        f32x4 s = (f32x4){0.f, 0.f, 0.f, 0.f};
#pragma unroll 8
        for (int c = 0; c < 64; ++c) {
            const f32x4 uu = *(const f32x4*)(up + (size_t)c * 16384), dd = *(const f32x4*)(dp + c * 128);
            s = dd * s + uu;
            u32x2 w; w.x = pk2(s[0], s[1]); w.y = pk2(s[2], s[3]);
            *(u32x2*)(sp + (size_t)c * 16384) = w;
        }
    }
}

constexpr int PQ = 132, PS = 68;
__device__ __forceinline__ void hc_unit(Frame& F, const Args& A, int bh, int cc) {
    const int b = bh >> 2, h = bh & 3, tid = F.tid;
    LAS float* QT = (LAS float*)F.lds;
    LAS float* KI = QT + 64 * PQ;
    LAS float* VV = KI + 64 * PQ;
    LAS float* SC = VV + 64 * 128;
    LAS float* TOT = SC + 64 * PS;
    LAS float* SSQ = TOT + 4 * 128;
    const bf16* HQ = ((bf16*)(A.ws + WS_PROJ)); const bf16* LF = ((bf16*)(A.ws + WS_PROJ)) + 1 * ARR; const bf16* HV = ((bf16*)(A.ws + WS_PROJ)) + 2 * ARR; const bf16* HG = ((bf16*)(A.ws + WS_PROJ)) + 3 * ARR;
    {
        const int d = tid & 127, sq = tid >> 7;
        const size_t rb = (size_t)(b * ROWS + 64 * cc + 16 * sq) * 512 + 128 * h + d;
        float lf[16], pre[16], qv[16]; float run = 0.f;
#pragma unroll
        for (int i = 0; i < 16; ++i) { lf[i] = bf2f(LF[rb + (size_t)i * 512]); qv[i] = bf2f(HQ[rb + (size_t)i * 512]); VV[(16 * sq + i) * 128 + d] = bf2f(HV[rb + (size_t)i * 512]); }
#pragma unroll
        for (int i = 0; i < 16; ++i) { run += lf[i]; pre[i] = run; }
        TOT[sq * 128 + d] = run;
        __syncthreads();
        float off = 0.f;
#pragma unroll
        for (int q = 0; q < 4; ++q) { const float t = TOT[q * 128 + d]; off += (q < sq) ? t : 0.f; }
#pragma unroll
        for (int i = 0; i < 16; ++i) { const float bc = off + pre[i];
            QT[(16 * sq + i) * PQ + d] = qv[i] * ex2(bc);
            KI[(16 * sq + i) * PQ + d] = (1.f - ex2(lf[i])) * ex2(-bc); }
    }
    __syncthreads();
    {
        const int t = tid >> 3, sg = tid & 7;
        float a[8];
#pragma unroll
        for (int i = 0; i < 8; ++i) a[i] = 0.f;
#pragma unroll 2
        for (int d = 0; d < 128; d += 4) {
            const f32x4 qq = *(const LAS f32x4*)(QT + t * PQ + d);
#pragma unroll
            for (int i = 0; i < 8; ++i) { const f32x4 kk = *(const LAS f32x4*)(KI + (sg + 8 * i) * PQ + d); a[i] += qq[0] * kk[0] + qq[1] * kk[1] + qq[2] * kk[2] + qq[3] * kk[3]; }
        }
#pragma unroll
        for (int i = 0; i < 8; ++i) { const int s = sg + 8 * i; SC[t * PS + s] = (s <= t) ? a[i] : 0.f; }
    }
    __syncthreads();
    {
        const int v = tid & 127, tq = tid >> 7;
        float acc[16];
#pragma unroll
        for (int i = 0; i < 16; ++i) acc[i] = 0.f;
        for (int s = 0; s < 64; s += 4) {
            const float v0 = VV[s * 128 + v], v1 = VV[(s + 1) * 128 + v], v2 = VV[(s + 2) * 128 + v], v3 = VV[(s + 3) * 128 + v];
#pragma unroll
            for (int i = 0; i < 16; ++i) { const f32x4 sc = *(const LAS f32x4*)(SC + (tq + 4 * i) * PS + s); acc[i] += sc[0] * v0 + sc[1] * v1 + sc[2] * v2 + sc[3] * v3; }
        }
        const bf16* sp = ((bf16*)(A.ws + WS_S)) + (size_t)(bh * 64 + cc - 1) * 16384 + (size_t)v * 128;
        for (int d = 0; d < 128; d += 8) {
            const u32x4 w = *(const u32x4*)(sp + d);
            const float s0 = bflo(w.x), s1 = bfhi(w.x), s2 = bflo(w.y), s3 = bfhi(w.y), s4 = bflo(w.z), s5 = bfhi(w.z), s6 = bflo(w.w), s7 = bfhi(w.w);
#pragma unroll
            for (int i = 0; i < 16; ++i) {
                const f32x4 q0 = *(const LAS f32x4*)(QT + (tq + 4 * i) * PQ + d), q1 = *(const LAS f32x4*)(QT + (tq + 4 * i) * PQ + d + 4);
                acc[i] += q0[0] * s0 + q0[1] * s1 + q0[2] * s2 + q0[3] * s3 + q1[0] * s4 + q1[1] * s5 + q1[2] * s6 + q1[3] * s7;
            }
        }
        const int wv = tid >> 6;
#pragma unroll
        for (int i = 0; i < 16; ++i) { const float ss = wave_sum(acc[i] * acc[i]); if (F.lane == 0) SSQ[wv * 16 + i] = ss; }
        __syncthreads();
        const float ng = A.in[4][128 * h + v];
#pragma unroll
        for (int i = 0; i < 16; ++i) {
            const int t = tq + 4 * i;
            const float tot = SSQ[(2 * tq) * 16 + i] + SSQ[(2 * tq + 1) * 16 + i];
            const float rs = 1.0f / sqrtf(tot * (1.f / 128.f) + RMS_EPS);
            const float gate = bf2f(HG[(size_t)(b * ROWS + 64 * cc + t) * 512 + 128 * h + v]);
            ((bf16*)(A.ws + WS_MIX))[(size_t)(b * SEQ + 64 * (cc - 1) + t) * DM + 128 * h + v] = (bf16)f2bf(acc[i] * rs * ng * gate);
        }
    }
    __syncthreads();
}

__device__ __forceinline__ void ln_stats(const f32x4 (&v)[4], float& mean, float& rstd) {
    float s = 0.f;
#pragma unroll
    for (int j = 0; j < 4; ++j) s += (v[j][0] + v[j][1]) + (v[j][2] + v[j][3]);
    mean = wave_sum(s) * (1.f / DM);
    float s2 = 0.f;
#pragma unroll
    for (int j = 0; j < 4; ++j) { const f32x4 d = v[j] - mean; s2 += (d[0] * d[0] + d[1] * d[1]) + (d[2] * d[2] + d[3] * d[3]); }
    rstd = 1.0f / sqrtf(wave_sum(s2) * (1.f / DM) + LN_EPS);
}

__device__ __forceinline__ void route_row(Frame& F, const Args& A, const float (&lg)[20], int rl, LAS int* lcnt, LAS int* rec) {
    const float* brg = A.in[10];
    float g0 = lg[0] + brg[0], g1 = lg[1] + brg[1], g2 = lg[2] + brg[2], g3 = lg[3] + brg[3];
    int grp = 0; float gm = g0;
    if (g1 > gm) { gm = g1; grp = 1; } if (g2 > gm) { gm = g2; grp = 2; } if (g3 > gm) { gm = g3; grp = 3; }
    const float pg = 1.f / (__expf(g0 - gm) + __expf(g1 - gm) + __expf(g2 - gm) + __expf(g3 - gm));
    float in0, in1, in2, in3;
    if (grp == 0) { in0 = lg[4]; in1 = lg[5]; in2 = lg[6]; in3 = lg[7]; }
    else if (grp == 1) { in0 = lg[8]; in1 = lg[9]; in2 = lg[10]; in3 = lg[11]; }
    else if (grp == 2) { in0 = lg[12]; in1 = lg[13]; in2 = lg[14]; in3 = lg[15]; }
    else { in0 = lg[16]; in1 = lg[17]; in2 = lg[18]; in3 = lg[19]; }
    const float* be = A.in[12] + grp * 4;
    in0 += be[0]; in1 += be[1]; in2 += be[2]; in3 += be[3];
    int i0 = 0; float m0 = in0;
    if (in1 > m0) { m0 = in1; i0 = 1; } if (in2 > m0) { m0 = in2; i0 = 2; } if (in3 > m0) { m0 = in3; i0 = 3; }
    int i1 = -1; float m1 = 0.f;
    if (i0 != 0) { m1 = in0; i1 = 0; }
    if (i0 != 1 && (i1 < 0 || in1 > m1)) { m1 = in1; i1 = 1; }
    if (i0 != 2 && (i1 < 0 || in2 > m1)) { m1 = in2; i1 = 2; }
    if (i0 != 3 && (i1 < 0 || in3 > m1)) { m1 = in3; i1 = 3; }
    const float w0 = 1.f / (1.f + __expf(m1 - m0)), w1 = 1.f - w0;
    const int e0 = grp * 4 + i0, e1 = grp * 4 + i1;
    const int p0 = atomicAdd((int*)&lcnt[e0], 1), p1 = atomicAdd((int*)&lcnt[e1], 1);
    rec[rl * 6 + 0] = e0; rec[rl * 6 + 1] = p0; rec[rl * 6 + 2] = __float_as_int(pg * w0);
    rec[rl * 6 + 3] = e1; rec[rl * 6 + 4] = p1; rec[rl * 6 + 5] = __float_as_int(pg * w1);
}
__device__ __forceinline__ void p6_ln_router(Frame& F, const Args& A) {
    LAS int* lcnt = F.misc + 32; LAS int* lbase = F.misc + 48;
    LAS f32x4* WL = (LAS f32x4*)F.lds;
    LAS int* rec = (LAS int*)(F.lds + 81920);
    for (int it = F.tid; it < 1024 * 5; it += NTHREADS) {
        const int k = it / 5, c = it % 5, j = k >> 8, ln = (k >> 2) & 63, e = k & 3;
        const f32x4 w = (c == 0) ? *(const f32x4*)(A.in[9] + (size_t)k * 4) : *(const f32x4*)(A.in[11] + (size_t)k * 16 + 4 * (c - 1));
        WL[((j * 4 + e) * 5 + c) * 64 + ln] = w;
    }
    __syncthreads();
    const LAS f32x4* wl = WL + F.lane;
    for (int slab = blockIdx.x; slab < MTOK / 128; slab += F.G) {
        if (F.tid < 16) lcnt[F.tid] = 0;
        __syncthreads();
#pragma unroll 1
        for (int i = 0; i < 16; i += 2) {
            const int rl = F.wave * 16 + i, row = slab * 128 + rl;
            f32x4* xr0 = (f32x4*)(A.out + (size_t)row * DM) + F.lane; f32x4* xr1 = xr0 + DM / 4;
            f32x4 v0[4], v1[4];
#pragma unroll
            for (int j = 0; j < 4; ++j) { v0[j] = xr0[64 * j]; v1[j] = xr1[64 * j]; }
            float mean0, rstd0, mean1, rstd1; ln_stats(v0, mean0, rstd0); ln_stats(v1, mean1, rstd1);
#pragma unroll
            for (int j = 0; j < 4; ++j) {
                const f32x4 g = ((const f32x4*)A.in[7])[64 * j + F.lane], bb = ((const f32x4*)A.in[8])[64 * j + F.lane];
                v0[j] = (v0[j] - mean0) * rstd0 * g + bb; v1[j] = (v1[j] - mean1) * rstd1 * g + bb;
                xr0[64 * j] = v0[j]; xr1[64 * j] = v1[j];
            }
            float la[20], lb2[20];
#pragma unroll
            for (int e = 0; e < 20; ++e) { la[e] = 0.f; lb2[e] = 0.f; }
#pragma unroll 1
            for (int j = 0; j < 4; ++j) {
                const f32x4 s0 = (j == 0) ? v0[0] : (j == 1) ? v0[1] : (j == 2) ? v0[2] : v0[3];
                const f32x4 s1 = (j == 0) ? v1[0] : (j == 1) ? v1[1] : (j == 2) ? v1[2] : v1[3];
                const LAS f32x4* wj = wl + j * (20 * 64);
#pragma unroll
                for (int e = 0; e < 4; ++e) {
                    const float h0 = s0[e], h1 = s1[e];
#pragma unroll
                    for (int c = 0; c < 5; ++c) { const f32x4 w = wj[(e * 5 + c) * 64];
                        la[4 * c] += h0 * w[0]; la[4 * c + 1] += h0 * w[1]; la[4 * c + 2] += h0 * w[2]; la[4 * c + 3] += h0 * w[3];
                        lb2[4 * c] += h1 * w[0]; lb2[4 * c + 1] += h1 * w[1]; lb2[4 * c + 2] += h1 * w[2]; lb2[4 * c + 3] += h1 * w[3]; }
                }
            }
#pragma unroll
            for (int e = 0; e < 20; ++e) { la[e] = wave_sum(la[e]); lb2[e] = wave_sum(lb2[e]); }
            if (F.lane == 0) { route_row(F, A, la, rl, lcnt, rec); route_row(F, A, lb2, rl + 1, lcnt, rec); }
        }
        __syncthreads();
        if (F.tid < 16) lbase[F.tid] = (int)atomicAdd(((unsigned*)(A.ws + WS_CTL)) + CW_CNT + F.tid, (unsigned)lcnt[F.tid]);
        __syncthreads();
        if (F.tid < 128) {
            unsigned* mp = ((unsigned*)(A.ws + WS_META)) + (size_t)(slab * 128 + F.tid) * 8;
            const int e0 = rec[F.tid * 6 + 0], e1 = rec[F.tid * 6 + 3];
            u32x4 a, c;
            a.x = (unsigned)e0; a.y = (unsigned)(lbase[e0] + rec[F.tid * 6 + 1]); a.z = (unsigned)rec[F.tid * 6 + 2]; a.w = (unsigned)e1;
            c.x = (unsigned)(lbase[e1] + rec[F.tid * 6 + 4]); c.y = (unsigned)rec[F.tid * 6 + 5]; c.z = 0u; c.w = 0u;
            *(u32x4*)mp = a; *(u32x4*)(mp + 4) = c;
        }
        __syncthreads();
    }
}

__device__ __forceinline__ void build_toff(Frame& F, const Args& A) {
    __syncthreads();
    if (F.tid == 0) { int acc = 0;
        for (int e = 0; e < NEXP; ++e) { F.misc[e] = acc; const unsigned c = __hip_atomic_load(((unsigned*)(A.ws + WS_CTL)) + CW_CNT + e, __ATOMIC_RELAXED, __HIP_MEMORY_SCOPE_AGENT); acc += (int)((c + 255u) >> 8); }
        F.misc[NEXP] = acc; }
    __syncthreads();
}

__device__ __forceinline__ void p7_scatter(Frame& F, const Args& A) {
    build_toff(F, A);
    for (int row = F.gw; row < MTOK; row += F.ngw) {
        const unsigned* mp = ((unsigned*)(A.ws + WS_META)) + (size_t)row * 8;
        const int e0 = (int)mp[0], p0 = (int)mp[1], e1 = (int)mp[3], p1 = (int)mp[4];
        const size_t s0 = (size_t)F.misc[e0] * 256 + p0, s1 = (size_t)F.misc[e1] * 256 + p1;
        const f32x4* xr = (const f32x4*)(A.out + (size_t)row * DM) + F.lane;
        u32x2* o0 = (u32x2*)(((bf16*)(A.ws + WS_XS)) + s0 * DM) + F.lane; u32x2* o1 = (u32x2*)(((bf16*)(A.ws + WS_XS)) + s1 * DM) + F.lane;
#pragma unroll
        for (int j = 0; j < 4; ++j) { const f32x4 v = xr[64 * j]; u32x2 w; w.x = pk2(v[0], v[1]); w.y = pk2(v[2], v[3]); o0[64 * j] = w; o1[64 * j] = w; }
    }
    LAS float* scr = (LAS float*)(F.lds + F.wave * 16384);
    constexpr int I13 = (DM / 64) * (DEXP / 32), I2 = (DEXP / 64) * (DM / 32);
    for (int it = F.gw; it < NEXP * (2 * I13 + I2); it += F.ngw) {
        const int e = it / (2 * I13 + I2), r = it % (2 * I13 + I2);
        if (r < I13) transpose_item<1>(A.in[13] + (size_t)e * DM * DEXP, DM, DEXP, ((bf16*)(A.ws + WS_W13)) + (size_t)e * 1024 * DM, scr, r, F.lane);
        else if (r < 2 * I13) transpose_item<2>(A.in[14] + (size_t)e * DM * DEXP, DM, DEXP, ((bf16*)(A.ws + WS_W13)) + (size_t)e * 1024 * DM, scr, r - I13, F.lane);
        else transpose_item<0>(A.in[15] + (size_t)e * DEXP * DM, DEXP, DM, ((bf16*)(A.ws + WS_W2)) + (size_t)e * DM * DEXP, scr, r - 2 * I13, F.lane);
    }
}

__device__ __forceinline__ void p10_final(Frame& F, const Args& A) {
    build_toff(F, A);
    for (int row = F.gw; row < MTOK; row += F.ngw) {
        const unsigned* mp = ((unsigned*)(A.ws + WS_META)) + (size_t)row * 8;
        const int e0 = (int)mp[0], p0 = (int)mp[1], e1 = (int)mp[3], p1 = (int)mp[4];
        const float g0 = __uint_as_float(mp[2]), g1 = __uint_as_float(mp[5]);
        const size_t s0 = (size_t)F.misc[e0] * 256 + p0, s1 = (size_t)F.misc[e1] * 256 + p1;
        f32x4* xr = (f32x4*)(A.out + (size_t)row * DM) + F.lane;
        const u32x2* y0 = (const u32x2*)(((bf16*)(A.ws + WS_YS)) + s0 * DM) + F.lane; const u32x2* y1 = (const u32x2*)(((bf16*)(A.ws + WS_YS)) + s1 * DM) + F.lane;
        f32x4 v[4];
#pragma unroll
        for (int j = 0; j < 4; ++j) { const f32x4 hv = xr[64 * j]; const u32x2 a = y0[64 * j], c = y1[64 * j];
            v[j][0] = ALPHA * hv[0] + g0 * bflo(a.x) + g1 * bflo(c.x); v[j][1] = ALPHA * hv[1] + g0 * bfhi(a.x) + g1 * bfhi(c.x);
            v[j][2] = ALPHA * hv[2] + g0 * bflo(a.y) + g1 * bflo(c.y); v[j][3] = ALPHA * hv[3] + g0 * bfhi(a.y) + g1 * bfhi(c.y); }
        float mean, rstd; ln_stats(v, mean, rstd);
#pragma unroll
        for (int j = 0; j < 4; ++j) { const f32x4 g = ((const f32x4*)A.in[16])[64 * j + F.lane], bb = ((const f32x4*)A.in[17])[64 * j + F.lane]; xr[64 * j] = (v[j] - mean) * rstd * g + bb; }
    }
}

constexpr int NPHASE = 11;
__global__ void __launch_bounds__(NTHREADS, 2) mega_fwd(Args args) {
    extern __shared__ __attribute__((aligned(16))) unsigned char lds[];
    cg::grid_group grid = cg::this_grid();
    Frame F;
    F.lds = (LAS unsigned char*)lds; F.misc = (LAS int*)(F.lds + MISC_OFF);
    F.tid = threadIdx.x; F.lane = F.tid & 63; F.wave = __builtin_amdgcn_readfirstlane(F.tid >> 6); F.G = gridDim.x;
    F.gw = blockIdx.x * NWAVES + F.wave; F.ngw = F.G * NWAVES;
    const Args& A = args;
    const int lo = args.ph_lo, hi = args.ph_hi;
#define IN(k) (lo <= (k) && (k) < hi)
#define SEAM(k) do { if (IN((k) + 1)) grid.sync(); } while (0)

    if (IN(0)) { p0_prep(F, A); SEAM(0); }
    if (IN(1)) {
        pg8::Gemm g{((bf16*)(A.ws + WS_XB)), ((bf16*)(A.ws + WS_WIN)), MTOK, NIN, DM}; pg8::StaticOrder S; S.init(MTOK, NIN, F.G, (int)blockIdx.x);
        EpiProj E{((bf16*)(A.ws + WS_PROJ)), ((float*)(A.ws + WS_LB))};
        pg8::gemm_phase<EpiProj, pg8::StaticOrder, PG8_ALIGN, PG8_SP2>(F.lds, g, S, E);
        SEAM(1);
    }
    if (IN(2)) {
        for (int u = blockIdx.x; u < 32 * 64; u += F.G) ha_unit(F, A, u >> 6, u & 63);
        attn_phase(F, A);
        SEAM(2);
    }
    if (IN(3)) { hb_phase(F, A); SEAM(3); }
    if (IN(4)) {
        for (int u = blockIdx.x; u < 32 * 64; u += F.G) hc_unit(F, A, u >> 6, (u & 63) + 1);
        SEAM(4);
    }
    if (IN(5)) {
        pg8::Gemm g{((bf16*)(A.ws + WS_MIX)), ((bf16*)(A.ws + WS_WOUT)), MTOK, DM, DM}; pg8::StaticOrder S; S.init(MTOK, DM, F.G, (int)blockIdx.x);
        EpiOut E{A.in[0], A.out};
        pg8::gemm_phase<EpiOut, pg8::StaticOrder, PG8_ALIGN, PG8_SP2>(F.lds, g, S, E);
        SEAM(5);
    }
    if (IN(6)) { p6_ln_router(F, A); SEAM(6); }
    if (IN(7)) { p7_scatter(F, A); SEAM(7); }
    if (IN(8)) {
        build_toff(F, A);
        pg8::Gemm g{((bf16*)(A.ws + WS_XS)), ((bf16*)(A.ws + WS_W13)), XS_ROWS, 1024, DM}; MoeOrder S{(const LAS int*)F.misc, F.G, (int)blockIdx.x, F.misc[NEXP]};
        EpiHid E{((bf16*)(A.ws + WS_HID))};
        pg8::gemm_phase<EpiHid, MoeOrder, PG8_ALIGN, PG8_SP2>(F.lds, g, S, E);
        SEAM(8);
    }
    if (IN(9)) {
        build_toff(F, A);
        pg8::Gemm g{((bf16*)(A.ws + WS_HID)), ((bf16*)(A.ws + WS_W2)), XS_ROWS, 1024, DEXP}; MoeOrder S{(const LAS int*)F.misc, F.G, (int)blockIdx.x, F.misc[NEXP]};
        EpiYs E{((bf16*)(A.ws + WS_YS))};
        pg8::gemm_phase<EpiYs, MoeOrder, PG8_ALIGN, PG8_SP2>(F.lds, g, S, E);
        SEAM(9);
    }
    if (IN(10)) { p10_final(F, A); }
#undef IN
#undef SEAM
}

extern "C" void kernel_launch(void* const* d_in, const int* in_sizes, int n_in, void* d_out, int out_size, void* d_ws, size_t ws_size, hipStream_t stream) {
    static int grid = 0;
    if (grid == 0) {
        if (n_in != 18 || in_sizes[0] != MTOK * DM || out_size != MTOK * DM || ws_size < WS_END) {
            fprintf(stderr, "kernel_launch: unexpected shapes (n_in %d, in0 %d, out %d, ws %zu); nothing launched\n", n_in, n_in > 0 ? in_sizes[0] : -1, out_size, ws_size); grid = -1; return; }
        int dev = 0, cus = 0, per_cu = 0;
        if (hipGetDevice(&dev) != hipSuccess || hipDeviceGetAttribute(&cus, hipDeviceAttributeMultiprocessorCount, dev) != hipSuccess) { grid = -1; return; }
        if (hipFuncSetAttribute((const void*)mega_fwd, hipFuncAttributeMaxDynamicSharedMemorySize, LDS_BYTES) != hipSuccess) { fprintf(stderr, "kernel_launch: hipFuncSetAttribute failed\n"); grid = -1; return; }
        if (hipOccupancyMaxActiveBlocksPerMultiprocessor(&per_cu, (const void*)mega_fwd, NTHREADS, LDS_BYTES) != hipSuccess || per_cu < 1) { fprintf(stderr, "kernel_launch: occupancy query says %d\n", per_cu); per_cu = 1; }
        (void)hipGetLastError();
        grid = cus;
    }
    if (grid < 0) return;
    (void)hipMemsetAsync((char*)d_ws + WS_CTL, 0, CTL_ZERO_BYTES, stream);
    Args a{};
    for (int i = 0; i < 18; ++i) a.in[i] = (const float*)d_in[i];
    a.out = (float*)d_out; a.ws = (unsigned char*)d_ws;
#if MK_LAUNCHES == 1
    a.ph_lo = 0; a.ph_hi = NPHASE;
    void* kargs[] = {&a};
    hipError_t e = hipLaunchCooperativeKernel((const void*)mega_fwd, dim3(grid), dim3(NTHREADS), kargs, LDS_BYTES, stream);
    if (e != hipSuccess) fprintf(stderr, "kernel_launch: cooperative launch failed: %s (grid %d)\n", hipGetErrorString(e), grid);
#else
    for (int p = 0; p < NPHASE; ++p) { a.ph_lo = p; a.ph_hi = p + 1; hipLaunchKernelGGL(mega_fwd, dim3(grid), dim3(NTHREADS), LDS_BYTES, stream, a); }
#endif
}
```

```cpp
#include <hip/hip_runtime.h>
#include <hip/hip_cooperative_groups.h>
#include <cstdio>
#include <cstdint>
namespace cg = cooperative_groups;
namespace pg8 {
#define PG8_LAS __attribute__((address_space(3)))
typedef unsigned short bf16_t;
typedef short bf16x8 __attribute__((ext_vector_type(8)));
typedef float f32x4 __attribute__((ext_vector_type(4)));
typedef unsigned u32x4 __attribute__((ext_vector_type(4)));
constexpr int BM = 256, BK = 64, HALF = 128, HTB = HALF * BK * 2  , STAGE_BYTES = 8 * HTB, NXCD = 8, WGM = 8;

__host__ __device__ __forceinline__ int lds_byte(int r, int c) { const int st = (r >> 4) * 2 + (c >> 5), rr = r & 15, cc = c & 31, ob = rr * 64 + cc * 2; return st * 1024 + (ob ^ (((ob >> 9) & 1) << 5)); }
__host__ __device__ __forceinline__ void stage_rc(int b, int& R, int& C) { const int st = b / 1024, sb = b % 1024, swz = sb ^ (((sb >> 9) & 1) << 5); R = (st >> 1) * 16 + swz / 64; C = (st & 1) * 32 + (swz % 64) / 2; }
__host__ __device__ __forceinline__ int perm32(int rho) { const int n = rho >> 4, i = rho & 15; return 8 * (i >> 2) + 4 * n + (i & 3); }

struct Unit { int pm, pn; };
struct Gemm { const bf16_t* A; const bf16_t* Bt; int M, N, K; };

struct StaticOrder {
    int nM, nN, nwg, G, c;
    __host__ __device__ void init(int M, int N, int G_, int c_) { nM = M / BM; nN = N / BM; nwg = nM * nN; G = G_; c = c_; }
    __host__ __device__ bool next(int i, Unit& u) const {
        const long L = (long)i * G + c; if (L >= nwg) return false;
        int wgid = (int)L; { const int q = nwg / NXCD, r = nwg % NXCD, xcd = wgid % NXCD, off = wgid / NXCD; wgid = (xcd < r ? xcd * (q + 1) : r * (q + 1) + (xcd - r) * q) + off; }
        const int nig = WGM * nN, gid = wgid / nig, fm = gid * WGM, gsz = (nM - fm) < WGM ? (nM - fm) : WGM;
        u.pm = fm + ((wgid % nig) % gsz); u.pn = (wgid % nig) / gsz; return true;
    }
    __device__ __forceinline__ void a_ready(const Unit&) const {}
    __device__ __forceinline__ void done(const Unit&) const {}
};

__device__ __forceinline__ unsigned cvt_pk_bf16(float lo, float hi) { unsigned r; asm volatile("v_cvt_pk_bf16_f32 %0, %1, %2" : "=v"(r) : "v"(lo), "v"(hi)); return r; }
template <class Epi, class Sched, bool ALIGN_EPI = false, bool SP2 = false>
__device__ __forceinline__ void gemm_phase(PG8_LAS unsigned char* lds, const Gemm g, const Sched& S, const Epi& E) {
    int tid_ = threadIdx.x; asm volatile("" : "+v"(tid_));
    const int tid = tid_, wid = __builtin_amdgcn_readfirstlane(tid >> 6), lane = tid & 63, wr = wid >> 2, wc = wid & 3, fr = lane & 15, fq = lane >> 4;
    const int K = g.K, nt = K / BK;
    unsigned voffA[2], voffB[2];
#pragma unroll
    for (int i = 0; i < 2; ++i) { int R, C; stage_rc(tid * 16 + i * 8192, R, C); const int Rb = Epi::PERM ? ((R & ~31) + perm32(R & 31)) : R;
        voffA[i] = (unsigned)(R * K + C) * 2u; voffB[i] = (unsigned)(Rb * K + C) * 2u; }
    const size_t kstep = (size_t)(BK * 2);
    const size_t hstep = (size_t)HALF * K * 2;
    const size_t tstep = 2 * hstep;
    const unsigned ldsw = (unsigned)wid * 1024u;
    const int aoff = lds_byte(wr * 64 + fr, fq * 8), boff = lds_byte(wc * 32 + fr, fq * 8);
#define PG8_SA(b, h) (((b) * 2 + (h)) * HTB)
#define PG8_SB(b, h) ((4 + (b) * 2 + (h)) * HTB)
#define PG8_STAGE(bufoff, gbase, voff) do { _Pragma("unroll") for (int _i = 0; _i < 2; ++_i) \
        __builtin_amdgcn_global_load_lds((const unsigned*)((const char*)(gbase) + (voff)[_i]), (PG8_LAS unsigned*)(lds + (bufoff) + ldsw + _i * 8192), 16, 0, 0); } while (0)
#define PG8_LDA(dst, b, h) do { _Pragma("unroll") for (int m = 0; m < 4; ++m) _Pragma("unroll") for (int k = 0; k < 2; ++k) dst[m][k] = *(const PG8_LAS bf16x8*)(lds + PG8_SA(b, h) + aoff + m * 2048 + k * 1024); } while (0)
#define PG8_LDB(dst, b, h) do { _Pragma("unroll") for (int n = 0; n < 2; ++n) _Pragma("unroll") for (int k = 0; k < 2; ++k) dst[n][k] = *(const PG8_LAS bf16x8*)(lds + PG8_SB(b, h) + boff + n * 2048 + k * 1024); } while (0)
#define PG8_MMA(ai, bj, At, Bt) do { __builtin_amdgcn_s_setprio(1); _Pragma("unroll") for (int m = 0; m < 4; ++m) _Pragma("unroll") for (int n = 0; n < 2; ++n) _Pragma("unroll") for (int k = 0; k < 2; ++k) \
        acc[ai][bj][m][n] = __builtin_amdgcn_mfma_f32_16x16x32_bf16(Bt[n][k], At[m][k], acc[ai][bj][m][n], 0, 0, 0); __builtin_amdgcn_s_setprio(0); } while (0)
#define PG8_WAIT_V(n) asm volatile("s_waitcnt vmcnt(" #n ")" ::: "memory")
#define PG8_WAIT_L(n) asm volatile("s_waitcnt lgkmcnt(" #n ")" ::: "memory")
#define PG8_BAR __builtin_amdgcn_s_barrier()
#define PG8_SCHED __builtin_amdgcn_sched_barrier(0)
    Unit cur, nxt; int ui = 0;
    if (!S.next(0, cur)) return;
    f32x4 acc[2][2][4][2];
#pragma unroll
    for (int a = 0; a < 2; ++a)
#pragma unroll
        for (int b = 0; b < 2; ++b)
#pragma unroll
            for (int m = 0; m < 4; ++m)
#pragma unroll
                for (int n = 0; n < 2; ++n) acc[a][b][m][n] = (f32x4){0.f, 0.f, 0.f, 0.f};
    bf16x8 At[4][2], B0[2][2], B1[2][2];
    const char* cA = (const char*)g.A + (size_t)cur.pm * tstep; const char* cB = (const char*)g.Bt + (size_t)cur.pn * tstep;
    S.a_ready(cur);
    if constexpr (SP2) {
        PG8_STAGE(PG8_SB(0, 0), cB, voffB); PG8_STAGE(PG8_SB(0, 1), cB + hstep, voffB); PG8_STAGE(PG8_SA(0, 0), cA, voffA); PG8_STAGE(PG8_SA(0, 1), cA + hstep, voffA);
        if (wr == 1) PG8_BAR;
        PG8_WAIT_V(2); PG8_BAR;
        PG8_STAGE(PG8_SB(1, 0), cB + kstep, voffB); PG8_STAGE(PG8_SA(1, 0), cA + kstep, voffA); PG8_STAGE(PG8_SB(1, 1), cB + hstep + kstep, voffB);
        PG8_WAIT_V(6); PG8_BAR;
    } else {
        PG8_STAGE(PG8_SB(0, 0), cB, voffB); PG8_STAGE(PG8_SA(0, 0), cA, voffA); PG8_STAGE(PG8_SB(0, 1), cB + hstep, voffB); PG8_STAGE(PG8_SA(0, 1), cA + hstep, voffA);
        if (wr == 1) PG8_BAR;
        PG8_WAIT_V(4); PG8_BAR;
        PG8_STAGE(PG8_SB(1, 0), cB + kstep, voffB); PG8_STAGE(PG8_SA(1, 0), cA + kstep, voffA); PG8_STAGE(PG8_SB(1, 1), cB + hstep + kstep, voffB);
        PG8_WAIT_V(6); PG8_BAR;
    }
    for (;;) {
        const bool has_next = S.next(ui + 1, nxt);
        const char* nA = has_next ? (const char*)g.A + (size_t)nxt.pm * tstep : cA; const char* nB = has_next ? (const char*)g.Bt + (size_t)nxt.pn * tstep : cB;
        for (int t = 0; t < nt; t += 2) {
            const bool last = (t == nt - 2);
            const char* a1 = cA + (size_t)(t + 1) * kstep;
            const char* a2 = last ? nA : cA + (size_t)(t + 2) * kstep; const char* b2 = last ? nB : cB + (size_t)(t + 2) * kstep;
            const char* a3 = a2 + kstep; const char* b3 = b2 + kstep;
            if (last && has_next) S.a_ready(nxt);
            if constexpr (SP2) {
            PG8_LDB(B0, 0, 0); PG8_LDB(B1, 0, 1); PG8_SCHED; PG8_LDA(At, 0, 0); PG8_STAGE(PG8_SA(1, 1), a1 + hstep, voffA);
            PG8_WAIT_V(8); PG8_WAIT_L(0); PG8_BAR; PG8_MMA(0, 0, At, B0); PG8_MMA(0, 1, At, B1); PG8_BAR; PG8_SCHED;
            PG8_LDA(At, 0, 1); PG8_STAGE(PG8_SB(0, 0), b2, voffB); PG8_STAGE(PG8_SB(0, 1), b2 + hstep, voffB); PG8_STAGE(PG8_SA(0, 0), a2, voffA);
            PG8_WAIT_V(8); PG8_WAIT_L(0); PG8_BAR; PG8_MMA(1, 0, At, B0); PG8_MMA(1, 1, At, B1); PG8_BAR; PG8_SCHED;
            PG8_LDB(B0, 1, 0); PG8_LDB(B1, 1, 1); PG8_SCHED; PG8_LDA(At, 1, 0); PG8_STAGE(PG8_SA(0, 1), a2 + hstep, voffA);
            PG8_WAIT_V(8); PG8_WAIT_L(0); PG8_BAR; PG8_MMA(0, 0, At, B0); PG8_MMA(0, 1, At, B1); PG8_BAR; PG8_SCHED;
            PG8_LDA(At, 1, 1); PG8_STAGE(PG8_SB(1, 0), b3, voffB); PG8_STAGE(PG8_SB(1, 1), b3 + hstep, voffB); PG8_STAGE(PG8_SA(1, 0), a3, voffA);
            PG8_WAIT_V(8); PG8_WAIT_L(0); PG8_BAR; PG8_MMA(1, 0, At, B0); PG8_MMA(1, 1, At, B1); PG8_BAR; PG8_SCHED;
            } else {
            PG8_LDB(B0, 0, 0); PG8_SCHED; PG8_LDA(At, 0, 0); PG8_STAGE(PG8_SA(1, 1), a1 + hstep, voffA);
            PG8_WAIT_L(8); PG8_BAR; PG8_WAIT_L(0); PG8_MMA(0, 0, At, B0); PG8_BAR; PG8_SCHED;
            PG8_LDB(B1, 0, 1); PG8_STAGE(PG8_SB(0, 0), b2, voffB);
            PG8_BAR; PG8_WAIT_L(0); PG8_MMA(0, 1, At, B1); PG8_BAR;
            PG8_LDA(At, 0, 1); PG8_STAGE(PG8_SA(0, 0), a2, voffA);
            PG8_BAR; PG8_WAIT_L(0); PG8_MMA(1, 0, At, B0); PG8_BAR; PG8_SCHED;
            PG8_STAGE(PG8_SB(0, 1), b2 + hstep, voffB);
            PG8_WAIT_V(6); PG8_BAR; PG8_MMA(1, 1, At, B1); PG8_BAR;
            PG8_LDB(B0, 1, 0); PG8_SCHED; PG8_LDA(At, 1, 0); PG8_STAGE(PG8_SA(0, 1), a2 + hstep, voffA);
            PG8_WAIT_L(8); PG8_BAR; PG8_WAIT_L(0); PG8_MMA(0, 0, At, B0); PG8_BAR; PG8_SCHED;
            PG8_LDB(B1, 1, 1); PG8_STAGE(PG8_SB(1, 0), b3, voffB);
            PG8_BAR; PG8_WAIT_L(0); PG8_MMA(0, 1, At, B1); PG8_BAR;
            PG8_LDA(At, 1, 1); PG8_STAGE(PG8_SA(1, 0), a3, voffA);
            PG8_BAR; PG8_WAIT_L(0); PG8_MMA(1, 0, At, B0); PG8_BAR; PG8_SCHED;
            PG8_STAGE(PG8_SB(1, 1), b3 + hstep, voffB);
            PG8_WAIT_V(6); PG8_BAR; PG8_MMA(1, 1, At, B1); PG8_BAR;
            }
        }
        if constexpr (ALIGN_EPI) { if (wr == 0) PG8_BAR; }
        if constexpr (!Epi::AFTER_DRAIN) { E(acc, cur, wr, wc, fr, fq); S.done(cur); }
        if (!has_next) break;
#pragma unroll
        for (int a = 0; a < 2; ++a)
#pragma unroll
            for (int b = 0; b < 2; ++b)
#pragma unroll
                for (int m = 0; m < 4; ++m)
#pragma unroll
                    for (int n = 0; n < 2; ++n) acc[a][b][m][n] = (f32x4){0.f, 0.f, 0.f, 0.f};
        cur = nxt; cA = nA; cB = nB; ++ui;
        if constexpr (ALIGN_EPI) { if (wr == 1) PG8_BAR; }
    }
    PG8_WAIT_V(0);
    if constexpr (!ALIGN_EPI) { if (wr == 0) PG8_BAR; }
    PG8_BAR;
    if constexpr (Epi::AFTER_DRAIN) { E.fused(acc, cur, wr, wc, fr, fq, lds, wid, lane); S.done(cur); }
#undef PG8_SA
#undef PG8_SB
#undef PG8_STAGE
#undef PG8_LDA
#undef PG8_LDB
#undef PG8_MMA
#undef PG8_WAIT_V
#undef PG8_WAIT_L
#undef PG8_BAR
#undef PG8_SCHED
}
}


#ifndef PG8_SP2
#define PG8_SP2 true
#endif
#ifndef PG8_ALIGN
#define PG8_ALIGN true
#endif
#ifndef MK_LAUNCHES
#define MK_LAUNCHES 1
#endif

#define GAS __attribute__((address_space(1)))
#define LAS __attribute__((address_space(3)))
typedef unsigned short bf16;
typedef float f32x4 __attribute__((ext_vector_type(4)));
typedef unsigned u32x4 __attribute__((ext_vector_type(4)));
typedef unsigned u32x2 __attribute__((ext_vector_type(2)));

constexpr int NB = 8, SEQ = 4096, DM = 1024, NMETA = 16;
constexpr int ROWS = 4160, PADR = 48, TOK0 = 64;
constexpr int MTOK = NB * SEQ;
constexpr int NIN = 3584;
constexpr int BROWS = NB * ROWS;
constexpr size_t ARR = (size_t)BROWS * 512;
constexpr int NCH = 64;
constexpr int NEXP = 16, DEXP = 512;
constexpr int XS_ROWS = 69632;
constexpr float ALPHA = 1.189207115002721f;
constexpr float LN_EPS = 1e-5f, RMS_EPS = 1e-6f;
constexpr float LOG2E = 1.4426950408889634f;
constexpr float C2Q = 0.125f * LOG2E;
constexpr float STICK_THR = 48.0f;

constexpr size_t MiB = 1u << 20;
constexpr size_t WS_CTL = 0, CTL_ZERO_BYTES = 1 * MiB;
constexpr size_t WS_WIN = 1 * MiB;
constexpr size_t WS_WOUT = 8 * MiB;
constexpr size_t WS_LB = 10 * MiB;
constexpr size_t WS_META = 11 * MiB;
constexpr size_t WS_DV = 12 * MiB;
constexpr size_t WS_XB = 16 * MiB;
constexpr size_t WS_S = 16 * MiB;
constexpr size_t WS_PROJ = 80 * MiB;
constexpr size_t WS_U = 308 * MiB;
constexpr size_t WS_MIX = 436 * MiB;
constexpr size_t WS_W13 = 80 * MiB;
constexpr size_t WS_W2 = 112 * MiB;
constexpr size_t WS_XS = 128 * MiB;
constexpr size_t WS_HID = 264 * MiB;
constexpr size_t WS_YS = 332 * MiB;
constexpr size_t WS_END = 500 * MiB;
static_assert(WS_PROJ + 7 * ARR * 2 <= WS_U && WS_U + (size_t)32 * 64 * 16384 * 4 <= WS_MIX && WS_MIX + (size_t)MTOK * DM * 2 <= WS_END, "ws map A");
static_assert(WS_W13 + (size_t)16 * 1024 * 1024 * 2 <= WS_W2 && WS_W2 + (size_t)16 * 1024 * 512 * 2 <= WS_XS && WS_XS + (size_t)XS_ROWS * 1024 * 2 <= WS_HID &&
              WS_HID + (size_t)XS_ROWS * 512 * 2 <= WS_YS && WS_YS + (size_t)XS_ROWS * 1024 * 2 <= WS_END, "ws map B");
constexpr int CW_CNT = 64;
constexpr int CW_BAR = 4096;
constexpr int MISC_BAR = 100;

constexpr int RING_BYTES = 131072;
constexpr int MISC_OFF = RING_BYTES;
constexpr int LDS_BYTES = 147456;
constexpr int NWAVES = 8, NTHREADS = 512;

__device__ __forceinline__ unsigned f2bf(float f) { unsigned u = __builtin_bit_cast(unsigned, f); return (u + 0x7fffu + ((u >> 16) & 1u)) >> 16; }
__device__ __forceinline__ unsigned pk2(float lo, float hi) { return f2bf(lo) | (f2bf(hi) << 16); }
__device__ __forceinline__ float bf2f(unsigned h) { return __builtin_bit_cast(float, h << 16); }
__device__ __forceinline__ float bflo(unsigned w) { return __builtin_bit_cast(float, w << 16); }
__device__ __forceinline__ float bfhi(unsigned w) { return __builtin_bit_cast(float, w & 0xffff0000u); }
__device__ __forceinline__ float ex2(float x) { return __builtin_amdgcn_exp2f(x); }
__device__ __forceinline__ float lg2(float x) { return __builtin_amdgcn_logf(x); }
__device__ __forceinline__ float rcpf_(float x) { return __builtin_amdgcn_rcpf(x); }
__device__ __forceinline__ float sigm(float v) { return rcpf_(1.f + ex2(-v * LOG2E)); }
__device__ __forceinline__ float wave_sum(float v) {
#pragma unroll
    for (int o = 1; o < 64; o <<= 1) v += __shfl_xor(v, o);
    return v;
}
template <int XF> __device__ __forceinline__ float xform(float v, float lb) {
    if (XF == 0) return v * sigm(v);
    if (XF == 1) return lg2(lb + (1.f - lb) * sigm(v));
    if (XF == 3) return sigm(v);
    if (XF == 4) return v * C2Q;
    return v;
}
__device__ __forceinline__ float xform_rt(int kind, float v, float lb) {
    switch (kind) { case 0: return xform<0>(v, lb); case 1: return xform<1>(v, lb); case 3: return xform<3>(v, lb); case 4: return xform<4>(v, lb); default: return v; }
}

using pg8::Unit;
struct EpiProj {
    static constexpr bool PERM = true, AFTER_DRAIN = false;
    bf16* proj; const float* lb;
    template <int XF> __device__ __forceinline__ void run(int kind, const f32x4 (&acc)[2][2][4][2], const Unit& u, int wr, int wc, int fr, int fq) const {
        const int b = u.pm >> 4;
        const int r0 = b * ROWS + TOK0 + (u.pm & 15) * 256 + wr * 64 + fr;
        const int c0 = (u.pn & 1) * 256 + wc * 32 + 8 * fq;
        bf16* base = proj + (size_t)kind * ARR;
        f32x4 l0[2], l1[2];
#pragma unroll
        for (int bj = 0; bj < 2; ++bj) {
            if (XF == 1) { l0[bj] = *(const f32x4*)(lb + c0 + bj * 128); l1[bj] = *(const f32x4*)(lb + c0 + bj * 128 + 4); }
            else { l0[bj] = (f32x4){0.f, 0.f, 0.f, 0.f}; l1[bj] = l0[bj]; }
        }
#pragma unroll
        for (int ai = 0; ai < 2; ++ai)
#pragma unroll
            for (int m = 0; m < 4; ++m) {
                bf16* rowp = base + (size_t)(r0 + ai * 128 + m * 16) * 512 + c0;
#pragma unroll
                for (int bj = 0; bj < 2; ++bj) {
                    const f32x4 v0 = acc[ai][bj][m][0], v1 = acc[ai][bj][m][1];
                    u32x4 w;
                    w.x = pk2(xform<XF>(v0[0], l0[bj][0]), xform<XF>(v0[1], l0[bj][1]));
                    w.y = pk2(xform<XF>(v0[2], l0[bj][2]), xform<XF>(v0[3], l0[bj][3]));
                    w.z = pk2(xform<XF>(v1[0], l1[bj][0]), xform<XF>(v1[1], l1[bj][1]));
                    w.w = pk2(xform<XF>(v1[2], l1[bj][2]), xform<XF>(v1[3], l1[bj][3]));
                    *(u32x4*)(rowp + bj * 128) = w;
                }
            }
    }
    __device__ __forceinline__ void operator()(const f32x4 (&acc)[2][2][4][2], const Unit& u, int wr, int wc, int fr, int fq) const {
        const int kind = u.pn >> 1;
        if (kind == 0) run<0>(kind, acc, u, wr, wc, fr, fq);
        else if (kind == 1) run<1>(kind, acc, u, wr, wc, fr, fq);
        else if (kind == 3) run<3>(kind, acc, u, wr, wc, fr, fq);
        else if (kind == 4) run<4>(kind, acc, u, wr, wc, fr, fq);
        else run<2>(kind, acc, u, wr, wc, fr, fq);
    }
};
struct EpiOut {
    static constexpr bool PERM = false, AFTER_DRAIN = false;
    const float* x; float* out;
    __device__ __forceinline__ void operator()(const f32x4 (&acc)[2][2][4][2], const Unit& u, int wr, int wc, int fr, int fq) const {
        const int row0 = u.pm * 256 + wr * 64 + fr, col0 = u.pn * 256 + wc * 32 + 4 * fq;
#pragma unroll
        for (int ai = 0; ai < 2; ++ai)
#pragma unroll
            for (int m = 0; m < 4; ++m) {
                const size_t ro = (size_t)(row0 + ai * 128 + m * 16) * DM + col0;
#pragma unroll
                for (int bj = 0; bj < 2; ++bj)
#pragma unroll
                    for (int n = 0; n < 2; ++n) {
                        const f32x4 xv = *(const f32x4*)(x + ro + bj * 128 + 16 * n);
                        *(f32x4*)(out + ro + bj * 128 + 16 * n) = acc[ai][bj][m][n] + xv * ALPHA;
                    }
            }
    }
};
struct EpiHid {
    static constexpr bool PERM = true, AFTER_DRAIN = false;
    bf16* hid;
    __device__ __forceinline__ void operator()(const f32x4 (&acc)[2][2][4][2], const Unit& u, int wr, int wc, int fr, int fq) const {
        const int row0 = u.pm * 256 + wr * 64 + fr, hc0 = (u.pn & 3) * 128 + wc * 16 + 4 * fq;
#pragma unroll
        for (int ai = 0; ai < 2; ++ai)
#pragma unroll
            for (int m = 0; m < 4; ++m) {
                bf16* rowp = hid + (size_t)(row0 + ai * 128 + m * 16) * DEXP + hc0;
#pragma unroll
                for (int bj = 0; bj < 2; ++bj) {
                    const f32x4 g = acc[ai][bj][m][0], up = acc[ai][bj][m][1];
                    u32x2 w;
                    w.x = pk2(g[0] * sigm(g[0]) * up[0], g[1] * sigm(g[1]) * up[1]);
                    w.y = pk2(g[2] * sigm(g[2]) * up[2], g[3] * sigm(g[3]) * up[3]);
                    *(u32x2*)(rowp + bj * 64) = w;
                }
            }
    }
};
struct EpiYs {
    static constexpr bool PERM = true, AFTER_DRAIN = false;
    bf16* ys;
    __device__ __forceinline__ void operator()(const f32x4 (&acc)[2][2][4][2], const Unit& u, int wr, int wc, int fr, int fq) const {
        const int row0 = u.pm * 256 + wr * 64 + fr, col0 = (u.pn & 3) * 256 + wc * 32 + 8 * fq;
#pragma unroll
        for (int ai = 0; ai < 2; ++ai)
#pragma unroll
            for (int m = 0; m < 4; ++m) {
                bf16* rowp = ys + (size_t)(row0 + ai * 128 + m * 16) * DM + col0;
#pragma unroll
                for (int bj = 0; bj < 2; ++bj) {
                    const f32x4 v0 = acc[ai][bj][m][0], v1 = acc[ai][bj][m][1];
                    u32x4 w; w.x = pk2(v0[0], v0[1]); w.y = pk2(v0[2], v0[3]); w.z = pk2(v1[0], v1[1]); w.w = pk2(v1[2], v1[3]);
                    *(u32x4*)(rowp + bj * 128) = w;
                }
            }
    }
};
struct MoeOrder {
    const LAS int* toff; int G, c, ntot;
    __device__ __forceinline__ bool next(int i, Unit& u) const {
        const long L = (long)i * G + c; if (L >= (long)ntot * 4) return false;
        const int mt = (int)(L >> 2), pl = (int)(L & 3); int e = 0;
#pragma unroll
        for (int j = 1; j < NEXP; ++j) e += (mt >= toff[j]) ? 1 : 0;
        u.pm = mt; u.pn = e * 4 + pl; return true;
    }
    __device__ __forceinline__ void a_ready(const Unit&) const {}
    __device__ __forceinline__ void done(const Unit&) const {}
};

struct Args { const float* in[18]; float* out; unsigned char* ws; int ph_lo, ph_hi; };
struct Frame {
    LAS unsigned char* lds; LAS int* misc;
    int tid, lane, wave, G, gw, ngw;
};

template <int MODE> __device__ __forceinline__ int rowmap(int n) { return MODE == 0 ? n : ((n >> 2) * 8 + (n & 3) + (MODE == 2 ? 4 : 0)); }
template <int MODE> __device__ __forceinline__ void transpose_item(const float* W, int K, int N, bf16* WT, LAS float* scr, int item, int lane) {
    const int nblk = N / 32, kb = item / nblk, nb = item % nblk, k0 = 64 * kb, n0 = 32 * nb;
#pragma unroll 8
    for (int i = 0; i < 32; ++i) { const int kk = 2 * i + (lane >> 5); scr[kk * 33 + (lane & 31)] = W[(size_t)(k0 + kk) * N + n0 + (lane & 31)]; }
    asm volatile("s_waitcnt lgkmcnt(0)" ::: "memory");
    const int c = lane & 7;
#pragma unroll
    for (int j = 0; j < 4; ++j) { const int n = (lane >> 3) + 8 * j; const LAS float* s = scr + (8 * c) * 33 + n;
        u32x4 o; o.x = pk2(s[0 * 33], s[1 * 33]); o.y = pk2(s[2 * 33], s[3 * 33]); o.z = pk2(s[4 * 33], s[5 * 33]); o.w = pk2(s[6 * 33], s[7 * 33]);
        *(u32x4*)(WT + (size_t)rowmap<MODE>(n0 + n) * K + k0 + 8 * c) = o; }
    asm volatile("s_waitcnt lgkmcnt(0)" ::: "memory");
}

__device__ __forceinline__ void p0_prep(Frame& F, const Args& A) {
    LAS float* scr = (LAS float*)(F.lds + F.wave * 16384);
    const int gtid = blockIdx.x * NTHREADS + F.tid, gthreads = F.G * NTHREADS;
    for (int i = gtid; i < 512; i += gthreads) ((float*)(A.ws + WS_LB))[i] = 1.f / (1.f + __expf(A.in[3][512 + i] - A.in[3][i]));
    for (int i = gtid; i < 7 * NB * 3072; i += gthreads) {
        const int a = i / (NB * 3072), r = i % (NB * 3072), b = r / 3072, o = r % 3072;
        *(u32x4*)(((bf16*)(A.ws + WS_PROJ)) + (size_t)a * ARR + (size_t)b * ROWS * 512 + (size_t)o * 8) = (u32x4){0u, 0u, 0u, 0u};
    }
    for (int job = F.gw; job < 56 * 4; job += F.ngw) {
        const int cgp = job >> 2, rq = job & 3, n = cgp * 64 + F.lane, kind = cgp >> 3;
        float acc0 = 0.f, acc1 = 0.f, acc2 = 0.f, acc3 = 0.f;
        const float* mt = A.in[1] + (size_t)(4 * rq) * DM;
#pragma unroll 8
        for (int k = 0; k < DM; ++k) {
            const float w = A.in[2][(size_t)k * NIN + n];
            acc0 += mt[k] * w; acc1 += mt[DM + k] * w; acc2 += mt[2 * DM + k] * w; acc3 += mt[3 * DM + k] * w;
        }
        const int col = n & 511;
        const float lbv = 1.f / (1.f + __expf(A.in[3][512 + col] - A.in[3][col]));
        const unsigned short o0 = (unsigned short)f2bf(xform_rt(kind, acc0, lbv)), o1 = (unsigned short)f2bf(xform_rt(kind, acc1, lbv)),
                             o2 = (unsigned short)f2bf(xform_rt(kind, acc2, lbv)), o3 = (unsigned short)f2bf(xform_rt(kind, acc3, lbv));
        bf16* base = ((bf16*)(A.ws + WS_PROJ)) + (size_t)kind * ARR + col;
        for (int b = 0; b < NB; ++b) {
            bf16* p = base + (size_t)(b * ROWS + PADR + 4 * rq) * 512;
            p[0] = o0; p[512] = o1; p[1024] = o2; p[1536] = o3;
        }
    }
    constexpr int I_IN = (DM / 64) * (NIN / 32), I_OUT = (DM / 64) * (DM / 32);
    for (int it = F.gw; it < I_IN + I_OUT; it += F.ngw) {
        if (it < I_IN) transpose_item<0>(A.in[2], DM, NIN, ((bf16*)(A.ws + WS_WIN)), scr, it, F.lane);
        else transpose_item<0>(A.in[6], DM, DM, ((bf16*)(A.ws + WS_WOUT)), scr, it - I_IN, F.lane);
    }
    for (int m = F.gw; m < MTOK; m += F.ngw) {
        const f32x4* xr = (const f32x4*)(A.in[0] + (size_t)m * DM) + F.lane;
        u32x2* o8 = (u32x2*)(((bf16*)(A.ws + WS_XB)) + (size_t)m * DM) + F.lane;
#pragma unroll
        for (int j = 0; j < 4; ++j) { const f32x4 v = xr[64 * j]; u32x2 w; w.x = pk2(v[0], v[1]); w.y = pk2(v[2], v[3]); o8[64 * j] = w; }
    }
}

__device__ __forceinline__ void ha_unit(Frame& F, const Args& A, int bh, int c) {
    const int b = bh >> 2, h = bh & 3, tid = F.tid;
    LAS float* VV = (LAS float*)F.lds;
    LAS float* KH = VV + 64 * 128;
    LAS float* TOT = KH + 64 * 128;
    const int d = tid & 127, sq = tid >> 7;
    const size_t rb = (size_t)(b * ROWS + 64 * c + 16 * sq) * 512 + 128 * h + d;
    const bf16* LF = ((bf16*)(A.ws + WS_PROJ)) + 1 * ARR; const bf16* HV = ((bf16*)(A.ws + WS_PROJ)) + 2 * ARR;
    float lf[16], pre[16]; float run = 0.f;
#pragma unroll
    for (int i = 0; i < 16; ++i) { lf[i] = bf2f(LF[rb + (size_t)i * 512]); VV[(16 * sq + i) * 128 + d] = bf2f(HV[rb + (size_t)i * 512]); }
#pragma unroll
    for (int i = 0; i < 16; ++i) { run += lf[i]; pre[i] = run; }
    TOT[sq * 128 + d] = run;
    __syncthreads();
    float off = 0.f, blast = 0.f;
#pragma unroll
    for (int q = 0; q < 4; ++q) { const float t = TOT[q * 128 + d]; off += (q < sq) ? t : 0.f; blast += t; }
#pragma unroll
    for (int i = 0; i < 16; ++i) { const float bc = off + pre[i]; KH[(16 * sq + i) * 128 + d] = (1.f - ex2(lf[i])) * ex2(blast - bc); }
    if (sq == 0) ((float*)(A.ws + WS_DV))[(size_t)(bh * 64 + c) * 128 + d] = ex2(blast);
    __syncthreads();
    const int vq = tid >> 4, dq = tid & 15;
    f32x4 a0[4], a1[4];
#pragma unroll
    for (int a = 0; a < 4; ++a) { a0[a] = (f32x4){0.f, 0.f, 0.f, 0.f}; a1[a] = a0[a]; }
#pragma unroll 4
    for (int s = 0; s < 64; ++s) {
        const f32x4 vv = *(const LAS f32x4*)(VV + s * 128 + 4 * vq);
        const f32x4 k0 = *(const LAS f32x4*)(KH + s * 128 + 8 * dq), k1 = *(const LAS f32x4*)(KH + s * 128 + 8 * dq + 4);
#pragma unroll
        for (int a = 0; a < 4; ++a) { a0[a] += k0 * vv[a]; a1[a] += k1 * vv[a]; }
    }
    float* up = ((float*)(A.ws + WS_U)) + (size_t)(bh * 64 + c) * 16384 + (size_t)(4 * vq) * 128 + 8 * dq;
#pragma unroll
    for (int a = 0; a < 4; ++a) { *(f32x4*)(up + a * 128) = a0[a]; *(f32x4*)(up + a * 128 + 4) = a1[a]; }
    __syncthreads();
}

__device__ __forceinline__ void attn_phase(Frame& F, const Args& A) {
    const bf16* SQ = ((bf16*)(A.ws + WS_PROJ)) + 4 * ARR; const bf16* SK = ((bf16*)(A.ws + WS_PROJ)) + 5 * ARR; const bf16* SV = ((bf16*)(A.ws + WS_PROJ)) + 6 * ARR;
    for (int u = blockIdx.x; u < 64 * 8; u += F.G) {
        const int bh = u >> 3, b = bh >> 3, h = bh & 7, t = (u & 7) * 512 + F.tid, r = TOK0 + t;
        float q[64], o[64];
        { const u32x4* qp = (const u32x4*)(SQ + (size_t)(b * ROWS + r) * 512 + 64 * h);
#pragma unroll
          for (int i = 0; i < 8; ++i) { const u32x4 w = qp[i]; q[8 * i] = bflo(w.x); q[8 * i + 1] = bfhi(w.x); q[8 * i + 2] = bflo(w.y); q[8 * i + 3] = bfhi(w.y);
              q[8 * i + 4] = bflo(w.z); q[8 * i + 5] = bfhi(w.z); q[8 * i + 6] = bflo(w.w); q[8 * i + 7] = bfhi(w.w); } }
#pragma unroll
        for (int i = 0; i < 64; ++i) o[i] = 0.f;
        float T = 0.f;
        for (int j = r - 1; j >= PADR; --j) {
            if (T > STICK_THR) break;
            const u32x4* kp = (const u32x4*)(SK + (size_t)(b * ROWS + j) * 512 + 64 * h);
            const u32x4* vp = (const u32x4*)(SV + (size_t)(b * ROWS + j) * 512 + 64 * h);
            float z0 = 0.f, z1 = 0.f;
#pragma unroll
            for (int i = 0; i < 8; ++i) { const u32x4 w = kp[i];
                z0 += q[8 * i] * bflo(w.x) + q[8 * i + 2] * bflo(w.y) + q[8 * i + 4] * bflo(w.z) + q[8 * i + 6] * bflo(w.w);
                z1 += q[8 * i + 1] * bfhi(w.x) + q[8 * i + 3] * bfhi(w.y) + q[8 * i + 5] * bfhi(w.z) + q[8 * i + 7] * bfhi(w.w); }
            const float z = fminf(z0 + z1, 100.f);
            const float sp = lg2(1.f + ex2(z));
            const float a = ex2(z - T - sp);
            T += sp;
#pragma unroll
            for (int i = 0; i < 8; ++i) { const u32x4 w = vp[i];
                o[8 * i] += a * bflo(w.x); o[8 * i + 1] += a * bfhi(w.x); o[8 * i + 2] += a * bflo(w.y); o[8 * i + 3] += a * bfhi(w.y);
                o[8 * i + 4] += a * bflo(w.z); o[8 * i + 5] += a * bfhi(w.z); o[8 * i + 6] += a * bflo(w.w); o[8 * i + 7] += a * bfhi(w.w); }
        }
        float ss = 0.f;
#pragma unroll
        for (int i = 0; i < 64; ++i) ss += o[i] * o[i];
        const float rs = 1.0f / sqrtf(ss * (1.f / 64.f) + RMS_EPS);
        const f32x4* gp = (const f32x4*)(A.in[5] + 64 * h);
        u32x4* op = (u32x4*)(((bf16*)(A.ws + WS_MIX)) + (size_t)(b * SEQ + t) * DM + 512 + 64 * h);
#pragma unroll
        for (int i = 0; i < 8; ++i) { const f32x4 g0 = gp[2 * i], g1 = gp[2 * i + 1]; u32x4 w;
            w.x = pk2(o[8 * i] * rs * g0[0], o[8 * i + 1] * rs * g0[1]); w.y = pk2(o[8 * i + 2] * rs * g0[2], o[8 * i + 3] * rs * g0[3]);
            w.z = pk2(o[8 * i + 4] * rs * g1[0], o[8 * i + 5] * rs * g1[1]); w.w = pk2(o[8 * i + 6] * rs * g1[2], o[8 * i + 7] * rs * g1[3]);
            op[i] = w; }
    }
}

__device__ __forceinline__ void hb_phase(Frame& F, const Args& A) {
    for (int g = blockIdx.x * NTHREADS + F.tid; g < 32 * 4096; g += F.G * NTHREADS) {
        const int bh = g >> 12, r = g & 4095, v = r >> 5, d4 = (r & 31) * 4;
        const float* up = ((float*)(A.ws + WS_U)) + (size_t)bh * 64 * 16384 + v * 128 + d4;
        const float* dp = ((float*)(A.ws + WS_DV)) + (size_t)bh * 64 * 128 + d4;
        bf16* sp = ((bf16*)(A.ws + WS_S)) + (size_t)bh * 64 * 16384 + v * 128 + d4;
        f32x4 s = (f32x4){0.f, 0.f, 0.f, 0.f};
#pragma unroll 8
        for (int c = 0; c < 64; ++c) {
            const f32x4 uu = *(const f32x4*)(up + (size_t)c * 16384), dd = *(const f32x4*)(dp + c * 128);
            s = dd * s + uu;
            u32x2 w; w.x = pk2(s[0], s[1]); w.y = pk2(s[2], s[3]);
            *(u32x2*)(sp + (size_t)c * 16384) = w;
        }
    }
}

constexpr int PQ = 132, PS = 68;
__device__ __forceinline__ void hc_unit(Frame& F, const Args& A, int bh, int cc) {
    const int b = bh >> 2, h = bh & 3, tid = F.tid;
    LAS float* QT = (LAS float*)F.lds;
    LAS float* KI = QT + 64 * PQ;
    LAS float* VV = KI + 64 * PQ;
    LAS float* SC = VV + 64 * 128;
    LAS float* TOT = SC + 64 * PS;
    LAS float* SSQ = TOT + 4 * 128;
    const bf16* HQ = ((bf16*)(A.ws + WS_PROJ)); const bf16* LF = ((bf16*)(A.ws + WS_PROJ)) + 1 * ARR; const bf16* HV = ((bf16*)(A.ws + WS_PROJ)) + 2 * ARR; const bf16* HG = ((bf16*)(A.ws + WS_PROJ)) + 3 * ARR;
    {
        const int d = tid & 127, sq = tid >> 7;
        const size_t rb = (size_t)(b * ROWS + 64 * cc + 16 * sq) * 512 + 128 * h + d;
        float lf[16], pre[16], qv[16]; float run = 0.f;
#pragma unroll
        for (int i = 0; i < 16; ++i) { lf[i] = bf2f(LF[rb + (size_t)i * 512]); qv[i] = bf2f(HQ[rb + (size_t)i * 512]); VV[(16 * sq + i) * 128 + d] = bf2f(HV[rb + (size_t)i * 512]); }
#pragma unroll
        for (int i = 0; i < 16; ++i) { run += lf[i]; pre[i] = run; }
        TOT[sq * 128 + d] = run;
        __syncthreads();
        float off = 0.f;
#pragma unroll
        for (int q = 0; q < 4; ++q) { const float t = TOT[q * 128 + d]; off += (q < sq) ? t : 0.f; }
#pragma unroll
        for (int i = 0; i < 16; ++i) { const float bc = off + pre[i];
            QT[(16 * sq + i) * PQ + d] = qv[i] * ex2(bc);
            KI[(16 * sq + i) * PQ + d] = (1.f - ex2(lf[i])) * ex2(-bc); }
    }
    __syncthreads();
    {
        const int t = tid >> 3, sg = tid & 7;
        float a[8];
#pragma unroll
        for (int i = 0; i < 8; ++i) a[i] = 0.f;
#pragma unroll 2
        for (int d = 0; d < 128; d += 4) {
            const f32x4 qq = *(const LAS f32x4*)(QT + t * PQ + d);
#pragma unroll
            for (int i = 0; i < 8; ++i) { const f32x4 kk = *(const LAS f32x4*)(KI + (sg + 8 * i) * PQ + d); a[i] += qq[0] * kk[0] + qq[1] * kk[1] + qq[2] * kk[2] + qq[3] * kk[3]; }
        }
#pragma unroll
        for (int i = 0; i < 8; ++i) { const int s = sg + 8 * i; SC[t * PS + s] = (s <= t) ? a[i] : 0.f; }
    }
    __syncthreads();
    {
        const int v = tid & 127, tq = tid >> 7;
        float acc[16];
#pragma unroll
        for (int i = 0; i < 16; ++i) acc[i] = 0.f;
        for (int s = 0; s < 64; s += 4) {
            const float v0 = VV[s * 128 + v], v1 = VV[(s + 1) * 128 + v], v2 = VV[(s + 2) * 128 + v], v3 = VV[(s + 3) * 128 + v];
#pragma unroll
            for (int i = 0; i < 16; ++i) { const f32x4 sc = *(const LAS f32x4*)(SC + (tq + 4 * i) * PS + s); acc[i] += sc[0] * v0 + sc[1] * v1 + sc[2] * v2 + sc[3] * v3; }
        }
        const bf16* sp = ((bf16*)(A.ws + WS_S)) + (size_t)(bh * 64 + cc - 1) * 16384 + (size_t)v * 128;
        for (int d = 0; d < 128; d += 8) {
            const u32x4 w = *(const u32x4*)(sp + d);
            const float s0 = bflo(w.x), s1 = bfhi(w.x), s2 = bflo(w.y), s3 = bfhi(w.y), s4 = bflo(w.z), s5 = bfhi(w.z), s6 = bflo(w.w), s7 = bfhi(w.w);
#pragma unroll
            for (int i = 0; i < 16; ++i) {
                const f32x4 q0 = *(const LAS f32x4*)(QT + (tq + 4 * i) * PQ + d), q1 = *(const LAS f32x4*)(QT + (tq + 4 * i) * PQ + d + 4);
                acc[i] += q0[0] * s0 + q0[1] * s1 + q0[2] * s2 + q0[3] * s3 + q1[0] * s4 + q1[1] * s5 + q1[2] * s6 + q1[3] * s7;
            }
        }
        const int wv = tid >> 6;
#pragma unroll
        for (int i = 0; i < 16; ++i) { const float ss = wave_sum(acc[i] * acc[i]); if (F.lane == 0) SSQ[wv * 16 + i] = ss; }
        __syncthreads();
        const float ng = A.in[4][128 * h + v];
#pragma unroll
        for (int i = 0; i < 16; ++i) {
            const int t = tq + 4 * i;
            const float tot = SSQ[(2 * tq) * 16 + i] + SSQ[(2 * tq + 1) * 16 + i];
            const float rs = 1.0f / sqrtf(tot * (1.f / 128.f) + RMS_EPS);
            const float gate = bf2f(HG[(size_t)(b * ROWS + 64 * cc + t) * 512 + 128 * h + v]);
            ((bf16*)(A.ws + WS_MIX))[(size_t)(b * SEQ + 64 * (cc - 1) + t) * DM + 128 * h + v] = (bf16)f2bf(acc[i] * rs * ng * gate);
        }
    }
    __syncthreads();
}

__device__ __forceinline__ void ln_stats(const f32x4 (&v)[4], float& mean, float& rstd) {
    float s = 0.f;
#pragma unroll
    for (int j = 0; j < 4; ++j) s += (v[j][0] + v[j][1]) + (v[j][2] + v[j][3]);
    mean = wave_sum(s) * (1.f / DM);
    float s2 = 0.f;
#pragma unroll
    for (int j = 0; j < 4; ++j) { const f32x4 d = v[j] - mean; s2 += (d[0] * d[0] + d[1] * d[1]) + (d[2] * d[2] + d[3] * d[3]); }
    rstd = 1.0f / sqrtf(wave_sum(s2) * (1.f / DM) + LN_EPS);
}

__device__ __forceinline__ void route_row(Frame& F, const Args& A, const float (&lg)[20], int rl, LAS int* lcnt, LAS int* rec) {
    const float* brg = A.in[10];
    float g0 = lg[0] + brg[0], g1 = lg[1] + brg[1], g2 = lg[2] + brg[2], g3 = lg[3] + brg[3];
    int grp = 0; float gm = g0;
    if (g1 > gm) { gm = g1; grp = 1; } if (g2 > gm) { gm = g2; grp = 2; } if (g3 > gm) { gm = g3; grp = 3; }
    const float pg = 1.f / (__expf(g0 - gm) + __expf(g1 - gm) + __expf(g2 - gm) + __expf(g3 - gm));
    float in0, in1, in2, in3;
    if (grp == 0) { in0 = lg[4]; in1 = lg[5]; in2 = lg[6]; in3 = lg[7]; }
    else if (grp == 1) { in0 = lg[8]; in1 = lg[9]; in2 = lg[10]; in3 = lg[11]; }
    else if (grp == 2) { in0 = lg[12]; in1 = lg[13]; in2 = lg[14]; in3 = lg[15]; }
    else { in0 = lg[16]; in1 = lg[17]; in2 = lg[18]; in3 = lg[19]; }
    const float* be = A.in[12] + grp * 4;
    in0 += be[0]; in1 += be[1]; in2 += be[2]; in3 += be[3];
    int i0 = 0; float m0 = in0;
    if (in1 > m0) { m0 = in1; i0 = 1; } if (in2 > m0) { m0 = in2; i0 = 2; } if (in3 > m0) { m0 = in3; i0 = 3; }
    int i1 = -1; float m1 = 0.f;
    if (i0 != 0) { m1 = in0; i1 = 0; }
    if (i0 != 1 && (i1 < 0 || in1 > m1)) { m1 = in1; i1 = 1; }
    if (i0 != 2 && (i1 < 0 || in2 > m1)) { m1 = in2; i1 = 2; }
    if (i0 != 3 && (i1 < 0 || in3 > m1)) { m1 = in3; i1 = 3; }
    const float w0 = 1.f / (1.f + __expf(m1 - m0)), w1 = 1.f - w0;
    const int e0 = grp * 4 + i0, e1 = grp * 4 + i1;
    const int p0 = atomicAdd((int*)&lcnt[e0], 1), p1 = atomicAdd((int*)&lcnt[e1], 1);
    rec[rl * 6 + 0] = e0; rec[rl * 6 + 1] = p0; rec[rl * 6 + 2] = __float_as_int(pg * w0);
    rec[rl * 6 + 3] = e1; rec[rl * 6 + 4] = p1; rec[rl * 6 + 5] = __float_as_int(pg * w1);
}
__device__ __forceinline__ void p6_ln_router(Frame& F, const Args& A) {
    LAS int* lcnt = F.misc + 32; LAS int* lbase = F.misc + 48;
    LAS f32x4* WL = (LAS f32x4*)F.lds;
    LAS int* rec = (LAS int*)(F.lds + 81920);
    for (int it = F.tid; it < 1024 * 5; it += NTHREADS) {
        const int k = it / 5, c = it % 5, j = k >> 8, ln = (k >> 2) & 63, e = k & 3;
        const f32x4 w = (c == 0) ? *(const f32x4*)(A.in[9] + (size_t)k * 4) : *(const f32x4*)(A.in[11] + (size_t)k * 16 + 4 * (c - 1));
        WL[((j * 4 + e) * 5 + c) * 64 + ln] = w;
    }
    __syncthreads();
    const LAS f32x4* wl = WL + F.lane;
    for (int slab = blockIdx.x; slab < MTOK / 128; slab += F.G) {
        if (F.tid < 16) lcnt[F.tid] = 0;
        __syncthreads();
#pragma unroll 1
        for (int i = 0; i < 16; i += 2) {
            const int rl = F.wave * 16 + i, row = slab * 128 + rl;
            f32x4* xr0 = (f32x4*)(A.out + (size_t)row * DM) + F.lane; f32x4* xr1 = xr0 + DM / 4;
            f32x4 v0[4], v1[4];
#pragma unroll
            for (int j = 0; j < 4; ++j) { v0[j] = xr0[64 * j]; v1[j] = xr1[64 * j]; }
            float mean0, rstd0, mean1, rstd1; ln_stats(v0, mean0, rstd0); ln_stats(v1, mean1, rstd1);
#pragma unroll
            for (int j = 0; j < 4; ++j) {
                const f32x4 g = ((const f32x4*)A.in[7])[64 * j + F.lane], bb = ((const f32x4*)A.in[8])[64 * j + F.lane];
                v0[j] = (v0[j] - mean0) * rstd0 * g + bb; v1[j] = (v1[j] - mean1) * rstd1 * g + bb;
                xr0[64 * j] = v0[j]; xr1[64 * j] = v1[j];
            }
            float la[20], lb2[20];
#pragma unroll
            for (int e = 0; e < 20; ++e) { la[e] = 0.f; lb2[e] = 0.f; }
#pragma unroll 1
            for (int j = 0; j < 4; ++j) {
                const f32x4 s0 = (j == 0) ? v0[0] : (j == 1) ? v0[1] : (j == 2) ? v0[2] : v0[3];
                const f32x4 s1 = (j == 0) ? v1[0] : (j == 1) ? v1[1] : (j == 2) ? v1[2] : v1[3];
                const LAS f32x4* wj = wl + j * (20 * 64);
#pragma unroll
                for (int e = 0; e < 4; ++e) {
                    const float h0 = s0[e], h1 = s1[e];
#pragma unroll
                    for (int c = 0; c < 5; ++c) { const f32x4 w = wj[(e * 5 + c) * 64];
                        la[4 * c] += h0 * w[0]; la[4 * c + 1] += h0 * w[1]; la[4 * c + 2] += h0 * w[2]; la[4 * c + 3] += h0 * w[3];
                        lb2[4 * c] += h1 * w[0]; lb2[4 * c + 1] += h1 * w[1]; lb2[4 * c + 2] += h1 * w[2]; lb2[4 * c + 3] += h1 * w[3]; }
                }
            }
#pragma unroll
            for (int e = 0; e < 20; ++e) { la[e] = wave_sum(la[e]); lb2[e] = wave_sum(lb2[e]); }
            if (F.lane == 0) { route_row(F, A, la, rl, lcnt, rec); route_row(F, A, lb2, rl + 1, lcnt, rec); }
        }
        __syncthreads();
        if (F.tid < 16) lbase[F.tid] = (int)atomicAdd(((unsigned*)(A.ws + WS_CTL)) + CW_CNT + F.tid, (unsigned)lcnt[F.tid]);
        __syncthreads();
        if (F.tid < 128) {
            unsigned* mp = ((unsigned*)(A.ws + WS_META)) + (size_t)(slab * 128 + F.tid) * 8;
            const int e0 = rec[F.tid * 6 + 0], e1 = rec[F.tid * 6 + 3];
            u32x4 a, c;
            a.x = (unsigned)e0; a.y = (unsigned)(lbase[e0] + rec[F.tid * 6 + 1]); a.z = (unsigned)rec[F.tid * 6 + 2]; a.w = (unsigned)e1;
            c.x = (unsigned)(lbase[e1] + rec[F.tid * 6 + 4]); c.y = (unsigned)rec[F.tid * 6 + 5]; c.z = 0u; c.w = 0u;
            *(u32x4*)mp = a; *(u32x4*)(mp + 4) = c;
        }
        __syncthreads();
    }
}

__device__ __forceinline__ void build_toff(Frame& F, const Args& A) {
    __syncthreads();
    if (F.tid == 0) { int acc = 0;
        for (int e = 0; e < NEXP; ++e) { F.misc[e] = acc; const unsigned c = __hip_atomic_load(((unsigned*)(A.ws + WS_CTL)) + CW_CNT + e, __ATOMIC_RELAXED, __HIP_MEMORY_SCOPE_AGENT); acc += (int)((c + 255u) >> 8); }
        F.misc[NEXP] = acc; }
    __syncthreads();
}

__device__ __forceinline__ void p7_scatter(Frame& F, const Args& A) {
    build_toff(F, A);
    for (int row = F.gw; row < MTOK; row += F.ngw) {
        const unsigned* mp = ((unsigned*)(A.ws + WS_META)) + (size_t)row * 8;
        const int e0 = (int)mp[0], p0 = (int)mp[1], e1 = (int)mp[3], p1 = (int)mp[4];
        const size_t s0 = (size_t)F.misc[e0] * 256 + p0, s1 = (size_t)F.misc[e1] * 256 + p1;
        const f32x4* xr = (const f32x4*)(A.out + (size_t)row * DM) + F.lane;
        u32x2* o0 = (u32x2*)(((bf16*)(A.ws + WS_XS)) + s0 * DM) + F.lane; u32x2* o1 = (u32x2*)(((bf16*)(A.ws + WS_XS)) + s1 * DM) + F.lane;
#pragma unroll
        for (int j = 0; j < 4; ++j) { const f32x4 v = xr[64 * j]; u32x2 w; w.x = pk2(v[0], v[1]); w.y = pk2(v[2], v[3]); o0[64 * j] = w; o1[64 * j] = w; }
    }
    LAS float* scr = (LAS float*)(F.lds + F.wave * 16384);
    constexpr int I13 = (DM / 64) * (DEXP / 32), I2 = (DEXP / 64) * (DM / 32);
    for (int it = F.gw; it < NEXP * (2 * I13 + I2); it += F.ngw) {
        const int e = it / (2 * I13 + I2), r = it % (2 * I13 + I2);
        if (r < I13) transpose_item<1>(A.in[13] + (size_t)e * DM * DEXP, DM, DEXP, ((bf16*)(A.ws + WS_W13)) + (size_t)e * 1024 * DM, scr, r, F.lane);
        else if (r < 2 * I13) transpose_item<2>(A.in[14] + (size_t)e * DM * DEXP, DM, DEXP, ((bf16*)(A.ws + WS_W13)) + (size_t)e * 1024 * DM, scr, r - I13, F.lane);
        else transpose_item<0>(A.in[15] + (size_t)e * DEXP * DM, DEXP, DM, ((bf16*)(A.ws + WS_W2)) + (size_t)e * DM * DEXP, scr, r - 2 * I13, F.lane);
    }
}

__device__ __forceinline__ void p10_final(Frame& F, const Args& A) {
    build_toff(F, A);
    for (int row = F.gw; row < MTOK; row += F.ngw) {
        const unsigned* mp = ((unsigned*)(A.ws + WS_META)) + (size_t)row * 8;
        const int e0 = (int)mp[0], p0 = (int)mp[1], e1 = (int)mp[3], p1 = (int)mp[4];
        const float g0 = __uint_as_float(mp[2]), g1 = __uint_as_float(mp[5]);
        const size_t s0 = (size_t)F.misc[e0] * 256 + p0, s1 = (size_t)F.misc[e1] * 256 + p1;
        f32x4* xr = (f32x4*)(A.out + (size_t)row * DM) + F.lane;
        const u32x2* y0 = (const u32x2*)(((bf16*)(A.ws + WS_YS)) + s0 * DM) + F.lane; const u32x2* y1 = (const u32x2*)(((bf16*)(A.ws + WS_YS)) + s1 * DM) + F.lane;
        f32x4 v[4];
#pragma unroll
        for (int j = 0; j < 4; ++j) { const f32x4 hv = xr[64 * j]; const u32x2 a = y0[64 * j], c = y1[64 * j];
            v[j][0] = ALPHA * hv[0] + g0 * bflo(a.x) + g1 * bflo(c.x); v[j][1] = ALPHA * hv[1] + g0 * bfhi(a.x) + g1 * bfhi(c.x);
            v[j][2] = ALPHA * hv[2] + g0 * bflo(a.y) + g1 * bflo(c.y); v[j][3] = ALPHA * hv[3] + g0 * bfhi(a.y) + g1 * bfhi(c.y); }
        float mean, rstd; ln_stats(v, mean, rstd);
#pragma unroll
        for (int j = 0; j < 4; ++j) { const f32x4 g = ((const f32x4*)A.in[16])[64 * j + F.lane], bb = ((const f32x4*)A.in[17])[64 * j + F.lane]; xr[64 * j] = (v[j] - mean) * rstd * g + bb; }
    }
}

#define XB_TMO      128
#define XB_XCNT(j)  (256  + 64 * (j))
#define XB_XSUB(j)  (1280 + 64 * (j))
#define XB_XGEN(j)  (2304 + 64 * (j))
#define XB_TOP      3328
#define XB_TOPGEN   3392
#define XCD_BAR_WORDS 3456
#define XB_SPIN_CAP (1u << 18)

__device__ __forceinline__ unsigned xb_ld(unsigned* p)              { return __hip_atomic_load(p, __ATOMIC_RELAXED, __HIP_MEMORY_SCOPE_AGENT); }
__device__ __forceinline__ unsigned xb_add(unsigned* p, unsigned v) { return __hip_atomic_fetch_add(p, v, __ATOMIC_RELAXED, __HIP_MEMORY_SCOPE_AGENT); }
__device__ __forceinline__ unsigned xb_xcc_id() { return (unsigned)__builtin_amdgcn_s_getreg((3 << 11) | 20) & 0xFu; }
#define XB_SPIN(cond, bar) do { unsigned _sp = 0; while (cond) { __builtin_amdgcn_s_sleep(1); \
    if ((++_sp & 255u) == 0u) { if (xb_ld(&(bar)[XB_TMO])) break; if (_sp > XB_SPIN_CAP) { atomicAdd(&(bar)[XB_TMO], 1u); break; } } } } while (0)

struct XcdBarrier {
    unsigned* bar; unsigned x;
    volatile LAS unsigned* st;
};

__device__ __forceinline__ XcdBarrier xcd_barrier_post(unsigned* bar, volatile LAS unsigned* st) {
    XcdBarrier b; b.bar = bar; b.x = xb_xcc_id(); b.st = st;
    if (threadIdx.x == 0) (void)xb_add(&bar[XB_XCNT(b.x)], 1u);
    return b;
}
__device__ __forceinline__ void xcd_barrier_complete(unsigned* bar, unsigned x, unsigned& nloc, unsigned& nx) {
    const unsigned G = gridDim.x * gridDim.y * gridDim.z;
    unsigned sum, cnt, mine, sp = 0u;
    for (;;) {
        sum = 0u; cnt = 0u; mine = 0u;
#pragma unroll
        for (unsigned j = 0; j < 16; ++j) { const unsigned c = xb_ld(&bar[XB_XCNT(j)]); sum += c; cnt += (c > 0u) ? 1u : 0u; mine = (j == x) ? c : mine; }
        if (sum == G) break;
        __builtin_amdgcn_s_sleep(1);
        if ((++sp & 255u) == 0u) { if (xb_ld(&bar[XB_TMO])) break; if (sp > XB_SPIN_CAP) { atomicAdd(&bar[XB_TMO], 1u); break; } }
    }
    nloc = mine > 0u ? mine : 1u; nx = cnt > 0u ? cnt : 1u;
}

__device__ __forceinline__ void xcd_barrier(const XcdBarrier& b) {
    asm volatile("s_waitcnt vmcnt(0)" ::: "memory");
    __syncthreads();
    if (threadIdx.x == 0) {
        unsigned* bar = b.bar;
        __builtin_amdgcn_s_waitcnt(0);
        unsigned nloc = b.st[0], nx = b.st[1];
        if (nloc == 0u) { xcd_barrier_complete(bar, b.x, nloc, nx); b.st[0] = nloc; b.st[1] = nx; }
        const unsigned old = xb_add(&bar[XB_XSUB(b.x)], 1u);
        const unsigned gen = old / nloc;
        if (old + 1u == (gen + 1u) * nloc) {
            __builtin_amdgcn_fence(__ATOMIC_RELEASE, "agent");
            asm volatile("s_waitcnt vmcnt(0)" ::: "memory");
            const unsigned og = xb_add(&bar[XB_TOP], 1u);
            const unsigned tg = og / nx;
            if (og + 1u == (tg + 1u) * nx) xb_add(&bar[XB_TOPGEN], 1u);
            else XB_SPIN(xb_ld(&bar[XB_TOPGEN]) == tg, bar);
            __builtin_amdgcn_fence(__ATOMIC_ACQUIRE, "agent");
            xb_add(&bar[XB_XGEN(b.x)], 1u);
            asm volatile("s_waitcnt vmcnt(0)" ::: "memory");
        } else {
            XB_SPIN(xb_ld(&bar[XB_XGEN(b.x)]) == gen, bar);
            __builtin_amdgcn_fence(__ATOMIC_ACQUIRE, "agent");
            asm volatile("s_waitcnt vmcnt(0)" ::: "memory");
        }
    }
    __syncthreads();
}

constexpr int NPHASE = 11;
__global__ void __launch_bounds__(NTHREADS, 2) mega_fwd(Args args) {
    extern __shared__ __attribute__((aligned(16))) unsigned char lds[];
    cg::grid_group grid = cg::this_grid();
    Frame F;
    F.lds = (LAS unsigned char*)lds; F.misc = (LAS int*)(F.lds + MISC_OFF);
    F.tid = threadIdx.x; F.lane = F.tid & 63; F.wave = __builtin_amdgcn_readfirstlane(F.tid >> 6); F.G = gridDim.x;
    F.gw = blockIdx.x * NWAVES + F.wave; F.ngw = F.G * NWAVES;
    const Args& A = args;
    const int lo = args.ph_lo, hi = args.ph_hi;
    if (F.tid < 2) F.misc[MISC_BAR + F.tid] = 0;
    __syncthreads();
    XcdBarrier bar; bar.bar = (unsigned*)(args.ws + WS_CTL) + CW_BAR; bar.x = 0; bar.st = nullptr;
    if (MK_LAUNCHES == 1) bar = xcd_barrier_post((unsigned*)(args.ws + WS_CTL) + CW_BAR, (volatile LAS unsigned*)(F.misc + MISC_BAR));
#define IN(k) (lo <= (k) && (k) < hi)
#define SEAM(k) do { if (IN((k) + 1)) { if ((k) == 0) grid.sync(); else xcd_barrier(bar); } } while (0)

    if (IN(0)) { p0_prep(F, A); SEAM(0); }
    if (IN(1)) {
        pg8::Gemm g{((bf16*)(A.ws + WS_XB)), ((bf16*)(A.ws + WS_WIN)), MTOK, NIN, DM}; pg8::StaticOrder S; S.init(MTOK, NIN, F.G, (int)blockIdx.x);
        EpiProj E{((bf16*)(A.ws + WS_PROJ)), ((float*)(A.ws + WS_LB))};
        pg8::gemm_phase<EpiProj, pg8::StaticOrder, PG8_ALIGN, PG8_SP2>(F.lds, g, S, E);
        SEAM(1);
    }
    if (IN(2)) {
        for (int u = blockIdx.x; u < 32 * 64; u += F.G) ha_unit(F, A, u >> 6, u & 63);
        attn_phase(F, A);
        SEAM(2);
    }
    if (IN(3)) { hb_phase(F, A); SEAM(3); }
    if (IN(4)) {
        for (int u = blockIdx.x; u < 32 * 64; u += F.G) hc_unit(F, A, u >> 6, (u & 63) + 1);
        SEAM(4);
    }
    if (IN(5)) {
        pg8::Gemm g{((bf16*)(A.ws + WS_MIX)), ((bf16*)(A.ws + WS_WOUT)), MTOK, DM, DM}; pg8::StaticOrder S; S.init(MTOK, DM, F.G, (int)blockIdx.x);
        EpiOut E{A.in[0], A.out};
        pg8::gemm_phase<EpiOut, pg8::StaticOrder, PG8_ALIGN, PG8_SP2>(F.lds, g, S, E);
        SEAM(5);
    }
    if (IN(6)) { p6_ln_router(F, A); SEAM(6); }
    if (IN(7)) { p7_scatter(F, A); SEAM(7); }
    if (IN(8)) {
        build_toff(F, A);
        pg8::Gemm g{((bf16*)(A.ws + WS_XS)), ((bf16*)(A.ws + WS_W13)), XS_ROWS, 1024, DM}; MoeOrder S{(const LAS int*)F.misc, F.G, (int)blockIdx.x, F.misc[NEXP]};
        EpiHid E{((bf16*)(A.ws + WS_HID))};
        pg8::gemm_phase<EpiHid, MoeOrder, PG8_ALIGN, PG8_SP2>(F.lds, g, S, E);
        SEAM(8);
    }
    if (IN(9)) {
        build_toff(F, A);
        pg8::Gemm g{((bf16*)(A.ws + WS_HID)), ((bf16*)(A.ws + WS_W2)), XS_ROWS, 1024, DEXP}; MoeOrder S{(const LAS int*)F.misc, F.G, (int)blockIdx.x, F.misc[NEXP]};
        EpiYs E{((bf16*)(A.ws + WS_YS))};
        pg8::gemm_phase<EpiYs, MoeOrder, PG8_ALIGN, PG8_SP2>(F.lds, g, S, E);
        SEAM(9);
    }
    if (IN(10)) { p10_final(F, A); }
#undef IN
#undef SEAM
}

extern "C" void kernel_launch(void* const* d_in, const int* in_sizes, int n_in, void* d_out, int out_size, void* d_ws, size_t ws_size, hipStream_t stream) {
    static int grid = 0;
    if (grid == 0) {
        if (n_in != 18 || in_sizes[0] != MTOK * DM || out_size != MTOK * DM || ws_size < WS_END) {
            fprintf(stderr, "kernel_launch: unexpected shapes (n_in %d, in0 %d, out %d, ws %zu); nothing launched\n", n_in, n_in > 0 ? in_sizes[0] : -1, out_size, ws_size); grid = -1; return; }
        int dev = 0, cus = 0, per_cu = 0;
        if (hipGetDevice(&dev) != hipSuccess || hipDeviceGetAttribute(&cus, hipDeviceAttributeMultiprocessorCount, dev) != hipSuccess) { grid = -1; return; }
        if (hipFuncSetAttribute((const void*)mega_fwd, hipFuncAttributeMaxDynamicSharedMemorySize, LDS_BYTES) != hipSuccess) { fprintf(stderr, "kernel_launch: hipFuncSetAttribute failed\n"); grid = -1; return; }
        if (hipOccupancyMaxActiveBlocksPerMultiprocessor(&per_cu, (const void*)mega_fwd, NTHREADS, LDS_BYTES) != hipSuccess || per_cu < 1) { fprintf(stderr, "kernel_launch: occupancy query says %d\n", per_cu); per_cu = 1; }
        (void)hipGetLastError();
        grid = cus;
    }
    if (grid < 0) return;
    (void)hipMemsetAsync((char*)d_ws + WS_CTL, 0, CTL_ZERO_BYTES, stream);
    Args a{};
    for (int i = 0; i < 18; ++i) a.in[i] = (const float*)d_in[i];
    a.out = (float*)d_out; a.ws = (unsigned char*)d_ws;
#if MK_LAUNCHES == 1
    a.ph_lo = 0; a.ph_hi = NPHASE;
    void* kargs[] = {&a};
    hipError_t e = hipLaunchCooperativeKernel((const void*)mega_fwd, dim3(grid), dim3(NTHREADS), kargs, LDS_BYTES, stream);
    if (e != hipSuccess) fprintf(stderr, "kernel_launch: cooperative launch failed: %s (grid %d)\n", hipGetErrorString(e), grid);
#else
    for (int p = 0; p < NPHASE; ++p) { a.ph_lo = p; a.ph_hi = p + 1; hipLaunchKernelGGL(mega_fwd, dim3(grid), dim3(NTHREADS), LDS_BYTES, stream, a); }
#endif
}
```

```cpp
#include <hip/hip_runtime.h>
#include <hip/hip_cooperative_groups.h>
#include <cstdio>
#include <cstdint>
namespace cg = cooperative_groups;
namespace pg8 {
#define PG8_LAS __attribute__((address_space(3)))
typedef unsigned short bf16_t;
typedef short bf16x8 __attribute__((ext_vector_type(8)));
typedef float f32x4 __attribute__((ext_vector_type(4)));
typedef unsigned u32x4 __attribute__((ext_vector_type(4)));
constexpr int BM = 256, BK = 64, HALF = 128, HTB = HALF * BK * 2  , STAGE_BYTES = 8 * HTB, NXCD = 8, WGM = 8;

__host__ __device__ __forceinline__ int lds_byte(int r, int c) { const int st = (r >> 4) * 2 + (c >> 5), rr = r & 15, cc = c & 31, ob = rr * 64 + cc * 2; return st * 1024 + (ob ^ (((ob >> 9) & 1) << 5)); }
__host__ __device__ __forceinline__ void stage_rc(int b, int& R, int& C) { const int st = b / 1024, sb = b % 1024, swz = sb ^ (((sb >> 9) & 1) << 5); R = (st >> 1) * 16 + swz / 64; C = (st & 1) * 32 + (swz % 64) / 2; }
__host__ __device__ __forceinline__ int perm32(int rho) { const int n = rho >> 4, i = rho & 15; return 8 * (i >> 2) + 4 * n + (i & 3); }

struct Unit { int pm, pn; };
struct Gemm { const bf16_t* A; const bf16_t* Bt; int M, N, K; };

struct StaticOrder {
    int nM, nN, nwg, G, c;
    __host__ __device__ void init(int M, int N, int G_, int c_) { nM = M / BM; nN = N / BM; nwg = nM * nN; G = G_; c = c_; }
    __host__ __device__ bool next(int i, Unit& u) const {
        const long L = (long)i * G + c; if (L >= nwg) return false;
        int wgid = (int)L; { const int q = nwg / NXCD, r = nwg % NXCD, xcd = wgid % NXCD, off = wgid / NXCD; wgid = (xcd < r ? xcd * (q + 1) : r * (q + 1) + (xcd - r) * q) + off; }
        const int nig = WGM * nN, gid = wgid / nig, fm = gid * WGM, gsz = (nM - fm) < WGM ? (nM - fm) : WGM;
        u.pm = fm + ((wgid % nig) % gsz); u.pn = (wgid % nig) / gsz; return true;
    }
    __device__ __forceinline__ void a_ready(const Unit&) const {}
    __device__ __forceinline__ void done(const Unit&) const {}
};

__device__ __forceinline__ unsigned cvt_pk_bf16(float lo, float hi) { unsigned r; asm volatile("v_cvt_pk_bf16_f32 %0, %1, %2" : "=v"(r) : "v"(lo), "v"(hi)); return r; }
template <class Epi, class Sched, bool ALIGN_EPI = false, bool SP2 = false>
__device__ __forceinline__ void gemm_phase(PG8_LAS unsigned char* lds, const Gemm g, const Sched& S, const Epi& E) {
    int tid_ = threadIdx.x; asm volatile("" : "+v"(tid_));
    const int tid = tid_, wid = __builtin_amdgcn_readfirstlane(tid >> 6), lane = tid & 63, wr = wid >> 2, wc = wid & 3, fr = lane & 15, fq = lane >> 4;
    const int K = g.K, nt = K / BK;
    unsigned voffA[2], voffB[2];
#pragma unroll
    for (int i = 0; i < 2; ++i) { int R, C; stage_rc(tid * 16 + i * 8192, R, C); const int Rb = Epi::PERM ? ((R & ~31) + perm32(R & 31)) : R;
        voffA[i] = (unsigned)(R * K + C) * 2u; voffB[i] = (unsigned)(Rb * K + C) * 2u; }
    const size_t kstep = (size_t)(BK * 2);
    const size_t hstep = (size_t)HALF * K * 2;
    const size_t tstep = 2 * hstep;
    const unsigned ldsw = (unsigned)wid * 1024u;
    const int aoff = lds_byte(wr * 64 + fr, fq * 8), boff = lds_byte(wc * 32 + fr, fq * 8);
#define PG8_SA(b, h) (((b) * 2 + (h)) * HTB)
#define PG8_SB(b, h) ((4 + (b) * 2 + (h)) * HTB)
#define PG8_STAGE(bufoff, gbase, voff) do { _Pragma("unroll") for (int _i = 0; _i < 2; ++_i) \
        __builtin_amdgcn_global_load_lds((const unsigned*)((const char*)(gbase) + (voff)[_i]), (PG8_LAS unsigned*)(lds + (bufoff) + ldsw + _i * 8192), 16, 0, 0); } while (0)
#define PG8_LDA(dst, b, h) do { _Pragma("unroll") for (int m = 0; m < 4; ++m) _Pragma("unroll") for (int k = 0; k < 2; ++k) dst[m][k] = *(const PG8_LAS bf16x8*)(lds + PG8_SA(b, h) + aoff + m * 2048 + k * 1024); } while (0)
#define PG8_LDB(dst, b, h) do { _Pragma("unroll") for (int n = 0; n < 2; ++n) _Pragma("unroll") for (int k = 0; k < 2; ++k) dst[n][k] = *(const PG8_LAS bf16x8*)(lds + PG8_SB(b, h) + boff + n * 2048 + k * 1024); } while (0)
#define PG8_MMA(ai, bj, At, Bt) do { __builtin_amdgcn_s_setprio(1); _Pragma("unroll") for (int m = 0; m < 4; ++m) _Pragma("unroll") for (int n = 0; n < 2; ++n) _Pragma("unroll") for (int k = 0; k < 2; ++k) \
        acc[ai][bj][m][n] = __builtin_amdgcn_mfma_f32_16x16x32_bf16(Bt[n][k], At[m][k], acc[ai][bj][m][n], 0, 0, 0); __builtin_amdgcn_s_setprio(0); } while (0)
#define PG8_WAIT_V(n) asm volatile("s_waitcnt vmcnt(" #n ")" ::: "memory")
#define PG8_WAIT_L(n) asm volatile("s_waitcnt lgkmcnt(" #n ")" ::: "memory")
#define PG8_BAR __builtin_amdgcn_s_barrier()
#define PG8_SCHED __builtin_amdgcn_sched_barrier(0)
    Unit cur, nxt; int ui = 0;
    if (!S.next(0, cur)) return;
    f32x4 acc[2][2][4][2];
#pragma unroll
    for (int a = 0; a < 2; ++a)
#pragma unroll
        for (int b = 0; b < 2; ++b)
#pragma unroll
            for (int m = 0; m < 4; ++m)
#pragma unroll
                for (int n = 0; n < 2; ++n) acc[a][b][m][n] = (f32x4){0.f, 0.f, 0.f, 0.f};
    bf16x8 At[4][2], B0[2][2], B1[2][2];
    const char* cA = (const char*)g.A + (size_t)cur.pm * tstep; const char* cB = (const char*)g.Bt + (size_t)cur.pn * tstep;
    S.a_ready(cur);
    if constexpr (SP2) {
        PG8_STAGE(PG8_SB(0, 0), cB, voffB); PG8_STAGE(PG8_SB(0, 1), cB + hstep, voffB); PG8_STAGE(PG8_SA(0, 0), cA, voffA); PG8_STAGE(PG8_SA(0, 1), cA + hstep, voffA);
        if (wr == 1) PG8_BAR;
        PG8_WAIT_V(2); PG8_BAR;
        PG8_STAGE(PG8_SB(1, 0), cB + kstep, voffB); PG8_STAGE(PG8_SA(1, 0), cA + kstep, voffA); PG8_STAGE(PG8_SB(1, 1), cB + hstep + kstep, voffB);
        PG8_WAIT_V(6); PG8_BAR;
    } else {
        PG8_STAGE(PG8_SB(0, 0), cB, voffB); PG8_STAGE(PG8_SA(0, 0), cA, voffA); PG8_STAGE(PG8_SB(0, 1), cB + hstep, voffB); PG8_STAGE(PG8_SA(0, 1), cA + hstep, voffA);
        if (wr == 1) PG8_BAR;
        PG8_WAIT_V(4); PG8_BAR;
        PG8_STAGE(PG8_SB(1, 0), cB + kstep, voffB); PG8_STAGE(PG8_SA(1, 0), cA + kstep, voffA); PG8_STAGE(PG8_SB(1, 1), cB + hstep + kstep, voffB);
        PG8_WAIT_V(6); PG8_BAR;
    }
    for (;;) {
        const bool has_next = S.next(ui + 1, nxt);
        const char* nA = has_next ? (const char*)g.A + (size_t)nxt.pm * tstep : cA; const char* nB = has_next ? (const char*)g.Bt + (size_t)nxt.pn * tstep : cB;
        for (int t = 0; t < nt; t += 2) {
            const bool last = (t == nt - 2);
            const char* a1 = cA + (size_t)(t + 1) * kstep;
            const char* a2 = last ? nA : cA + (size_t)(t + 2) * kstep; const char* b2 = last ? nB : cB + (size_t)(t + 2) * kstep;
            const char* a3 = a2 + kstep; const char* b3 = b2 + kstep;
            if (last && has_next) S.a_ready(nxt);
            if constexpr (SP2) {
            PG8_LDB(B0, 0, 0); PG8_LDB(B1, 0, 1); PG8_SCHED; PG8_LDA(At, 0, 0); PG8_STAGE(PG8_SA(1, 1), a1 + hstep, voffA);
            PG8_WAIT_V(8); PG8_WAIT_L(0); PG8_BAR; PG8_MMA(0, 0, At, B0); PG8_MMA(0, 1, At, B1); PG8_BAR; PG8_SCHED;
            PG8_LDA(At, 0, 1); PG8_STAGE(PG8_SB(0, 0), b2, voffB); PG8_STAGE(PG8_SB(0, 1), b2 + hstep, voffB); PG8_STAGE(PG8_SA(0, 0), a2, voffA);
            PG8_WAIT_V(8); PG8_WAIT_L(0); PG8_BAR; PG8_MMA(1, 0, At, B0); PG8_MMA(1, 1, At, B1); PG8_BAR; PG8_SCHED;
            PG8_LDB(B0, 1, 0); PG8_LDB(B1, 1, 1); PG8_SCHED; PG8_LDA(At, 1, 0); PG8_STAGE(PG8_SA(0, 1), a2 + hstep, voffA);
            PG8_WAIT_V(8); PG8_WAIT_L(0); PG8_BAR; PG8_MMA(0, 0, At, B0); PG8_MMA(0, 1, At, B1); PG8_BAR; PG8_SCHED;
            PG8_LDA(At, 1, 1); PG8_STAGE(PG8_SB(1, 0), b3, voffB); PG8_STAGE(PG8_SB(1, 1), b3 + hstep, voffB); PG8_STAGE(PG8_SA(1, 0), a3, voffA);
            PG8_WAIT_V(8); PG8_WAIT_L(0); PG8_BAR; PG8_MMA(1, 0, At, B0); PG8_MMA(1, 1, At, B1); PG8_BAR; PG8_SCHED;
            } else {
            PG8_LDB(B0, 0, 0); PG8_SCHED; PG8_LDA(At, 0, 0); PG8_STAGE(PG8_SA(1, 1), a1 + hstep, voffA);
            PG8_WAIT_L(8); PG8_BAR; PG8_WAIT_L(0); PG8_MMA(0, 0, At, B0); PG8_BAR; PG8_SCHED;
            PG8_LDB(B1, 0, 1); PG8_STAGE(PG8_SB(0, 0), b2, voffB);
            PG8_BAR; PG8_WAIT_L(0); PG8_MMA(0, 1, At, B1); PG8_BAR;
            PG8_LDA(At, 0, 1); PG8_STAGE(PG8_SA(0, 0), a2, voffA);
            PG8_BAR; PG8_WAIT_L(0); PG8_MMA(1, 0, At, B0); PG8_BAR; PG8_SCHED;
            PG8_STAGE(PG8_SB(0, 1), b2 + hstep, voffB);
            PG8_WAIT_V(6); PG8_BAR; PG8_MMA(1, 1, At, B1); PG8_BAR;
            PG8_LDB(B0, 1, 0); PG8_SCHED; PG8_LDA(At, 1, 0); PG8_STAGE(PG8_SA(0, 1), a2 + hstep, voffA);
            PG8_WAIT_L(8); PG8_BAR; PG8_WAIT_L(0); PG8_MMA(0, 0, At, B0); PG8_BAR; PG8_SCHED;
            PG8_LDB(B1, 1, 1); PG8_STAGE(PG8_SB(1, 0), b3, voffB);
            PG8_BAR; PG8_WAIT_L(0); PG8_MMA(0, 1, At, B1); PG8_BAR;
            PG8_LDA(At, 1, 1); PG8_STAGE(PG8_SA(1, 0), a3, voffA);
            PG8_BAR; PG8_WAIT_L(0); PG8_MMA(1, 0, At, B0); PG8_BAR; PG8_SCHED;
            PG8_STAGE(PG8_SB(1, 1), b3 + hstep, voffB);
            PG8_WAIT_V(6); PG8_BAR; PG8_MMA(1, 1, At, B1); PG8_BAR;
            }
        }
        if constexpr (ALIGN_EPI) { if (wr == 0) PG8_BAR; }
        if constexpr (!Epi::AFTER_DRAIN) { E(acc, cur, wr, wc, fr, fq); S.done(cur); }
        if (!has_next) break;
#pragma unroll
        for (int a = 0; a < 2; ++a)
#pragma unroll
            for (int b = 0; b < 2; ++b)
#pragma unroll
                for (int m = 0; m < 4; ++m)
#pragma unroll
                    for (int n = 0; n < 2; ++n) acc[a][b][m][n] = (f32x4){0.f, 0.f, 0.f, 0.f};
        cur = nxt; cA = nA; cB = nB; ++ui;
        if constexpr (ALIGN_EPI) { if (wr == 1) PG8_BAR; }
    }
    PG8_WAIT_V(0);
    if constexpr (!ALIGN_EPI) { if (wr == 0) PG8_BAR; }
    PG8_BAR;
    if constexpr (Epi::AFTER_DRAIN) { E.fused(acc, cur, wr, wc, fr, fq, lds, wid, lane); S.done(cur); }
#undef PG8_SA
#undef PG8_SB
#undef PG8_STAGE
#undef PG8_LDA
#undef PG8_LDB
#undef PG8_MMA
#undef PG8_WAIT_V
#undef PG8_WAIT_L
#undef PG8_BAR
#undef PG8_SCHED
}
}


#ifndef PG8_SP2
#define PG8_SP2 true
#endif
#ifndef PG8_ALIGN
#define PG8_ALIGN true
#endif
#ifndef MK_LAUNCHES
#define MK_LAUNCHES 1
#endif

#define GAS __attribute__((address_space(1)))
#define LAS __attribute__((address_space(3)))
typedef unsigned short bf16;
typedef float f32x4 __attribute__((ext_vector_type(4)));
typedef unsigned u32x4 __attribute__((ext_vector_type(4)));
typedef unsigned u32x2 __attribute__((ext_vector_type(2)));

constexpr int NB = 8, SEQ = 4096, DM = 1024, NMETA = 16;
constexpr int ROWS = 4160, PADR = 48, TOK0 = 64;
constexpr int MTOK = NB * SEQ;
constexpr int NIN = 3584;
constexpr int BROWS = NB * ROWS;
constexpr size_t ARR = (size_t)BROWS * 512;
constexpr int NCH = 64;
constexpr int NEXP = 16, DEXP = 512;
constexpr int XS_ROWS = 69632;
constexpr float ALPHA = 1.189207115002721f;
constexpr float LN_EPS = 1e-5f, RMS_EPS = 1e-6f;
constexpr float LOG2E = 1.4426950408889634f;
constexpr float C2Q = 0.125f * LOG2E;
constexpr float STICK_THR = 48.0f;

constexpr size_t MiB = 1u << 20;
constexpr size_t WS_CTL = 0, CTL_ZERO_BYTES = 1 * MiB;
constexpr size_t WS_WIN = 1 * MiB;
constexpr size_t WS_WOUT = 8 * MiB;
constexpr size_t WS_LB = 10 * MiB;
constexpr size_t WS_META = 11 * MiB;
constexpr size_t WS_DV = 12 * MiB;
constexpr size_t WS_XB = 16 * MiB;
constexpr size_t WS_S = 16 * MiB;
constexpr size_t WS_PROJ = 80 * MiB;
constexpr size_t WS_U = 308 * MiB;
constexpr size_t WS_MIX = 436 * MiB;
constexpr size_t WS_W13 = 80 * MiB;
constexpr size_t WS_W2 = 112 * MiB;
constexpr size_t WS_XS = 128 * MiB;
constexpr size_t WS_HID = 264 * MiB;
constexpr size_t WS_YS = 332 * MiB;
constexpr size_t WS_END = 500 * MiB;
static_assert(WS_PROJ + 7 * ARR * 2 <= WS_U && WS_U + (size_t)32 * 64 * 16384 * 4 <= WS_MIX && WS_MIX + (size_t)MTOK * DM * 2 <= WS_END, "ws map A");
static_assert(WS_W13 + (size_t)16 * 1024 * 1024 * 2 <= WS_W2 && WS_W2 + (size_t)16 * 1024 * 512 * 2 <= WS_XS && WS_XS + (size_t)XS_ROWS * 1024 * 2 <= WS_HID &&
              WS_HID + (size_t)XS_ROWS * 512 * 2 <= WS_YS && WS_YS + (size_t)XS_ROWS * 1024 * 2 <= WS_END, "ws map B");
constexpr int CW_CNT = 64;
constexpr int CW_BAR = 4096;
constexpr int MISC_BAR = 100;

constexpr int RING_BYTES = 131072;
constexpr int MISC_OFF = RING_BYTES;
constexpr int LDS_BYTES = 147456;
constexpr int NWAVES = 8, NTHREADS = 512;

__device__ __forceinline__ unsigned f2bf(float f) { unsigned u = __builtin_bit_cast(unsigned, f); return (u + 0x7fffu + ((u >> 16) & 1u)) >> 16; }
__device__ __forceinline__ unsigned pk2(float lo, float hi) { return f2bf(lo) | (f2bf(hi) << 16); }
__device__ __forceinline__ float bf2f(unsigned h) { return __builtin_bit_cast(float, h << 16); }
__device__ __forceinline__ float bflo(unsigned w) { return __builtin_bit_cast(float, w << 16); }
__device__ __forceinline__ float bfhi(unsigned w) { return __builtin_bit_cast(float, w & 0xffff0000u); }
__device__ __forceinline__ float ex2(float x) { return __builtin_amdgcn_exp2f(x); }
__device__ __forceinline__ float lg2(float x) { return __builtin_amdgcn_logf(x); }
__device__ __forceinline__ float rcpf_(float x) { return __builtin_amdgcn_rcpf(x); }
__device__ __forceinline__ float sigm(float v) { return rcpf_(1.f + ex2(-v * LOG2E)); }
__device__ __forceinline__ float wave_sum(float v) {
#pragma unroll
    for (int o = 1; o < 64; o <<= 1) v += __shfl_xor(v, o);
    return v;
}
template <int XF> __device__ __forceinline__ float xform(float v, float lb) {
    if (XF == 0) return v * sigm(v);
    if (XF == 1) return lg2(lb + (1.f - lb) * sigm(v));
    if (XF == 3) return sigm(v);
    if (XF == 4) return v * C2Q;
    return v;
}
__device__ __forceinline__ float xform_rt(int kind, float v, float lb) {
    switch (kind) { case 0: return xform<0>(v, lb); case 1: return xform<1>(v, lb); case 3: return xform<3>(v, lb); case 4: return xform<4>(v, lb); default: return v; }
}

using pg8::Unit;
struct EpiProj {
    static constexpr bool PERM = true, AFTER_DRAIN = false;
    bf16* proj; const float* lb;
    template <int XF> __device__ __forceinline__ void run(int kind, const f32x4 (&acc)[2][2][4][2], const Unit& u, int wr, int wc, int fr, int fq) const {
        const int b = u.pm >> 4;
        const int r0 = b * ROWS + TOK0 + (u.pm & 15) * 256 + wr * 64 + fr;
        const int c0 = (u.pn & 1) * 256 + wc * 32 + 8 * fq;
        bf16* base = proj + (size_t)kind * ARR;
        f32x4 l0[2], l1[2];
#pragma unroll
        for (int bj = 0; bj < 2; ++bj) {
            if (XF == 1) { l0[bj] = *(const f32x4*)(lb + c0 + bj * 128); l1[bj] = *(const f32x4*)(lb + c0 + bj * 128 + 4); }
            else { l0[bj] = (f32x4){0.f, 0.f, 0.f, 0.f}; l1[bj] = l0[bj]; }
        }
#pragma unroll
        for (int ai = 0; ai < 2; ++ai)
#pragma unroll
            for (int m = 0; m < 4; ++m) {
                bf16* rowp = base + (size_t)(r0 + ai * 128 + m * 16) * 512 + c0;
#pragma unroll
                for (int bj = 0; bj < 2; ++bj) {
                    const f32x4 v0 = acc[ai][bj][m][0], v1 = acc[ai][bj][m][1];
                    u32x4 w;
                    w.x = pk2(xform<XF>(v0[0], l0[bj][0]), xform<XF>(v0[1], l0[bj][1]));
                    w.y = pk2(xform<XF>(v0[2], l0[bj][2]), xform<XF>(v0[3], l0[bj][3]));
                    w.z = pk2(xform<XF>(v1[0], l1[bj][0]), xform<XF>(v1[1], l1[bj][1]));
                    w.w = pk2(xform<XF>(v1[2], l1[bj][2]), xform<XF>(v1[3], l1[bj][3]));
                    *(u32x4*)(rowp + bj * 128) = w;
                }
            }
    }
    __device__ __forceinline__ void run_t(int kind, const f32x4 (&acc)[2][2][4][2], const Unit& u, int wr, int wc, int fr, int fq) const {
        const int b = u.pm >> 4;
        const int rb = TOK0 + (u.pm & 15) * 256 + wr * 64 + fr;
        const int c0 = (u.pn & 1) * 256 + wc * 32 + 8 * fq;
        bf16* base = proj + (size_t)kind * ARR + (size_t)(b * 512 + c0) * ROWS + rb;
#pragma unroll
        for (int ai = 0; ai < 2; ++ai)
#pragma unroll
            for (int m = 0; m < 4; ++m)
#pragma unroll
                for (int bj = 0; bj < 2; ++bj) {
                    bf16* p = base + (size_t)(bj * 128) * ROWS + ai * 128 + m * 16;
                    const f32x4 v0 = acc[ai][bj][m][0], v1 = acc[ai][bj][m][1];
                    p[0] = (bf16)f2bf(v0[0]); p[ROWS] = (bf16)f2bf(v0[1]); p[2 * ROWS] = (bf16)f2bf(v0[2]); p[3 * ROWS] = (bf16)f2bf(v0[3]);
                    p[4 * ROWS] = (bf16)f2bf(v1[0]); p[5 * ROWS] = (bf16)f2bf(v1[1]); p[6 * ROWS] = (bf16)f2bf(v1[2]); p[7 * ROWS] = (bf16)f2bf(v1[3]);
                }
    }
    __device__ __forceinline__ void operator()(const f32x4 (&acc)[2][2][4][2], const Unit& u, int wr, int wc, int fr, int fq) const {
        const int kind = u.pn >> 1;
        if (kind == 2 || kind == 6) run_t(kind, acc, u, wr, wc, fr, fq);
        else if (kind == 0) run<0>(kind, acc, u, wr, wc, fr, fq);
        else if (kind == 1) run<1>(kind, acc, u, wr, wc, fr, fq);
        else if (kind == 3) run<3>(kind, acc, u, wr, wc, fr, fq);
        else if (kind == 4) run<4>(kind, acc, u, wr, wc, fr, fq);
        else run<2>(kind, acc, u, wr, wc, fr, fq);
    }
};
struct EpiOut {
    static constexpr bool PERM = false, AFTER_DRAIN = false;
    const float* x; float* out;
    __device__ __forceinline__ void operator()(const f32x4 (&acc)[2][2][4][2], const Unit& u, int wr, int wc, int fr, int fq) const {
        const int row0 = u.pm * 256 + wr * 64 + fr, col0 = u.pn * 256 + wc * 32 + 4 * fq;
#pragma unroll
        for (int ai = 0; ai < 2; ++ai)
#pragma unroll
            for (int m = 0; m < 4; ++m) {
                const size_t ro = (size_t)(row0 + ai * 128 + m * 16) * DM + col0;
#pragma unroll
                for (int bj = 0; bj < 2; ++bj)
#pragma unroll
                    for (int n = 0; n < 2; ++n) {
                        const f32x4 xv = *(const f32x4*)(x + ro + bj * 128 + 16 * n);
                        *(f32x4*)(out + ro + bj * 128 + 16 * n) = acc[ai][bj][m][n] + xv * ALPHA;
                    }
            }
    }
};
struct EpiHid {
    static constexpr bool PERM = true, AFTER_DRAIN = false;
    bf16* hid;
    __device__ __forceinline__ void operator()(const f32x4 (&acc)[2][2][4][2], const Unit& u, int wr, int wc, int fr, int fq) const {
        const int row0 = u.pm * 256 + wr * 64 + fr, hc0 = (u.pn & 3) * 128 + wc * 16 + 4 * fq;
#pragma unroll
        for (int ai = 0; ai < 2; ++ai)
#pragma unroll
            for (int m = 0; m < 4; ++m) {
                bf16* rowp = hid + (size_t)(row0 + ai * 128 + m * 16) * DEXP + hc0;
#pragma unroll
                for (int bj = 0; bj < 2; ++bj) {
                    const f32x4 g = acc[ai][bj][m][0], up = acc[ai][bj][m][1];
                    u32x2 w;
                    w.x = pk2(g[0] * sigm(g[0]) * up[0], g[1] * sigm(g[1]) * up[1]);
                    w.y = pk2(g[2] * sigm(g[2]) * up[2], g[3] * sigm(g[3]) * up[3]);
                    *(u32x2*)(rowp + bj * 64) = w;
                }
            }
    }
};
struct EpiYs {
    static constexpr bool PERM = true, AFTER_DRAIN = false;
    bf16* ys;
    __device__ __forceinline__ void operator()(const f32x4 (&acc)[2][2][4][2], const Unit& u, int wr, int wc, int fr, int fq) const {
        const int row0 = u.pm * 256 + wr * 64 + fr, col0 = (u.pn & 3) * 256 + wc * 32 + 8 * fq;
#pragma unroll
        for (int ai = 0; ai < 2; ++ai)
#pragma unroll
            for (int m = 0; m < 4; ++m) {
                bf16* rowp = ys + (size_t)(row0 + ai * 128 + m * 16) * DM + col0;
#pragma unroll
                for (int bj = 0; bj < 2; ++bj) {
                    const f32x4 v0 = acc[ai][bj][m][0], v1 = acc[ai][bj][m][1];
                    u32x4 w; w.x = pk2(v0[0], v0[1]); w.y = pk2(v0[2], v0[3]); w.z = pk2(v1[0], v1[1]); w.w = pk2(v1[2], v1[3]);
                    *(u32x4*)(rowp + bj * 128) = w;
                }
            }
    }
};
struct MoeOrder {
    const LAS int* toff; int G, c, ntot;
    __device__ __forceinline__ bool next(int i, Unit& u) const {
        const long L = (long)i * G + c; if (L >= (long)ntot * 4) return false;
        const int mt = (int)(L >> 2), pl = (int)(L & 3); int e = 0;
#pragma unroll
        for (int j = 1; j < NEXP; ++j) e += (mt >= toff[j]) ? 1 : 0;
        u.pm = mt; u.pn = e * 4 + pl; return true;
    }
    __device__ __forceinline__ void a_ready(const Unit&) const {}
    __device__ __forceinline__ void done(const Unit&) const {}
};

struct Args { const float* in[18]; float* out; unsigned char* ws; int ph_lo, ph_hi; };
struct Frame {
    LAS unsigned char* lds; LAS int* misc;
    int tid, lane, wave, G, gw, ngw;
};

template <int MODE> __device__ __forceinline__ int rowmap(int n) { return MODE == 0 ? n : ((n >> 2) * 8 + (n & 3) + (MODE == 2 ? 4 : 0)); }
template <int MODE> __device__ __forceinline__ void transpose_item(const float* W, int K, int N, bf16* WT, LAS float* scr, int item, int lane) {
    const int nblk = N / 32, kb = item / nblk, nb = item % nblk, k0 = 64 * kb, n0 = 32 * nb;
#pragma unroll 8
    for (int i = 0; i < 32; ++i) { const int kk = 2 * i + (lane >> 5); scr[kk * 33 + (lane & 31)] = W[(size_t)(k0 + kk) * N + n0 + (lane & 31)]; }
    asm volatile("s_waitcnt lgkmcnt(0)" ::: "memory");
    const int c = lane & 7;
#pragma unroll
    for (int j = 0; j < 4; ++j) { const int n = (lane >> 3) + 8 * j; const LAS float* s = scr + (8 * c) * 33 + n;
        u32x4 o; o.x = pk2(s[0 * 33], s[1 * 33]); o.y = pk2(s[2 * 33], s[3 * 33]); o.z = pk2(s[4 * 33], s[5 * 33]); o.w = pk2(s[6 * 33], s[7 * 33]);
        *(u32x4*)(WT + (size_t)rowmap<MODE>(n0 + n) * K + k0 + 8 * c) = o; }
    asm volatile("s_waitcnt lgkmcnt(0)" ::: "memory");
}

__device__ __forceinline__ void p0_prep(Frame& F, const Args& A) {
    LAS float* scr = (LAS float*)(F.lds + F.wave * 16384);
    const int gtid = blockIdx.x * NTHREADS + F.tid, gthreads = F.G * NTHREADS;
    for (int i = gtid; i < 512; i += gthreads) ((float*)(A.ws + WS_LB))[i] = 1.f / (1.f + __expf(A.in[3][512 + i] - A.in[3][i]));
    for (int i = gtid; i < 7 * NB * 3072; i += gthreads) {
        const int a = i / (NB * 3072), r = i % (NB * 3072), b = r / 3072, o = r % 3072;
        if (a == 2 || a == 6) { const int c = o / 6, p = o % 6;
            *(u32x4*)(((bf16*)(A.ws + WS_PROJ)) + (size_t)a * ARR + (size_t)(b * 512 + c) * ROWS + p * 8) = (u32x4){0u, 0u, 0u, 0u}; }
        else *(u32x4*)(((bf16*)(A.ws + WS_PROJ)) + (size_t)a * ARR + (size_t)b * ROWS * 512 + (size_t)o * 8) = (u32x4){0u, 0u, 0u, 0u};
    }
    for (int job = F.gw; job < 56 * 4; job += F.ngw) {
        const int cgp = job >> 2, rq = job & 3, n = cgp * 64 + F.lane, kind = cgp >> 3;
        float acc0 = 0.f, acc1 = 0.f, acc2 = 0.f, acc3 = 0.f;
        const float* mt = A.in[1] + (size_t)(4 * rq) * DM;
#pragma unroll 8
        for (int k = 0; k < DM; ++k) {
            const float w = A.in[2][(size_t)k * NIN + n];
            acc0 += mt[k] * w; acc1 += mt[DM + k] * w; acc2 += mt[2 * DM + k] * w; acc3 += mt[3 * DM + k] * w;
        }
        const int col = n & 511;
        const float lbv = 1.f / (1.f + __expf(A.in[3][512 + col] - A.in[3][col]));
        const unsigned short o0 = (unsigned short)f2bf(xform_rt(kind, acc0, lbv)), o1 = (unsigned short)f2bf(xform_rt(kind, acc1, lbv)),
                             o2 = (unsigned short)f2bf(xform_rt(kind, acc2, lbv)), o3 = (unsigned short)f2bf(xform_rt(kind, acc3, lbv));
        bf16* base = ((bf16*)(A.ws + WS_PROJ)) + (size_t)kind * ARR;
        for (int b = 0; b < NB; ++b) {
            if (kind == 2 || kind == 6) { bf16* p = base + (size_t)(b * 512 + col) * ROWS + PADR + 4 * rq; p[0] = o0; p[1] = o1; p[2] = o2; p[3] = o3; }
            else { bf16* p = base + col + (size_t)(b * ROWS + PADR + 4 * rq) * 512; p[0] = o0; p[512] = o1; p[1024] = o2; p[1536] = o3; }
        }
    }
    constexpr int I_IN = (DM / 64) * (NIN / 32), I_OUT = (DM / 64) * (DM / 32);
    for (int it = F.gw; it < I_IN + I_OUT; it += F.ngw) {
        if (it < I_IN) transpose_item<0>(A.in[2], DM, NIN, ((bf16*)(A.ws + WS_WIN)), scr, it, F.lane);
        else transpose_item<0>(A.in[6], DM, DM, ((bf16*)(A.ws + WS_WOUT)), scr, it - I_IN, F.lane);
    }
    for (int m = F.gw; m < MTOK; m += F.ngw) {
        const f32x4* xr = (const f32x4*)(A.in[0] + (size_t)m * DM) + F.lane;
        u32x2* o8 = (u32x2*)(((bf16*)(A.ws + WS_XB)) + (size_t)m * DM) + F.lane;
#pragma unroll
        for (int j = 0; j < 4; ++j) { const f32x4 v = xr[64 * j]; u32x2 w; w.x = pk2(v[0], v[1]); w.y = pk2(v[2], v[3]); o8[64 * j] = w; }
    }
}

__device__ __forceinline__ void ha_unit(Frame& F, const Args& A, int bh, int c) {
    const int b = bh >> 2, h = bh & 3, tid = F.tid;
    LAS float* VV = (LAS float*)F.lds;
    LAS float* KH = VV + 64 * 128;
    LAS float* TOT = KH + 64 * 128;
    const int d = tid & 127, sq = tid >> 7;
    const size_t rb = (size_t)(b * ROWS + 64 * c + 16 * sq) * 512 + 128 * h + d;
    const bf16* LF = ((bf16*)(A.ws + WS_PROJ)) + 1 * ARR; const bf16* HV = ((bf16*)(A.ws + WS_PROJ)) + 2 * ARR;
    const size_t vb = (size_t)(b * 512 + 128 * h + d) * ROWS + 64 * c + 16 * sq;
    float lf[16], pre[16]; float run = 0.f;
#pragma unroll
    for (int i = 0; i < 16; ++i) { lf[i] = bf2f(LF[rb + (size_t)i * 512]); VV[(16 * sq + i) * 128 + d] = bf2f(HV[vb + i]); }
#pragma unroll
    for (int i = 0; i < 16; ++i) { run += lf[i]; pre[i] = run; }
    TOT[sq * 128 + d] = run;
    __syncthreads();
    float off = 0.f, blast = 0.f;
#pragma unroll
    for (int q = 0; q < 4; ++q) { const float t = TOT[q * 128 + d]; off += (q < sq) ? t : 0.f; blast += t; }
#pragma unroll
    for (int i = 0; i < 16; ++i) { const float bc = off + pre[i]; KH[(16 * sq + i) * 128 + d] = (1.f - ex2(lf[i])) * ex2(blast - bc); }
    if (sq == 0) ((float*)(A.ws + WS_DV))[(size_t)(bh * 64 + c) * 128 + d] = ex2(blast);
    __syncthreads();
    const int vq = tid >> 4, dq = tid & 15;
    f32x4 a0[4], a1[4];
#pragma unroll
    for (int a = 0; a < 4; ++a) { a0[a] = (f32x4){0.f, 0.f, 0.f, 0.f}; a1[a] = a0[a]; }
#pragma unroll 4
    for (int s = 0; s < 64; ++s) {
        const f32x4 vv = *(const LAS f32x4*)(VV + s * 128 + 4 * vq);
        const f32x4 k0 = *(const LAS f32x4*)(KH + s * 128 + 8 * dq), k1 = *(const LAS f32x4*)(KH + s * 128 + 8 * dq + 4);
#pragma unroll
        for (int a = 0; a < 4; ++a) { a0[a] += k0 * vv[a]; a1[a] += k1 * vv[a]; }
    }
    float* up = ((float*)(A.ws + WS_U)) + (size_t)(bh * 64 + c) * 16384 + (size_t)(4 * vq) * 128 + 8 * dq;
#pragma unroll
    for (int a = 0; a < 4; ++a) { *(f32x4*)(up + a * 128) = a0[a]; *(f32x4*)(up + a * 128 + 4) = a1[a]; }
    __syncthreads();
}

typedef float f32x16 __attribute__((ext_vector_type(16)));
typedef short s16x8 __attribute__((ext_vector_type(8)));
__device__ __forceinline__ s16x8 pack8(u32x2 a, u32x2 c) { const u32x4 w = (u32x4){a.x, a.y, c.x, c.y}; return __builtin_bit_cast(s16x8, w); }
__device__ __forceinline__ void attn_phase(Frame& F, const Args& A) {
    const bf16* SQ = ((bf16*)(A.ws + WS_PROJ)) + 4 * ARR; const bf16* SK = ((bf16*)(A.ws + WS_PROJ)) + 5 * ARR; const bf16* SVT = ((bf16*)(A.ws + WS_PROJ)) + 6 * ARR;
    const int r32 = F.lane & 31, hi = F.lane >> 5;
    for (int wu = F.gw; wu < 64 * 128; wu += F.ngw) {
        const int bh = wu >> 7, qi = wu & 127, b = bh >> 3, h = bh & 7, q0 = TOK0 + 32 * qi, qrow = q0 + r32;
        s16x8 qf[4];
        { const bf16* qp = SQ + (size_t)(b * ROWS + qrow) * 512 + 64 * h + 8 * hi;
#pragma unroll
          for (int s2 = 0; s2 < 4; ++s2) qf[s2] = *(const s16x8*)(qp + 16 * s2); }
        const bf16* kbase = SK + (size_t)(b * ROWS + r32) * 512 + 64 * h + 8 * hi;
        const bf16* vbase = SVT + (size_t)(b * 512 + 64 * h + r32) * ROWS + 4 * hi;
        f32x16 o0, o1;
#pragma unroll
        for (int r = 0; r < 16; ++r) { o0[r] = 0.f; o1[r] = 0.f; }
        float T = 0.f;
        const int ktd = q0 >> 5;
        s16x8 kf[4]; u32x2 vlo[2][2], vhi[2][2];
        { const bf16* kp = kbase + (size_t)(32 * ktd) * 512; const bf16* vp = vbase + 32 * ktd;
#pragma unroll
          for (int s2 = 0; s2 < 4; ++s2) kf[s2] = *(const s16x8*)(kp + 16 * s2);
#pragma unroll
          for (int dt = 0; dt < 2; ++dt)
#pragma unroll
              for (int s2 = 0; s2 < 2; ++s2) { vlo[dt][s2] = *(const u32x2*)(vp + (size_t)dt * 32 * ROWS + 16 * s2); vhi[dt][s2] = *(const u32x2*)(vp + (size_t)dt * 32 * ROWS + 16 * s2 + 8); } }
        for (int kt = ktd; kt >= 1; --kt) {
            const int k0 = 32 * kt;
            f32x16 p;
#pragma unroll
            for (int r = 0; r < 16; ++r) p[r] = 0.f;
#pragma unroll
            for (int s2 = 0; s2 < 4; ++s2) p = __builtin_amdgcn_mfma_f32_32x32x16_bf16(kf[s2], qf[s2], p, 0, 0, 0);
            s16x8 va[2][2];
#pragma unroll
            for (int dt = 0; dt < 2; ++dt)
#pragma unroll
                for (int s2 = 0; s2 < 2; ++s2) va[dt][s2] = pack8(vlo[dt][s2], vhi[dt][s2]);
            if (kt > 1) {
                const bf16* kp = kbase + (size_t)(k0 - 32) * 512; const bf16* vp = vbase + (k0 - 32);
#pragma unroll
                for (int s2 = 0; s2 < 4; ++s2) kf[s2] = *(const s16x8*)(kp + 16 * s2);
#pragma unroll
                for (int dt = 0; dt < 2; ++dt)
#pragma unroll
                    for (int s2 = 0; s2 < 2; ++s2) { vlo[dt][s2] = *(const u32x2*)(vp + (size_t)dt * 32 * ROWS + 16 * s2); vhi[dt][s2] = *(const u32x2*)(vp + (size_t)dt * 32 * ROWS + 16 * s2 + 8); }
            }
            const bool edge = (kt == ktd) || (kt == 1);
            float sp[16], iss[16], gs[4];
#pragma unroll
            for (int r = 0; r < 16; ++r) {
                const float z = fminf(p[r], 100.f); p[r] = z;
                float v = lg2(1.f + ex2(z));
                if (edge) { const int key = k0 + (r & 3) + 8 * (r >> 2) + 4 * hi; if (!(key >= PADR && key < qrow)) v = 0.f; }
                sp[r] = v;
            }
#pragma unroll
            for (int g = 0; g < 4; ++g) { iss[4 * g + 3] = sp[4 * g + 3]; iss[4 * g + 2] = iss[4 * g + 3] + sp[4 * g + 2]; iss[4 * g + 1] = iss[4 * g + 2] + sp[4 * g + 1]; iss[4 * g] = iss[4 * g + 1] + sp[4 * g]; gs[g] = iss[4 * g]; }
            float sg[4], go[4];
#pragma unroll
            for (int g = 0; g < 4; ++g) { const auto rr = __builtin_amdgcn_permlane32_swap(__float_as_uint(gs[g]), __float_as_uint(gs[g]), false, false);
                sg[g] = __uint_as_float(rr[0]) + __uint_as_float(rr[1]); go[g] = hi ? 0.f : __uint_as_float(rr[1]); }
            float off[4];
            off[3] = T + go[3]; const float e2 = sg[3]; off[2] = T + e2 + go[2]; const float e1 = e2 + sg[2]; off[1] = T + e1 + go[1]; const float e0 = e1 + sg[1]; off[0] = T + e0 + go[0];
            T += e0 + sg[0];
            float a[16];
#pragma unroll
            for (int r = 0; r < 16; ++r) {
                float v = ex2(p[r] - (off[r >> 2] + iss[r]));
                if (edge) { const int key = k0 + (r & 3) + 8 * (r >> 2) + 4 * hi; if (!(key >= PADR && key < qrow)) v = 0.f; }
                a[r] = v;
            }
#pragma unroll
            for (int s2 = 0; s2 < 2; ++s2) {
                u32x4 w; w.x = pk2(a[8 * s2], a[8 * s2 + 1]); w.y = pk2(a[8 * s2 + 2], a[8 * s2 + 3]); w.z = pk2(a[8 * s2 + 4], a[8 * s2 + 5]); w.w = pk2(a[8 * s2 + 6], a[8 * s2 + 7]);
                const s16x8 pb = __builtin_bit_cast(s16x8, w);
                o0 = __builtin_amdgcn_mfma_f32_32x32x16_bf16(va[0][s2], pb, o0, 0, 0, 0);
                o1 = __builtin_amdgcn_mfma_f32_32x32x16_bf16(va[1][s2], pb, o1, 0, 0, 0);
            }
            if (__all(T > STICK_THR)) break;
        }
        float ss = 0.f;
#pragma unroll
        for (int r = 0; r < 16; ++r) ss += o0[r] * o0[r] + o1[r] * o1[r];
        { const auto rr = __builtin_amdgcn_permlane32_swap(__float_as_uint(ss), __float_as_uint(ss), false, false); ss = __uint_as_float(rr[0]) + __uint_as_float(rr[1]); }
        const float rs = 1.0f / sqrtf(ss * (1.f / 64.f) + RMS_EPS);
        const float* gp = A.in[5] + 64 * h + 4 * hi;
        bf16* op = ((bf16*)(A.ws + WS_MIX)) + (size_t)(b * SEQ + qrow - TOK0) * DM + 512 + 64 * h + 4 * hi;
#pragma unroll
        for (int g = 0; g < 4; ++g) {
            const f32x4 g0 = *(const f32x4*)(gp + 8 * g), g1 = *(const f32x4*)(gp + 32 + 8 * g);
            u32x2 w0, w1;
            w0.x = pk2(o0[4 * g] * rs * g0[0], o0[4 * g + 1] * rs * g0[1]); w0.y = pk2(o0[4 * g + 2] * rs * g0[2], o0[4 * g + 3] * rs * g0[3]);
            w1.x = pk2(o1[4 * g] * rs * g1[0], o1[4 * g + 1] * rs * g1[1]); w1.y = pk2(o1[4 * g + 2] * rs * g1[2], o1[4 * g + 3] * rs * g1[3]);
            *(u32x2*)(op + 8 * g) = w0; *(u32x2*)(op + 32 + 8 * g) = w1;
        }
    }
}

__device__ __forceinline__ void hb_phase(Frame& F, const Args& A) {
    for (int g = blockIdx.x * NTHREADS + F.tid; g < 32 * 4096; g += F.G * NTHREADS) {
        const int bh = g >> 12, r = g & 4095, v = r >> 5, d4 = (r & 31) * 4;
        const float* up = ((float*)(A.ws + WS_U)) + (size_t)bh * 64 * 16384 + v * 128 + d4;
        const float* dp = ((float*)(A.ws + WS_DV)) + (size_t)bh * 64 * 128 + d4;
        bf16* sp = ((bf16*)(A.ws + WS_S)) + (size_t)bh * 64 * 16384 + v * 128 + d4;
        f32x4 s = (f32x4){0.f, 0.f, 0.f, 0.f};
#pragma unroll 8
        for (int c = 0; c < 64; ++c) {
            const f32x4 uu = *(const f32x4*)(up + (size_t)c * 16384), dd = *(const f32x4*)(dp + c * 128);
            s = dd * s + uu;
            u32x2 w; w.x = pk2(s[0], s[1]); w.y = pk2(s[2], s[3]);
            *(u32x2*)(sp + (size_t)c * 16384) = w;
        }
    }
}

constexpr int PQ = 132, PS = 68;
__device__ __forceinline__ void hc_unit(Frame& F, const Args& A, int bh, int cc) {
    const int b = bh >> 2, h = bh & 3, tid = F.tid;
    LAS float* QT = (LAS float*)F.lds;
    LAS float* KI = QT + 64 * PQ;
    LAS float* VV = KI + 64 * PQ;
    LAS float* SC = VV + 64 * 128;
    LAS float* TOT = SC + 64 * PS;
    LAS float* SSQ = TOT + 4 * 128;
    const bf16* HQ = ((bf16*)(A.ws + WS_PROJ)); const bf16* LF = ((bf16*)(A.ws + WS_PROJ)) + 1 * ARR; const bf16* HV = ((bf16*)(A.ws + WS_PROJ)) + 2 * ARR; const bf16* HG = ((bf16*)(A.ws + WS_PROJ)) + 3 * ARR;
    {
        const int d = tid & 127, sq = tid >> 7;
        const size_t rb = (size_t)(b * ROWS + 64 * cc + 16 * sq) * 512 + 128 * h + d;
        const size_t vb = (size_t)(b * 512 + 128 * h + d) * ROWS + 64 * cc + 16 * sq;
        float lf[16], pre[16], qv[16]; float run = 0.f;
#pragma unroll
        for (int i = 0; i < 16; ++i) { lf[i] = bf2f(LF[rb + (size_t)i * 512]); qv[i] = bf2f(HQ[rb + (size_t)i * 512]); VV[(16 * sq + i) * 128 + d] = bf2f(HV[vb + i]); }
#pragma unroll
        for (int i = 0; i < 16; ++i) { run += lf[i]; pre[i] = run; }
        TOT[sq * 128 + d] = run;
        __syncthreads();
        float off = 0.f;
#pragma unroll
        for (int q = 0; q < 4; ++q) { const float t = TOT[q * 128 + d]; off += (q < sq) ? t : 0.f; }
#pragma unroll
        for (int i = 0; i < 16; ++i) { const float bc = off + pre[i];
            QT[(16 * sq + i) * PQ + d] = qv[i] * ex2(bc);
            KI[(16 * sq + i) * PQ + d] = (1.f - ex2(lf[i])) * ex2(-bc); }
    }
    __syncthreads();
    {
        const int t = tid >> 3, sg = tid & 7;
        float a[8];
#pragma unroll
        for (int i = 0; i < 8; ++i) a[i] = 0.f;
#pragma unroll 2
        for (int d = 0; d < 128; d += 4) {
            const f32x4 qq = *(const LAS f32x4*)(QT + t * PQ + d);
#pragma unroll
            for (int i = 0; i < 8; ++i) { const f32x4 kk = *(const LAS f32x4*)(KI + (sg + 8 * i) * PQ + d); a[i] += qq[0] * kk[0] + qq[1] * kk[1] + qq[2] * kk[2] + qq[3] * kk[3]; }
        }
#pragma unroll
        for (int i = 0; i < 8; ++i) { const int s = sg + 8 * i; SC[t * PS + s] = (s <= t) ? a[i] : 0.f; }
    }
    __syncthreads();
    {
        const int v = tid & 127, tq = tid >> 7;
        float acc[16];
#pragma unroll
        for (int i = 0; i < 16; ++i) acc[i] = 0.f;
        for (int s = 0; s < 64; s += 4) {
            const float v0 = VV[s * 128 + v], v1 = VV[(s + 1) * 128 + v], v2 = VV[(s + 2) * 128 + v], v3 = VV[(s + 3) * 128 + v];
#pragma unroll
            for (int i = 0; i < 16; ++i) { const f32x4 sc = *(const LAS f32x4*)(SC + (tq + 4 * i) * PS + s); acc[i] += sc[0] * v0 + sc[1] * v1 + sc[2] * v2 + sc[3] * v3; }
        }
        const bf16* sp = ((bf16*)(A.ws + WS_S)) + (size_t)(bh * 64 + cc - 1) * 16384 + (size_t)v * 128;
        for (int d = 0; d < 128; d += 8) {
            const u32x4 w = *(const u32x4*)(sp + d);
            const float s0 = bflo(w.x), s1 = bfhi(w.x), s2 = bflo(w.y), s3 = bfhi(w.y), s4 = bflo(w.z), s5 = bfhi(w.z), s6 = bflo(w.w), s7 = bfhi(w.w);
#pragma unroll
            for (int i = 0; i < 16; ++i) {
                const f32x4 q0 = *(const LAS f32x4*)(QT + (tq + 4 * i) * PQ + d), q1 = *(const LAS f32x4*)(QT + (tq + 4 * i) * PQ + d + 4);
                acc[i] += q0[0] * s0 + q0[1] * s1 + q0[2] * s2 + q0[3] * s3 + q1[0] * s4 + q1[1] * s5 + q1[2] * s6 + q1[3] * s7;
            }
        }
        const int wv = tid >> 6;
#pragma unroll
        for (int i = 0; i < 16; ++i) { const float ss = wave_sum(acc[i] * acc[i]); if (F.lane == 0) SSQ[wv * 16 + i] = ss; }
        __syncthreads();
        const float ng = A.in[4][128 * h + v];
#pragma unroll
        for (int i = 0; i < 16; ++i) {
            const int t = tq + 4 * i;
            const float tot = SSQ[(2 * tq) * 16 + i] + SSQ[(2 * tq + 1) * 16 + i];
            const float rs = 1.0f / sqrtf(tot * (1.f / 128.f) + RMS_EPS);
            const float gate = bf2f(HG[(size_t)(b * ROWS + 64 * cc + t) * 512 + 128 * h + v]);
            ((bf16*)(A.ws + WS_MIX))[(size_t)(b * SEQ + 64 * (cc - 1) + t) * DM + 128 * h + v] = (bf16)f2bf(acc[i] * rs * ng * gate);
        }
    }
    __syncthreads();
}

__device__ __forceinline__ void ln_stats(const f32x4 (&v)[4], float& mean, float& rstd) {
    float s = 0.f;
#pragma unroll
    for (int j = 0; j < 4; ++j) s += (v[j][0] + v[j][1]) + (v[j][2] + v[j][3]);
    mean = wave_sum(s) * (1.f / DM);
    float s2 = 0.f;
#pragma unroll
    for (int j = 0; j < 4; ++j) { const f32x4 d = v[j] - mean; s2 += (d[0] * d[0] + d[1] * d[1]) + (d[2] * d[2] + d[3] * d[3]); }
    rstd = 1.0f / sqrtf(wave_sum(s2) * (1.f / DM) + LN_EPS);
}

__device__ __forceinline__ void route_row(Frame& F, const Args& A, const float (&lg)[20], int rl, LAS int* lcnt, LAS int* rec) {
    const float* brg = A.in[10];
    float g0 = lg[0] + brg[0], g1 = lg[1] + brg[1], g2 = lg[2] + brg[2], g3 = lg[3] + brg[3];
    int grp = 0; float gm = g0;
    if (g1 > gm) { gm = g1; grp = 1; } if (g2 > gm) { gm = g2; grp = 2; } if (g3 > gm) { gm = g3; grp = 3; }
    const float pg = 1.f / (__expf(g0 - gm) + __expf(g1 - gm) + __expf(g2 - gm) + __expf(g3 - gm));
    float in0, in1, in2, in3;
    if (grp == 0) { in0 = lg[4]; in1 = lg[5]; in2 = lg[6]; in3 = lg[7]; }
    else if (grp == 1) { in0 = lg[8]; in1 = lg[9]; in2 = lg[10]; in3 = lg[11]; }
    else if (grp == 2) { in0 = lg[12]; in1 = lg[13]; in2 = lg[14]; in3 = lg[15]; }
    else { in0 = lg[16]; in1 = lg[17]; in2 = lg[18]; in3 = lg[19]; }
    const float* be = A.in[12] + grp * 4;
    in0 += be[0]; in1 += be[1]; in2 += be[2]; in3 += be[3];
    int i0 = 0; float m0 = in0;
    if (in1 > m0) { m0 = in1; i0 = 1; } if (in2 > m0) { m0 = in2; i0 = 2; } if (in3 > m0) { m0 = in3; i0 = 3; }
    int i1 = -1; float m1 = 0.f;
    if (i0 != 0) { m1 = in0; i1 = 0; }
    if (i0 != 1 && (i1 < 0 || in1 > m1)) { m1 = in1; i1 = 1; }
    if (i0 != 2 && (i1 < 0 || in2 > m1)) { m1 = in2; i1 = 2; }
    if (i0 != 3 && (i1 < 0 || in3 > m1)) { m1 = in3; i1 = 3; }
    const float w0 = 1.f / (1.f + __expf(m1 - m0)), w1 = 1.f - w0;
    const int e0 = grp * 4 + i0, e1 = grp * 4 + i1;
    const int p0 = atomicAdd((int*)&lcnt[e0], 1), p1 = atomicAdd((int*)&lcnt[e1], 1);
    rec[rl * 6 + 0] = e0; rec[rl * 6 + 1] = p0; rec[rl * 6 + 2] = __float_as_int(pg * w0);
    rec[rl * 6 + 3] = e1; rec[rl * 6 + 4] = p1; rec[rl * 6 + 5] = __float_as_int(pg * w1);
}
__device__ __forceinline__ void p6_ln_router(Frame& F, const Args& A) {
    LAS int* lcnt = F.misc + 32; LAS int* lbase = F.misc + 48;
    LAS f32x4* WL = (LAS f32x4*)F.lds;
    LAS int* rec = (LAS int*)(F.lds + 81920);
    for (int it = F.tid; it < 1024 * 5; it += NTHREADS) {
        const int k = it / 5, c = it % 5, j = k >> 8, ln = (k >> 2) & 63, e = k & 3;
        const f32x4 w = (c == 0) ? *(const f32x4*)(A.in[9] + (size_t)k * 4) : *(const f32x4*)(A.in[11] + (size_t)k * 16 + 4 * (c - 1));
        WL[((j * 4 + e) * 5 + c) * 64 + ln] = w;
    }
    __syncthreads();
    const LAS f32x4* wl = WL + F.lane;
    for (int slab = blockIdx.x; slab < MTOK / 128; slab += F.G) {
        if (F.tid < 16) lcnt[F.tid] = 0;
        __syncthreads();
#pragma unroll 1
        for (int i = 0; i < 16; i += 2) {
            const int rl = F.wave * 16 + i, row = slab * 128 + rl;
            f32x4* xr0 = (f32x4*)(A.out + (size_t)row * DM) + F.lane; f32x4* xr1 = xr0 + DM / 4;
            f32x4 v0[4], v1[4];
#pragma unroll
            for (int j = 0; j < 4; ++j) { v0[j] = xr0[64 * j]; v1[j] = xr1[64 * j]; }
            float mean0, rstd0, mean1, rstd1; ln_stats(v0, mean0, rstd0); ln_stats(v1, mean1, rstd1);
#pragma unroll
            for (int j = 0; j < 4; ++j) {
                const f32x4 g = ((const f32x4*)A.in[7])[64 * j + F.lane], bb = ((const f32x4*)A.in[8])[64 * j + F.lane];
                v0[j] = (v0[j] - mean0) * rstd0 * g + bb; v1[j] = (v1[j] - mean1) * rstd1 * g + bb;
                xr0[64 * j] = v0[j]; xr1[64 * j] = v1[j];
            }
            float la[20], lb2[20];
#pragma unroll
            for (int e = 0; e < 20; ++e) { la[e] = 0.f; lb2[e] = 0.f; }
#pragma unroll 1
            for (int j = 0; j < 4; ++j) {
                const f32x4 s0 = (j == 0) ? v0[0] : (j == 1) ? v0[1] : (j == 2) ? v0[2] : v0[3];
                const f32x4 s1 = (j == 0) ? v1[0] : (j == 1) ? v1[1] : (j == 2) ? v1[2] : v1[3];
                const LAS f32x4* wj = wl + j * (20 * 64);
#pragma unroll
                for (int e = 0; e < 4; ++e) {
                    const float h0 = s0[e], h1 = s1[e];
#pragma unroll
                    for (int c = 0; c < 5; ++c) { const f32x4 w = wj[(e * 5 + c) * 64];
                        la[4 * c] += h0 * w[0]; la[4 * c + 1] += h0 * w[1]; la[4 * c + 2] += h0 * w[2]; la[4 * c + 3] += h0 * w[3];
                        lb2[4 * c] += h1 * w[0]; lb2[4 * c + 1] += h1 * w[1]; lb2[4 * c + 2] += h1 * w[2]; lb2[4 * c + 3] += h1 * w[3]; }
                }
            }
#pragma unroll
            for (int e = 0; e < 20; ++e) { la[e] = wave_sum(la[e]); lb2[e] = wave_sum(lb2[e]); }
            if (F.lane == 0) { route_row(F, A, la, rl, lcnt, rec); route_row(F, A, lb2, rl + 1, lcnt, rec); }
        }
        __syncthreads();
        if (F.tid < 16) lbase[F.tid] = (int)atomicAdd(((unsigned*)(A.ws + WS_CTL)) + CW_CNT + F.tid, (unsigned)lcnt[F.tid]);
        __syncthreads();
        if (F.tid < 128) {
            unsigned* mp = ((unsigned*)(A.ws + WS_META)) + (size_t)(slab * 128 + F.tid) * 8;
            const int e0 = rec[F.tid * 6 + 0], e1 = rec[F.tid * 6 + 3];
            u32x4 a, c;
            a.x = (unsigned)e0; a.y = (unsigned)(lbase[e0] + rec[F.tid * 6 + 1]); a.z = (unsigned)rec[F.tid * 6 + 2]; a.w = (unsigned)e1;
            c.x = (unsigned)(lbase[e1] + rec[F.tid * 6 + 4]); c.y = (unsigned)rec[F.tid * 6 + 5]; c.z = 0u; c.w = 0u;
            *(u32x4*)mp = a; *(u32x4*)(mp + 4) = c;
        }
        __syncthreads();
    }
}

__device__ __forceinline__ void build_toff(Frame& F, const Args& A) {
    __syncthreads();
    if (F.tid == 0) { int acc = 0;
        for (int e = 0; e < NEXP; ++e) { F.misc[e] = acc; const unsigned c = __hip_atomic_load(((unsigned*)(A.ws + WS_CTL)) + CW_CNT + e, __ATOMIC_RELAXED, __HIP_MEMORY_SCOPE_AGENT); acc += (int)((c + 255u) >> 8); }
        F.misc[NEXP] = acc; }
    __syncthreads();
}

__device__ __forceinline__ void p7_scatter(Frame& F, const Args& A) {
    build_toff(F, A);
    for (int row = F.gw; row < MTOK; row += F.ngw) {
        const unsigned* mp = ((unsigned*)(A.ws + WS_META)) + (size_t)row * 8;
        const int e0 = (int)mp[0], p0 = (int)mp[1], e1 = (int)mp[3], p1 = (int)mp[4];
        const size_t s0 = (size_t)F.misc[e0] * 256 + p0, s1 = (size_t)F.misc[e1] * 256 + p1;
        const f32x4* xr = (const f32x4*)(A.out + (size_t)row * DM) + F.lane;
        u32x2* o0 = (u32x2*)(((bf16*)(A.ws + WS_XS)) + s0 * DM) + F.lane; u32x2* o1 = (u32x2*)(((bf16*)(A.ws + WS_XS)) + s1 * DM) + F.lane;
#pragma unroll
        for (int j = 0; j < 4; ++j) { const f32x4 v = xr[64 * j]; u32x2 w; w.x = pk2(v[0], v[1]); w.y = pk2(v[2], v[3]); o0[64 * j] = w; o1[64 * j] = w; }
    }
    LAS float* scr = (LAS float*)(F.lds + F.wave * 16384);
    constexpr int I13 = (DM / 64) * (DEXP / 32), I2 = (DEXP / 64) * (DM / 32);
    for (int it = F.gw; it < NEXP * (2 * I13 + I2); it += F.ngw) {
        const int e = it / (2 * I13 + I2), r = it % (2 * I13 + I2);
        if (r < I13) transpose_item<1>(A.in[13] + (size_t)e * DM * DEXP, DM, DEXP, ((bf16*)(A.ws + WS_W13)) + (size_t)e * 1024 * DM, scr, r, F.lane);
        else if (r < 2 * I13) transpose_item<2>(A.in[14] + (size_t)e * DM * DEXP, DM, DEXP, ((bf16*)(A.ws + WS_W13)) + (size_t)e * 1024 * DM, scr, r - I13, F.lane);
        else transpose_item<0>(A.in[15] + (size_t)e * DEXP * DM, DEXP, DM, ((bf16*)(A.ws + WS_W2)) + (size_t)e * DM * DEXP, scr, r - 2 * I13, F.lane);
    }
}

__device__ __forceinline__ void p10_final(Frame& F, const Args& A) {
    build_toff(F, A);
    for (int row = F.gw; row < MTOK; row += F.ngw) {
        const unsigned* mp = ((unsigned*)(A.ws + WS_META)) + (size_t)row * 8;
        const int e0 = (int)mp[0], p0 = (int)mp[1], e1 = (int)mp[3], p1 = (int)mp[4];
        const float g0 = __uint_as_float(mp[2]), g1 = __uint_as_float(mp[5]);
        const size_t s0 = (size_t)F.misc[e0] * 256 + p0, s1 = (size_t)F.misc[e1] * 256 + p1;
        f32x4* xr = (f32x4*)(A.out + (size_t)row * DM) + F.lane;
        const u32x2* y0 = (const u32x2*)(((bf16*)(A.ws + WS_YS)) + s0 * DM) + F.lane; const u32x2* y1 = (const u32x2*)(((bf16*)(A.ws + WS_YS)) + s1 * DM) + F.lane;
        f32x4 v[4];
#pragma unroll
        for (int j = 0; j < 4; ++j) { const f32x4 hv = xr[64 * j]; const u32x2 a = y0[64 * j], c = y1[64 * j];
            v[j][0] = ALPHA * hv[0] + g0 * bflo(a.x) + g1 * bflo(c.x); v[j][1] = ALPHA * hv[1] + g0 * bfhi(a.x) + g1 * bfhi(c.x);
            v[j][2] = ALPHA * hv[2] + g0 * bflo(a.y) + g1 * bflo(c.y); v[j][3] = ALPHA * hv[3] + g0 * bfhi(a.y) + g1 * bfhi(c.y); }
        float mean, rstd; ln_stats(v, mean, rstd);
#pragma unroll
        for (int j = 0; j < 4; ++j) { const f32x4 g = ((const f32x4*)A.in[16])[64 * j + F.lane], bb = ((const f32x4*)A.in[17])[64 * j + F.lane]; xr[64 * j] = (v[j] - mean) * rstd * g + bb; }
    }
}

#define XB_TMO      128
#define XB_XCNT(j)  (256  + 64 * (j))
#define XB_XSUB(j)  (1280 + 64 * (j))
#define XB_XGEN(j)  (2304 + 64 * (j))
#define XB_TOP      3328
#define XB_TOPGEN   3392
#define XCD_BAR_WORDS 3456
#define XB_SPIN_CAP (1u << 18)

__device__ __forceinline__ unsigned xb_ld(unsigned* p)              { return __hip_atomic_load(p, __ATOMIC_RELAXED, __HIP_MEMORY_SCOPE_AGENT); }
__device__ __forceinline__ unsigned xb_add(unsigned* p, unsigned v) { return __hip_atomic_fetch_add(p, v, __ATOMIC_RELAXED, __HIP_MEMORY_SCOPE_AGENT); }
__device__ __forceinline__ unsigned xb_xcc_id() { return (unsigned)__builtin_amdgcn_s_getreg((3 << 11) | 20) & 0xFu; }
#define XB_SPIN(cond, bar) do { unsigned _sp = 0; while (cond) { __builtin_amdgcn_s_sleep(1); \
    if ((++_sp & 255u) == 0u) { if (xb_ld(&(bar)[XB_TMO])) break; if (_sp > XB_SPIN_CAP) { atomicAdd(&(bar)[XB_TMO], 1u); break; } } } } while (0)

struct XcdBarrier {
    unsigned* bar; unsigned x;
    volatile LAS unsigned* st;
};

__device__ __forceinline__ XcdBarrier xcd_barrier_post(unsigned* bar, volatile LAS unsigned* st) {
    XcdBarrier b; b.bar = bar; b.x = xb_xcc_id(); b.st = st;
    if (threadIdx.x == 0) (void)xb_add(&bar[XB_XCNT(b.x)], 1u);
    return b;
}
__device__ __forceinline__ void xcd_barrier_complete(unsigned* bar, unsigned x, unsigned& nloc, unsigned& nx) {
    const unsigned G = gridDim.x * gridDim.y * gridDim.z;
    unsigned sum, cnt, mine, sp = 0u;
    for (;;) {
        sum = 0u; cnt = 0u; mine = 0u;
#pragma unroll
        for (unsigned j = 0; j < 16; ++j) { const unsigned c = xb_ld(&bar[XB_XCNT(j)]); sum += c; cnt += (c > 0u) ? 1u : 0u; mine = (j == x) ? c : mine; }
        if (sum == G) break;
        __builtin_amdgcn_s_sleep(1);
        if ((++sp & 255u) == 0u) { if (xb_ld(&bar[XB_TMO])) break; if (sp > XB_SPIN_CAP) { atomicAdd(&bar[XB_TMO], 1u); break; } }
    }
    nloc = mine > 0u ? mine : 1u; nx = cnt > 0u ? cnt : 1u;
}

__device__ __forceinline__ void xcd_barrier(const XcdBarrier& b) {
    asm volatile("s_waitcnt vmcnt(0)" ::: "memory");
    __syncthreads();
    if (threadIdx.x == 0) {
        unsigned* bar = b.bar;
        __builtin_amdgcn_s_waitcnt(0);
        unsigned nloc = b.st[0], nx = b.st[1];
        if (nloc == 0u) { xcd_barrier_complete(bar, b.x, nloc, nx); b.st[0] = nloc; b.st[1] = nx; }
        const unsigned old = xb_add(&bar[XB_XSUB(b.x)], 1u);
        const unsigned gen = old / nloc;
        if (old + 1u == (gen + 1u) * nloc) {
            __builtin_amdgcn_fence(__ATOMIC_RELEASE, "agent");
            asm volatile("s_waitcnt vmcnt(0)" ::: "memory");
            const unsigned og = xb_add(&bar[XB_TOP], 1u);
            const unsigned tg = og / nx;
            if (og + 1u == (tg + 1u) * nx) xb_add(&bar[XB_TOPGEN], 1u);
            else XB_SPIN(xb_ld(&bar[XB_TOPGEN]) == tg, bar);
            __builtin_amdgcn_fence(__ATOMIC_ACQUIRE, "agent");
            xb_add(&bar[XB_XGEN(b.x)], 1u);
            asm volatile("s_waitcnt vmcnt(0)" ::: "memory");
        } else {
            XB_SPIN(xb_ld(&bar[XB_XGEN(b.x)]) == gen, bar);
            __builtin_amdgcn_fence(__ATOMIC_ACQUIRE, "agent");
            asm volatile("s_waitcnt vmcnt(0)" ::: "memory");
        }
    }
    __syncthreads();
}

constexpr int NPHASE = 11;
__global__ void __launch_bounds__(NTHREADS, 2) mega_fwd(Args args) {
    extern __shared__ __attribute__((aligned(16))) unsigned char lds[];
    cg::grid_group grid = cg::this_grid();
    Frame F;
    F.lds = (LAS unsigned char*)lds; F.misc = (LAS int*)(F.lds + MISC_OFF);
    F.tid = threadIdx.x; F.lane = F.tid & 63; F.wave = __builtin_amdgcn_readfirstlane(F.tid >> 6); F.G = gridDim.x;
    F.gw = blockIdx.x * NWAVES + F.wave; F.ngw = F.G * NWAVES;
    const Args& A = args;
    const int lo = args.ph_lo, hi = args.ph_hi;
    if (F.tid < 2) F.misc[MISC_BAR + F.tid] = 0;
    __syncthreads();
    XcdBarrier bar; bar.bar = (unsigned*)(args.ws + WS_CTL) + CW_BAR; bar.x = 0; bar.st = nullptr;
    if (MK_LAUNCHES == 1) bar = xcd_barrier_post((unsigned*)(args.ws + WS_CTL) + CW_BAR, (volatile LAS unsigned*)(F.misc + MISC_BAR));
#define IN(k) (lo <= (k) && (k) < hi)
#define SEAM(k) do { if (IN((k) + 1)) { if ((k) == 0) grid.sync(); else xcd_barrier(bar); } } while (0)

    if (IN(0)) { p0_prep(F, A); SEAM(0); }
    if (IN(1)) {
        pg8::Gemm g{((bf16*)(A.ws + WS_XB)), ((bf16*)(A.ws + WS_WIN)), MTOK, NIN, DM}; pg8::StaticOrder S; S.init(MTOK, NIN, F.G, (int)blockIdx.x);
        EpiProj E{((bf16*)(A.ws + WS_PROJ)), ((float*)(A.ws + WS_LB))};
        pg8::gemm_phase<EpiProj, pg8::StaticOrder, PG8_ALIGN, PG8_SP2>(F.lds, g, S, E);
        SEAM(1);
    }
    if (IN(2)) {
        for (int u = blockIdx.x; u < 32 * 64; u += F.G) ha_unit(F, A, u >> 6, u & 63);
        attn_phase(F, A);
        SEAM(2);
    }
    if (IN(3)) { hb_phase(F, A); SEAM(3); }
    if (IN(4)) {
        for (int u = blockIdx.x; u < 32 * 64; u += F.G) hc_unit(F, A, u >> 6, (u & 63) + 1);
        SEAM(4);
    }
    if (IN(5)) {
        pg8::Gemm g{((bf16*)(A.ws + WS_MIX)), ((bf16*)(A.ws + WS_WOUT)), MTOK, DM, DM}; pg8::StaticOrder S; S.init(MTOK, DM, F.G, (int)blockIdx.x);
        EpiOut E{A.in[0], A.out};
        pg8::gemm_phase<EpiOut, pg8::StaticOrder, PG8_ALIGN, PG8_SP2>(F.lds, g, S, E);
        SEAM(5);
    }
    if (IN(6)) { p6_ln_router(F, A); SEAM(6); }
    if (IN(7)) { p7_scatter(F, A); SEAM(7); }
    if (IN(8)) {
        build_toff(F, A);
        pg8::Gemm g{((bf16*)(A.ws + WS_XS)), ((bf16*)(A.ws + WS_W13)), XS_ROWS, 1024, DM}; MoeOrder S{(const LAS int*)F.misc, F.G, (int)blockIdx.x, F.misc[NEXP]};
        EpiHid E{((bf16*)(A.ws + WS_HID))};
        pg8::gemm_phase<EpiHid, MoeOrder, PG8_ALIGN, PG8_SP2>(F.lds, g, S, E);
        SEAM(8);
    }
    if (IN(9)) {
        build_toff(F, A);
        pg8::Gemm g{((bf16*)(A.ws + WS_HID)), ((bf16*)(A.ws + WS_W2)), XS_ROWS, 1024, DEXP}; MoeOrder S{(const LAS int*)F.misc, F.G, (int)blockIdx.x, F.misc[NEXP]};
        EpiYs E{((bf16*)(A.ws + WS_YS))};
        pg8::gemm_phase<EpiYs, MoeOrder, PG8_ALIGN, PG8_SP2>(F.lds, g, S, E);
        SEAM(9);
    }
    if (IN(10)) { p10_final(F, A); }
#undef IN
#undef SEAM
}

extern "C" void kernel_launch(void* const* d_in, const int* in_sizes, int n_in, void* d_out, int out_size, void* d_ws, size_t ws_size, hipStream_t stream) {
    static int grid = 0;
    if (grid == 0) {
        if (n_in != 18 || in_sizes[0] != MTOK * DM || out_size != MTOK * DM || ws_size < WS_END) {
            fprintf(stderr, "kernel_launch: unexpected shapes (n_in %d, in0 %d, out %d, ws %zu); nothing launched\n", n_in, n_in > 0 ? in_sizes[0] : -1, out_size, ws_size); grid = -1; return; }
        int dev = 0, cus = 0, per_cu = 0;
        if (hipGetDevice(&dev) != hipSuccess || hipDeviceGetAttribute(&cus, hipDeviceAttributeMultiprocessorCount, dev) != hipSuccess) { grid = -1; return; }
        if (hipFuncSetAttribute((const void*)mega_fwd, hipFuncAttributeMaxDynamicSharedMemorySize, LDS_BYTES) != hipSuccess) { fprintf(stderr, "kernel_launch: hipFuncSetAttribute failed\n"); grid = -1; return; }
        if (hipOccupancyMaxActiveBlocksPerMultiprocessor(&per_cu, (const void*)mega_fwd, NTHREADS, LDS_BYTES) != hipSuccess || per_cu < 1) { fprintf(stderr, "kernel_launch: occupancy query says %d\n", per_cu); per_cu = 1; }
        (void)hipGetLastError();
        grid = cus;
    }
    if (grid < 0) return;
    (void)hipMemsetAsync((char*)d_ws + WS_CTL, 0, CTL_ZERO_BYTES, stream);
    Args a{};
    for (int i = 0; i < 18; ++i) a.in[i] = (const float*)d_in[i];
    a.out = (float*)d_out; a.ws = (unsigned char*)d_ws;
#if MK_LAUNCHES == 1
    a.ph_lo = 0; a.ph_hi = NPHASE;
    void* kargs[] = {&a};
    hipError_t e = hipLaunchCooperativeKernel((const void*)mega_fwd, dim3(grid), dim3(NTHREADS), kargs, LDS_BYTES, stream);
    if (e != hipSuccess) fprintf(stderr, "kernel_launch: cooperative launch failed: %s (grid %d)\n", hipGetErrorString(e), grid);
#else
    for (int p = 0; p < NPHASE; ++p) { a.ph_lo = p; a.ph_hi = p + 1; hipLaunchKernelGGL(mega_fwd, dim3(grid), dim3(NTHREADS), LDS_BYTES, stream, a); }
#endif
}
```

```cpp
#include <hip/hip_runtime.h>
#include <hip/hip_cooperative_groups.h>
#include <cstdio>
#include <cstdint>
namespace cg = cooperative_groups;
namespace pg8 {
#define PG8_LAS __attribute__((address_space(3)))
typedef unsigned short bf16_t;
typedef short bf16x8 __attribute__((ext_vector_type(8)));
typedef float f32x4 __attribute__((ext_vector_type(4)));
typedef unsigned u32x4 __attribute__((ext_vector_type(4)));
constexpr int BM = 256, BK = 64, HALF = 128, HTB = HALF * BK * 2  , STAGE_BYTES = 8 * HTB, NXCD = 8, WGM = 8;

__host__ __device__ __forceinline__ int lds_byte(int r, int c) { const int st = (r >> 4) * 2 + (c >> 5), rr = r & 15, cc = c & 31, ob = rr * 64 + cc * 2; return st * 1024 + (ob ^ (((ob >> 9) & 1) << 5)); }
__host__ __device__ __forceinline__ void stage_rc(int b, int& R, int& C) { const int st = b / 1024, sb = b % 1024, swz = sb ^ (((sb >> 9) & 1) << 5); R = (st >> 1) * 16 + swz / 64; C = (st & 1) * 32 + (swz % 64) / 2; }
__host__ __device__ __forceinline__ int perm32(int rho) { const int n = rho >> 4, i = rho & 15; return 8 * (i >> 2) + 4 * n + (i & 3); }

struct Unit { int pm, pn; };
struct Gemm { const bf16_t* A; const bf16_t* Bt; int M, N, K; };

struct StaticOrder {
    int nM, nN, nwg, G, c;
    __host__ __device__ void init(int M, int N, int G_, int c_) { nM = M / BM; nN = N / BM; nwg = nM * nN; G = G_; c = c_; }
    __host__ __device__ bool next(int i, Unit& u) const {
        const long L = (long)i * G + c; if (L >= nwg) return false;
        int wgid = (int)L; { const int q = nwg / NXCD, r = nwg % NXCD, xcd = wgid % NXCD, off = wgid / NXCD; wgid = (xcd < r ? xcd * (q + 1) : r * (q + 1) + (xcd - r) * q) + off; }
        const int nig = WGM * nN, gid = wgid / nig, fm = gid * WGM, gsz = (nM - fm) < WGM ? (nM - fm) : WGM;
        u.pm = fm + ((wgid % nig) % gsz); u.pn = (wgid % nig) / gsz; return true;
    }
    __device__ __forceinline__ void a_ready(const Unit&) const {}
    __device__ __forceinline__ void done(const Unit&) const {}
};

__device__ __forceinline__ unsigned cvt_pk_bf16(float lo, float hi) { unsigned r; asm volatile("v_cvt_pk_bf16_f32 %0, %1, %2" : "=v"(r) : "v"(lo), "v"(hi)); return r; }
template <class Epi, class Sched, bool ALIGN_EPI = false, bool SP2 = false>
__device__ __forceinline__ void gemm_phase(PG8_LAS unsigned char* lds, const Gemm g, const Sched& S, const Epi& E) {
    int tid_ = threadIdx.x; asm volatile("" : "+v"(tid_));
    const int tid = tid_, wid = __builtin_amdgcn_readfirstlane(tid >> 6), lane = tid & 63, wr = wid >> 2, wc = wid & 3, fr = lane & 15, fq = lane >> 4;
    const int K = g.K, nt = K / BK;
    unsigned voffA[2], voffB[2];
#pragma unroll
    for (int i = 0; i < 2; ++i) { int R, C; stage_rc(tid * 16 + i * 8192, R, C); const int Rb = Epi::PERM ? ((R & ~31) + perm32(R & 31)) : R;
        voffA[i] = (unsigned)(R * K + C) * 2u; voffB[i] = (unsigned)(Rb * K + C) * 2u; }
    const size_t kstep = (size_t)(BK * 2);
    const size_t hstep = (size_t)HALF * K * 2;
    const size_t tstep = 2 * hstep;
    const unsigned ldsw = (unsigned)wid * 1024u;
    const int aoff = lds_byte(wr * 64 + fr, fq * 8), boff = lds_byte(wc * 32 + fr, fq * 8);
#define PG8_SA(b, h) (((b) * 2 + (h)) * HTB)
#define PG8_SB(b, h) ((4 + (b) * 2 + (h)) * HTB)
#define PG8_STAGE(bufoff, gbase, voff) do { _Pragma("unroll") for (int _i = 0; _i < 2; ++_i) \
        __builtin_amdgcn_global_load_lds((const unsigned*)((const char*)(gbase) + (voff)[_i]), (PG8_LAS unsigned*)(lds + (bufoff) + ldsw + _i * 8192), 16, 0, 0); } while (0)
#define PG8_LDA(dst, b, h) do { _Pragma("unroll") for (int m = 0; m < 4; ++m) _Pragma("unroll") for (int k = 0; k < 2; ++k) dst[m][k] = *(const PG8_LAS bf16x8*)(lds + PG8_SA(b, h) + aoff + m * 2048 + k * 1024); } while (0)
#define PG8_LDB(dst, b, h) do { _Pragma("unroll") for (int n = 0; n < 2; ++n) _Pragma("unroll") for (int k = 0; k < 2; ++k) dst[n][k] = *(const PG8_LAS bf16x8*)(lds + PG8_SB(b, h) + boff + n * 2048 + k * 1024); } while (0)
#define PG8_MMA(ai, bj, At, Bt) do { __builtin_amdgcn_s_setprio(1); _Pragma("unroll") for (int m = 0; m < 4; ++m) _Pragma("unroll") for (int n = 0; n < 2; ++n) _Pragma("unroll") for (int k = 0; k < 2; ++k) \
        acc[ai][bj][m][n] = __builtin_amdgcn_mfma_f32_16x16x32_bf16(Bt[n][k], At[m][k], acc[ai][bj][m][n], 0, 0, 0); __builtin_amdgcn_s_setprio(0); } while (0)
#define PG8_WAIT_V(n) asm volatile("s_waitcnt vmcnt(" #n ")" ::: "memory")
#define PG8_WAIT_L(n) asm volatile("s_waitcnt lgkmcnt(" #n ")" ::: "memory")
#define PG8_BAR __builtin_amdgcn_s_barrier()
#define PG8_SCHED __builtin_amdgcn_sched_barrier(0)
    Unit cur, nxt; int ui = 0;
    if (!S.next(0, cur)) return;
    f32x4 acc[2][2][4][2];
#pragma unroll
    for (int a = 0; a < 2; ++a)
#pragma unroll
        for (int b = 0; b < 2; ++b)
#pragma unroll
            for (int m = 0; m < 4; ++m)
#pragma unroll
                for (int n = 0; n < 2; ++n) acc[a][b][m][n] = (f32x4){0.f, 0.f, 0.f, 0.f};
    bf16x8 At[4][2], B0[2][2], B1[2][2];
    const char* cA = (const char*)g.A + (size_t)cur.pm * tstep; const char* cB = (const char*)g.Bt + (size_t)cur.pn * tstep;
    S.a_ready(cur);
    if constexpr (SP2) {
        PG8_STAGE(PG8_SB(0, 0), cB, voffB); PG8_STAGE(PG8_SB(0, 1), cB + hstep, voffB); PG8_STAGE(PG8_SA(0, 0), cA, voffA); PG8_STAGE(PG8_SA(0, 1), cA + hstep, voffA);
        if (wr == 1) PG8_BAR;
        PG8_WAIT_V(2); PG8_BAR;
        PG8_STAGE(PG8_SB(1, 0), cB + kstep, voffB); PG8_STAGE(PG8_SA(1, 0), cA + kstep, voffA); PG8_STAGE(PG8_SB(1, 1), cB + hstep + kstep, voffB);
        PG8_WAIT_V(6); PG8_BAR;
    } else {
        PG8_STAGE(PG8_SB(0, 0), cB, voffB); PG8_STAGE(PG8_SA(0, 0), cA, voffA); PG8_STAGE(PG8_SB(0, 1), cB + hstep, voffB); PG8_STAGE(PG8_SA(0, 1), cA + hstep, voffA);
        if (wr == 1) PG8_BAR;
        PG8_WAIT_V(4); PG8_BAR;
        PG8_STAGE(PG8_SB(1, 0), cB + kstep, voffB); PG8_STAGE(PG8_SA(1, 0), cA + kstep, voffA); PG8_STAGE(PG8_SB(1, 1), cB + hstep + kstep, voffB);
        PG8_WAIT_V(6); PG8_BAR;
    }
    for (;;) {
        const bool has_next = S.next(ui + 1, nxt);
        const char* nA = has_next ? (const char*)g.A + (size_t)nxt.pm * tstep : cA; const char* nB = has_next ? (const char*)g.Bt + (size_t)nxt.pn * tstep : cB;
        for (int t = 0; t < nt; t += 2) {
            const bool last = (t == nt - 2);
            const char* a1 = cA + (size_t)(t + 1) * kstep;
            const char* a2 = last ? nA : cA + (size_t)(t + 2) * kstep; const char* b2 = last ? nB : cB + (size_t)(t + 2) * kstep;
            const char* a3 = a2 + kstep; const char* b3 = b2 + kstep;
            if (last && has_next) S.a_ready(nxt);
            if constexpr (SP2) {
            PG8_LDB(B0, 0, 0); PG8_LDB(B1, 0, 1); PG8_SCHED; PG8_LDA(At, 0, 0); PG8_STAGE(PG8_SA(1, 1), a1 + hstep, voffA);
            PG8_WAIT_V(8); PG8_WAIT_L(0); PG8_BAR; PG8_MMA(0, 0, At, B0); PG8_MMA(0, 1, At, B1); PG8_BAR; PG8_SCHED;
            PG8_LDA(At, 0, 1); PG8_STAGE(PG8_SB(0, 0), b2, voffB); PG8_STAGE(PG8_SB(0, 1), b2 + hstep, voffB); PG8_STAGE(PG8_SA(0, 0), a2, voffA);
            PG8_WAIT_V(8); PG8_WAIT_L(0); PG8_BAR; PG8_MMA(1, 0, At, B0); PG8_MMA(1, 1, At, B1); PG8_BAR; PG8_SCHED;
            PG8_LDB(B0, 1, 0); PG8_LDB(B1, 1, 1); PG8_SCHED; PG8_LDA(At, 1, 0); PG8_STAGE(PG8_SA(0, 1), a2 + hstep, voffA);
            PG8_WAIT_V(8); PG8_WAIT_L(0); PG8_BAR; PG8_MMA(0, 0, At, B0); PG8_MMA(0, 1, At, B1); PG8_BAR; PG8_SCHED;
            PG8_LDA(At, 1, 1); PG8_STAGE(PG8_SB(1, 0), b3, voffB); PG8_STAGE(PG8_SB(1, 1), b3 + hstep, voffB); PG8_STAGE(PG8_SA(1, 0), a3, voffA);
            PG8_WAIT_V(8); PG8_WAIT_L(0); PG8_BAR; PG8_MMA(1, 0, At, B0); PG8_MMA(1, 1, At, B1); PG8_BAR; PG8_SCHED;
            } else {
            PG8_LDB(B0, 0, 0); PG8_SCHED; PG8_LDA(At, 0, 0); PG8_STAGE(PG8_SA(1, 1), a1 + hstep, voffA);
            PG8_WAIT_L(8); PG8_BAR; PG8_WAIT_L(0); PG8_MMA(0, 0, At, B0); PG8_BAR; PG8_SCHED;
            PG8_LDB(B1, 0, 1); PG8_STAGE(PG8_SB(0, 0), b2, voffB);
            PG8_BAR; PG8_WAIT_L(0); PG8_MMA(0, 1, At, B1); PG8_BAR;
            PG8_LDA(At, 0, 1); PG8_STAGE(PG8_SA(0, 0), a2, voffA);
            PG8_BAR; PG8_WAIT_L(0); PG8_MMA(1, 0, At, B0); PG8_BAR; PG8_SCHED;
            PG8_STAGE(PG8_SB(0, 1), b2 + hstep, voffB);
            PG8_WAIT_V(6); PG8_BAR; PG8_MMA(1, 1, At, B1); PG8_BAR;
            PG8_LDB(B0, 1, 0); PG8_SCHED; PG8_LDA(At, 1, 0); PG8_STAGE(PG8_SA(0, 1), a2 + hstep, voffA);
            PG8_WAIT_L(8); PG8_BAR; PG8_WAIT_L(0); PG8_MMA(0, 0, At, B0); PG8_BAR; PG8_SCHED;
            PG8_LDB(B1, 1, 1); PG8_STAGE(PG8_SB(1, 0), b3, voffB);
            PG8_BAR; PG8_WAIT_L(0); PG8_MMA(0, 1, At, B1); PG8_BAR;
            PG8_LDA(At, 1, 1); PG8_STAGE(PG8_SA(1, 0), a3, voffA);
            PG8_BAR; PG8_WAIT_L(0); PG8_MMA(1, 0, At, B0); PG8_BAR; PG8_SCHED;
            PG8_STAGE(PG8_SB(1, 1), b3 + hstep, voffB);
            PG8_WAIT_V(6); PG8_BAR; PG8_MMA(1, 1, At, B1); PG8_BAR;
            }
        }
        if constexpr (ALIGN_EPI) { if (wr == 0) PG8_BAR; }
        if constexpr (!Epi::AFTER_DRAIN) { E(acc, cur, wr, wc, fr, fq); S.done(cur); }
        if (!has_next) break;
#pragma unroll
        for (int a = 0; a < 2; ++a)
#pragma unroll
            for (int b = 0; b < 2; ++b)
#pragma unroll
                for (int m = 0; m < 4; ++m)
#pragma unroll
                    for (int n = 0; n < 2; ++n) acc[a][b][m][n] = (f32x4){0.f, 0.f, 0.f, 0.f};
        cur = nxt; cA = nA; cB = nB; ++ui;
        if constexpr (ALIGN_EPI) { if (wr == 1) PG8_BAR; }
    }
    PG8_WAIT_V(0);
    if constexpr (!ALIGN_EPI) { if (wr == 0) PG8_BAR; }
    PG8_BAR;
    if constexpr (Epi::AFTER_DRAIN) { E.fused(acc, cur, wr, wc, fr, fq, lds, wid, lane); S.done(cur); }
#undef PG8_SA
#undef PG8_SB
#undef PG8_STAGE
#undef PG8_LDA
#undef PG8_LDB
#undef PG8_MMA
#undef PG8_WAIT_V
#undef PG8_WAIT_L
#undef PG8_BAR
#undef PG8_SCHED
}
}


#ifndef PG8_SP2
#define PG8_SP2 true
#endif
#ifndef PG8_ALIGN
#define PG8_ALIGN true
#endif
#ifndef MK_LAUNCHES
#define MK_LAUNCHES 1
#endif

#define GAS __attribute__((address_space(1)))
#define LAS __attribute__((address_space(3)))
typedef unsigned short bf16;
typedef float f32x4 __attribute__((ext_vector_type(4)));
typedef unsigned u32x4 __attribute__((ext_vector_type(4)));
typedef unsigned u32x2 __attribute__((ext_vector_type(2)));

constexpr int NB = 8, SEQ = 4096, DM = 1024, NMETA = 16;
constexpr int ROWS = 4160, PADR = 48, TOK0 = 64;
constexpr int MTOK = NB * SEQ;
constexpr int NIN = 3584;
constexpr int BROWS = NB * ROWS;
constexpr size_t ARR = (size_t)BROWS * 512;
constexpr int NCH = 64;
constexpr int NEXP = 16, DEXP = 512;
constexpr int XS_ROWS = 69632;
constexpr float ALPHA = 1.189207115002721f;
constexpr float LN_EPS = 1e-5f, RMS_EPS = 1e-6f;
constexpr float LOG2E = 1.4426950408889634f;
constexpr float C2Q = 0.125f * LOG2E;
constexpr float STICK_THR = 48.0f;

constexpr size_t MiB = 1u << 20;
constexpr size_t WS_CTL = 0, CTL_ZERO_BYTES = 1 * MiB;
constexpr size_t WS_WIN = 1 * MiB;
constexpr size_t WS_WOUT = 8 * MiB;
constexpr size_t WS_LB = 10 * MiB;
constexpr size_t WS_META = 11 * MiB;
constexpr size_t WS_DV = 12 * MiB;
constexpr size_t WS_XB = 16 * MiB;
constexpr size_t WS_S = 16 * MiB;
constexpr size_t WS_PROJ = 80 * MiB;
constexpr size_t WS_U = 308 * MiB;
constexpr size_t WS_MIX = 436 * MiB;
constexpr size_t WS_W13 = 80 * MiB;
constexpr size_t WS_W2 = 112 * MiB;
constexpr size_t WS_XS = 128 * MiB;
constexpr size_t WS_HID = 264 * MiB;
constexpr size_t WS_YS = 332 * MiB;
constexpr size_t WS_END = 500 * MiB;
static_assert(WS_PROJ + 7 * ARR * 2 <= WS_U && WS_U + (size_t)32 * 64 * 16384 * 4 <= WS_MIX && WS_MIX + (size_t)MTOK * DM * 2 <= WS_END, "ws map A");
static_assert(WS_W13 + (size_t)16 * 1024 * 1024 * 2 <= WS_W2 && WS_W2 + (size_t)16 * 1024 * 512 * 2 <= WS_XS && WS_XS + (size_t)XS_ROWS * 1024 * 2 <= WS_HID &&
              WS_HID + (size_t)XS_ROWS * 512 * 2 <= WS_YS && WS_YS + (size_t)XS_ROWS * 1024 * 2 <= WS_END, "ws map B");
constexpr int CW_CNT = 64;
constexpr int CW_BAR = 4096;
constexpr int MISC_BAR = 100;

constexpr int RING_BYTES = 131072;
constexpr int MISC_OFF = RING_BYTES;
constexpr int LDS_BYTES = 147456;
constexpr int NWAVES = 8, NTHREADS = 512;

__device__ __forceinline__ unsigned f2bf(float f) { unsigned u = __builtin_bit_cast(unsigned, f); return (u + 0x7fffu + ((u >> 16) & 1u)) >> 16; }
typedef float f32x2_t __attribute__((ext_vector_type(2))); typedef __bf16 bf16x2_t __attribute__((ext_vector_type(2)));
__device__ __forceinline__ unsigned pk2(float lo, float hi) { f32x2_t v = {lo, hi}; bf16x2_t b = __builtin_convertvector(v, bf16x2_t); return __builtin_bit_cast(unsigned, b); }
__device__ __forceinline__ float bf2f(unsigned h) { return __builtin_bit_cast(float, h << 16); }
__device__ __forceinline__ float bflo(unsigned w) { return __builtin_bit_cast(float, w << 16); }
__device__ __forceinline__ float bfhi(unsigned w) { return __builtin_bit_cast(float, w & 0xffff0000u); }
__device__ __forceinline__ float ex2(float x) { return __builtin_amdgcn_exp2f(x); }
__device__ __forceinline__ float lg2(float x) { return __builtin_amdgcn_logf(x); }
__device__ __forceinline__ float rcpf_(float x) { return __builtin_amdgcn_rcpf(x); }
__device__ __forceinline__ float sigm(float v) { return rcpf_(1.f + ex2(-v * LOG2E)); }
__device__ __forceinline__ float wave_sum(float v) {
#pragma unroll
    for (int o = 1; o < 64; o <<= 1) v += __shfl_xor(v, o);
    return v;
}
template <int XF> __device__ __forceinline__ float xform(float v, float lb) {
    if (XF == 0) return v * sigm(v);
    if (XF == 1) return lg2(lb + (1.f - lb) * sigm(v));
    if (XF == 3) return sigm(v);
    if (XF == 4) return v * C2Q;
    return v;
}
__device__ __forceinline__ float xform_rt(int kind, float v, float lb) {
    switch (kind) { case 0: return xform<0>(v, lb); case 1: return xform<1>(v, lb); case 3: return xform<3>(v, lb); case 4: return xform<4>(v, lb); default: return v; }
}

using pg8::Unit;
struct EpiProj {
    static constexpr bool PERM = true, AFTER_DRAIN = false;
    bf16* proj; const float* lb;
    template <int XF> __device__ __forceinline__ void run(int kind, const f32x4 (&acc)[2][2][4][2], const Unit& u, int wr, int wc, int fr, int fq) const {
        const int b = u.pm >> 4;
        const int r0 = b * ROWS + TOK0 + (u.pm & 15) * 256 + wr * 64 + fr;
        const int c0 = (u.pn & 1) * 256 + wc * 32 + 8 * fq;
        bf16* base = proj + (size_t)kind * ARR;
        f32x4 l0[2], l1[2];
#pragma unroll
        for (int bj = 0; bj < 2; ++bj) {
            if (XF == 1) { l0[bj] = *(const f32x4*)(lb + c0 + bj * 128); l1[bj] = *(const f32x4*)(lb + c0 + bj * 128 + 4); }
            else { l0[bj] = (f32x4){0.f, 0.f, 0.f, 0.f}; l1[bj] = l0[bj]; }
        }
#pragma unroll
        for (int ai = 0; ai < 2; ++ai)
#pragma unroll
            for (int m = 0; m < 4; ++m) {
                bf16* rowp = base + (size_t)(r0 + ai * 128 + m * 16) * 512 + c0;
#pragma unroll
                for (int bj = 0; bj < 2; ++bj) {
                    const f32x4 v0 = acc[ai][bj][m][0], v1 = acc[ai][bj][m][1];
                    u32x4 w;
                    w.x = pk2(xform<XF>(v0[0], l0[bj][0]), xform<XF>(v0[1], l0[bj][1]));
                    w.y = pk2(xform<XF>(v0[2], l0[bj][2]), xform<XF>(v0[3], l0[bj][3]));
                    w.z = pk2(xform<XF>(v1[0], l1[bj][0]), xform<XF>(v1[1], l1[bj][1]));
                    w.w = pk2(xform<XF>(v1[2], l1[bj][2]), xform<XF>(v1[3], l1[bj][3]));
                    *(u32x4*)(rowp + bj * 128) = w;
                }
            }
    }
    __device__ __forceinline__ void operator()(const f32x4 (&acc)[2][2][4][2], const Unit& u, int wr, int wc, int fr, int fq) const {
        const int kind = u.pn >> 1;
        if (kind == 0) run<0>(kind, acc, u, wr, wc, fr, fq);
        else if (kind == 1) run<1>(kind, acc, u, wr, wc, fr, fq);
        else if (kind == 3) run<3>(kind, acc, u, wr, wc, fr, fq);
        else if (kind == 4) run<4>(kind, acc, u, wr, wc, fr, fq);
        else run<2>(kind, acc, u, wr, wc, fr, fq);
    }
};
struct EpiOut {
    static constexpr bool PERM = false, AFTER_DRAIN = false;
    const float* x; float* out;
    __device__ __forceinline__ void operator()(const f32x4 (&acc)[2][2][4][2], const Unit& u, int wr, int wc, int fr, int fq) const {
        const int row0 = u.pm * 256 + wr * 64 + fr, col0 = u.pn * 256 + wc * 32 + 4 * fq;
#pragma unroll
        for (int ai = 0; ai < 2; ++ai)
#pragma unroll
            for (int m = 0; m < 4; ++m) {
                const size_t ro = (size_t)(row0 + ai * 128 + m * 16) * DM + col0;
#pragma unroll
                for (int bj = 0; bj < 2; ++bj)
#pragma unroll
                    for (int n = 0; n < 2; ++n) {
                        const f32x4 xv = *(const f32x4*)(x + ro + bj * 128 + 16 * n);
                        *(f32x4*)(out + ro + bj * 128 + 16 * n) = acc[ai][bj][m][n] + xv * ALPHA;
                    }
            }
    }
};
struct EpiHid {
    static constexpr bool PERM = true, AFTER_DRAIN = false;
    bf16* hid;
    __device__ __forceinline__ void operator()(const f32x4 (&acc)[2][2][4][2], const Unit& u, int wr, int wc, int fr, int fq) const {
        const int row0 = u.pm * 256 + wr * 64 + fr, hc0 = (u.pn & 3) * 128 + wc * 16 + 4 * fq;
#pragma unroll
        for (int ai = 0; ai < 2; ++ai)
#pragma unroll
            for (int m = 0; m < 4; ++m) {
                bf16* rowp = hid + (size_t)(row0 + ai * 128 + m * 16) * DEXP + hc0;
#pragma unroll
                for (int bj = 0; bj < 2; ++bj) {
                    const f32x4 g = acc[ai][bj][m][0], up = acc[ai][bj][m][1];
                    u32x2 w;
                    w.x = pk2(g[0] * sigm(g[0]) * up[0], g[1] * sigm(g[1]) * up[1]);
                    w.y = pk2(g[2] * sigm(g[2]) * up[2], g[3] * sigm(g[3]) * up[3]);
                    *(u32x2*)(rowp + bj * 64) = w;
                }
            }
    }
};
struct EpiYs {
    static constexpr bool PERM = true, AFTER_DRAIN = false;
    bf16* ys;
    __device__ __forceinline__ void operator()(const f32x4 (&acc)[2][2][4][2], const Unit& u, int wr, int wc, int fr, int fq) const {
        const int row0 = u.pm * 256 + wr * 64 + fr, col0 = (u.pn & 3) * 256 + wc * 32 + 8 * fq;
#pragma unroll
        for (int ai = 0; ai < 2; ++ai)
#pragma unroll
            for (int m = 0; m < 4; ++m) {
                bf16* rowp = ys + (size_t)(row0 + ai * 128 + m * 16) * DM + col0;
#pragma unroll
                for (int bj = 0; bj < 2; ++bj) {
                    const f32x4 v0 = acc[ai][bj][m][0], v1 = acc[ai][bj][m][1];
                    u32x4 w; w.x = pk2(v0[0], v0[1]); w.y = pk2(v0[2], v0[3]); w.z = pk2(v1[0], v1[1]); w.w = pk2(v1[2], v1[3]);
                    *(u32x4*)(rowp + bj * 128) = w;
                }
            }
    }
};
struct MoeOrder {
    const LAS int* toff; int G, c, ntot;
    __device__ __forceinline__ bool next(int i, Unit& u) const {
        const long L = (long)i * G + c; if (L >= (long)ntot * 4) return false;
        const int mt = (int)(L >> 2), pl = (int)(L & 3); int e = 0;
#pragma unroll
        for (int j = 1; j < NEXP; ++j) e += (mt >= toff[j]) ? 1 : 0;
        u.pm = mt; u.pn = e * 4 + pl; return true;
    }
    __device__ __forceinline__ void a_ready(const Unit&) const {}
    __device__ __forceinline__ void done(const Unit&) const {}
};

struct Args { const float* in[18]; float* out; unsigned char* ws; int ph_lo, ph_hi; };
struct Frame {
    LAS unsigned char* lds; LAS int* misc;
    int tid, lane, wave, G, gw, ngw;
};

template <int MODE> __device__ __forceinline__ int rowmap(int n) { return MODE == 0 ? n : ((n >> 2) * 8 + (n & 3) + (MODE == 2 ? 4 : 0)); }
template <int MODE> __device__ __forceinline__ void transpose_item(const float* W, int K, int N, bf16* WT, LAS float* scr, int item, int lane) {
    const int nblk = N / 32, kb = item / nblk, nb = item % nblk, k0 = 64 * kb, n0 = 32 * nb;
#pragma unroll 8
    for (int i = 0; i < 32; ++i) { const int kk = 2 * i + (lane >> 5); scr[kk * 33 + (lane & 31)] = W[(size_t)(k0 + kk) * N + n0 + (lane & 31)]; }
    asm volatile("s_waitcnt lgkmcnt(0)" ::: "memory");
    const int c = lane & 7;
#pragma unroll
    for (int j = 0; j < 4; ++j) { const int n = (lane >> 3) + 8 * j; const LAS float* s = scr + (8 * c) * 33 + n;
        u32x4 o; o.x = pk2(s[0 * 33], s[1 * 33]); o.y = pk2(s[2 * 33], s[3 * 33]); o.z = pk2(s[4 * 33], s[5 * 33]); o.w = pk2(s[6 * 33], s[7 * 33]);
        *(u32x4*)(WT + (size_t)rowmap<MODE>(n0 + n) * K + k0 + 8 * c) = o; }
    asm volatile("s_waitcnt lgkmcnt(0)" ::: "memory");
}

__device__ __forceinline__ void p0_prep(Frame& F, const Args& A) {
    LAS float* scr = (LAS float*)(F.lds + F.wave * 16384);
    const int gtid = blockIdx.x * NTHREADS + F.tid, gthreads = F.G * NTHREADS;
    for (int i = gtid; i < 512; i += gthreads) ((float*)(A.ws + WS_LB))[i] = 1.f / (1.f + __expf(A.in[3][512 + i] - A.in[3][i]));
    for (int i = gtid; i < 7 * NB * 3072; i += gthreads) {
        const int a = i / (NB * 3072), r = i % (NB * 3072), b = r / 3072, o = r % 3072;
        *(u32x4*)(((bf16*)(A.ws + WS_PROJ)) + (size_t)a * ARR + (size_t)b * ROWS * 512 + (size_t)o * 8) = (u32x4){0u, 0u, 0u, 0u};
    }
    for (int job = F.gw; job < 56 * 4; job += F.ngw) {
        const int cgp = job >> 2, rq = job & 3, n = cgp * 64 + F.lane, kind = cgp >> 3;
        float acc0 = 0.f, acc1 = 0.f, acc2 = 0.f, acc3 = 0.f;
        const float* mt = A.in[1] + (size_t)(4 * rq) * DM;
#pragma unroll 8
        for (int k = 0; k < DM; ++k) {
            const float w = A.in[2][(size_t)k * NIN + n];
            acc0 += mt[k] * w; acc1 += mt[DM + k] * w; acc2 += mt[2 * DM + k] * w; acc3 += mt[3 * DM + k] * w;
        }
        const int col = n & 511;
        const float lbv = 1.f / (1.f + __expf(A.in[3][512 + col] - A.in[3][col]));
        const unsigned short o0 = (unsigned short)f2bf(xform_rt(kind, acc0, lbv)), o1 = (unsigned short)f2bf(xform_rt(kind, acc1, lbv)),
                             o2 = (unsigned short)f2bf(xform_rt(kind, acc2, lbv)), o3 = (unsigned short)f2bf(xform_rt(kind, acc3, lbv));
        bf16* base = ((bf16*)(A.ws + WS_PROJ)) + (size_t)kind * ARR;
        for (int b = 0; b < NB; ++b) {
            { bf16* p = base + col + (size_t)(b * ROWS + PADR + 4 * rq) * 512; p[0] = o0; p[512] = o1; p[1024] = o2; p[1536] = o3; }
        }
    }
    constexpr int I_IN = (DM / 64) * (NIN / 32), I_OUT = (DM / 64) * (DM / 32);
    for (int it = F.gw; it < I_IN + I_OUT; it += F.ngw) {
        if (it < I_IN) transpose_item<0>(A.in[2], DM, NIN, ((bf16*)(A.ws + WS_WIN)), scr, it, F.lane);
        else transpose_item<0>(A.in[6], DM, DM, ((bf16*)(A.ws + WS_WOUT)), scr, it - I_IN, F.lane);
    }
    for (int m = F.gw; m < MTOK; m += F.ngw) {
        const f32x4* xr = (const f32x4*)(A.in[0] + (size_t)m * DM) + F.lane;
        u32x2* o8 = (u32x2*)(((bf16*)(A.ws + WS_XB)) + (size_t)m * DM) + F.lane;
#pragma unroll
        for (int j = 0; j < 4; ++j) { const f32x4 v = xr[64 * j]; u32x2 w; w.x = pk2(v[0], v[1]); w.y = pk2(v[2], v[3]); o8[64 * j] = w; }
    }
}

typedef short s16x8 __attribute__((ext_vector_type(8)));
typedef short v4i16_t __attribute__((ext_vector_type(4)));
__device__ __forceinline__ s16x8 tr8(const LAS unsigned char* p, int rowskip) {
    const v4i16_t lo = __builtin_amdgcn_ds_read_tr16_b64_v4i16((LAS v4i16_t*)p);
    const v4i16_t hh = __builtin_amdgcn_ds_read_tr16_b64_v4i16((LAS v4i16_t*)(p + rowskip));
    return (s16x8){lo[0], lo[1], lo[2], lo[3], hh[0], hh[1], hh[2], hh[3]};
}
struct RawTile { u32x4 a, b; };
__device__ __forceinline__ RawTile raw_load(const bf16* arr, int b, int h, int c, int tid) {
    const bf16* p = arr + (size_t)(b * ROWS + 64 * c + (tid >> 4)) * 512 + 128 * h + 8 * (tid & 15);
    RawTile r; r.a = *(const u32x4*)p; r.b = *(const u32x4*)(p + (size_t)32 * 512); return r;
}
__device__ __forceinline__ void raw_store(LAS unsigned char* dst, int pitch, const RawTile& r, int tid) {
    LAS unsigned char* p = dst + (tid >> 4) * pitch + (tid & 15) * 16;
    *(LAS u32x4*)p = r.a; *(LAS u32x4*)(p + 32 * pitch) = r.b;
}
constexpr int PRAW = 272;
constexpr int PKT = 144;
__device__ __forceinline__ void ha_phase(Frame& F, const Args& A) {
    const bf16* LF = ((bf16*)(A.ws + WS_PROJ)) + 1 * ARR; const bf16* HV = ((bf16*)(A.ws + WS_PROJ)) + 2 * ARR;
    LAS unsigned char* RLF = F.lds;
    LAS unsigned char* VN = RLF + 64 * PRAW;
    LAS unsigned char* KT = VN + 64 * PRAW;
    LAS float* TOT = (LAS float*)(KT + 128 * PKT);
    const int tid = F.tid, lane = F.lane, w = F.wave, fr = lane & 15, fq = lane >> 4;
    const int d = tid & 127, sq = tid >> 7;
    int u = blockIdx.x;
    RawTile rl, rv;
    if (u < 32 * 64) { rl = raw_load(LF, u >> 8, (u >> 6) & 3, u & 63, tid); rv = raw_load(HV, u >> 8, (u >> 6) & 3, u & 63, tid); }
    for (; u < 32 * 64; u += F.G) {
        const int bh = u >> 6, c = u & 63;
        raw_store(RLF, PRAW, rl, tid); raw_store(VN, PRAW, rv, tid);
        __syncthreads();
        { const int un = u + F.G; if (un < 32 * 64) { rl = raw_load(LF, un >> 8, (un >> 6) & 3, un & 63, tid); rv = raw_load(HV, un >> 8, (un >> 6) & 3, un & 63, tid); } }
        float lf[16], pre[16]; float run = 0.f;
#pragma unroll
        for (int i = 0; i < 16; ++i) { lf[i] = bf2f(*(const LAS unsigned short*)(RLF + (16 * sq + i) * PRAW + 2 * d)); run += lf[i]; pre[i] = run; }
        TOT[sq * 128 + d] = run;
        __syncthreads();
        float off = 0.f, blast = 0.f;
#pragma unroll
        for (int q = 0; q < 4; ++q) { const float t = TOT[q * 128 + d]; off += (q < sq) ? t : 0.f; blast += t; }
        { unsigned kw[8];
#pragma unroll
          for (int i = 0; i < 8; ++i) { const float k0 = (1.f - ex2(lf[2 * i])) * ex2(blast - (off + pre[2 * i])), k1 = (1.f - ex2(lf[2 * i + 1])) * ex2(blast - (off + pre[2 * i + 1])); kw[i] = pk2(k0, k1); }
          LAS u32x4* kp = (LAS u32x4*)(KT + d * PKT + 32 * sq);
          kp[0] = (u32x4){kw[0], kw[1], kw[2], kw[3]}; kp[1] = (u32x4){kw[4], kw[5], kw[6], kw[7]}; }
        if (sq == 0) ((float*)(A.ws + WS_DV))[(size_t)(bh * 64 + c) * 128 + d] = ex2(blast);
        __syncthreads();
        const LAS unsigned char* vt = VN + (8 * fq + (fr >> 2)) * PRAW + (16 * w + 4 * (fr & 3)) * 2;
        const s16x8 b0 = tr8(vt, 4 * PRAW), b1 = tr8(vt + 32 * PRAW, 4 * PRAW);
        float* up = ((float*)(A.ws + WS_U)) + (size_t)(bh * 64 + c) * 16384 + (size_t)(16 * w + fr) * 128 + 4 * fq;
#pragma unroll
        for (int dt = 0; dt < 8; ++dt) {
            const LAS unsigned char* kp = KT + (16 * dt + fr) * PKT + 16 * fq;
            const s16x8 a0 = *(const LAS s16x8*)kp, a1 = *(const LAS s16x8*)(kp + 64);
            f32x4 acc = (f32x4){0.f, 0.f, 0.f, 0.f};
            acc = __builtin_amdgcn_mfma_f32_16x16x32_bf16(a0, b0, acc, 0, 0, 0);
            acc = __builtin_amdgcn_mfma_f32_16x16x32_bf16(a1, b1, acc, 0, 0, 0);
            *(f32x4*)(up + 16 * dt) = acc;
        }
        __syncthreads();
    }
}

typedef float f32x16 __attribute__((ext_vector_type(16)));
__device__ __forceinline__ s16x8 pack8(u32x2 a, u32x2 c) { const u32x4 w = (u32x4){a.x, a.y, c.x, c.y}; return __builtin_bit_cast(s16x8, w); }
__device__ __forceinline__ void attn_phase(Frame& F, const Args& A) {
    const bf16* SQ = ((bf16*)(A.ws + WS_PROJ)) + 4 * ARR; const bf16* SK = ((bf16*)(A.ws + WS_PROJ)) + 5 * ARR; const bf16* SV = ((bf16*)(A.ws + WS_PROJ)) + 6 * ARR;
    const int r32 = F.lane & 31, hi = F.lane >> 5;
    LAS unsigned char* vw = F.lds + F.wave * 4096 + (F.lane >> 3) * 128 + (F.lane & 7) * 16;
    LAS unsigned char* vt = F.lds + F.wave * 4096 + (4 * hi + ((F.lane & 15) >> 2)) * 128 + ((F.lane >> 4) & 1) * 32 + (F.lane & 3) * 8;
    for (int wu = F.gw; wu < 64 * 128; wu += F.ngw) {
        const int bh = wu >> 7, qi = wu & 127, b = bh >> 3, h = bh & 7, q0 = TOK0 + 32 * qi, qrow = q0 + r32;
        s16x8 qf[4];
        { const bf16* qp = SQ + (size_t)(b * ROWS + qrow) * 512 + 64 * h + 8 * hi;
#pragma unroll
          for (int s2 = 0; s2 < 4; ++s2) qf[s2] = *(const s16x8*)(qp + 16 * s2); }
        const bf16* kbase = SK + (size_t)(b * ROWS + r32) * 512 + 64 * h + 8 * hi;
        const bf16* vbase = SV + (size_t)(b * ROWS + (F.lane >> 3)) * 512 + 64 * h + 8 * (F.lane & 7);
        f32x16 o0, o1;
#pragma unroll
        for (int r = 0; r < 16; ++r) { o0[r] = 0.f; o1[r] = 0.f; }
        float T = 0.f;
        const int ktd = q0 >> 5;
        s16x8 kf[4]; u32x4 vr[4];
        { const bf16* kp = kbase + (size_t)(32 * ktd) * 512; const bf16* vp = vbase + (size_t)(32 * ktd) * 512;
#pragma unroll
          for (int s2 = 0; s2 < 4; ++s2) kf[s2] = *(const s16x8*)(kp + 16 * s2);
#pragma unroll
          for (int i = 0; i < 4; ++i) vr[i] = *(const u32x4*)(vp + (size_t)(8 * i) * 512); }
        for (int kt = ktd; kt >= 1; --kt) {
            const int k0 = 32 * kt;
            f32x16 p;
#pragma unroll
            for (int r = 0; r < 16; ++r) p[r] = 0.f;
#pragma unroll
            for (int s2 = 0; s2 < 4; ++s2) p = __builtin_amdgcn_mfma_f32_32x32x16_bf16(kf[s2], qf[s2], p, 0, 0, 0);
#pragma unroll
            for (int i = 0; i < 4; ++i) *(LAS u32x4*)(vw + i * 1024) = vr[i];
            s16x8 va[2][2];
#pragma unroll
            for (int dt = 0; dt < 2; ++dt)
#pragma unroll
                for (int s2 = 0; s2 < 2; ++s2) {
                    const v4i16_t lo = __builtin_amdgcn_ds_read_tr16_b64_v4i16((LAS v4i16_t*)(vt + dt * 64 + s2 * 2048));
                    const v4i16_t hh = __builtin_amdgcn_ds_read_tr16_b64_v4i16((LAS v4i16_t*)(vt + dt * 64 + s2 * 2048 + 1024));
                    va[dt][s2] = (s16x8){lo[0], lo[1], lo[2], lo[3], hh[0], hh[1], hh[2], hh[3]};
                }
            if (kt > 1) {
                const bf16* kp = kbase + (size_t)(k0 - 32) * 512; const bf16* vp = vbase + (size_t)(k0 - 32) * 512;
#pragma unroll
                for (int s2 = 0; s2 < 4; ++s2) kf[s2] = *(const s16x8*)(kp + 16 * s2);
#pragma unroll
                for (int i = 0; i < 4; ++i) vr[i] = *(const u32x4*)(vp + (size_t)(8 * i) * 512);
            }
            const bool edge = (kt == ktd) || (kt == 1);
            float sp[16], iss[16], gs[4];
#pragma unroll
            for (int r = 0; r < 16; ++r) {
                const float z = fminf(p[r], 100.f); p[r] = z;
                float v = lg2(1.f + ex2(z));
                if (edge) { const int key = k0 + (r & 3) + 8 * (r >> 2) + 4 * hi; if (!(key >= PADR && key < qrow)) v = 0.f; }
                sp[r] = v;
            }
#pragma unroll
            for (int g = 0; g < 4; ++g) { iss[4 * g + 3] = sp[4 * g + 3]; iss[4 * g + 2] = iss[4 * g + 3] + sp[4 * g + 2]; iss[4 * g + 1] = iss[4 * g + 2] + sp[4 * g + 1]; iss[4 * g] = iss[4 * g + 1] + sp[4 * g]; gs[g] = iss[4 * g]; }
            float sg[4], go[4];
#pragma unroll
            for (int g = 0; g < 4; ++g) { const auto rr = __builtin_amdgcn_permlane32_swap(__float_as_uint(gs[g]), __float_as_uint(gs[g]), false, false);
                sg[g] = __uint_as_float(rr[0]) + __uint_as_float(rr[1]); go[g] = hi ? 0.f : __uint_as_float(rr[1]); }
            float off[4];
            off[3] = T + go[3]; const float e2 = sg[3]; off[2] = T + e2 + go[2]; const float e1 = e2 + sg[2]; off[1] = T + e1 + go[1]; const float e0 = e1 + sg[1]; off[0] = T + e0 + go[0];
            T += e0 + sg[0];
            float a[16];
#pragma unroll
            for (int r = 0; r < 16; ++r) {
                float v = ex2(p[r] - (off[r >> 2] + iss[r]));
                if (edge) { const int key = k0 + (r & 3) + 8 * (r >> 2) + 4 * hi; if (!(key >= PADR && key < qrow)) v = 0.f; }
                a[r] = v;
            }
#pragma unroll
            for (int s2 = 0; s2 < 2; ++s2) {
                u32x4 w; w.x = pk2(a[8 * s2], a[8 * s2 + 1]); w.y = pk2(a[8 * s2 + 2], a[8 * s2 + 3]); w.z = pk2(a[8 * s2 + 4], a[8 * s2 + 5]); w.w = pk2(a[8 * s2 + 6], a[8 * s2 + 7]);
                const s16x8 pb = __builtin_bit_cast(s16x8, w);
                o0 = __builtin_amdgcn_mfma_f32_32x32x16_bf16(va[0][s2], pb, o0, 0, 0, 0);
                o1 = __builtin_amdgcn_mfma_f32_32x32x16_bf16(va[1][s2], pb, o1, 0, 0, 0);
            }
            if (__all(T > STICK_THR)) break;
        }
        float ss = 0.f;
#pragma unroll
        for (int r = 0; r < 16; ++r) ss += o0[r] * o0[r] + o1[r] * o1[r];
        { const auto rr = __builtin_amdgcn_permlane32_swap(__float_as_uint(ss), __float_as_uint(ss), false, false); ss = __uint_as_float(rr[0]) + __uint_as_float(rr[1]); }
        const float rs = 1.0f / sqrtf(ss * (1.f / 64.f) + RMS_EPS);
        const float* gp = A.in[5] + 64 * h + 4 * hi;
        bf16* op = ((bf16*)(A.ws + WS_MIX)) + (size_t)(b * SEQ + qrow - TOK0) * DM + 512 + 64 * h + 4 * hi;
#pragma unroll
        for (int g = 0; g < 4; ++g) {
            const f32x4 g0 = *(const f32x4*)(gp + 8 * g), g1 = *(const f32x4*)(gp + 32 + 8 * g);
            u32x2 w0, w1;
            w0.x = pk2(o0[4 * g] * rs * g0[0], o0[4 * g + 1] * rs * g0[1]); w0.y = pk2(o0[4 * g + 2] * rs * g0[2], o0[4 * g + 3] * rs * g0[3]);
            w1.x = pk2(o1[4 * g] * rs * g1[0], o1[4 * g + 1] * rs * g1[1]); w1.y = pk2(o1[4 * g + 2] * rs * g1[2], o1[4 * g + 3] * rs * g1[3]);
            *(u32x2*)(op + 8 * g) = w0; *(u32x2*)(op + 32 + 8 * g) = w1;
        }
    }
}

__device__ __forceinline__ void hb_phase(Frame& F, const Args& A) {
    for (int g = blockIdx.x * NTHREADS + F.tid; g < 32 * 4096; g += F.G * NTHREADS) {
        const int bh = g >> 12, r = g & 4095, v = r >> 5, d4 = (r & 31) * 4;
        const float* up = ((float*)(A.ws + WS_U)) + (size_t)bh * 64 * 16384 + v * 128 + d4;
        const float* dp = ((float*)(A.ws + WS_DV)) + (size_t)bh * 64 * 128 + d4;
        bf16* sp = ((bf16*)(A.ws + WS_S)) + (size_t)bh * 64 * 16384 + v * 128 + d4;
        f32x4 s = (f32x4){0.f, 0.f, 0.f, 0.f};
#pragma unroll 8
        for (int c = 0; c < 64; ++c) {
            const f32x4 uu = *(const f32x4*)(up + (size_t)c * 16384), dd = *(const f32x4*)(dp + c * 128);
            s = dd * s + uu;
            u32x2 w; w.x = pk2(s[0], s[1]); w.y = pk2(s[2], s[3]);
            *(u32x2*)(sp + (size_t)c * 16384) = w;
        }
    }
}

__device__ __forceinline__ void hc_phase(Frame& F, const Args& A) {
    const bf16* HQ = ((bf16*)(A.ws + WS_PROJ)); const bf16* LF = HQ + 1 * ARR; const bf16* HV = HQ + 2 * ARR; const bf16* HG = HQ + 3 * ARR;
    LAS unsigned char* RLF = F.lds;
    LAS unsigned char* RQ = RLF + 64 * PRAW;
    LAS unsigned char* VN = RQ + 64 * PRAW;
    LAS unsigned char* QT = VN + 64 * PRAW;
    LAS unsigned char* KI = QT + 64 * PRAW;
    LAS unsigned char* SC = KI + 64 * PRAW;
    LAS float* TOT = (LAS float*)(SC + 64 * PKT);
    LAS float* SSQ = TOT + 512;
    const int tid = F.tid, lane = F.lane, w = F.wave, fr = lane & 15, fq = lane >> 4;
    const int d = tid & 127, sq = tid >> 7;
    int u = blockIdx.x;
    RawTile rl, rq, rv;
    if (u < 32 * 64) { const int b = u >> 8, h = (u >> 6) & 3, cc = (u & 63) + 1; rl = raw_load(LF, b, h, cc, tid); rq = raw_load(HQ, b, h, cc, tid); rv = raw_load(HV, b, h, cc, tid); }
    for (; u < 32 * 64; u += F.G) {
        const int bh = u >> 6, b = bh >> 2, h = bh & 3, cc = (u & 63) + 1;
        raw_store(RLF, PRAW, rl, tid); raw_store(RQ, PRAW, rq, tid); raw_store(VN, PRAW, rv, tid);
        __syncthreads();
        { const int un = u + F.G; if (un < 32 * 64) { const int b2 = un >> 8, h2 = (un >> 6) & 3, c2 = (un & 63) + 1; rl = raw_load(LF, b2, h2, c2, tid); rq = raw_load(HQ, b2, h2, c2, tid); rv = raw_load(HV, b2, h2, c2, tid); } }
        s16x8 sa[4]; u32x2 gt[4];
        { const bf16* sp = ((bf16*)(A.ws + WS_S)) + (size_t)(bh * 64 + cc - 1) * 16384 + (size_t)(16 * w + fr) * 128 + 8 * fq;
#pragma unroll
          for (int ks = 0; ks < 4; ++ks) sa[ks] = *(const s16x8*)(sp + 32 * ks);
          const bf16* gp = HG + (size_t)(b * ROWS + 64 * cc + fr) * 512 + 128 * h + 16 * w + 4 * fq;
#pragma unroll
          for (int tt = 0; tt < 4; ++tt) gt[tt] = *(const u32x2*)(gp + (size_t)(16 * tt) * 512); }
        {
            float lf[16], pre[16], qv[16]; float run = 0.f;
#pragma unroll
            for (int i = 0; i < 16; ++i) { lf[i] = bf2f(*(const LAS unsigned short*)(RLF + (16 * sq + i) * PRAW + 2 * d)); qv[i] = bf2f(*(const LAS unsigned short*)(RQ + (16 * sq + i) * PRAW + 2 * d)); run += lf[i]; pre[i] = run; }
            TOT[sq * 128 + d] = run;
            __syncthreads();
            float off = 0.f;
#pragma unroll
            for (int q = 0; q < 4; ++q) { const float t = TOT[q * 128 + d]; off += (q < sq) ? t : 0.f; }
#pragma unroll
            for (int i = 0; i < 16; ++i) { const float bc = off + pre[i];
                *(LAS unsigned short*)(QT + (16 * sq + i) * PRAW + 2 * d) = (unsigned short)f2bf(qv[i] * ex2(bc));
                *(LAS unsigned short*)(KI + (16 * sq + i) * PRAW + 2 * d) = (unsigned short)f2bf((1.f - ex2(lf[i])) * ex2(-bc)); }
        }
        __syncthreads();
        {
            const int tt = w >> 1;
            s16x8 bq[4];
            const LAS unsigned char* qp = QT + (16 * tt + fr) * PRAW + 16 * fq;
#pragma unroll
            for (int ks = 0; ks < 4; ++ks) bq[ks] = *(const LAS s16x8*)(qp + 64 * ks);
#pragma unroll
            for (int j = 0; j < 2; ++j) {
                const int st = 2 * (w & 1) + j;
                const LAS unsigned char* kp = KI + (16 * st + fr) * PRAW + 16 * fq;
                f32x4 acc = (f32x4){0.f, 0.f, 0.f, 0.f};
#pragma unroll
                for (int ks = 0; ks < 4; ++ks) acc = __builtin_amdgcn_mfma_f32_16x16x32_bf16(*(const LAS s16x8*)(kp + 64 * ks), bq[ks], acc, 0, 0, 0);
                const int t = 16 * tt + fr, s0 = 16 * st + 4 * fq;
                u32x2 wv; wv.x = pk2(s0 <= t ? acc[0] : 0.f, s0 + 1 <= t ? acc[1] : 0.f); wv.y = pk2(s0 + 2 <= t ? acc[2] : 0.f, s0 + 3 <= t ? acc[3] : 0.f);
                *(LAS u32x2*)(SC + t * PKT + 2 * s0) = wv;
            }
        }
        __syncthreads();
        f32x4 acc[4];
        {
            const LAS unsigned char* vt = VN + (8 * fq + (fr >> 2)) * PRAW + (16 * w + 4 * (fr & 3)) * 2;
            const s16x8 av0 = tr8(vt, 4 * PRAW), av1 = tr8(vt + 32 * PRAW, 4 * PRAW);
#pragma unroll
            for (int tt = 0; tt < 4; ++tt) {
                const LAS unsigned char* scp = SC + (16 * tt + fr) * PKT + 16 * fq;
                const LAS unsigned char* qp = QT + (16 * tt + fr) * PRAW + 16 * fq;
                f32x4 c = (f32x4){0.f, 0.f, 0.f, 0.f};
                c = __builtin_amdgcn_mfma_f32_16x16x32_bf16(av0, *(const LAS s16x8*)scp, c, 0, 0, 0);
                c = __builtin_amdgcn_mfma_f32_16x16x32_bf16(av1, *(const LAS s16x8*)(scp + 64), c, 0, 0, 0);
#pragma unroll
                for (int ks = 0; ks < 4; ++ks) c = __builtin_amdgcn_mfma_f32_16x16x32_bf16(sa[ks], *(const LAS s16x8*)(qp + 64 * ks), c, 0, 0, 0);
                acc[tt] = c;
                float ss = (c[0] * c[0] + c[1] * c[1]) + (c[2] * c[2] + c[3] * c[3]);
                ss += __shfl_xor(ss, 16); ss += __shfl_xor(ss, 32);
                if (fq == 0) SSQ[w * 64 + 16 * tt + fr] = ss;
            }
        }
        __syncthreads();
        {
            const f32x4 ng = *(const f32x4*)(A.in[4] + 128 * h + 16 * w + 4 * fq);
            bf16* op = ((bf16*)(A.ws + WS_MIX)) + (size_t)(b * SEQ + 64 * (cc - 1) + fr) * DM + 128 * h + 16 * w + 4 * fq;
#pragma unroll
            for (int tt = 0; tt < 4; ++tt) {
                float tot = 0.f;
#pragma unroll
                for (int k = 0; k < 8; ++k) tot += SSQ[k * 64 + 16 * tt + fr];
                const float rs = 1.0f / sqrtf(tot * (1.f / 128.f) + RMS_EPS);
                u32x2 o;
                o.x = pk2(acc[tt][0] * rs * ng[0] * bflo(gt[tt].x), acc[tt][1] * rs * ng[1] * bfhi(gt[tt].x));
                o.y = pk2(acc[tt][2] * rs * ng[2] * bflo(gt[tt].y), acc[tt][3] * rs * ng[3] * bfhi(gt[tt].y));
                *(u32x2*)(op + (size_t)(16 * tt) * DM) = o;
            }
        }
        __syncthreads();
    }
}

__device__ __forceinline__ void ln_stats(const f32x4 (&v)[4], float& mean, float& rstd) {
    float s = 0.f;
#pragma unroll
    for (int j = 0; j < 4; ++j) s += (v[j][0] + v[j][1]) + (v[j][2] + v[j][3]);
    mean = wave_sum(s) * (1.f / DM);
    float s2 = 0.f;
#pragma unroll
    for (int j = 0; j < 4; ++j) { const f32x4 d = v[j] - mean; s2 += (d[0] * d[0] + d[1] * d[1]) + (d[2] * d[2] + d[3] * d[3]); }
    rstd = 1.0f / sqrtf(wave_sum(s2) * (1.f / DM) + LN_EPS);
}

__device__ __forceinline__ void route_row(Frame& F, const Args& A, const float (&lg)[20], int rl, LAS int* lcnt, LAS int* rec) {
    const float* brg = A.in[10];
    float g0 = lg[0] + brg[0], g1 = lg[1] + brg[1], g2 = lg[2] + brg[2], g3 = lg[3] + brg[3];
    int grp = 0; float gm = g0;
    if (g1 > gm) { gm = g1; grp = 1; } if (g2 > gm) { gm = g2; grp = 2; } if (g3 > gm) { gm = g3; grp = 3; }
    const float pg = 1.f / (__expf(g0 - gm) + __expf(g1 - gm) + __expf(g2 - gm) + __expf(g3 - gm));
    float in0, in1, in2, in3;
    if (grp == 0) { in0 = lg[4]; in1 = lg[5]; in2 = lg[6]; in3 = lg[7]; }
    else if (grp == 1) { in0 = lg[8]; in1 = lg[9]; in2 = lg[10]; in3 = lg[11]; }
    else if (grp == 2) { in0 = lg[12]; in1 = lg[13]; in2 = lg[14]; in3 = lg[15]; }
    else { in0 = lg[16]; in1 = lg[17]; in2 = lg[18]; in3 = lg[19]; }
    const float* be = A.in[12] + grp * 4;
    in0 += be[0]; in1 += be[1]; in2 += be[2]; in3 += be[3];
    int i0 = 0; float m0 = in0;
    if (in1 > m0) { m0 = in1; i0 = 1; } if (in2 > m0) { m0 = in2; i0 = 2; } if (in3 > m0) { m0 = in3; i0 = 3; }
    int i1 = -1; float m1 = 0.f;
    if (i0 != 0) { m1 = in0; i1 = 0; }
    if (i0 != 1 && (i1 < 0 || in1 > m1)) { m1 = in1; i1 = 1; }
    if (i0 != 2 && (i1 < 0 || in2 > m1)) { m1 = in2; i1 = 2; }
    if (i0 != 3 && (i1 < 0 || in3 > m1)) { m1 = in3; i1 = 3; }
    const float w0 = 1.f / (1.f + __expf(m1 - m0)), w1 = 1.f - w0;
    const int e0 = grp * 4 + i0, e1 = grp * 4 + i1;
    const int p0 = atomicAdd((int*)&lcnt[e0], 1), p1 = atomicAdd((int*)&lcnt[e1], 1);
    rec[rl * 6 + 0] = e0; rec[rl * 6 + 1] = p0; rec[rl * 6 + 2] = __float_as_int(pg * w0);
    rec[rl * 6 + 3] = e1; rec[rl * 6 + 4] = p1; rec[rl * 6 + 5] = __float_as_int(pg * w1);
}
__device__ __forceinline__ void p6_ln_router(Frame& F, const Args& A) {
    LAS int* lcnt = F.misc + 32; LAS int* lbase = F.misc + 48;
    LAS f32x4* WL = (LAS f32x4*)F.lds;
    LAS int* rec = (LAS int*)(F.lds + 81920);
    for (int it = F.tid; it < 1024 * 5; it += NTHREADS) {
        const int k = it / 5, c = it % 5, j = k >> 8, ln = (k >> 2) & 63, e = k & 3;
        const f32x4 w = (c == 0) ? *(const f32x4*)(A.in[9] + (size_t)k * 4) : *(const f32x4*)(A.in[11] + (size_t)k * 16 + 4 * (c - 1));
        WL[((j * 4 + e) * 5 + c) * 64 + ln] = w;
    }
    __syncthreads();
    const LAS f32x4* wl = WL + F.lane;
    for (int slab = blockIdx.x; slab < MTOK / 128; slab += F.G) {
        if (F.tid < 16) lcnt[F.tid] = 0;
        __syncthreads();
#pragma unroll 1
        for (int i = 0; i < 16; i += 2) {
            const int rl = F.wave * 16 + i, row = slab * 128 + rl;
            f32x4* xr0 = (f32x4*)(A.out + (size_t)row * DM) + F.lane; f32x4* xr1 = xr0 + DM / 4;
            f32x4 v0[4], v1[4];
#pragma unroll
            for (int j = 0; j < 4; ++j) { v0[j] = xr0[64 * j]; v1[j] = xr1[64 * j]; }
            float mean0, rstd0, mean1, rstd1; ln_stats(v0, mean0, rstd0); ln_stats(v1, mean1, rstd1);
#pragma unroll
            for (int j = 0; j < 4; ++j) {
                const f32x4 g = ((const f32x4*)A.in[7])[64 * j + F.lane], bb = ((const f32x4*)A.in[8])[64 * j + F.lane];
                v0[j] = (v0[j] - mean0) * rstd0 * g + bb; v1[j] = (v1[j] - mean1) * rstd1 * g + bb;
                xr0[64 * j] = v0[j]; xr1[64 * j] = v1[j];
            }
            float la[20], lb2[20];
#pragma unroll
            for (int e = 0; e < 20; ++e) { la[e] = 0.f; lb2[e] = 0.f; }
#pragma unroll 1
            for (int j = 0; j < 4; ++j) {
                const f32x4 s0 = (j == 0) ? v0[0] : (j == 1) ? v0[1] : (j == 2) ? v0[2] : v0[3];
                const f32x4 s1 = (j == 0) ? v1[0] : (j == 1) ? v1[1] : (j == 2) ? v1[2] : v1[3];
                const LAS f32x4* wj = wl + j * (20 * 64);
#pragma unroll
                for (int e = 0; e < 4; ++e) {
                    const float h0 = s0[e], h1 = s1[e];
#pragma unroll
                    for (int c = 0; c < 5; ++c) { const f32x4 w = wj[(e * 5 + c) * 64];
                        la[4 * c] += h0 * w[0]; la[4 * c + 1] += h0 * w[1]; la[4 * c + 2] += h0 * w[2]; la[4 * c + 3] += h0 * w[3];
                        lb2[4 * c] += h1 * w[0]; lb2[4 * c + 1] += h1 * w[1]; lb2[4 * c + 2] += h1 * w[2]; lb2[4 * c + 3] += h1 * w[3]; }
                }
            }
#pragma unroll
            for (int e = 0; e < 20; ++e) { la[e] = wave_sum(la[e]); lb2[e] = wave_sum(lb2[e]); }
            if (F.lane == 0) { route_row(F, A, la, rl, lcnt, rec); route_row(F, A, lb2, rl + 1, lcnt, rec); }
        }
        __syncthreads();
        if (F.tid < 16) lbase[F.tid] = (int)atomicAdd(((unsigned*)(A.ws + WS_CTL)) + CW_CNT + F.tid, (unsigned)lcnt[F.tid]);
        __syncthreads();
        if (F.tid < 128) {
            unsigned* mp = ((unsigned*)(A.ws + WS_META)) + (size_t)(slab * 128 + F.tid) * 8;
            const int e0 = rec[F.tid * 6 + 0], e1 = rec[F.tid * 6 + 3];
            u32x4 a, c;
            a.x = (unsigned)e0; a.y = (unsigned)(lbase[e0] + rec[F.tid * 6 + 1]); a.z = (unsigned)rec[F.tid * 6 + 2]; a.w = (unsigned)e1;
            c.x = (unsigned)(lbase[e1] + rec[F.tid * 6 + 4]); c.y = (unsigned)rec[F.tid * 6 + 5]; c.z = 0u; c.w = 0u;
            *(u32x4*)mp = a; *(u32x4*)(mp + 4) = c;
        }
        __syncthreads();
    }
}

__device__ __forceinline__ void build_toff(Frame& F, const Args& A) {
    __syncthreads();
    if (F.tid == 0) { int acc = 0;
        for (int e = 0; e < NEXP; ++e) { F.misc[e] = acc; const unsigned c = __hip_atomic_load(((unsigned*)(A.ws + WS_CTL)) + CW_CNT + e, __ATOMIC_RELAXED, __HIP_MEMORY_SCOPE_AGENT); acc += (int)((c + 255u) >> 8); }
        F.misc[NEXP] = acc; }
    __syncthreads();
}

__device__ __forceinline__ void p7_scatter(Frame& F, const Args& A) {
    build_toff(F, A);
    for (int row = F.gw; row < MTOK; row += F.ngw) {
        const unsigned* mp = ((unsigned*)(A.ws + WS_META)) + (size_t)row * 8;
        const int e0 = (int)mp[0], p0 = (int)mp[1], e1 = (int)mp[3], p1 = (int)mp[4];
        const size_t s0 = (size_t)F.misc[e0] * 256 + p0, s1 = (size_t)F.misc[e1] * 256 + p1;
        const f32x4* xr = (const f32x4*)(A.out + (size_t)row * DM) + F.lane;
        u32x2* o0 = (u32x2*)(((bf16*)(A.ws + WS_XS)) + s0 * DM) + F.lane; u32x2* o1 = (u32x2*)(((bf16*)(A.ws + WS_XS)) + s1 * DM) + F.lane;
#pragma unroll
        for (int j = 0; j < 4; ++j) { const f32x4 v = xr[64 * j]; u32x2 w; w.x = pk2(v[0], v[1]); w.y = pk2(v[2], v[3]); o0[64 * j] = w; o1[64 * j] = w; }
    }
    LAS float* scr = (LAS float*)(F.lds + F.wave * 16384);
    constexpr int I13 = (DM / 64) * (DEXP / 32), I2 = (DEXP / 64) * (DM / 32);
    for (int it = F.gw; it < NEXP * (2 * I13 + I2); it += F.ngw) {
        const int e = it / (2 * I13 + I2), r = it % (2 * I13 + I2);
        if (r < I13) transpose_item<1>(A.in[13] + (size_t)e * DM * DEXP, DM, DEXP, ((bf16*)(A.ws + WS_W13)) + (size_t)e * 1024 * DM, scr, r, F.lane);
        else if (r < 2 * I13) transpose_item<2>(A.in[14] + (size_t)e * DM * DEXP, DM, DEXP, ((bf16*)(A.ws + WS_W13)) + (size_t)e * 1024 * DM, scr, r - I13, F.lane);
        else transpose_item<0>(A.in[15] + (size_t)e * DEXP * DM, DEXP, DM, ((bf16*)(A.ws + WS_W2)) + (size_t)e * DM * DEXP, scr, r - 2 * I13, F.lane);
    }
}

__device__ __forceinline__ void p10_final(Frame& F, const Args& A) {
    build_toff(F, A);
    for (int row = F.gw; row < MTOK; row += F.ngw) {
        const unsigned* mp = ((unsigned*)(A.ws + WS_META)) + (size_t)row * 8;
        const int e0 = (int)mp[0], p0 = (int)mp[1], e1 = (int)mp[3], p1 = (int)mp[4];
        const float g0 = __uint_as_float(mp[2]), g1 = __uint_as_float(mp[5]);
        const size_t s0 = (size_t)F.misc[e0] * 256 + p0, s1 = (size_t)F.misc[e1] * 256 + p1;
        f32x4* xr = (f32x4*)(A.out + (size_t)row * DM) + F.lane;
        const u32x2* y0 = (const u32x2*)(((bf16*)(A.ws + WS_YS)) + s0 * DM) + F.lane; const u32x2* y1 = (const u32x2*)(((bf16*)(A.ws + WS_YS)) + s1 * DM) + F.lane;
        f32x4 v[4];
#pragma unroll
        for (int j = 0; j < 4; ++j) { const f32x4 hv = xr[64 * j]; const u32x2 a = y0[64 * j], c = y1[64 * j];
            v[j][0] = ALPHA * hv[0] + g0 * bflo(a.x) + g1 * bflo(c.x); v[j][1] = ALPHA * hv[1] + g0 * bfhi(a.x) + g1 * bfhi(c.x);
            v[j][2] = ALPHA * hv[2] + g0 * bflo(a.y) + g1 * bflo(c.y); v[j][3] = ALPHA * hv[3] + g0 * bfhi(a.y) + g1 * bfhi(c.y); }
        float mean, rstd; ln_stats(v, mean, rstd);
#pragma unroll
        for (int j = 0; j < 4; ++j) { const f32x4 g = ((const f32x4*)A.in[16])[64 * j + F.lane], bb = ((const f32x4*)A.in[17])[64 * j + F.lane]; xr[64 * j] = (v[j] - mean) * rstd * g + bb; }
    }
}

#define XB_TMO      128
#define XB_XCNT(j)  (256  + 64 * (j))
#define XB_XSUB(j)  (1280 + 64 * (j))
#define XB_XGEN(j)  (2304 + 64 * (j))
#define XB_TOP      3328
#define XB_TOPGEN   3392
#define XCD_BAR_WORDS 3456
#define XB_SPIN_CAP (1u << 18)

__device__ __forceinline__ unsigned xb_ld(unsigned* p)              { return __hip_atomic_load(p, __ATOMIC_RELAXED, __HIP_MEMORY_SCOPE_AGENT); }
__device__ __forceinline__ unsigned xb_add(unsigned* p, unsigned v) { return __hip_atomic_fetch_add(p, v, __ATOMIC_RELAXED, __HIP_MEMORY_SCOPE_AGENT); }
__device__ __forceinline__ unsigned xb_xcc_id() { return (unsigned)__builtin_amdgcn_s_getreg((3 << 11) | 20) & 0xFu; }
#define XB_SPIN(cond, bar) do { unsigned _sp = 0; while (cond) { __builtin_amdgcn_s_sleep(1); \
    if ((++_sp & 255u) == 0u) { if (xb_ld(&(bar)[XB_TMO])) break; if (_sp > XB_SPIN_CAP) { atomicAdd(&(bar)[XB_TMO], 1u); break; } } } } while (0)

struct XcdBarrier {
    unsigned* bar; unsigned x;
    volatile LAS unsigned* st;
};

__device__ __forceinline__ XcdBarrier xcd_barrier_post(unsigned* bar, volatile LAS unsigned* st) {
    XcdBarrier b; b.bar = bar; b.x = xb_xcc_id(); b.st = st;
    if (threadIdx.x == 0) (void)xb_add(&bar[XB_XCNT(b.x)], 1u);
    return b;
}
__device__ __forceinline__ void xcd_barrier_complete(unsigned* bar, unsigned x, unsigned& nloc, unsigned& nx) {
    const unsigned G = gridDim.x * gridDim.y * gridDim.z;
    unsigned sum, cnt, mine, sp = 0u;
    for (;;) {
        sum = 0u; cnt = 0u; mine = 0u;
#pragma unroll
        for (unsigned j = 0; j < 16; ++j) { const unsigned c = xb_ld(&bar[XB_XCNT(j)]); sum += c; cnt += (c > 0u) ? 1u : 0u; mine = (j == x) ? c : mine; }
        if (sum == G) break;
        __builtin_amdgcn_s_sleep(1);
        if ((++sp & 255u) == 0u) { if (xb_ld(&bar[XB_TMO])) break; if (sp > XB_SPIN_CAP) { atomicAdd(&bar[XB_TMO], 1u); break; } }
    }
    nloc = mine > 0u ? mine : 1u; nx = cnt > 0u ? cnt : 1u;
}

__device__ __forceinline__ void xcd_barrier(const XcdBarrier& b) {
    asm volatile("s_waitcnt vmcnt(0)" ::: "memory");
    __syncthreads();
    if (threadIdx.x == 0) {
        unsigned* bar = b.bar;
        __builtin_amdgcn_s_waitcnt(0);
        unsigned nloc = b.st[0], nx = b.st[1];
        if (nloc == 0u) { xcd_barrier_complete(bar, b.x, nloc, nx); b.st[0] = nloc; b.st[1] = nx; }
        const unsigned old = xb_add(&bar[XB_XSUB(b.x)], 1u);
        const unsigned gen = old / nloc;
        if (old + 1u == (gen + 1u) * nloc) {
            __builtin_amdgcn_fence(__ATOMIC_RELEASE, "agent");
            asm volatile("s_waitcnt vmcnt(0)" ::: "memory");
            const unsigned og = xb_add(&bar[XB_TOP], 1u);
            const unsigned tg = og / nx;
            if (og + 1u == (tg + 1u) * nx) xb_add(&bar[XB_TOPGEN], 1u);
            else XB_SPIN(xb_ld(&bar[XB_TOPGEN]) == tg, bar);
            __builtin_amdgcn_fence(__ATOMIC_ACQUIRE, "agent");
            xb_add(&bar[XB_XGEN(b.x)], 1u);
            asm volatile("s_waitcnt vmcnt(0)" ::: "memory");
        } else {
            XB_SPIN(xb_ld(&bar[XB_XGEN(b.x)]) == gen, bar);
            __builtin_amdgcn_fence(__ATOMIC_ACQUIRE, "agent");
            asm volatile("s_waitcnt vmcnt(0)" ::: "memory");
        }
    }
    __syncthreads();
}

constexpr int NPHASE = 11;
__global__ void __launch_bounds__(NTHREADS, 2) mega_fwd(Args args) {
    extern __shared__ __attribute__((aligned(16))) unsigned char lds[];
    cg::grid_group grid = cg::this_grid();
    Frame F;
    F.lds = (LAS unsigned char*)lds; F.misc = (LAS int*)(F.lds + MISC_OFF);
    F.tid = threadIdx.x; F.lane = F.tid & 63; F.wave = __builtin_amdgcn_readfirstlane(F.tid >> 6); F.G = gridDim.x;
    F.gw = blockIdx.x * NWAVES + F.wave; F.ngw = F.G * NWAVES;
    const Args& A = args;
    const int lo = args.ph_lo, hi = args.ph_hi;
    if (F.tid < 2) F.misc[MISC_BAR + F.tid] = 0;
    __syncthreads();
    XcdBarrier bar; bar.bar = (unsigned*)(args.ws + WS_CTL) + CW_BAR; bar.x = 0; bar.st = nullptr;
    if (MK_LAUNCHES == 1) bar = xcd_barrier_post((unsigned*)(args.ws + WS_CTL) + CW_BAR, (volatile LAS unsigned*)(F.misc + MISC_BAR));
#define IN(k) (lo <= (k) && (k) < hi)
#define SEAM(k) do { if (IN((k) + 1)) { if ((k) == 0) grid.sync(); else xcd_barrier(bar); } } while (0)

    if (IN(0)) { p0_prep(F, A); SEAM(0); }
    if (IN(1)) {
        pg8::Gemm g{((bf16*)(A.ws + WS_XB)), ((bf16*)(A.ws + WS_WIN)), MTOK, NIN, DM}; pg8::StaticOrder S; S.init(MTOK, NIN, F.G, (int)blockIdx.x);
        EpiProj E{((bf16*)(A.ws + WS_PROJ)), ((float*)(A.ws + WS_LB))};
        pg8::gemm_phase<EpiProj, pg8::StaticOrder, PG8_ALIGN, PG8_SP2>(F.lds, g, S, E);
        SEAM(1);
    }
    if (IN(2)) {
        ha_phase(F, A);
        attn_phase(F, A);
        SEAM(2);
    }
    if (IN(3)) { hb_phase(F, A); SEAM(3); }
    if (IN(4)) {
        hc_phase(F, A);
        SEAM(4);
    }
    if (IN(5)) {
        pg8::Gemm g{((bf16*)(A.ws + WS_MIX)), ((bf16*)(A.ws + WS_WOUT)), MTOK, DM, DM}; pg8::StaticOrder S; S.init(MTOK, DM, F.G, (int)blockIdx.x);
        EpiOut E{A.in[0], A.out};
        pg8::gemm_phase<EpiOut, pg8::StaticOrder, PG8_ALIGN, PG8_SP2>(F.lds, g, S, E);
        SEAM(5);
    }
    if (IN(6)) { p6_ln_router(F, A); SEAM(6); }
    if (IN(7)) { p7_scatter(F, A); SEAM(7); }
    if (IN(8)) {
        build_toff(F, A);
        pg8::Gemm g{((bf16*)(A.ws + WS_XS)), ((bf16*)(A.ws + WS_W13)), XS_ROWS, 1024, DM}; MoeOrder S{(const LAS int*)F.misc, F.G, (int)blockIdx.x, F.misc[NEXP]};
        EpiHid E{((bf16*)(A.ws + WS_HID))};
        pg8::gemm_phase<EpiHid, MoeOrder, PG8_ALIGN, PG8_SP2>(F.lds, g, S, E);
        SEAM(8);
    }
    if (IN(9)) {
        build_toff(F, A);
        pg8::Gemm g{((bf16*)(A.ws + WS_HID)), ((bf16*)(A.ws + WS_W2)), XS_ROWS, 1024, DEXP}; MoeOrder S{(const LAS int*)F.misc, F.G, (int)blockIdx.x, F.misc[NEXP]};
        EpiYs E{((bf16*)(A.ws + WS_YS))};
        pg8::gemm_phase<EpiYs, MoeOrder, PG8_ALIGN, PG8_SP2>(F.lds, g, S, E);
        SEAM(9);
    }
    if (IN(10)) { p10_final(F, A); }
#undef IN
#undef SEAM
}

extern "C" void kernel_launch(void* const* d_in, const int* in_sizes, int n_in, void* d_out, int out_size, void* d_ws, size_t ws_size, hipStream_t stream) {
    static int grid = 0;
    if (grid == 0) {
        if (n_in != 18 || in_sizes[0] != MTOK * DM || out_size != MTOK * DM || ws_size < WS_END) {
            fprintf(stderr, "kernel_launch: unexpected shapes (n_in %d, in0 %d, out %d, ws %zu); nothing launched\n", n_in, n_in > 0 ? in_sizes[0] : -1, out_size, ws_size); grid = -1; return; }
        int dev = 0, cus = 0, per_cu = 0;
        if (hipGetDevice(&dev) != hipSuccess || hipDeviceGetAttribute(&cus, hipDeviceAttributeMultiprocessorCount, dev) != hipSuccess) { grid = -1; return; }
        if (hipFuncSetAttribute((const void*)mega_fwd, hipFuncAttributeMaxDynamicSharedMemorySize, LDS_BYTES) != hipSuccess) { fprintf(stderr, "kernel_launch: hipFuncSetAttribute failed\n"); grid = -1; return; }
        if (hipOccupancyMaxActiveBlocksPerMultiprocessor(&per_cu, (const void*)mega_fwd, NTHREADS, LDS_BYTES) != hipSuccess || per_cu < 1) { fprintf(stderr, "kernel_launch: occupancy query says %d\n", per_cu); per_cu = 1; }
        (void)hipGetLastError();
        grid = cus;
    }
    if (grid < 0) return;
    (void)hipMemsetAsync((char*)d_ws + WS_CTL, 0, CTL_ZERO_BYTES, stream);
    Args a{};
    for (int i = 0; i < 18; ++i) a.in[i] = (const float*)d_in[i];
    a.out = (float*)d_out; a.ws = (unsigned char*)d_ws;
#if MK_LAUNCHES == 1
    a.ph_lo = 0; a.ph_hi = NPHASE;
    void* kargs[] = {&a};
    hipError_t e = hipLaunchCooperativeKernel((const void*)mega_fwd, dim3(grid), dim3(NTHREADS), kargs, LDS_BYTES, stream);
    if (e != hipSuccess) fprintf(stderr, "kernel_launch: cooperative launch failed: %s (grid %d)\n", hipGetErrorString(e), grid);
#else
    for (int p = 0; p < NPHASE; ++p) { a.ph_lo = p; a.ph_hi = p + 1; hipLaunchKernelGGL(mega_fwd, dim3(grid), dim3(NTHREADS), LDS_BYTES, stream, a); }
#endif
}
```

```cpp
#include <hip/hip_runtime.h>
#include <hip/hip_cooperative_groups.h>
#include <cstdio>
#include <cstdint>
namespace cg = cooperative_groups;
namespace pg8 {
#define PG8_LAS __attribute__((address_space(3)))
typedef unsigned short bf16_t;
typedef short bf16x8 __attribute__((ext_vector_type(8)));
typedef float f32x4 __attribute__((ext_vector_type(4)));
typedef unsigned u32x4 __attribute__((ext_vector_type(4)));
constexpr int BM = 256, BK = 64, HALF = 128, HTB = HALF * BK * 2  , STAGE_BYTES = 8 * HTB, NXCD = 8, WGM = 8;

__host__ __device__ __forceinline__ int lds_byte(int r, int c) { const int st = (r >> 4) * 2 + (c >> 5), rr = r & 15, cc = c & 31, ob = rr * 64 + cc * 2; return st * 1024 + (ob ^ (((ob >> 9) & 1) << 5)); }
__host__ __device__ __forceinline__ void stage_rc(int b, int& R, int& C) { const int st = b / 1024, sb = b % 1024, swz = sb ^ (((sb >> 9) & 1) << 5); R = (st >> 1) * 16 + swz / 64; C = (st & 1) * 32 + (swz % 64) / 2; }
__host__ __device__ __forceinline__ int perm32(int rho) { const int n = rho >> 4, i = rho & 15; return 8 * (i >> 2) + 4 * n + (i & 3); }

struct Unit { int pm, pn; };
struct Gemm { const bf16_t* A; const bf16_t* Bt; int M, N, K; };

struct StaticOrder {
    int nM, nN, nwg, G, c;
    __host__ __device__ void init(int M, int N, int G_, int c_) { nM = M / BM; nN = N / BM; nwg = nM * nN; G = G_; c = c_; }
    __host__ __device__ bool next(int i, Unit& u) const {
        const long L = (long)i * G + c; if (L >= nwg) return false;
        int wgid = (int)L; { const int q = nwg / NXCD, r = nwg % NXCD, xcd = wgid % NXCD, off = wgid / NXCD; wgid = (xcd < r ? xcd * (q + 1) : r * (q + 1) + (xcd - r) * q) + off; }
        const int nig = WGM * nN, gid = wgid / nig, fm = gid * WGM, gsz = (nM - fm) < WGM ? (nM - fm) : WGM;
        u.pm = fm + ((wgid % nig) % gsz); u.pn = (wgid % nig) / gsz; return true;
    }
    __device__ __forceinline__ void a_ready(const Unit&) const {}
    __device__ __forceinline__ void done(const Unit&) const {}
};

__device__ __forceinline__ unsigned cvt_pk_bf16(float lo, float hi) { unsigned r; asm volatile("v_cvt_pk_bf16_f32 %0, %1, %2" : "=v"(r) : "v"(lo), "v"(hi)); return r; }
template <class Epi, class Sched, bool ALIGN_EPI = false, bool SP2 = false>
__device__ __forceinline__ void gemm_phase(PG8_LAS unsigned char* lds, const Gemm g, const Sched& S, const Epi& E) {
    int tid_ = threadIdx.x; asm volatile("" : "+v"(tid_));
    const int tid = tid_, wid = __builtin_amdgcn_readfirstlane(tid >> 6), lane = tid & 63, wr = wid >> 2, wc = wid & 3, fr = lane & 15, fq = lane >> 4;
    const int K = g.K, nt = K / BK;
    unsigned voffA[2], voffB[2];
#pragma unroll
    for (int i = 0; i < 2; ++i) { int R, C; stage_rc(tid * 16 + i * 8192, R, C); const int Rb = Epi::PERM ? ((R & ~31) + perm32(R & 31)) : R;
        voffA[i] = (unsigned)(R * K + C) * 2u; voffB[i] = (unsigned)(Rb * K + C) * 2u; }
    const size_t kstep = (size_t)(BK * 2);
    const size_t hstep = (size_t)HALF * K * 2;
    const size_t tstep = 2 * hstep;
    const unsigned ldsw = (unsigned)wid * 1024u;
    const int aoff = lds_byte(wr * 64 + fr, fq * 8), boff = lds_byte(wc * 32 + fr, fq * 8);
#define PG8_SA(b, h) (((b) * 2 + (h)) * HTB)
#define PG8_SB(b, h) ((4 + (b) * 2 + (h)) * HTB)
#define PG8_STAGE(bufoff, gbase, voff) do { _Pragma("unroll") for (int _i = 0; _i < 2; ++_i) \
        __builtin_amdgcn_global_load_lds((const unsigned*)((const char*)(gbase) + (voff)[_i]), (PG8_LAS unsigned*)(lds + (bufoff) + ldsw + _i * 8192), 16, 0, 0); } while (0)
#define PG8_LDA(dst, b, h) do { _Pragma("unroll") for (int m = 0; m < 4; ++m) _Pragma("unroll") for (int k = 0; k < 2; ++k) dst[m][k] = *(const PG8_LAS bf16x8*)(lds + PG8_SA(b, h) + aoff + m * 2048 + k * 1024); } while (0)
#define PG8_LDB(dst, b, h) do { _Pragma("unroll") for (int n = 0; n < 2; ++n) _Pragma("unroll") for (int k = 0; k < 2; ++k) dst[n][k] = *(const PG8_LAS bf16x8*)(lds + PG8_SB(b, h) + boff + n * 2048 + k * 1024); } while (0)
#define PG8_MMA(ai, bj, At, Bt) do { __builtin_amdgcn_s_setprio(1); _Pragma("unroll") for (int m = 0; m < 4; ++m) _Pragma("unroll") for (int n = 0; n < 2; ++n) _Pragma("unroll") for (int k = 0; k < 2; ++k) \
        acc[ai][bj][m][n] = __builtin_amdgcn_mfma_f32_16x16x32_bf16(Bt[n][k], At[m][k], acc[ai][bj][m][n], 0, 0, 0); __builtin_amdgcn_s_setprio(0); } while (0)
#define PG8_WAIT_V(n) asm volatile("s_waitcnt vmcnt(" #n ")" ::: "memory")
#define PG8_WAIT_L(n) asm volatile("s_waitcnt lgkmcnt(" #n ")" ::: "memory")
#define PG8_BAR __builtin_amdgcn_s_barrier()
#define PG8_SCHED __builtin_amdgcn_sched_barrier(0)
    Unit cur, nxt; int ui = 0;
    if (!S.next(0, cur)) return;
    f32x4 acc[2][2][4][2];
#pragma unroll
    for (int a = 0; a < 2; ++a)
#pragma unroll
        for (int b = 0; b < 2; ++b)
#pragma unroll
            for (int m = 0; m < 4; ++m)
#pragma unroll
                for (int n = 0; n < 2; ++n) acc[a][b][m][n] = (f32x4){0.f, 0.f, 0.f, 0.f};
    bf16x8 At[4][2], B0[2][2], B1[2][2];
    const char* cA = (const char*)g.A + (size_t)cur.pm * tstep; const char* cB = (const char*)g.Bt + (size_t)cur.pn * tstep;
    S.a_ready(cur);
    if constexpr (SP2) {
        PG8_STAGE(PG8_SB(0, 0), cB, voffB); PG8_STAGE(PG8_SB(0, 1), cB + hstep, voffB); PG8_STAGE(PG8_SA(0, 0), cA, voffA); PG8_STAGE(PG8_SA(0, 1), cA + hstep, voffA);
        if (wr == 1) PG8_BAR;
        PG8_WAIT_V(2); PG8_BAR;
        PG8_STAGE(PG8_SB(1, 0), cB + kstep, voffB); PG8_STAGE(PG8_SA(1, 0), cA + kstep, voffA); PG8_STAGE(PG8_SB(1, 1), cB + hstep + kstep, voffB);
        PG8_WAIT_V(6); PG8_BAR;
    } else {
        PG8_STAGE(PG8_SB(0, 0), cB, voffB); PG8_STAGE(PG8_SA(0, 0), cA, voffA); PG8_STAGE(PG8_SB(0, 1), cB + hstep, voffB); PG8_STAGE(PG8_SA(0, 1), cA + hstep, voffA);
        if (wr == 1) PG8_BAR;
        PG8_WAIT_V(4); PG8_BAR;
        PG8_STAGE(PG8_SB(1, 0), cB + kstep, voffB); PG8_STAGE(PG8_SA(1, 0), cA + kstep, voffA); PG8_STAGE(PG8_SB(1, 1), cB + hstep + kstep, voffB);
        PG8_WAIT_V(6); PG8_BAR;
    }
    for (;;) {
        const bool has_next = S.next(ui + 1, nxt);
        const char* nA = has_next ? (const char*)g.A + (size_t)nxt.pm * tstep : cA; const char* nB = has_next ? (const char*)g.Bt + (size_t)nxt.pn * tstep : cB;
        for (int t = 0; t < nt; t += 2) {
            const bool last = (t == nt - 2);
            const char* a1 = cA + (size_t)(t + 1) * kstep;
            const char* a2 = last ? nA : cA + (size_t)(t + 2) * kstep; const char* b2 = last ? nB : cB + (size_t)(t + 2) * kstep;
            const char* a3 = a2 + kstep; const char* b3 = b2 + kstep;
            if (last && has_next) S.a_ready(nxt);
            if constexpr (SP2) {
            PG8_LDB(B0, 0, 0); PG8_LDB(B1, 0, 1); PG8_SCHED; PG8_LDA(At, 0, 0); PG8_STAGE(PG8_SA(1, 1), a1 + hstep, voffA);
            PG8_WAIT_V(8); PG8_WAIT_L(0); PG8_BAR; PG8_MMA(0, 0, At, B0); PG8_MMA(0, 1, At, B1); PG8_BAR; PG8_SCHED;
            PG8_LDA(At, 0, 1); PG8_STAGE(PG8_SB(0, 0), b2, voffB); PG8_STAGE(PG8_SB(0, 1), b2 + hstep, voffB); PG8_STAGE(PG8_SA(0, 0), a2, voffA);
            PG8_WAIT_V(8); PG8_WAIT_L(0); PG8_BAR; PG8_MMA(1, 0, At, B0); PG8_MMA(1, 1, At, B1); PG8_BAR; PG8_SCHED;
            PG8_LDB(B0, 1, 0); PG8_LDB(B1, 1, 1); PG8_SCHED; PG8_LDA(At, 1, 0); PG8_STAGE(PG8_SA(0, 1), a2 + hstep, voffA);
            PG8_WAIT_V(8); PG8_WAIT_L(0); PG8_BAR; PG8_MMA(0, 0, At, B0); PG8_MMA(0, 1, At, B1); PG8_BAR; PG8_SCHED;
            PG8_LDA(At, 1, 1); PG8_STAGE(PG8_SB(1, 0), b3, voffB); PG8_STAGE(PG8_SB(1, 1), b3 + hstep, voffB); PG8_STAGE(PG8_SA(1, 0), a3, voffA);
            PG8_WAIT_V(8); PG8_WAIT_L(0); PG8_BAR; PG8_MMA(1, 0, At, B0); PG8_MMA(1, 1, At, B1); PG8_BAR; PG8_SCHED;
            } else {
            PG8_LDB(B0, 0, 0); PG8_SCHED; PG8_LDA(At, 0, 0); PG8_STAGE(PG8_SA(1, 1), a1 + hstep, voffA);
            PG8_WAIT_L(8); PG8_BAR; PG8_WAIT_L(0); PG8_MMA(0, 0, At, B0); PG8_BAR; PG8_SCHED;
            PG8_LDB(B1, 0, 1); PG8_STAGE(PG8_SB(0, 0), b2, voffB);
            PG8_BAR; PG8_WAIT_L(0); PG8_MMA(0, 1, At, B1); PG8_BAR;
            PG8_LDA(At, 0, 1); PG8_STAGE(PG8_SA(0, 0), a2, voffA);
            PG8_BAR; PG8_WAIT_L(0); PG8_MMA(1, 0, At, B0); PG8_BAR; PG8_SCHED;
            PG8_STAGE(PG8_SB(0, 1), b2 + hstep, voffB);
            PG8_WAIT_V(6); PG8_BAR; PG8_MMA(1, 1, At, B1); PG8_BAR;
            PG8_LDB(B0, 1, 0); PG8_SCHED; PG8_LDA(At, 1, 0); PG8_STAGE(PG8_SA(0, 1), a2 + hstep, voffA);
            PG8_WAIT_L(8); PG8_BAR; PG8_WAIT_L(0); PG8_MMA(0, 0, At, B0); PG8_BAR; PG8_SCHED;
            PG8_LDB(B1, 1, 1); PG8_STAGE(PG8_SB(1, 0), b3, voffB);
            PG8_BAR; PG8_WAIT_L(0); PG8_MMA(0, 1, At, B1); PG8_BAR;
            PG8_LDA(At, 1, 1); PG8_STAGE(PG8_SA(1, 0), a3, voffA);
            PG8_BAR; PG8_WAIT_L(0); PG8_MMA(1, 0, At, B0); PG8_BAR; PG8_SCHED;
            PG8_STAGE(PG8_SB(1, 1), b3 + hstep, voffB);
            PG8_WAIT_V(6); PG8_BAR; PG8_MMA(1, 1, At, B1); PG8_BAR;
            }
        }
        if constexpr (ALIGN_EPI) { if (wr == 0) PG8_BAR; }
        if constexpr (!Epi::AFTER_DRAIN) { E(acc, cur, wr, wc, fr, fq); S.done(cur); }
        if (!has_next) break;
#pragma unroll
        for (int a = 0; a < 2; ++a)
#pragma unroll
            for (int b = 0; b < 2; ++b)
#pragma unroll
                for (int m = 0; m < 4; ++m)
#pragma unroll
                    for (int n = 0; n < 2; ++n) acc[a][b][m][n] = (f32x4){0.f, 0.f, 0.f, 0.f};
        cur = nxt; cA = nA; cB = nB; ++ui;
        if constexpr (ALIGN_EPI) { if (wr == 1) PG8_BAR; }
    }
    PG8_WAIT_V(0);
    if constexpr (!ALIGN_EPI) { if (wr == 0) PG8_BAR; }
    PG8_BAR;
    if constexpr (Epi::AFTER_DRAIN) { E.fused(acc, cur, wr, wc, fr, fq, lds, wid, lane); S.done(cur); }
#undef PG8_SA
#undef PG8_SB
#undef PG8_STAGE
#undef PG8_LDA
#undef PG8_LDB
#undef PG8_MMA
#undef PG8_WAIT_V
#undef PG8_WAIT_L
#undef PG8_BAR
#undef PG8_SCHED
}
}


#ifndef PG8_SP2
#define PG8_SP2 true
#endif
#ifndef PG8_ALIGN
#define PG8_ALIGN true
#endif
#ifndef MK_LAUNCHES
#define MK_LAUNCHES 1
#endif

#define GAS __attribute__((address_space(1)))
#define LAS __attribute__((address_space(3)))
typedef unsigned short bf16;
typedef float f32x4 __attribute__((ext_vector_type(4)));
typedef unsigned u32x4 __attribute__((ext_vector_type(4)));
typedef unsigned u32x2 __attribute__((ext_vector_type(2)));

constexpr int NB = 8, SEQ = 4096, DM = 1024, NMETA = 16;
constexpr int ROWS = 4160, PADR = 48, TOK0 = 64;
constexpr int MTOK = NB * SEQ;
constexpr int NIN = 3584;
constexpr int BROWS = NB * ROWS;
constexpr size_t ARR = (size_t)BROWS * 512;
constexpr int NCH = 64;
constexpr int NEXP = 16, DEXP = 512;
constexpr int XS_ROWS = 69632;
constexpr float ALPHA = 1.189207115002721f;
constexpr float LN_EPS = 1e-5f, RMS_EPS = 1e-6f;
constexpr float LOG2E = 1.4426950408889634f;
constexpr float C2Q = 0.125f * LOG2E;
constexpr float STICK_THR = 48.0f;

constexpr size_t MiB = 1u << 20;
constexpr size_t WS_CTL = 0, CTL_ZERO_BYTES = 1 * MiB;
constexpr size_t WS_WIN = 1 * MiB;
constexpr size_t WS_WOUT = 8 * MiB;
constexpr size_t WS_LB = 10 * MiB;
constexpr size_t WS_META = 11 * MiB;
constexpr size_t WS_DV = 12 * MiB;
constexpr size_t WS_XB = 16 * MiB;
constexpr size_t WS_S = 16 * MiB;
constexpr size_t WS_PROJ = 80 * MiB;
constexpr size_t WS_U = 308 * MiB;
constexpr size_t WS_MIX = 436 * MiB;
constexpr size_t WS_H1 = 16 * MiB;
constexpr size_t WS_W13 = 80 * MiB;
constexpr size_t WS_W2 = 112 * MiB;
constexpr size_t WS_XS = 128 * MiB;
constexpr size_t WS_HID = 264 * MiB;
constexpr size_t WS_YS = 332 * MiB;
constexpr size_t WS_END = 500 * MiB;
static_assert(WS_PROJ + 7 * ARR * 2 <= WS_U && WS_U + (size_t)32 * 64 * 16384 * 4 <= WS_MIX && WS_MIX + (size_t)MTOK * DM * 2 <= WS_END, "ws map A");
static_assert(WS_W13 + (size_t)16 * 1024 * 1024 * 2 <= WS_W2 && WS_W2 + (size_t)16 * 1024 * 512 * 2 <= WS_XS && WS_XS + (size_t)XS_ROWS * 1024 * 2 <= WS_HID &&
              WS_HID + (size_t)XS_ROWS * 512 * 2 <= WS_YS && WS_YS + (size_t)XS_ROWS * 1024 * 2 <= WS_END, "ws map B");
constexpr int CW_CNT = 64;
constexpr int CW_BAR = 4096;
constexpr int MISC_BAR = 100;

constexpr int RING_BYTES = 131072;
constexpr int MISC_OFF = RING_BYTES;
constexpr int LDS_BYTES = 147456;
constexpr int NWAVES = 8, NTHREADS = 512;

__device__ __forceinline__ unsigned f2bf(float f) { unsigned u = __builtin_bit_cast(unsigned, f); return (u + 0x7fffu + ((u >> 16) & 1u)) >> 16; }
typedef float f32x2_t __attribute__((ext_vector_type(2))); typedef __bf16 bf16x2_t __attribute__((ext_vector_type(2)));
__device__ __forceinline__ unsigned pk2(float lo, float hi) { f32x2_t v = {lo, hi}; bf16x2_t b = __builtin_convertvector(v, bf16x2_t); return __builtin_bit_cast(unsigned, b); }
__device__ __forceinline__ float bf2f(unsigned h) { return __builtin_bit_cast(float, h << 16); }
__device__ __forceinline__ float bflo(unsigned w) { return __builtin_bit_cast(float, w << 16); }
__device__ __forceinline__ float bfhi(unsigned w) { return __builtin_bit_cast(float, w & 0xffff0000u); }
__device__ __forceinline__ float ex2(float x) { return __builtin_amdgcn_exp2f(x); }
__device__ __forceinline__ float lg2(float x) { return __builtin_amdgcn_logf(x); }
__device__ __forceinline__ float rcpf_(float x) { return __builtin_amdgcn_rcpf(x); }
__device__ __forceinline__ float sigm(float v) { return rcpf_(1.f + ex2(-v * LOG2E)); }
__device__ __forceinline__ float wave_sum(float v) {
#pragma unroll
    for (int o = 1; o < 64; o <<= 1) v += __shfl_xor(v, o);
    return v;
}
template <int XF> __device__ __forceinline__ float xform(float v, float lb) {
    if (XF == 0) return v * sigm(v);
    if (XF == 1) return lg2(lb + (1.f - lb) * sigm(v));
    if (XF == 3) return sigm(v);
    if (XF == 4) return v * C2Q;
    return v;
}
__device__ __forceinline__ float xform_rt(int kind, float v, float lb) {
    switch (kind) { case 0: return xform<0>(v, lb); case 1: return xform<1>(v, lb); case 3: return xform<3>(v, lb); case 4: return xform<4>(v, lb); default: return v; }
}

using pg8::Unit;
struct EpiProj {
    static constexpr bool PERM = true, AFTER_DRAIN = false;
    bf16* proj; const float* lb;
    template <int XF> __device__ __forceinline__ void run(int kind, const f32x4 (&acc)[2][2][4][2], const Unit& u, int wr, int wc, int fr, int fq) const {
        const int b = u.pm >> 4;
        const int r0 = b * ROWS + TOK0 + (u.pm & 15) * 256 + wr * 64 + fr;
        const int c0 = (u.pn & 1) * 256 + wc * 32 + 8 * fq;
        bf16* base = proj + (size_t)kind * ARR;
        f32x4 l0[2], l1[2];
#pragma unroll
        for (int bj = 0; bj < 2; ++bj) {
            if (XF == 1) { l0[bj] = *(const f32x4*)(lb + c0 + bj * 128); l1[bj] = *(const f32x4*)(lb + c0 + bj * 128 + 4); }
            else { l0[bj] = (f32x4){0.f, 0.f, 0.f, 0.f}; l1[bj] = l0[bj]; }
        }
#pragma unroll
        for (int ai = 0; ai < 2; ++ai)
#pragma unroll
            for (int m = 0; m < 4; ++m) {
                bf16* rowp = base + (size_t)(r0 + ai * 128 + m * 16) * 512 + c0;
#pragma unroll
                for (int bj = 0; bj < 2; ++bj) {
                    const f32x4 v0 = acc[ai][bj][m][0], v1 = acc[ai][bj][m][1];
                    u32x4 w;
                    w.x = pk2(xform<XF>(v0[0], l0[bj][0]), xform<XF>(v0[1], l0[bj][1]));
                    w.y = pk2(xform<XF>(v0[2], l0[bj][2]), xform<XF>(v0[3], l0[bj][3]));
                    w.z = pk2(xform<XF>(v1[0], l1[bj][0]), xform<XF>(v1[1], l1[bj][1]));
                    w.w = pk2(xform<XF>(v1[2], l1[bj][2]), xform<XF>(v1[3], l1[bj][3]));
                    *(u32x4*)(rowp + bj * 128) = w;
                }
            }
    }
    __device__ __forceinline__ void operator()(const f32x4 (&acc)[2][2][4][2], const Unit& u, int wr, int wc, int fr, int fq) const {
        const int kind = u.pn >> 1;
        if (kind == 0) run<0>(kind, acc, u, wr, wc, fr, fq);
        else if (kind == 1) run<1>(kind, acc, u, wr, wc, fr, fq);
        else if (kind == 3) run<3>(kind, acc, u, wr, wc, fr, fq);
        else if (kind == 4) run<4>(kind, acc, u, wr, wc, fr, fq);
        else run<2>(kind, acc, u, wr, wc, fr, fq);
    }
};
struct EpiOut {
    static constexpr bool PERM = false, AFTER_DRAIN = false;
    const float* x; float* out;
    __device__ __forceinline__ void operator()(const f32x4 (&acc)[2][2][4][2], const Unit& u, int wr, int wc, int fr, int fq) const {
        const int row0 = u.pm * 256 + wr * 64 + fr, col0 = u.pn * 256 + wc * 32 + 4 * fq;
#pragma unroll
        for (int ai = 0; ai < 2; ++ai)
#pragma unroll
            for (int m = 0; m < 4; ++m) {
                const size_t ro = (size_t)(row0 + ai * 128 + m * 16) * DM + col0;
#pragma unroll
                for (int bj = 0; bj < 2; ++bj)
#pragma unroll
                    for (int n = 0; n < 2; ++n) {
                        const f32x4 xv = *(const f32x4*)(x + ro + bj * 128 + 16 * n);
                        *(f32x4*)(out + ro + bj * 128 + 16 * n) = acc[ai][bj][m][n] + xv * ALPHA;
                    }
            }
    }
};
struct EpiHid {
    static constexpr bool PERM = true, AFTER_DRAIN = false;
    bf16* hid;
    __device__ __forceinline__ void operator()(const f32x4 (&acc)[2][2][4][2], const Unit& u, int wr, int wc, int fr, int fq) const {
        const int row0 = u.pm * 256 + wr * 64 + fr, hc0 = (u.pn & 3) * 128 + wc * 16 + 4 * fq;
#pragma unroll
        for (int ai = 0; ai < 2; ++ai)
#pragma unroll
            for (int m = 0; m < 4; ++m) {
                bf16* rowp = hid + (size_t)(row0 + ai * 128 + m * 16) * DEXP + hc0;
#pragma unroll
                for (int bj = 0; bj < 2; ++bj) {
                    const f32x4 g = acc[ai][bj][m][0], up = acc[ai][bj][m][1];
                    u32x2 w;
                    w.x = pk2(g[0] * sigm(g[0]) * up[0], g[1] * sigm(g[1]) * up[1]);
                    w.y = pk2(g[2] * sigm(g[2]) * up[2], g[3] * sigm(g[3]) * up[3]);
                    *(u32x2*)(rowp + bj * 64) = w;
                }
            }
    }
};
struct EpiYs {
    static constexpr bool PERM = true, AFTER_DRAIN = false;
    bf16* ys;
    __device__ __forceinline__ void operator()(const f32x4 (&acc)[2][2][4][2], const Unit& u, int wr, int wc, int fr, int fq) const {
        const int row0 = u.pm * 256 + wr * 64 + fr, col0 = (u.pn & 3) * 256 + wc * 32 + 8 * fq;
#pragma unroll
        for (int ai = 0; ai < 2; ++ai)
#pragma unroll
            for (int m = 0; m < 4; ++m) {
                bf16* rowp = ys + (size_t)(row0 + ai * 128 + m * 16) * DM + col0;
#pragma unroll
                for (int bj = 0; bj < 2; ++bj) {
                    const f32x4 v0 = acc[ai][bj][m][0], v1 = acc[ai][bj][m][1];
                    u32x4 w; w.x = pk2(v0[0], v0[1]); w.y = pk2(v0[2], v0[3]); w.z = pk2(v1[0], v1[1]); w.w = pk2(v1[2], v1[3]);
                    *(u32x4*)(rowp + bj * 128) = w;
                }
            }
    }
};
struct MoeOrder {
    const LAS int* toff; int G, c, ntot;
    __device__ __forceinline__ bool next(int i, Unit& u) const {
        const long L = (long)i * G + c; if (L >= (long)ntot * 4) return false;
        const int mt = (int)(L >> 2), pl = (int)(L & 3); int e = 0;
#pragma unroll
        for (int j = 1; j < NEXP; ++j) e += (mt >= toff[j]) ? 1 : 0;
        u.pm = mt; u.pn = e * 4 + pl; return true;
    }
    __device__ __forceinline__ void a_ready(const Unit&) const {}
    __device__ __forceinline__ void done(const Unit&) const {}
};

struct Args { const float* in[18]; float* out; unsigned char* ws; int ph_lo, ph_hi; };
struct Frame {
    LAS unsigned char* lds; LAS int* misc;
    int tid, lane, wave, G, gw, ngw;
};

template <int MODE> __device__ __forceinline__ int rowmap(int n) { return MODE == 0 ? n : ((n >> 2) * 8 + (n & 3) + (MODE == 2 ? 4 : 0)); }
template <int MODE> __device__ __forceinline__ void transpose_item(const float* W, int K, int N, bf16* WT, LAS float* scr, int item, int lane) {
    const int nblk = N / 32, kb = item / nblk, nb = item % nblk, k0 = 64 * kb, n0 = 32 * nb;
#pragma unroll 8
    for (int i = 0; i < 32; ++i) { const int kk = 2 * i + (lane >> 5); scr[kk * 33 + (lane & 31)] = W[(size_t)(k0 + kk) * N + n0 + (lane & 31)]; }
    asm volatile("s_waitcnt lgkmcnt(0)" ::: "memory");
    const int c = lane & 7;
#pragma unroll
    for (int j = 0; j < 4; ++j) { const int n = (lane >> 3) + 8 * j; const LAS float* s = scr + (8 * c) * 33 + n;
        u32x4 o; o.x = pk2(s[0 * 33], s[1 * 33]); o.y = pk2(s[2 * 33], s[3 * 33]); o.z = pk2(s[4 * 33], s[5 * 33]); o.w = pk2(s[6 * 33], s[7 * 33]);
        *(u32x4*)(WT + (size_t)rowmap<MODE>(n0 + n) * K + k0 + 8 * c) = o; }
    asm volatile("s_waitcnt lgkmcnt(0)" ::: "memory");
}

__device__ __forceinline__ void p0_prep(Frame& F, const Args& A) {
    LAS float* scr = (LAS float*)(F.lds + F.wave * 16384);
    const int gtid = blockIdx.x * NTHREADS + F.tid, gthreads = F.G * NTHREADS;
    for (int i = gtid; i < 512; i += gthreads) ((float*)(A.ws + WS_LB))[i] = 1.f / (1.f + __expf(A.in[3][512 + i] - A.in[3][i]));
    for (int i = gtid; i < 7 * NB * 3072; i += gthreads) {
        const int a = i / (NB * 3072), r = i % (NB * 3072), b = r / 3072, o = r % 3072;
        *(u32x4*)(((bf16*)(A.ws + WS_PROJ)) + (size_t)a * ARR + (size_t)b * ROWS * 512 + (size_t)o * 8) = (u32x4){0u, 0u, 0u, 0u};
    }
    for (int job = F.gw; job < 56 * 16; job += F.ngw) {
        const int cgp = job >> 4, kq = job & 15, n = cgp * 64 + F.lane;
        float acc[16];
#pragma unroll
        for (int r = 0; r < 16; ++r) acc[r] = 0.f;
        const float* mt = A.in[1] + 64 * kq; const float* wp = A.in[2] + (size_t)(64 * kq) * NIN + n;
#pragma unroll 8
        for (int k = 0; k < 64; ++k) {
            const float w = wp[(size_t)k * NIN];
#pragma unroll
            for (int r = 0; r < 16; ++r) acc[r] += mt[r * DM + k] * w;
        }
        float* mp = ((float*)(A.ws + WS_U)) + (size_t)(kq * 16) * NIN + n;
#pragma unroll
        for (int r = 0; r < 16; ++r) mp[(size_t)r * NIN] = acc[r];
    }
    constexpr int I_IN = (DM / 64) * (NIN / 32), I_OUT = (DM / 64) * (DM / 32);
    for (int it = F.gw; it < I_IN + I_OUT; it += F.ngw) {
        if (it < I_IN) transpose_item<0>(A.in[2], DM, NIN, ((bf16*)(A.ws + WS_WIN)), scr, it, F.lane);
        else transpose_item<0>(A.in[6], DM, DM, ((bf16*)(A.ws + WS_WOUT)), scr, it - I_IN, F.lane);
    }
    for (int m = F.gw; m < MTOK; m += F.ngw) {
        const f32x4* xr = (const f32x4*)(A.in[0] + (size_t)m * DM) + F.lane;
        u32x2* o8 = (u32x2*)(((bf16*)(A.ws + WS_XB)) + (size_t)m * DM) + F.lane;
#pragma unroll
        for (int j = 0; j < 4; ++j) { const f32x4 v = xr[64 * j]; u32x2 w; w.x = pk2(v[0], v[1]); w.y = pk2(v[2], v[3]); o8[64 * j] = w; }
    }
}

__device__ __forceinline__ void meta_finalize(Frame& F, const Args& A) {
    const float* mp = (const float*)(A.ws + WS_U); const float* lb = (const float*)(A.ws + WS_LB);
    for (int idx = blockIdx.x * NTHREADS + F.tid; idx < 16 * NIN; idx += F.G * NTHREADS) {
        const int r = idx / NIN, n = idx % NIN, kind = n >> 9, col = n & 511;
        float v = 0.f;
#pragma unroll
        for (int kq = 0; kq < 16; ++kq) v += mp[(size_t)(kq * 16 + r) * NIN + n];
        const unsigned short o = (unsigned short)f2bf(xform_rt(kind, v, lb[col]));
        bf16* p = ((bf16*)(A.ws + WS_PROJ)) + (size_t)kind * ARR + (size_t)(PADR + r) * 512 + col;
#pragma unroll
        for (int b = 0; b < NB; ++b) p[(size_t)b * ROWS * 512] = o;
    }
}

typedef short s16x8 __attribute__((ext_vector_type(8)));
typedef short v4i16_t __attribute__((ext_vector_type(4)));
__device__ __forceinline__ s16x8 tr8(const LAS unsigned char* p, int rowskip) {
    const v4i16_t lo = __builtin_amdgcn_ds_read_tr16_b64_v4i16((LAS v4i16_t*)p);
    const v4i16_t hh = __builtin_amdgcn_ds_read_tr16_b64_v4i16((LAS v4i16_t*)(p + rowskip));
    return (s16x8){lo[0], lo[1], lo[2], lo[3], hh[0], hh[1], hh[2], hh[3]};
}
struct RawTile { u32x4 a, b; };
__device__ __forceinline__ RawTile raw_load(const bf16* arr, int b, int h, int c, int tid) {
    const bf16* p = arr + (size_t)(b * ROWS + 64 * c + (tid >> 4)) * 512 + 128 * h + 8 * (tid & 15);
    RawTile r; r.a = *(const u32x4*)p; r.b = *(const u32x4*)(p + (size_t)32 * 512); return r;
}
__device__ __forceinline__ void raw_store(LAS unsigned char* dst, int pitch, const RawTile& r, int tid) {
    LAS unsigned char* p = dst + (tid >> 4) * pitch + (tid & 15) * 16;
    *(LAS u32x4*)p = r.a; *(LAS u32x4*)(p + 32 * pitch) = r.b;
}
constexpr int PRAW = 272;
constexpr int PKT = 144;
__device__ __forceinline__ void ha_phase(Frame& F, const Args& A) {
    const bf16* LF = ((bf16*)(A.ws + WS_PROJ)) + 1 * ARR; const bf16* HV = ((bf16*)(A.ws + WS_PROJ)) + 2 * ARR;
    LAS unsigned char* RLF = F.lds;
    LAS unsigned char* VN = RLF + 64 * PRAW;
    LAS unsigned char* KT = VN + 64 * PRAW;
    LAS float* TOT = (LAS float*)(KT + 128 * PKT);
    const int tid = F.tid, lane = F.lane, w = F.wave, fr = lane & 15, fq = lane >> 4;
    const int d = tid & 127, sq = tid >> 7;
    int u = blockIdx.x;
    RawTile rl, rv;
    if (u < 32 * 64) { rl = raw_load(LF, u >> 8, (u >> 6) & 3, u & 63, tid); rv = raw_load(HV, u >> 8, (u >> 6) & 3, u & 63, tid); }
    for (; u < 32 * 64; u += F.G) {
        const int bh = u >> 6, c = u & 63;
        raw_store(RLF, PRAW, rl, tid); raw_store(VN, PRAW, rv, tid);
        __syncthreads();
        { const int un = u + F.G; if (un < 32 * 64) { rl = raw_load(LF, un >> 8, (un >> 6) & 3, un & 63, tid); rv = raw_load(HV, un >> 8, (un >> 6) & 3, un & 63, tid); } }
        float lf[16], pre[16]; float run = 0.f;
#pragma unroll
        for (int i = 0; i < 16; ++i) { lf[i] = bf2f(*(const LAS unsigned short*)(RLF + (16 * sq + i) * PRAW + 2 * d)); run += lf[i]; pre[i] = run; }
        TOT[sq * 128 + d] = run;
        __syncthreads();
        float off = 0.f, blast = 0.f;
#pragma unroll
        for (int q = 0; q < 4; ++q) { const float t = TOT[q * 128 + d]; off += (q < sq) ? t : 0.f; blast += t; }
        { unsigned kw[8];
#pragma unroll
          for (int i = 0; i < 8; ++i) { const float k0 = (1.f - ex2(lf[2 * i])) * ex2(blast - (off + pre[2 * i])), k1 = (1.f - ex2(lf[2 * i + 1])) * ex2(blast - (off + pre[2 * i + 1])); kw[i] = pk2(k0, k1); }
          LAS u32x4* kp = (LAS u32x4*)(KT + d * PKT + 32 * sq);
          kp[0] = (u32x4){kw[0], kw[1], kw[2], kw[3]}; kp[1] = (u32x4){kw[4], kw[5], kw[6], kw[7]}; }
        if (sq == 0) ((float*)(A.ws + WS_DV))[(size_t)(bh * 64 + c) * 128 + d] = ex2(blast);
        __syncthreads();
        const LAS unsigned char* vt = VN + (8 * fq + (fr >> 2)) * PRAW + (16 * w + 4 * (fr & 3)) * 2;
        const s16x8 b0 = tr8(vt, 4 * PRAW), b1 = tr8(vt + 32 * PRAW, 4 * PRAW);
        bf16* up = ((bf16*)(A.ws + WS_U)) + (size_t)(bh * 64 + c) * 16384 + (size_t)(16 * w + fr) * 128 + 4 * fq;
#pragma unroll
        for (int dt = 0; dt < 8; ++dt) {
            const LAS unsigned char* kp = KT + (16 * dt + fr) * PKT + 16 * fq;
            const s16x8 a0 = *(const LAS s16x8*)kp, a1 = *(const LAS s16x8*)(kp + 64);
            f32x4 acc = (f32x4){0.f, 0.f, 0.f, 0.f};
            acc = __builtin_amdgcn_mfma_f32_16x16x32_bf16(a0, b0, acc, 0, 0, 0);
            acc = __builtin_amdgcn_mfma_f32_16x16x32_bf16(a1, b1, acc, 0, 0, 0);
            { u32x2 o; o.x = pk2(acc[0], acc[1]); o.y = pk2(acc[2], acc[3]); *(u32x2*)(up + 16 * dt) = o; }
        }
        __syncthreads();
    }
}

typedef float f32x16 __attribute__((ext_vector_type(16)));
__device__ __forceinline__ s16x8 pack8(u32x2 a, u32x2 c) { const u32x4 w = (u32x4){a.x, a.y, c.x, c.y}; return __builtin_bit_cast(s16x8, w); }
__device__ __forceinline__ void attn_phase(Frame& F, const Args& A) {
    const bf16* SQ = ((bf16*)(A.ws + WS_PROJ)) + 4 * ARR; const bf16* SK = ((bf16*)(A.ws + WS_PROJ)) + 5 * ARR; const bf16* SV = ((bf16*)(A.ws + WS_PROJ)) + 6 * ARR;
    const int r32 = F.lane & 31, hi = F.lane >> 5;
    LAS unsigned char* vw = F.lds + F.wave * 4096 + (F.lane >> 3) * 128 + (F.lane & 7) * 16;
    LAS unsigned char* vt = F.lds + F.wave * 4096 + (4 * hi + ((F.lane & 15) >> 2)) * 128 + ((F.lane >> 4) & 1) * 32 + (F.lane & 3) * 8;
    for (int wu = F.gw; wu < 64 * 128; wu += F.ngw) {
        const int bh = wu >> 7, qi = wu & 127, b = bh >> 3, h = bh & 7, q0 = TOK0 + 32 * qi, qrow = q0 + r32;
        s16x8 qf[4];
        { const bf16* qp = SQ + (size_t)(b * ROWS + qrow) * 512 + 64 * h + 8 * hi;
#pragma unroll
          for (int s2 = 0; s2 < 4; ++s2) qf[s2] = *(const s16x8*)(qp + 16 * s2); }
        const bf16* kbase = SK + (size_t)(b * ROWS + r32) * 512 + 64 * h + 8 * hi;
        const bf16* vbase = SV + (size_t)(b * ROWS + (F.lane >> 3)) * 512 + 64 * h + 8 * (F.lane & 7);
        f32x16 o0, o1;
#pragma unroll
        for (int r = 0; r < 16; ++r) { o0[r] = 0.f; o1[r] = 0.f; }
        float T = 0.f;
        const int ktd = q0 >> 5;
        s16x8 kf[4]; u32x4 vr[4];
        { const bf16* kp = kbase + (size_t)(32 * ktd) * 512; const bf16* vp = vbase + (size_t)(32 * ktd) * 512;
#pragma unroll
          for (int s2 = 0; s2 < 4; ++s2) kf[s2] = *(const s16x8*)(kp + 16 * s2);
#pragma unroll
          for (int i = 0; i < 4; ++i) vr[i] = *(const u32x4*)(vp + (size_t)(8 * i) * 512); }
        for (int kt = ktd; kt >= 1; --kt) {
            const int k0 = 32 * kt;
            f32x16 p;
#pragma unroll
            for (int r = 0; r < 16; ++r) p[r] = 0.f;
#pragma unroll
            for (int s2 = 0; s2 < 4; ++s2) p = __builtin_amdgcn_mfma_f32_32x32x16_bf16(kf[s2], qf[s2], p, 0, 0, 0);
#pragma unroll
            for (int i = 0; i < 4; ++i) *(LAS u32x4*)(vw + i * 1024) = vr[i];
            s16x8 va[2][2];
#pragma unroll
            for (int dt = 0; dt < 2; ++dt)
#pragma unroll
                for (int s2 = 0; s2 < 2; ++s2) {
                    const v4i16_t lo = __builtin_amdgcn_ds_read_tr16_b64_v4i16((LAS v4i16_t*)(vt + dt * 64 + s2 * 2048));
                    const v4i16_t hh = __builtin_amdgcn_ds_read_tr16_b64_v4i16((LAS v4i16_t*)(vt + dt * 64 + s2 * 2048 + 1024));
                    va[dt][s2] = (s16x8){lo[0], lo[1], lo[2], lo[3], hh[0], hh[1], hh[2], hh[3]};
                }
            if (kt > 1) {
                const bf16* kp = kbase + (size_t)(k0 - 32) * 512; const bf16* vp = vbase + (size_t)(k0 - 32) * 512;
#pragma unroll
                for (int s2 = 0; s2 < 4; ++s2) kf[s2] = *(const s16x8*)(kp + 16 * s2);
#pragma unroll
                for (int i = 0; i < 4; ++i) vr[i] = *(const u32x4*)(vp + (size_t)(8 * i) * 512);
            }
            const bool edge = (kt == ktd) || (kt == 1);
            float sp[16], iss[16], gs[4];
#pragma unroll
            for (int r = 0; r < 16; ++r) {
                const float z = fminf(p[r], 100.f); p[r] = z;
                float v = lg2(1.f + ex2(z));
                if (edge) { const int key = k0 + (r & 3) + 8 * (r >> 2) + 4 * hi; if (!(key >= PADR && key < qrow)) v = 0.f; }
                sp[r] = v;
            }
#pragma unroll
            for (int g = 0; g < 4; ++g) { iss[4 * g + 3] = sp[4 * g + 3]; iss[4 * g + 2] = iss[4 * g + 3] + sp[4 * g + 2]; iss[4 * g + 1] = iss[4 * g + 2] + sp[4 * g + 1]; iss[4 * g] = iss[4 * g + 1] + sp[4 * g]; gs[g] = iss[4 * g]; }
            float sg[4], go[4];
#pragma unroll
            for (int g = 0; g < 4; ++g) { const auto rr = __builtin_amdgcn_permlane32_swap(__float_as_uint(gs[g]), __float_as_uint(gs[g]), false, false);
                sg[g] = __uint_as_float(rr[0]) + __uint_as_float(rr[1]); go[g] = hi ? 0.f : __uint_as_float(rr[1]); }
            float off[4];
            off[3] = T + go[3]; const float e2 = sg[3]; off[2] = T + e2 + go[2]; const float e1 = e2 + sg[2]; off[1] = T + e1 + go[1]; const float e0 = e1 + sg[1]; off[0] = T + e0 + go[0];
            T += e0 + sg[0];
            float a[16];
#pragma unroll
            for (int r = 0; r < 16; ++r) {
                float v = ex2(p[r] - (off[r >> 2] + iss[r]));
                if (edge) { const int key = k0 + (r & 3) + 8 * (r >> 2) + 4 * hi; if (!(key >= PADR && key < qrow)) v = 0.f; }
                a[r] = v;
            }
#pragma unroll
            for (int s2 = 0; s2 < 2; ++s2) {
                u32x4 w; w.x = pk2(a[8 * s2], a[8 * s2 + 1]); w.y = pk2(a[8 * s2 + 2], a[8 * s2 + 3]); w.z = pk2(a[8 * s2 + 4], a[8 * s2 + 5]); w.w = pk2(a[8 * s2 + 6], a[8 * s2 + 7]);
                const s16x8 pb = __builtin_bit_cast(s16x8, w);
                o0 = __builtin_amdgcn_mfma_f32_32x32x16_bf16(va[0][s2], pb, o0, 0, 0, 0);
                o1 = __builtin_amdgcn_mfma_f32_32x32x16_bf16(va[1][s2], pb, o1, 0, 0, 0);
            }
            if (__all(T > STICK_THR)) break;
        }
        float ss = 0.f;
#pragma unroll
        for (int r = 0; r < 16; ++r) ss += o0[r] * o0[r] + o1[r] * o1[r];
        { const auto rr = __builtin_amdgcn_permlane32_swap(__float_as_uint(ss), __float_as_uint(ss), false, false); ss = __uint_as_float(rr[0]) + __uint_as_float(rr[1]); }
        const float rs = 1.0f / sqrtf(ss * (1.f / 64.f) + RMS_EPS);
        const float* gp = A.in[5] + 64 * h + 4 * hi;
        bf16* op = ((bf16*)(A.ws + WS_MIX)) + (size_t)(b * SEQ + qrow - TOK0) * DM + 512 + 64 * h + 4 * hi;
#pragma unroll
        for (int g = 0; g < 4; ++g) {
            const f32x4 g0 = *(const f32x4*)(gp + 8 * g), g1 = *(const f32x4*)(gp + 32 + 8 * g);
            u32x2 w0, w1;
            w0.x = pk2(o0[4 * g] * rs * g0[0], o0[4 * g + 1] * rs * g0[1]); w0.y = pk2(o0[4 * g + 2] * rs * g0[2], o0[4 * g + 3] * rs * g0[3]);
            w1.x = pk2(o1[4 * g] * rs * g1[0], o1[4 * g + 1] * rs * g1[1]); w1.y = pk2(o1[4 * g + 2] * rs * g1[2], o1[4 * g + 3] * rs * g1[3]);
            *(u32x2*)(op + 8 * g) = w0; *(u32x2*)(op + 32 + 8 * g) = w1;
        }
    }
}

__device__ __forceinline__ void hb_phase(Frame& F, const Args& A) {
    for (int g = blockIdx.x * NTHREADS + F.tid; g < 32 * 4096; g += F.G * NTHREADS) {
        const int bh = g >> 12, r = g & 4095, v = r >> 5, d4 = (r & 31) * 4;
        const bf16* up = ((bf16*)(A.ws + WS_U)) + (size_t)bh * 64 * 16384 + v * 128 + d4;
        const float* dp = ((float*)(A.ws + WS_DV)) + (size_t)bh * 64 * 128 + d4;
        bf16* sp = ((bf16*)(A.ws + WS_S)) + (size_t)bh * 64 * 16384 + v * 128 + d4;
        f32x4 s = (f32x4){0.f, 0.f, 0.f, 0.f};
#pragma unroll 8
        for (int c = 0; c < 64; ++c) {
            const u32x2 ub = *(const u32x2*)(up + (size_t)c * 16384); const f32x4 uu = (f32x4){bflo(ub.x), bfhi(ub.x), bflo(ub.y), bfhi(ub.y)}, dd = *(const f32x4*)(dp + c * 128);
            s = dd * s + uu;
            u32x2 w; w.x = pk2(s[0], s[1]); w.y = pk2(s[2], s[3]);
            *(u32x2*)(sp + (size_t)c * 16384) = w;
        }
    }
}

__device__ __forceinline__ void hc_phase(Frame& F, const Args& A) {
    const bf16* HQ = ((bf16*)(A.ws + WS_PROJ)); const bf16* LF = HQ + 1 * ARR; const bf16* HV = HQ + 2 * ARR; const bf16* HG = HQ + 3 * ARR;
    LAS unsigned char* RLF = F.lds;
    LAS unsigned char* RQ = RLF + 64 * PRAW;
    LAS unsigned char* VN = RQ + 64 * PRAW;
    LAS unsigned char* QT = VN + 64 * PRAW;
    LAS unsigned char* KI = QT + 64 * PRAW;
    LAS unsigned char* SC = KI + 64 * PRAW;
    LAS float* TOT = (LAS float*)(SC + 64 * PKT);
    LAS float* SSQ = TOT + 512;
    const int tid = F.tid, lane = F.lane, w = F.wave, fr = lane & 15, fq = lane >> 4;
    const int d = tid & 127, sq = tid >> 7;
    int u = blockIdx.x;
    RawTile rl, rq, rv;
    if (u < 32 * 64) { const int b = u >> 8, h = (u >> 6) & 3, cc = (u & 63) + 1; rl = raw_load(LF, b, h, cc, tid); rq = raw_load(HQ, b, h, cc, tid); rv = raw_load(HV, b, h, cc, tid); }
    for (; u < 32 * 64; u += F.G) {
        const int bh = u >> 6, b = bh >> 2, h = bh & 3, cc = (u & 63) + 1;
        raw_store(RLF, PRAW, rl, tid); raw_store(RQ, PRAW, rq, tid); raw_store(VN, PRAW, rv, tid);
        __syncthreads();
        { const int un = u + F.G; if (un < 32 * 64) { const int b2 = un >> 8, h2 = (un >> 6) & 3, c2 = (un & 63) + 1; rl = raw_load(LF, b2, h2, c2, tid); rq = raw_load(HQ, b2, h2, c2, tid); rv = raw_load(HV, b2, h2, c2, tid); } }
        s16x8 sa[4]; u32x2 gt[4];
        { const bf16* sp = ((bf16*)(A.ws + WS_S)) + (size_t)(bh * 64 + cc - 1) * 16384 + (size_t)(16 * w + fr) * 128 + 8 * fq;
#pragma unroll
          for (int ks = 0; ks < 4; ++ks) sa[ks] = *(const s16x8*)(sp + 32 * ks);
          const bf16* gp = HG + (size_t)(b * ROWS + 64 * cc + fr) * 512 + 128 * h + 16 * w + 4 * fq;
#pragma unroll
          for (int tt = 0; tt < 4; ++tt) gt[tt] = *(const u32x2*)(gp + (size_t)(16 * tt) * 512); }
        {
            float lf[16], pre[16], qv[16]; float run = 0.f;
#pragma unroll
            for (int i = 0; i < 16; ++i) { lf[i] = bf2f(*(const LAS unsigned short*)(RLF + (16 * sq + i) * PRAW + 2 * d)); qv[i] = bf2f(*(const LAS unsigned short*)(RQ + (16 * sq + i) * PRAW + 2 * d)); run += lf[i]; pre[i] = run; }
            TOT[sq * 128 + d] = run;
            __syncthreads();
            float off = 0.f;
#pragma unroll
            for (int q = 0; q < 4; ++q) { const float t = TOT[q * 128 + d]; off += (q < sq) ? t : 0.f; }
#pragma unroll
            for (int i = 0; i < 16; ++i) { const float bc = off + pre[i];
                *(LAS unsigned short*)(QT + (16 * sq + i) * PRAW + 2 * d) = (unsigned short)f2bf(qv[i] * ex2(bc));
                *(LAS unsigned short*)(KI + (16 * sq + i) * PRAW + 2 * d) = (unsigned short)f2bf((1.f - ex2(lf[i])) * ex2(-bc)); }
        }
        __syncthreads();
        {
            const int tt = w >> 1;
            s16x8 bq[4];
            const LAS unsigned char* qp = QT + (16 * tt + fr) * PRAW + 16 * fq;
#pragma unroll
            for (int ks = 0; ks < 4; ++ks) bq[ks] = *(const LAS s16x8*)(qp + 64 * ks);
#pragma unroll
            for (int j = 0; j < 2; ++j) {
                const int st = 2 * (w & 1) + j;
                const LAS unsigned char* kp = KI + (16 * st + fr) * PRAW + 16 * fq;
                f32x4 acc = (f32x4){0.f, 0.f, 0.f, 0.f};
#pragma unroll
                for (int ks = 0; ks < 4; ++ks) acc = __builtin_amdgcn_mfma_f32_16x16x32_bf16(*(const LAS s16x8*)(kp + 64 * ks), bq[ks], acc, 0, 0, 0);
                const int t = 16 * tt + fr, s0 = 16 * st + 4 * fq;
                u32x2 wv; wv.x = pk2(s0 <= t ? acc[0] : 0.f, s0 + 1 <= t ? acc[1] : 0.f); wv.y = pk2(s0 + 2 <= t ? acc[2] : 0.f, s0 + 3 <= t ? acc[3] : 0.f);
                *(LAS u32x2*)(SC + t * PKT + 2 * s0) = wv;
            }
        }
        __syncthreads();
        f32x4 acc[4];
        {
            const LAS unsigned char* vt = VN + (8 * fq + (fr >> 2)) * PRAW + (16 * w + 4 * (fr & 3)) * 2;
            const s16x8 av0 = tr8(vt, 4 * PRAW), av1 = tr8(vt + 32 * PRAW, 4 * PRAW);
#pragma unroll
            for (int tt = 0; tt < 4; ++tt) {
                const LAS unsigned char* scp = SC + (16 * tt + fr) * PKT + 16 * fq;
                const LAS unsigned char* qp = QT + (16 * tt + fr) * PRAW + 16 * fq;
                f32x4 c = (f32x4){0.f, 0.f, 0.f, 0.f};
                c = __builtin_amdgcn_mfma_f32_16x16x32_bf16(av0, *(const LAS s16x8*)scp, c, 0, 0, 0);
                c = __builtin_amdgcn_mfma_f32_16x16x32_bf16(av1, *(const LAS s16x8*)(scp + 64), c, 0, 0, 0);
#pragma unroll
                for (int ks = 0; ks < 4; ++ks) c = __builtin_amdgcn_mfma_f32_16x16x32_bf16(sa[ks], *(const LAS s16x8*)(qp + 64 * ks), c, 0, 0, 0);
                acc[tt] = c;
                float ss = (c[0] * c[0] + c[1] * c[1]) + (c[2] * c[2] + c[3] * c[3]);
                ss += __shfl_xor(ss, 16); ss += __shfl_xor(ss, 32);
                if (fq == 0) SSQ[w * 64 + 16 * tt + fr] = ss;
            }
        }
        __syncthreads();
        {
            const f32x4 ng = *(const f32x4*)(A.in[4] + 128 * h + 16 * w + 4 * fq);
            bf16* op = ((bf16*)(A.ws + WS_MIX)) + (size_t)(b * SEQ + 64 * (cc - 1) + fr) * DM + 128 * h + 16 * w + 4 * fq;
#pragma unroll
            for (int tt = 0; tt < 4; ++tt) {
                float tot = 0.f;
#pragma unroll
                for (int k = 0; k < 8; ++k) tot += SSQ[k * 64 + 16 * tt + fr];
                const float rs = 1.0f / sqrtf(tot * (1.f / 128.f) + RMS_EPS);
                u32x2 o;
                o.x = pk2(acc[tt][0] * rs * ng[0] * bflo(gt[tt].x), acc[tt][1] * rs * ng[1] * bfhi(gt[tt].x));
                o.y = pk2(acc[tt][2] * rs * ng[2] * bflo(gt[tt].y), acc[tt][3] * rs * ng[3] * bfhi(gt[tt].y));
                *(u32x2*)(op + (size_t)(16 * tt) * DM) = o;
            }
        }
        __syncthreads();
    }
}

__device__ __forceinline__ void ln_stats(const f32x4 (&v)[4], float& mean, float& rstd) {
    float s = 0.f;
#pragma unroll
    for (int j = 0; j < 4; ++j) s += (v[j][0] + v[j][1]) + (v[j][2] + v[j][3]);
    mean = wave_sum(s) * (1.f / DM);
    float s2 = 0.f;
#pragma unroll
    for (int j = 0; j < 4; ++j) { const f32x4 d = v[j] - mean; s2 += (d[0] * d[0] + d[1] * d[1]) + (d[2] * d[2] + d[3] * d[3]); }
    rstd = 1.0f / sqrtf(wave_sum(s2) * (1.f / DM) + LN_EPS);
}

__device__ __forceinline__ void route_row(Frame& F, const Args& A, const float (&lg)[20], int rl, LAS int* lcnt, LAS int* rec) {
    const float* brg = A.in[10];
    float g0 = lg[0] + brg[0], g1 = lg[1] + brg[1], g2 = lg[2] + brg[2], g3 = lg[3] + brg[3];
    int grp = 0; float gm = g0;
    if (g1 > gm) { gm = g1; grp = 1; } if (g2 > gm) { gm = g2; grp = 2; } if (g3 > gm) { gm = g3; grp = 3; }
    const float pg = 1.f / (__expf(g0 - gm) + __expf(g1 - gm) + __expf(g2 - gm) + __expf(g3 - gm));
    float in0, in1, in2, in3;
    if (grp == 0) { in0 = lg[4]; in1 = lg[5]; in2 = lg[6]; in3 = lg[7]; }
    else if (grp == 1) { in0 = lg[8]; in1 = lg[9]; in2 = lg[10]; in3 = lg[11]; }
    else if (grp == 2) { in0 = lg[12]; in1 = lg[13]; in2 = lg[14]; in3 = lg[15]; }
    else { in0 = lg[16]; in1 = lg[17]; in2 = lg[18]; in3 = lg[19]; }
    const float* be = A.in[12] + grp * 4;
    in0 += be[0]; in1 += be[1]; in2 += be[2]; in3 += be[3];
    int i0 = 0; float m0 = in0;
    if (in1 > m0) { m0 = in1; i0 = 1; } if (in2 > m0) { m0 = in2; i0 = 2; } if (in3 > m0) { m0 = in3; i0 = 3; }
    int i1 = -1; float m1 = 0.f;
    if (i0 != 0) { m1 = in0; i1 = 0; }
    if (i0 != 1 && (i1 < 0 || in1 > m1)) { m1 = in1; i1 = 1; }
    if (i0 != 2 && (i1 < 0 || in2 > m1)) { m1 = in2; i1 = 2; }
    if (i0 != 3 && (i1 < 0 || in3 > m1)) { m1 = in3; i1 = 3; }
    const float w0 = 1.f / (1.f + __expf(m1 - m0)), w1 = 1.f - w0;
    const int e0 = grp * 4 + i0, e1 = grp * 4 + i1;
    const int p0 = atomicAdd((int*)&lcnt[e0], 1), p1 = atomicAdd((int*)&lcnt[e1], 1);
    rec[rl * 6 + 0] = e0; rec[rl * 6 + 1] = p0; rec[rl * 6 + 2] = __float_as_int(pg * w0);
    rec[rl * 6 + 3] = e1; rec[rl * 6 + 4] = p1; rec[rl * 6 + 5] = __float_as_int(pg * w1);
}
__device__ __forceinline__ void p6_ln_router(Frame& F, const Args& A) {
    LAS int* lcnt = F.misc + 32; LAS int* lbase = F.misc + 48;
    LAS f32x4* WL = (LAS f32x4*)F.lds;
    LAS int* rec = (LAS int*)(F.lds + 81920);
    for (int it = F.tid; it < 1024 * 5; it += NTHREADS) {
        const int k = it / 5, c = it % 5, j = k >> 8, ln = (k >> 2) & 63, e = k & 3;
        const f32x4 w = (c == 0) ? *(const f32x4*)(A.in[9] + (size_t)k * 4) : *(const f32x4*)(A.in[11] + (size_t)k * 16 + 4 * (c - 1));
        WL[((j * 4 + e) * 5 + c) * 64 + ln] = w;
    }
    __syncthreads();
    const LAS f32x4* wl = WL + F.lane;
    for (int slab = blockIdx.x; slab < MTOK / 128; slab += F.G) {
        if (F.tid < 16) lcnt[F.tid] = 0;
        __syncthreads();
#pragma unroll 1
        for (int i = 0; i < 16; i += 2) {
            const int rl = F.wave * 16 + i, row = slab * 128 + rl;
            const f32x4* xr0 = (const f32x4*)(A.out + (size_t)row * DM) + F.lane; const f32x4* xr1 = xr0 + DM / 4;
            u32x2* hb0 = (u32x2*)(((bf16*)(A.ws + WS_H1)) + (size_t)row * DM) + F.lane; u32x2* hb1 = hb0 + DM / 4;
            f32x4 v0[4], v1[4];
#pragma unroll
            for (int j = 0; j < 4; ++j) { v0[j] = xr0[64 * j]; v1[j] = xr1[64 * j]; }
            float mean0, rstd0, mean1, rstd1; ln_stats(v0, mean0, rstd0); ln_stats(v1, mean1, rstd1);
#pragma unroll
            for (int j = 0; j < 4; ++j) {
                const f32x4 g = ((const f32x4*)A.in[7])[64 * j + F.lane], bb = ((const f32x4*)A.in[8])[64 * j + F.lane];
                v0[j] = (v0[j] - mean0) * rstd0 * g + bb; v1[j] = (v1[j] - mean1) * rstd1 * g + bb;
                { u32x2 o; o.x = pk2(v0[j][0], v0[j][1]); o.y = pk2(v0[j][2], v0[j][3]); hb0[64 * j] = o; o.x = pk2(v1[j][0], v1[j][1]); o.y = pk2(v1[j][2], v1[j][3]); hb1[64 * j] = o; }
            }
            float la[20], lb2[20];
#pragma unroll
            for (int e = 0; e < 20; ++e) { la[e] = 0.f; lb2[e] = 0.f; }
#pragma unroll 1
            for (int j = 0; j < 4; ++j) {
                const f32x4 s0 = (j == 0) ? v0[0] : (j == 1) ? v0[1] : (j == 2) ? v0[2] : v0[3];
                const f32x4 s1 = (j == 0) ? v1[0] : (j == 1) ? v1[1] : (j == 2) ? v1[2] : v1[3];
                const LAS f32x4* wj = wl + j * (20 * 64);
#pragma unroll
                for (int e = 0; e < 4; ++e) {
                    const float h0 = s0[e], h1 = s1[e];
#pragma unroll
                    for (int c = 0; c < 5; ++c) { const f32x4 w = wj[(e * 5 + c) * 64];
                        la[4 * c] += h0 * w[0]; la[4 * c + 1] += h0 * w[1]; la[4 * c + 2] += h0 * w[2]; la[4 * c + 3] += h0 * w[3];
                        lb2[4 * c] += h1 * w[0]; lb2[4 * c + 1] += h1 * w[1]; lb2[4 * c + 2] += h1 * w[2]; lb2[4 * c + 3] += h1 * w[3]; }
                }
            }
#pragma unroll
            for (int e = 0; e < 20; ++e) { la[e] = wave_sum(la[e]); lb2[e] = wave_sum(lb2[e]); }
            if (F.lane == 0) { route_row(F, A, la, rl, lcnt, rec); route_row(F, A, lb2, rl + 1, lcnt, rec); }
        }
        __syncthreads();
        if (F.tid < 16) lbase[F.tid] = (int)atomicAdd(((unsigned*)(A.ws + WS_CTL)) + CW_CNT + F.tid, (unsigned)lcnt[F.tid]);
        __syncthreads();
        if (F.tid < 128) {
            unsigned* mp = ((unsigned*)(A.ws + WS_META)) + (size_t)(slab * 128 + F.tid) * 8;
            const int e0 = rec[F.tid * 6 + 0], e1 = rec[F.tid * 6 + 3];
            u32x4 a, c;
            a.x = (unsigned)e0; a.y = (unsigned)(lbase[e0] + rec[F.tid * 6 + 1]); a.z = (unsigned)rec[F.tid * 6 + 2]; a.w = (unsigned)e1;
            c.x = (unsigned)(lbase[e1] + rec[F.tid * 6 + 4]); c.y = (unsigned)rec[F.tid * 6 + 5]; c.z = 0u; c.w = 0u;
            *(u32x4*)mp = a; *(u32x4*)(mp + 4) = c;
        }
        __syncthreads();
    }
}

__device__ __forceinline__ void build_toff(Frame& F, const Args& A) {
    __syncthreads();
    if (F.tid == 0) { int acc = 0;
        for (int e = 0; e < NEXP; ++e) { F.misc[e] = acc; const unsigned c = __hip_atomic_load(((unsigned*)(A.ws + WS_CTL)) + CW_CNT + e, __ATOMIC_RELAXED, __HIP_MEMORY_SCOPE_AGENT); acc += (int)((c + 255u) >> 8); }
        F.misc[NEXP] = acc; }
    __syncthreads();
}

__device__ __forceinline__ void p7_scatter(Frame& F, const Args& A) {
    build_toff(F, A);
    for (int row = F.gw; row < MTOK; row += F.ngw) {
        const unsigned* mp = ((unsigned*)(A.ws + WS_META)) + (size_t)row * 8;
        const int e0 = (int)mp[0], p0 = (int)mp[1], e1 = (int)mp[3], p1 = (int)mp[4];
        const size_t s0 = (size_t)F.misc[e0] * 256 + p0, s1 = (size_t)F.misc[e1] * 256 + p1;
        const u32x4* xr = (const u32x4*)(((bf16*)(A.ws + WS_H1)) + (size_t)row * DM) + F.lane;
        u32x4* o0 = (u32x4*)(((bf16*)(A.ws + WS_XS)) + s0 * DM) + F.lane; u32x4* o1 = (u32x4*)(((bf16*)(A.ws + WS_XS)) + s1 * DM) + F.lane;
#pragma unroll
        for (int j = 0; j < 2; ++j) { const u32x4 v = xr[64 * j]; o0[64 * j] = v; o1[64 * j] = v; }
    }
    LAS float* scr = (LAS float*)(F.lds + F.wave * 16384);
    constexpr int I13 = (DM / 64) * (DEXP / 32), I2 = (DEXP / 64) * (DM / 32);
    for (int it = F.gw; it < NEXP * (2 * I13 + I2); it += F.ngw) {
        const int e = it / (2 * I13 + I2), r = it % (2 * I13 + I2);
        if (r < I13) transpose_item<1>(A.in[13] + (size_t)e * DM * DEXP, DM, DEXP, ((bf16*)(A.ws + WS_W13)) + (size_t)e * 1024 * DM, scr, r, F.lane);
        else if (r < 2 * I13) transpose_item<2>(A.in[14] + (size_t)e * DM * DEXP, DM, DEXP, ((bf16*)(A.ws + WS_W13)) + (size_t)e * 1024 * DM, scr, r - I13, F.lane);
        else transpose_item<0>(A.in[15] + (size_t)e * DEXP * DM, DEXP, DM, ((bf16*)(A.ws + WS_W2)) + (size_t)e * DM * DEXP, scr, r - 2 * I13, F.lane);
    }
}

__device__ __forceinline__ void p10_final(Frame& F, const Args& A) {
    build_toff(F, A);
    for (int row = F.gw; row < MTOK; row += F.ngw) {
        const unsigned* mp = ((unsigned*)(A.ws + WS_META)) + (size_t)row * 8;
        const int e0 = (int)mp[0], p0 = (int)mp[1], e1 = (int)mp[3], p1 = (int)mp[4];
        const float g0 = __uint_as_float(mp[2]), g1 = __uint_as_float(mp[5]);
        const size_t s0 = (size_t)F.misc[e0] * 256 + p0, s1 = (size_t)F.misc[e1] * 256 + p1;
        f32x4* xr = (f32x4*)(A.out + (size_t)row * DM) + F.lane; const u32x2* hr = (const u32x2*)(((bf16*)(A.ws + WS_H1)) + (size_t)row * DM) + F.lane;
        const u32x2* y0 = (const u32x2*)(((bf16*)(A.ws + WS_YS)) + s0 * DM) + F.lane; const u32x2* y1 = (const u32x2*)(((bf16*)(A.ws + WS_YS)) + s1 * DM) + F.lane;
        f32x4 v[4];
#pragma unroll
        for (int j = 0; j < 4; ++j) { const u32x2 hw = hr[64 * j]; const f32x4 hv = (f32x4){bflo(hw.x), bfhi(hw.x), bflo(hw.y), bfhi(hw.y)}; const u32x2 a = y0[64 * j], c = y1[64 * j];
            v[j][0] = ALPHA * hv[0] + g0 * bflo(a.x) + g1 * bflo(c.x); v[j][1] = ALPHA * hv[1] + g0 * bfhi(a.x) + g1 * bfhi(c.x);
            v[j][2] = ALPHA * hv[2] + g0 * bflo(a.y) + g1 * bflo(c.y); v[j][3] = ALPHA * hv[3] + g0 * bfhi(a.y) + g1 * bfhi(c.y); }
        float mean, rstd; ln_stats(v, mean, rstd);
#pragma unroll
        for (int j = 0; j < 4; ++j) { const f32x4 g = ((const f32x4*)A.in[16])[64 * j + F.lane], bb = ((const f32x4*)A.in[17])[64 * j + F.lane]; xr[64 * j] = (v[j] - mean) * rstd * g + bb; }
    }
}

#define XB_TMO      128
#define XB_XCNT(j)  (256  + 64 * (j))
#define XB_XSUB(j)  (1280 + 64 * (j))
#define XB_XGEN(j)  (2304 + 64 * (j))
#define XB_TOP      3328
#define XB_TOPGEN   3392
#define XCD_BAR_WORDS 3456
#define XB_SPIN_CAP (1u << 18)

__device__ __forceinline__ unsigned xb_ld(unsigned* p)              { return __hip_atomic_load(p, __ATOMIC_RELAXED, __HIP_MEMORY_SCOPE_AGENT); }
__device__ __forceinline__ unsigned xb_add(unsigned* p, unsigned v) { return __hip_atomic_fetch_add(p, v, __ATOMIC_RELAXED, __HIP_MEMORY_SCOPE_AGENT); }
__device__ __forceinline__ unsigned xb_xcc_id() { return (unsigned)__builtin_amdgcn_s_getreg((3 << 11) | 20) & 0xFu; }
#define XB_SPIN(cond, bar) do { unsigned _sp = 0; while (cond) { __builtin_amdgcn_s_sleep(1); \
    if ((++_sp & 255u) == 0u) { if (xb_ld(&(bar)[XB_TMO])) break; if (_sp > XB_SPIN_CAP) { atomicAdd(&(bar)[XB_TMO], 1u); break; } } } } while (0)

struct XcdBarrier {
    unsigned* bar; unsigned x;
    volatile LAS unsigned* st;
};

__device__ __forceinline__ XcdBarrier xcd_barrier_post(unsigned* bar, volatile LAS unsigned* st) {
    XcdBarrier b; b.bar = bar; b.x = xb_xcc_id(); b.st = st;
    if (threadIdx.x == 0) (void)xb_add(&bar[XB_XCNT(b.x)], 1u);
    return b;
}
__device__ __forceinline__ void xcd_barrier_complete(unsigned* bar, unsigned x, unsigned& nloc, unsigned& nx) {
    const unsigned G = gridDim.x * gridDim.y * gridDim.z;
    unsigned sum, cnt, mine, sp = 0u;
    for (;;) {
        sum = 0u; cnt = 0u; mine = 0u;
#pragma unroll
        for (unsigned j = 0; j < 16; ++j) { const unsigned c = xb_ld(&bar[XB_XCNT(j)]); sum += c; cnt += (c > 0u) ? 1u : 0u; mine = (j == x) ? c : mine; }
        if (sum == G) break;
        __builtin_amdgcn_s_sleep(1);
        if ((++sp & 255u) == 0u) { if (xb_ld(&bar[XB_TMO])) break; if (sp > XB_SPIN_CAP) { atomicAdd(&bar[XB_TMO], 1u); break; } }
    }
    nloc = mine > 0u ? mine : 1u; nx = cnt > 0u ? cnt : 1u;
}

__device__ __forceinline__ void xcd_barrier(const XcdBarrier& b) {
    asm volatile("s_waitcnt vmcnt(0)" ::: "memory");
    __syncthreads();
    if (threadIdx.x == 0) {
        unsigned* bar = b.bar;
        __builtin_amdgcn_s_waitcnt(0);
        unsigned nloc = b.st[0], nx = b.st[1];
        if (nloc == 0u) { xcd_barrier_complete(bar, b.x, nloc, nx); b.st[0] = nloc; b.st[1] = nx; }
        const unsigned old = xb_add(&bar[XB_XSUB(b.x)], 1u);
        const unsigned gen = old / nloc;
        if (old + 1u == (gen + 1u) * nloc) {
            __builtin_amdgcn_fence(__ATOMIC_RELEASE, "agent");
            asm volatile("s_waitcnt vmcnt(0)" ::: "memory");
            const unsigned og = xb_add(&bar[XB_TOP], 1u);
            const unsigned tg = og / nx;
            if (og + 1u == (tg + 1u) * nx) xb_add(&bar[XB_TOPGEN], 1u);
            else XB_SPIN(xb_ld(&bar[XB_TOPGEN]) == tg, bar);
            __builtin_amdgcn_fence(__ATOMIC_ACQUIRE, "agent");
            xb_add(&bar[XB_XGEN(b.x)], 1u);
            asm volatile("s_waitcnt vmcnt(0)" ::: "memory");
        } else {
            XB_SPIN(xb_ld(&bar[XB_XGEN(b.x)]) == gen, bar);
            __builtin_amdgcn_fence(__ATOMIC_ACQUIRE, "agent");
            asm volatile("s_waitcnt vmcnt(0)" ::: "memory");
        }
    }
    __syncthreads();
}

constexpr int NPHASE = 11;
__global__ void __launch_bounds__(NTHREADS, 2) mega_fwd(Args args) {
    extern __shared__ __attribute__((aligned(16))) unsigned char lds[];
    cg::grid_group grid = cg::this_grid();
    Frame F;
    F.lds = (LAS unsigned char*)lds; F.misc = (LAS int*)(F.lds + MISC_OFF);
    F.tid = threadIdx.x; F.lane = F.tid & 63; F.wave = __builtin_amdgcn_readfirstlane(F.tid >> 6); F.G = gridDim.x;
    F.gw = blockIdx.x * NWAVES + F.wave; F.ngw = F.G * NWAVES;
    const Args& A = args;
    const int lo = args.ph_lo, hi = args.ph_hi;
    if (F.tid < 2) F.misc[MISC_BAR + F.tid] = 0;
    __syncthreads();
    XcdBarrier bar; bar.bar = (unsigned*)(args.ws + WS_CTL) + CW_BAR; bar.x = 0; bar.st = nullptr;
    if (MK_LAUNCHES == 1) bar = xcd_barrier_post((unsigned*)(args.ws + WS_CTL) + CW_BAR, (volatile LAS unsigned*)(F.misc + MISC_BAR));
#define IN(k) (lo <= (k) && (k) < hi)
#define SEAM(k) do { if (IN((k) + 1)) { if ((k) == 0) grid.sync(); else xcd_barrier(bar); } } while (0)

    if (IN(0)) { p0_prep(F, A); SEAM(0); }
    if (IN(1)) {
        meta_finalize(F, A);
        pg8::Gemm g{((bf16*)(A.ws + WS_XB)), ((bf16*)(A.ws + WS_WIN)), MTOK, NIN, DM}; pg8::StaticOrder S; S.init(MTOK, NIN, F.G, (int)blockIdx.x);
        EpiProj E{((bf16*)(A.ws + WS_PROJ)), ((float*)(A.ws + WS_LB))};
        pg8::gemm_phase<EpiProj, pg8::StaticOrder, PG8_ALIGN, PG8_SP2>(F.lds, g, S, E);
        SEAM(1);
    }
    if (IN(2)) {
        ha_phase(F, A);
        attn_phase(F, A);
        SEAM(2);
    }
    if (IN(3)) { hb_phase(F, A); SEAM(3); }
    if (IN(4)) {
        hc_phase(F, A);
        SEAM(4);
    }
    if (IN(5)) {
        pg8::Gemm g{((bf16*)(A.ws + WS_MIX)), ((bf16*)(A.ws + WS_WOUT)), MTOK, DM, DM}; pg8::StaticOrder S; S.init(MTOK, DM, F.G, (int)blockIdx.x);
        EpiOut E{A.in[0], A.out};
        pg8::gemm_phase<EpiOut, pg8::StaticOrder, PG8_ALIGN, PG8_SP2>(F.lds, g, S, E);
        SEAM(5);
    }
    if (IN(6)) { p6_ln_router(F, A); SEAM(6); }
    if (IN(7)) { p7_scatter(F, A); SEAM(7); }
    if (IN(8)) {
        build_toff(F, A);
        pg8::Gemm g{((bf16*)(A.ws + WS_XS)), ((bf16*)(A.ws + WS_W13)), XS_ROWS, 1024, DM}; MoeOrder S{(const LAS int*)F.misc, F.G, (int)blockIdx.x, F.misc[NEXP]};
        EpiHid E{((bf16*)(A.ws + WS_HID))};
        pg8::gemm_phase<EpiHid, MoeOrder, PG8_ALIGN, PG8_SP2>(F.lds, g, S, E);
        SEAM(8);
    }
    if (IN(9)) {
        build_toff(F, A);
        pg8::Gemm g{((bf16*)(A.ws + WS_HID)), ((bf16*)(A.ws + WS_W2)), XS_ROWS, 1024, DEXP}; MoeOrder S{(const LAS int*)F.misc, F.G, (int)blockIdx.x, F.misc[NEXP]};
        EpiYs E{((bf16*)(A.ws + WS_YS))};
        pg8::gemm_phase<EpiYs, MoeOrder, PG8_ALIGN, PG8_SP2>(F.lds, g, S, E);
        SEAM(9);
    }
    if (IN(10)) { p10_final(F, A); }
#undef IN
#undef SEAM
}

extern "C" void kernel_launch(void* const* d_in, const int* in_sizes, int n_in, void* d_out, int out_size, void* d_ws, size_t ws_size, hipStream_t stream) {
    static int grid = 0;
    if (grid == 0) {
        if (n_in != 18 || in_sizes[0] != MTOK * DM || out_size != MTOK * DM || ws_size < WS_END) {
            fprintf(stderr, "kernel_launch: unexpected shapes (n_in %d, in0 %d, out %d, ws %zu); nothing launched\n", n_in, n_in > 0 ? in_sizes[0] : -1, out_size, ws_size); grid = -1; return; }
        int dev = 0, cus = 0, per_cu = 0;
        if (hipGetDevice(&dev) != hipSuccess || hipDeviceGetAttribute(&cus, hipDeviceAttributeMultiprocessorCount, dev) != hipSuccess) { grid = -1; return; }
        if (hipFuncSetAttribute((const void*)mega_fwd, hipFuncAttributeMaxDynamicSharedMemorySize, LDS_BYTES) != hipSuccess) { fprintf(stderr, "kernel_launch: hipFuncSetAttribute failed\n"); grid = -1; return; }
        if (hipOccupancyMaxActiveBlocksPerMultiprocessor(&per_cu, (const void*)mega_fwd, NTHREADS, LDS_BYTES) != hipSuccess || per_cu < 1) { fprintf(stderr, "kernel_launch: occupancy query says %d\n", per_cu); per_cu = 1; }
        (void)hipGetLastError();
        grid = cus;
    }
    if (grid < 0) return;
    (void)hipMemsetAsync((char*)d_ws + WS_CTL, 0, CTL_ZERO_BYTES, stream);
    Args a{};
    for (int i = 0; i < 18; ++i) a.in[i] = (const float*)d_in[i];
    a.out = (float*)d_out; a.ws = (unsigned char*)d_ws;
#if MK_LAUNCHES == 1
    a.ph_lo = 0; a.ph_hi = NPHASE;
    void* kargs[] = {&a};
    hipError_t e = hipLaunchCooperativeKernel((const void*)mega_fwd, dim3(grid), dim3(NTHREADS), kargs, LDS_BYTES, stream);
    if (e != hipSuccess) fprintf(stderr, "kernel_launch: cooperative launch failed: %s (grid %d)\n", hipGetErrorString(e), grid);
#else
    for (int p = 0; p < NPHASE; ++p) { a.ph_lo = p; a.ph_hi = p + 1; hipLaunchKernelGGL(mega_fwd, dim3(grid), dim3(NTHREADS), LDS_BYTES, stream, a); }
#endif
}
```

```cpp
#include <hip/hip_runtime.h>
#include <hip/hip_cooperative_groups.h>
#include <cstdio>
#include <cstdint>
namespace cg = cooperative_groups;
namespace pg8 {
#define PG8_LAS __attribute__((address_space(3)))
typedef unsigned short bf16_t;
typedef short bf16x8 __attribute__((ext_vector_type(8)));
typedef float f32x4 __attribute__((ext_vector_type(4)));
typedef unsigned u32x4 __attribute__((ext_vector_type(4)));
constexpr int BM = 256, BK = 64, HALF = 128, HTB = HALF * BK * 2  , STAGE_BYTES = 8 * HTB, NXCD = 8, WGM = 8;

__host__ __device__ __forceinline__ int lds_byte(int r, int c) { const int st = (r >> 4) * 2 + (c >> 5), rr = r & 15, cc = c & 31, ob = rr * 64 + cc * 2; return st * 1024 + (ob ^ (((ob >> 9) & 1) << 5)); }
__host__ __device__ __forceinline__ void stage_rc(int b, int& R, int& C) { const int st = b / 1024, sb = b % 1024, swz = sb ^ (((sb >> 9) & 1) << 5); R = (st >> 1) * 16 + swz / 64; C = (st & 1) * 32 + (swz % 64) / 2; }
__host__ __device__ __forceinline__ int perm32(int rho) { const int n = rho >> 4, i = rho & 15; return 8 * (i >> 2) + 4 * n + (i & 3); }

struct Unit { int pm, pn; };
struct Gemm { const bf16_t* A; const bf16_t* Bt; int M, N, K; };

struct StaticOrder {
    int nM, nN, nwg, G, c;
    __host__ __device__ void init(int M, int N, int G_, int c_) { nM = M / BM; nN = N / BM; nwg = nM * nN; G = G_; c = c_; }
    __host__ __device__ bool next(int i, Unit& u) const {
        const long L = (long)i * G + c; if (L >= nwg) return false;
        int wgid = (int)L; { const int q = nwg / NXCD, r = nwg % NXCD, xcd = wgid % NXCD, off = wgid / NXCD; wgid = (xcd < r ? xcd * (q + 1) : r * (q + 1) + (xcd - r) * q) + off; }
        const int nig = WGM * nN, gid = wgid / nig, fm = gid * WGM, gsz = (nM - fm) < WGM ? (nM - fm) : WGM;
        u.pm = fm + ((wgid % nig) % gsz); u.pn = (wgid % nig) / gsz; return true;
    }
    __device__ __forceinline__ void a_ready(const Unit&) const {}
    __device__ __forceinline__ void done(const Unit&) const {}
};

__device__ __forceinline__ unsigned cvt_pk_bf16(float lo, float hi) { unsigned r; asm volatile("v_cvt_pk_bf16_f32 %0, %1, %2" : "=v"(r) : "v"(lo), "v"(hi)); return r; }
template <class Epi, class Sched, bool ALIGN_EPI = false, bool SP2 = false>
__device__ __forceinline__ void gemm_phase(PG8_LAS unsigned char* lds, const Gemm g, const Sched& S, const Epi& E) {
    int tid_ = threadIdx.x; asm volatile("" : "+v"(tid_));
    const int tid = tid_, wid = __builtin_amdgcn_readfirstlane(tid >> 6), lane = tid & 63, wr = wid >> 2, wc = wid & 3, fr = lane & 15, fq = lane >> 4;
    const int K = g.K, nt = K / BK;
    unsigned voffA[2], voffB[2];
#pragma unroll
    for (int i = 0; i < 2; ++i) { int R, C; stage_rc(tid * 16 + i * 8192, R, C); const int Rb = Epi::PERM ? ((R & ~31) + perm32(R & 31)) : R;
        voffA[i] = (unsigned)(R * K + C) * 2u; voffB[i] = (unsigned)(Rb * K + C) * 2u; }
    const size_t kstep = (size_t)(BK * 2);
    const size_t hstep = (size_t)HALF * K * 2;
    const size_t tstep = 2 * hstep;
    const unsigned ldsw = (unsigned)wid * 1024u;
    const int aoff = lds_byte(wr * 64 + fr, fq * 8), boff = lds_byte(wc * 32 + fr, fq * 8);
#define PG8_SA(b, h) (((b) * 2 + (h)) * HTB)
#define PG8_SB(b, h) ((4 + (b) * 2 + (h)) * HTB)
#define PG8_STAGE(bufoff, gbase, voff) do { _Pragma("unroll") for (int _i = 0; _i < 2; ++_i) \
        __builtin_amdgcn_global_load_lds((const unsigned*)((const char*)(gbase) + (voff)[_i]), (PG8_LAS unsigned*)(lds + (bufoff) + ldsw + _i * 8192), 16, 0, 0); } while (0)
#define PG8_LDA(dst, b, h) do { _Pragma("unroll") for (int m = 0; m < 4; ++m) _Pragma("unroll") for (int k = 0; k < 2; ++k) dst[m][k] = *(const PG8_LAS bf16x8*)(lds + PG8_SA(b, h) + aoff + m * 2048 + k * 1024); } while (0)
#define PG8_LDB(dst, b, h) do { _Pragma("unroll") for (int n = 0; n < 2; ++n) _Pragma("unroll") for (int k = 0; k < 2; ++k) dst[n][k] = *(const PG8_LAS bf16x8*)(lds + PG8_SB(b, h) + boff + n * 2048 + k * 1024); } while (0)
#define PG8_MMA(ai, bj, At, Bt) do { __builtin_amdgcn_s_setprio(1); _Pragma("unroll") for (int m = 0; m < 4; ++m) _Pragma("unroll") for (int n = 0; n < 2; ++n) _Pragma("unroll") for (int k = 0; k < 2; ++k) \
        acc[ai][bj][m][n] = __builtin_amdgcn_mfma_f32_16x16x32_bf16(Bt[n][k], At[m][k], acc[ai][bj][m][n], 0, 0, 0); __builtin_amdgcn_s_setprio(0); } while (0)
#define PG8_WAIT_V(n) asm volatile("s_waitcnt vmcnt(" #n ")" ::: "memory")
#define PG8_WAIT_L(n) asm volatile("s_waitcnt lgkmcnt(" #n ")" ::: "memory")
#define PG8_BAR __builtin_amdgcn_s_barrier()
#define PG8_SCHED __builtin_amdgcn_sched_barrier(0)
    Unit cur, nxt; int ui = 0;
    if (!S.next(0, cur)) return;
    f32x4 acc[2][2][4][2];
#pragma unroll
    for (int a = 0; a < 2; ++a)
#pragma unroll
        for (int b = 0; b < 2; ++b)
#pragma unroll
            for (int m = 0; m < 4; ++m)
#pragma unroll
                for (int n = 0; n < 2; ++n) acc[a][b][m][n] = (f32x4){0.f, 0.f, 0.f, 0.f};
    bf16x8 At[4][2], B0[2][2], B1[2][2];
    const char* cA = (const char*)g.A + (size_t)cur.pm * tstep; const char* cB = (const char*)g.Bt + (size_t)cur.pn * tstep;
    S.a_ready(cur);
    if constexpr (SP2) {
        PG8_STAGE(PG8_SB(0, 0), cB, voffB); PG8_STAGE(PG8_SB(0, 1), cB + hstep, voffB); PG8_STAGE(PG8_SA(0, 0), cA, voffA); PG8_STAGE(PG8_SA(0, 1), cA + hstep, voffA);
        if (wr == 1) PG8_BAR;
        PG8_WAIT_V(2); PG8_BAR;
        PG8_STAGE(PG8_SB(1, 0), cB + kstep, voffB); PG8_STAGE(PG8_SA(1, 0), cA + kstep, voffA); PG8_STAGE(PG8_SB(1, 1), cB + hstep + kstep, voffB);
        PG8_WAIT_V(6); PG8_BAR;
    } else {
        PG8_STAGE(PG8_SB(0, 0), cB, voffB); PG8_STAGE(PG8_SA(0, 0), cA, voffA); PG8_STAGE(PG8_SB(0, 1), cB + hstep, voffB); PG8_STAGE(PG8_SA(0, 1), cA + hstep, voffA);
        if (wr == 1) PG8_BAR;
        PG8_WAIT_V(4); PG8_BAR;
        PG8_STAGE(PG8_SB(1, 0), cB + kstep, voffB); PG8_STAGE(PG8_SA(1, 0), cA + kstep, voffA); PG8_STAGE(PG8_SB(1, 1), cB + hstep + kstep, voffB);
        PG8_WAIT_V(6); PG8_BAR;
    }
    for (;;) {
        const bool has_next = S.next(ui + 1, nxt);
        const char* nA = has_next ? (const char*)g.A + (size_t)nxt.pm * tstep : cA; const char* nB = has_next ? (const char*)g.Bt + (size_t)nxt.pn * tstep : cB;
        for (int t = 0; t < nt; t += 2) {
            const bool last = (t == nt - 2);
            const char* a1 = cA + (size_t)(t + 1) * kstep;
            const char* a2 = last ? nA : cA + (size_t)(t + 2) * kstep; const char* b2 = last ? nB : cB + (size_t)(t + 2) * kstep;
            const char* a3 = a2 + kstep; const char* b3 = b2 + kstep;
            if (last && has_next) S.a_ready(nxt);
            if constexpr (SP2) {
            PG8_LDB(B0, 0, 0); PG8_LDB(B1, 0, 1); PG8_SCHED; PG8_LDA(At, 0, 0); PG8_STAGE(PG8_SA(1, 1), a1 + hstep, voffA);
            PG8_WAIT_V(8); PG8_WAIT_L(0); PG8_BAR; PG8_MMA(0, 0, At, B0); PG8_MMA(0, 1, At, B1); PG8_BAR; PG8_SCHED;
            PG8_LDA(At, 0, 1); PG8_STAGE(PG8_SB(0, 0), b2, voffB); PG8_STAGE(PG8_SB(0, 1), b2 + hstep, voffB); PG8_STAGE(PG8_SA(0, 0), a2, voffA);
            PG8_WAIT_V(8); PG8_WAIT_L(0); PG8_BAR; PG8_MMA(1, 0, At, B0); PG8_MMA(1, 1, At, B1); PG8_BAR; PG8_SCHED;
            PG8_LDB(B0, 1, 0); PG8_LDB(B1, 1, 1); PG8_SCHED; PG8_LDA(At, 1, 0); PG8_STAGE(PG8_SA(0, 1), a2 + hstep, voffA);
            PG8_WAIT_V(8); PG8_WAIT_L(0); PG8_BAR; PG8_MMA(0, 0, At, B0); PG8_MMA(0, 1, At, B1); PG8_BAR; PG8_SCHED;
            PG8_LDA(At, 1, 1); PG8_STAGE(PG8_SB(1, 0), b3, voffB); PG8_STAGE(PG8_SB(1, 1), b3 + hstep, voffB); PG8_STAGE(PG8_SA(1, 0), a3, voffA);
            PG8_WAIT_V(8); PG8_WAIT_L(0); PG8_BAR; PG8_MMA(1, 0, At, B0); PG8_MMA(1, 1, At, B1); PG8_BAR; PG8_SCHED;
            } else {
            PG8_LDB(B0, 0, 0); PG8_SCHED; PG8_LDA(At, 0, 0); PG8_STAGE(PG8_SA(1, 1), a1 + hstep, voffA);
            PG8_WAIT_L(8); PG8_BAR; PG8_WAIT_L(0); PG8_MMA(0, 0, At, B0); PG8_BAR; PG8_SCHED;
            PG8_LDB(B1, 0, 1); PG8_STAGE(PG8_SB(0, 0), b2, voffB);
            PG8_BAR; PG8_WAIT_L(0); PG8_MMA(0, 1, At, B1); PG8_BAR;
            PG8_LDA(At, 0, 1); PG8_STAGE(PG8_SA(0, 0), a2, voffA);
            PG8_BAR; PG8_WAIT_L(0); PG8_MMA(1, 0, At, B0); PG8_BAR; PG8_SCHED;
            PG8_STAGE(PG8_SB(0, 1), b2 + hstep, voffB);
            PG8_WAIT_V(6); PG8_BAR; PG8_MMA(1, 1, At, B1); PG8_BAR;
            PG8_LDB(B0, 1, 0); PG8_SCHED; PG8_LDA(At, 1, 0); PG8_STAGE(PG8_SA(0, 1), a2 + hstep, voffA);
            PG8_WAIT_L(8); PG8_BAR; PG8_WAIT_L(0); PG8_MMA(0, 0, At, B0); PG8_BAR; PG8_SCHED;
            PG8_LDB(B1, 1, 1); PG8_STAGE(PG8_SB(1, 0), b3, voffB);
            PG8_BAR; PG8_WAIT_L(0); PG8_MMA(0, 1, At, B1); PG8_BAR;
            PG8_LDA(At, 1, 1); PG8_STAGE(PG8_SA(1, 0), a3, voffA);
            PG8_BAR; PG8_WAIT_L(0); PG8_MMA(1, 0, At, B0); PG8_BAR; PG8_SCHED;
            PG8_STAGE(PG8_SB(1, 1), b3 + hstep, voffB);
            PG8_WAIT_V(6); PG8_BAR; PG8_MMA(1, 1, At, B1); PG8_BAR;
            }
        }
        if constexpr (ALIGN_EPI) { if (wr == 0) PG8_BAR; }
        if constexpr (!Epi::AFTER_DRAIN) { E(acc, cur, wr, wc, fr, fq); S.done(cur); }
        if (!has_next) break;
#pragma unroll
        for (int a = 0; a < 2; ++a)
#pragma unroll
            for (int b = 0; b < 2; ++b)
#pragma unroll
                for (int m = 0; m < 4; ++m)
#pragma unroll
                    for (int n = 0; n < 2; ++n) acc[a][b][m][n] = (f32x4){0.f, 0.f, 0.f, 0.f};
        cur = nxt; cA = nA; cB = nB; ++ui;
        if constexpr (ALIGN_EPI) { if (wr == 1) PG8_BAR; }
    }
    PG8_WAIT_V(0);
    if constexpr (!ALIGN_EPI) { if (wr == 0) PG8_BAR; }
    PG8_BAR;
    if constexpr (Epi::AFTER_DRAIN) { E.fused(acc, cur, wr, wc, fr, fq, lds, wid, lane); S.done(cur); }
#undef PG8_SA
#undef PG8_SB
#undef PG8_STAGE
#undef PG8_LDA
#undef PG8_LDB
#undef PG8_MMA
#undef PG8_WAIT_V
#undef PG8_WAIT_L
#undef PG8_BAR
#undef PG8_SCHED
}
}


#ifndef PG8_SP2
#define PG8_SP2 true
#endif
#ifndef PG8_ALIGN
#define PG8_ALIGN true
#endif
#ifndef MK_LAUNCHES
#define MK_LAUNCHES 1
#endif

#define GAS __attribute__((address_space(1)))
#define LAS __attribute__((address_space(3)))
typedef unsigned short bf16;
typedef float f32x4 __attribute__((ext_vector_type(4)));
typedef unsigned u32x4 __attribute__((ext_vector_type(4)));
typedef unsigned u32x2 __attribute__((ext_vector_type(2)));

constexpr int NB = 8, SEQ = 4096, DM = 1024, NMETA = 16;
constexpr int ROWS = 4160, PADR = 48, TOK0 = 64;
constexpr int MTOK = NB * SEQ;
constexpr int NIN = 3584;
constexpr int BROWS = NB * ROWS;
constexpr size_t ARR = (size_t)BROWS * 512;
constexpr int NCH = 64;
constexpr int NEXP = 16, DEXP = 512;
constexpr int XS_ROWS = 69632;
constexpr float ALPHA = 1.189207115002721f;
constexpr float LN_EPS = 1e-5f, RMS_EPS = 1e-6f;
constexpr float LOG2E = 1.4426950408889634f;
constexpr float C2Q = 0.125f * LOG2E;
constexpr float STICK_THR = 48.0f;

constexpr size_t MiB = 1u << 20;
constexpr size_t WS_CTL = 0, CTL_ZERO_BYTES = 1 * MiB;
constexpr size_t WS_WIN = 1 * MiB;
constexpr size_t WS_WOUT = 8 * MiB;
constexpr size_t WS_LB = 10 * MiB;
constexpr size_t WS_META = 11 * MiB;
constexpr size_t WS_DV = 12 * MiB;
constexpr size_t WS_XB = 16 * MiB;
constexpr size_t WS_S = 16 * MiB;
constexpr size_t WS_PROJ = 80 * MiB;
constexpr size_t WS_U = 308 * MiB;
constexpr size_t WS_MIX = 436 * MiB;
constexpr size_t WS_Y1 = 308 * MiB;
constexpr size_t WS_H1 = 16 * MiB;
constexpr size_t WS_W13 = 80 * MiB;
constexpr size_t WS_W2 = 112 * MiB;
constexpr size_t WS_XS = 128 * MiB;
constexpr size_t WS_HID = 264 * MiB;
constexpr size_t WS_YS = 332 * MiB;
constexpr size_t WS_END = 500 * MiB;
static_assert(WS_PROJ + 7 * ARR * 2 <= WS_U && WS_U + (size_t)32 * 64 * 16384 * 4 <= WS_MIX && WS_MIX + (size_t)MTOK * DM * 2 <= WS_END, "ws map A");
static_assert(WS_W13 + (size_t)16 * 1024 * 1024 * 2 <= WS_W2 && WS_W2 + (size_t)16 * 1024 * 512 * 2 <= WS_XS && WS_XS + (size_t)XS_ROWS * 1024 * 2 <= WS_HID &&
              WS_HID + (size_t)XS_ROWS * 512 * 2 <= WS_YS && WS_YS + (size_t)XS_ROWS * 1024 * 2 <= WS_END, "ws map B");
constexpr int CW_CNT = 64;
constexpr int CW_BAR = 4096;
constexpr int MISC_BAR = 100;

constexpr int RING_BYTES = 131072;
constexpr int MISC_OFF = RING_BYTES;
constexpr int LDS_BYTES = 147456;
constexpr int NWAVES = 8, NTHREADS = 512;

#define LBAR() do { asm volatile("s_waitcnt lgkmcnt(0)" ::: "memory"); __builtin_amdgcn_s_barrier(); asm volatile("" ::: "memory"); } while (0)
__device__ __forceinline__ unsigned f2bf(float f) { unsigned u = __builtin_bit_cast(unsigned, f); return (u + 0x7fffu + ((u >> 16) & 1u)) >> 16; }
typedef float f32x2_t __attribute__((ext_vector_type(2))); typedef __bf16 bf16x2_t __attribute__((ext_vector_type(2)));
__device__ __forceinline__ unsigned pk2(float lo, float hi) { f32x2_t v = {lo, hi}; bf16x2_t b = __builtin_convertvector(v, bf16x2_t); return __builtin_bit_cast(unsigned, b); }
__device__ __forceinline__ float bf2f(unsigned h) { return __builtin_bit_cast(float, h << 16); }
__device__ __forceinline__ float bflo(unsigned w) { return __builtin_bit_cast(float, w << 16); }
__device__ __forceinline__ float bfhi(unsigned w) { return __builtin_bit_cast(float, w & 0xffff0000u); }
__device__ __forceinline__ float ex2(float x) { return __builtin_amdgcn_exp2f(x); }
__device__ __forceinline__ float lg2(float x) { return __builtin_amdgcn_logf(x); }
__device__ __forceinline__ float rcpf_(float x) { return __builtin_amdgcn_rcpf(x); }
__device__ __forceinline__ float sigm(float v) { return rcpf_(1.f + ex2(-v * LOG2E)); }
__device__ __forceinline__ float wave_sum(float v) {
#pragma unroll
    for (int o = 1; o < 64; o <<= 1) v += __shfl_xor(v, o);
    return v;
}
template <int XF> __device__ __forceinline__ float xform(float v, float lb) {
    if (XF == 0) return v * sigm(v);
    if (XF == 1) return lg2(lb + (1.f - lb) * sigm(v));
    if (XF == 3) return sigm(v);
    if (XF == 4) return v * C2Q;
    return v;
}
__device__ __forceinline__ float xform_rt(int kind, float v, float lb) {
    switch (kind) { case 0: return xform<0>(v, lb); case 1: return xform<1>(v, lb); case 3: return xform<3>(v, lb); case 4: return xform<4>(v, lb); default: return v; }
}

using pg8::Unit;
struct EpiProj {
    static constexpr bool PERM = true, AFTER_DRAIN = false;
    bf16* proj; const float* lb;
    template <int XF> __device__ __forceinline__ void run(int kind, const f32x4 (&acc)[2][2][4][2], const Unit& u, int wr, int wc, int fr, int fq) const {
        const int b = u.pm >> 4;
        const int r0 = b * ROWS + TOK0 + (u.pm & 15) * 256 + wr * 64 + fr;
        const int c0 = (u.pn & 1) * 256 + wc * 32 + 8 * fq;
        bf16* base = proj + (size_t)kind * ARR;
        f32x4 l0[2], l1[2];
#pragma unroll
        for (int bj = 0; bj < 2; ++bj) {
            if (XF == 1) { l0[bj] = *(const f32x4*)(lb + c0 + bj * 128); l1[bj] = *(const f32x4*)(lb + c0 + bj * 128 + 4); }
            else { l0[bj] = (f32x4){0.f, 0.f, 0.f, 0.f}; l1[bj] = l0[bj]; }
        }
#pragma unroll
        for (int ai = 0; ai < 2; ++ai)
#pragma unroll
            for (int m = 0; m < 4; ++m) {
                bf16* rowp = base + (size_t)(r0 + ai * 128 + m * 16) * 512 + c0;
#pragma unroll
                for (int bj = 0; bj < 2; ++bj) {
                    const f32x4 v0 = acc[ai][bj][m][0], v1 = acc[ai][bj][m][1];
                    u32x4 w;
                    w.x = pk2(xform<XF>(v0[0], l0[bj][0]), xform<XF>(v0[1], l0[bj][1]));
                    w.y = pk2(xform<XF>(v0[2], l0[bj][2]), xform<XF>(v0[3], l0[bj][3]));
                    w.z = pk2(xform<XF>(v1[0], l1[bj][0]), xform<XF>(v1[1], l1[bj][1]));
                    w.w = pk2(xform<XF>(v1[2], l1[bj][2]), xform<XF>(v1[3], l1[bj][3]));
                    *(u32x4*)(rowp + bj * 128) = w;
                }
            }
    }
    __device__ __forceinline__ void operator()(const f32x4 (&acc)[2][2][4][2], const Unit& u, int wr, int wc, int fr, int fq) const {
        const int kind = u.pn >> 1;
        if (kind == 0) run<0>(kind, acc, u, wr, wc, fr, fq);
        else if (kind == 1) run<1>(kind, acc, u, wr, wc, fr, fq);
        else if (kind == 3) run<3>(kind, acc, u, wr, wc, fr, fq);
        else if (kind == 4) run<4>(kind, acc, u, wr, wc, fr, fq);
        else run<2>(kind, acc, u, wr, wc, fr, fq);
    }
};
struct EpiOut {
    static constexpr bool PERM = false, AFTER_DRAIN = false;
    const float* x; float* out;
    __device__ __forceinline__ void operator()(const f32x4 (&acc)[2][2][4][2], const Unit& u, int wr, int wc, int fr, int fq) const {
        const int row0 = u.pm * 256 + wr * 64 + fr, col0 = u.pn * 256 + wc * 32 + 4 * fq;
#pragma unroll
        for (int ai = 0; ai < 2; ++ai)
#pragma unroll
            for (int m = 0; m < 4; ++m) {
                const size_t ro = (size_t)(row0 + ai * 128 + m * 16) * DM + col0;
#pragma unroll
                for (int bj = 0; bj < 2; ++bj)
#pragma unroll
                    for (int n = 0; n < 2; ++n) {
                        const f32x4 xv = *(const f32x4*)(x + ro + bj * 128 + 16 * n);
                        *(f32x4*)(out + ro + bj * 128 + 16 * n) = acc[ai][bj][m][n] + xv * ALPHA;
                    }
            }
    }
};
struct EpiHid {
    static constexpr bool PERM = true, AFTER_DRAIN = false;
    bf16* hid;
    __device__ __forceinline__ void operator()(const f32x4 (&acc)[2][2][4][2], const Unit& u, int wr, int wc, int fr, int fq) const {
        const int row0 = u.pm * 256 + wr * 64 + fr, hc0 = (u.pn & 3) * 128 + wc * 16 + 4 * fq;
#pragma unroll
        for (int ai = 0; ai < 2; ++ai)
#pragma unroll
            for (int m = 0; m < 4; ++m) {
                bf16* rowp = hid + (size_t)(row0 + ai * 128 + m * 16) * DEXP + hc0;
#pragma unroll
                for (int bj = 0; bj < 2; ++bj) {
                    const f32x4 g = acc[ai][bj][m][0], up = acc[ai][bj][m][1];
                    u32x2 w;
                    w.x = pk2(g[0] * sigm(g[0]) * up[0], g[1] * sigm(g[1]) * up[1]);
                    w.y = pk2(g[2] * sigm(g[2]) * up[2], g[3] * sigm(g[3]) * up[3]);
                    *(u32x2*)(rowp + bj * 64) = w;
                }
            }
    }
};
struct EpiYs {
    static constexpr bool PERM = true, AFTER_DRAIN = false;
    bf16* ys;
    __device__ __forceinline__ void operator()(const f32x4 (&acc)[2][2][4][2], const Unit& u, int wr, int wc, int fr, int fq) const {
        const int row0 = u.pm * 256 + wr * 64 + fr, col0 = (u.pn & 3) * 256 + wc * 32 + 8 * fq;
#pragma unroll
        for (int ai = 0; ai < 2; ++ai)
#pragma unroll
            for (int m = 0; m < 4; ++m) {
                bf16* rowp = ys + (size_t)(row0 + ai * 128 + m * 16) * DM + col0;
#pragma unroll
                for (int bj = 0; bj < 2; ++bj) {
                    const f32x4 v0 = acc[ai][bj][m][0], v1 = acc[ai][bj][m][1];
                    u32x4 w; w.x = pk2(v0[0], v0[1]); w.y = pk2(v0[2], v0[3]); w.z = pk2(v1[0], v1[1]); w.w = pk2(v1[2], v1[3]);
                    *(u32x4*)(rowp + bj * 128) = w;
                }
            }
    }
};
struct MoeOrder {
    const LAS int* toff; int G, c, ntot;
    __device__ __forceinline__ bool next(int i, Unit& u) const {
        const long L = (long)i * G + c; if (L >= (long)ntot * 4) return false;
        const int mt = (int)(L >> 2), pl = (int)(L & 3); int e = 0;
#pragma unroll
        for (int j = 1; j < NEXP; ++j) e += (mt >= toff[j]) ? 1 : 0;
        u.pm = mt; u.pn = e * 4 + pl; return true;
    }
    __device__ __forceinline__ void a_ready(const Unit&) const {}
    __device__ __forceinline__ void done(const Unit&) const {}
};

struct Args { const float* in[18]; float* out; unsigned char* ws; int ph_lo, ph_hi; };
struct Frame {
    LAS unsigned char* lds; LAS int* misc;
    int tid, lane, wave, G, gw, ngw;
};

template <int MODE> __device__ __forceinline__ int rowmap(int n) { return MODE == 0 ? n : ((n >> 2) * 8 + (n & 3) + (MODE == 2 ? 4 : 0)); }
template <int MODE> __device__ __forceinline__ void transpose_item(const float* W, int K, int N, bf16* WT, LAS float* scr, int item, int lane) {
    const int nblk = N / 32, kb = item / nblk, nb = item % nblk, k0 = 64 * kb, n0 = 32 * nb;
#pragma unroll 8
    for (int i = 0; i < 32; ++i) { const int kk = 2 * i + (lane >> 5); scr[kk * 33 + (lane & 31)] = W[(size_t)(k0 + kk) * N + n0 + (lane & 31)]; }
    asm volatile("s_waitcnt lgkmcnt(0)" ::: "memory");
    const int c = lane & 7;
#pragma unroll
    for (int j = 0; j < 4; ++j) { const int n = (lane >> 3) + 8 * j; const LAS float* s = scr + (8 * c) * 33 + n;
        u32x4 o; o.x = pk2(s[0 * 33], s[1 * 33]); o.y = pk2(s[2 * 33], s[3 * 33]); o.z = pk2(s[4 * 33], s[5 * 33]); o.w = pk2(s[6 * 33], s[7 * 33]);
        *(u32x4*)(WT + (size_t)rowmap<MODE>(n0 + n) * K + k0 + 8 * c) = o; }
    asm volatile("s_waitcnt lgkmcnt(0)" ::: "memory");
}

__device__ __forceinline__ void p0_prep(Frame& F, const Args& A) {
    LAS float* scr = (LAS float*)(F.lds + F.wave * 16384);
    const int gtid = blockIdx.x * NTHREADS + F.tid, gthreads = F.G * NTHREADS;
    for (int i = gtid; i < 512; i += gthreads) ((float*)(A.ws + WS_LB))[i] = 1.f / (1.f + __expf(A.in[3][512 + i] - A.in[3][i]));
    for (int i = gtid; i < 7 * NB * 3072; i += gthreads) {
        const int a = i / (NB * 3072), r = i % (NB * 3072), b = r / 3072, o = r % 3072;
        *(u32x4*)(((bf16*)(A.ws + WS_PROJ)) + (size_t)a * ARR + (size_t)b * ROWS * 512 + (size_t)o * 8) = (u32x4){0u, 0u, 0u, 0u};
    }
    for (int job = F.gw; job < 56 * 16; job += F.ngw) {
        const int cgp = job >> 4, kq = job & 15, n = cgp * 64 + F.lane;
        float acc[16];
#pragma unroll
        for (int r = 0; r < 16; ++r) acc[r] = 0.f;
        const float* mt = A.in[1] + 64 * kq; const float* wp = A.in[2] + (size_t)(64 * kq) * NIN + n;
#pragma unroll 8
        for (int k = 0; k < 64; ++k) {
            const float w = wp[(size_t)k * NIN];
#pragma unroll
            for (int r = 0; r < 16; ++r) acc[r] += mt[r * DM + k] * w;
        }
        float* mp = ((float*)(A.ws + WS_U)) + (size_t)(kq * 16) * NIN + n;
#pragma unroll
        for (int r = 0; r < 16; ++r) mp[(size_t)r * NIN] = acc[r];
    }
    constexpr int I_IN = (DM / 64) * (NIN / 32), I_OUT = (DM / 64) * (DM / 32);
    for (int it = F.gw; it < I_IN + I_OUT; it += F.ngw) {
        if (it < I_IN) transpose_item<0>(A.in[2], DM, NIN, ((bf16*)(A.ws + WS_WIN)), scr, it, F.lane);
        else transpose_item<0>(A.in[6], DM, DM, ((bf16*)(A.ws + WS_WOUT)), scr, it - I_IN, F.lane);
    }
    for (int m = F.gw; m < MTOK; m += F.ngw) {
        const f32x4* xr = (const f32x4*)(A.in[0] + (size_t)m * DM) + F.lane;
        u32x2* o8 = (u32x2*)(((bf16*)(A.ws + WS_XB)) + (size_t)m * DM) + F.lane;
#pragma unroll
        for (int j = 0; j < 4; ++j) { const f32x4 v = xr[64 * j]; u32x2 w; w.x = pk2(v[0], v[1]); w.y = pk2(v[2], v[3]); o8[64 * j] = w; }
    }
}

__device__ __forceinline__ void meta_finalize(Frame& F, const Args& A) {
    const float* mp = (const float*)(A.ws + WS_U); const float* lb = (const float*)(A.ws + WS_LB);
    for (int idx = blockIdx.x * NTHREADS + F.tid; idx < 16 * NIN; idx += F.G * NTHREADS) {
        const int r = idx / NIN, n = idx % NIN, kind = n >> 9, col = n & 511;
        float v = 0.f;
#pragma unroll
        for (int kq = 0; kq < 16; ++kq) v += mp[(size_t)(kq * 16 + r) * NIN + n];
        const unsigned short o = (unsigned short)f2bf(xform_rt(kind, v, lb[col]));
        bf16* p = ((bf16*)(A.ws + WS_PROJ)) + (size_t)kind * ARR + (size_t)(PADR + r) * 512 + col;
#pragma unroll
        for (int b = 0; b < NB; ++b) p[(size_t)b * ROWS * 512] = o;
    }
}

typedef short s16x8 __attribute__((ext_vector_type(8)));
typedef short v4i16_t __attribute__((ext_vector_type(4)));
__device__ __forceinline__ s16x8 tr8(const LAS unsigned char* p, int rowskip) {
    const v4i16_t lo = __builtin_amdgcn_ds_read_tr16_b64_v4i16((LAS v4i16_t*)p);
    const v4i16_t hh = __builtin_amdgcn_ds_read_tr16_b64_v4i16((LAS v4i16_t*)(p + rowskip));
    return (s16x8){lo[0], lo[1], lo[2], lo[3], hh[0], hh[1], hh[2], hh[3]};
}
struct RawTile { u32x4 a, b; };
__device__ __forceinline__ RawTile raw_load(const bf16* arr, int b, int h, int c, int tid) {
    const bf16* p = arr + (size_t)(b * ROWS + 64 * c + (tid >> 4)) * 512 + 128 * h + 8 * (tid & 15);
    RawTile r; r.a = *(const u32x4*)p; r.b = *(const u32x4*)(p + (size_t)32 * 512); return r;
}
__device__ __forceinline__ void raw_store(LAS unsigned char* dst, int pitch, const RawTile& r, int tid) {
    LAS unsigned char* p = dst + (tid >> 4) * pitch + (tid & 15) * 16;
    *(LAS u32x4*)p = r.a; *(LAS u32x4*)(p + 32 * pitch) = r.b;
}
constexpr int PRAW = 272;
constexpr int PKT = 144;
__device__ __forceinline__ void ha_phase(Frame& F, const Args& A) {
    const bf16* LF = ((bf16*)(A.ws + WS_PROJ)) + 1 * ARR; const bf16* HV = ((bf16*)(A.ws + WS_PROJ)) + 2 * ARR;
    LAS unsigned char* RLF = F.lds;
    LAS unsigned char* VN = RLF + 64 * PRAW;
    LAS unsigned char* KT = VN + 64 * PRAW;
    LAS float* TOT = (LAS float*)(KT + 128 * PKT);
    const int tid = F.tid, lane = F.lane, w = F.wave, fr = lane & 15, fq = lane >> 4;
    const int d = tid & 127, sq = tid >> 7;
    int u = blockIdx.x;
    RawTile rl, rv;
    if (u < 32 * 64) { rl = raw_load(LF, u >> 8, (u >> 6) & 3, u & 63, tid); rv = raw_load(HV, u >> 8, (u >> 6) & 3, u & 63, tid); }
    for (; u < 32 * 64; u += F.G) {
        const int bh = u >> 6, c = u & 63;
        raw_store(RLF, PRAW, rl, tid); raw_store(VN, PRAW, rv, tid);
        LBAR();
        { const int un = u + F.G; if (un < 32 * 64) { rl = raw_load(LF, un >> 8, (un >> 6) & 3, un & 63, tid); rv = raw_load(HV, un >> 8, (un >> 6) & 3, un & 63, tid); } }
        float lf[16], pre[16]; float run = 0.f;
#pragma unroll
        for (int i = 0; i < 16; ++i) { lf[i] = bf2f(*(const LAS unsigned short*)(RLF + (16 * sq + i) * PRAW + 2 * d)); run += lf[i]; pre[i] = run; }
        TOT[sq * 128 + d] = run;
        LBAR();
        float off = 0.f, blast = 0.f;
#pragma unroll
        for (int q = 0; q < 4; ++q) { const float t = TOT[q * 128 + d]; off += (q < sq) ? t : 0.f; blast += t; }
        { unsigned kw[8];
#pragma unroll
          for (int i = 0; i < 8; ++i) { const float k0 = (1.f - ex2(lf[2 * i])) * ex2(blast - (off + pre[2 * i])), k1 = (1.f - ex2(lf[2 * i + 1])) * ex2(blast - (off + pre[2 * i + 1])); kw[i] = pk2(k0, k1); }
          LAS u32x4* kp = (LAS u32x4*)(KT + d * PKT + 32 * sq);
          kp[0] = (u32x4){kw[0], kw[1], kw[2], kw[3]}; kp[1] = (u32x4){kw[4], kw[5], kw[6], kw[7]}; }
        if (sq == 0) ((float*)(A.ws + WS_DV))[(size_t)(bh * 64 + c) * 128 + d] = ex2(blast);
        LBAR();
        const LAS unsigned char* vt = VN + (8 * fq + (fr >> 2)) * PRAW + (16 * w + 4 * (fr & 3)) * 2;
        const s16x8 b0 = tr8(vt, 4 * PRAW), b1 = tr8(vt + 32 * PRAW, 4 * PRAW);
        bf16* up = ((bf16*)(A.ws + WS_U)) + (size_t)(bh * 64 + c) * 16384 + (size_t)(16 * w + fr) * 128 + 4 * fq;
#pragma unroll
        for (int dt = 0; dt < 8; ++dt) {
            const LAS unsigned char* kp = KT + (16 * dt + fr) * PKT + 16 * fq;
            const s16x8 a0 = *(const LAS s16x8*)kp, a1 = *(const LAS s16x8*)(kp + 64);
            f32x4 acc = (f32x4){0.f, 0.f, 0.f, 0.f};
            acc = __builtin_amdgcn_mfma_f32_16x16x32_bf16(a0, b0, acc, 0, 0, 0);
            acc = __builtin_amdgcn_mfma_f32_16x16x32_bf16(a1, b1, acc, 0, 0, 0);
            { u32x2 o; o.x = pk2(acc[0], acc[1]); o.y = pk2(acc[2], acc[3]); *(u32x2*)(up + 16 * dt) = o; }
        }
        LBAR();
    }
}

typedef float f32x16 __attribute__((ext_vector_type(16)));
__device__ __forceinline__ s16x8 pack8(u32x2 a, u32x2 c) { const u32x4 w = (u32x4){a.x, a.y, c.x, c.y}; return __builtin_bit_cast(s16x8, w); }
struct AttnCtx { const bf16* kbase; const bf16* vbase; LAS unsigned char* vw; const LAS unsigned char* vt; int ktd, qrow, hi; };
__device__ __forceinline__ bool attn_tile(const AttnCtx& C, int kt, const s16x8 (&qf)[4], s16x8 (&kf)[4], u32x4 (&vr)[4], f32x16& o0, f32x16& o1, float& T) {
    const int k0 = 32 * kt, hi = C.hi;
    f32x16 p;
#pragma unroll
    for (int r = 0; r < 16; ++r) p[r] = 0.f;
#pragma unroll
    for (int s2 = 0; s2 < 4; ++s2) p = __builtin_amdgcn_mfma_f32_32x32x16_bf16(kf[s2], qf[s2], p, 0, 0, 0);
#pragma unroll
    for (int i = 0; i < 4; ++i) *(LAS u32x4*)(C.vw + i * 1024) = vr[i];
    s16x8 va[2][2];
#pragma unroll
    for (int dt = 0; dt < 2; ++dt)
#pragma unroll
        for (int s2 = 0; s2 < 2; ++s2) va[dt][s2] = tr8(C.vt + dt * 64 + s2 * 2048, 1024);
    if (kt > 2) {
        const bf16* kp = C.kbase + (size_t)(k0 - 64) * 512; const bf16* vp = C.vbase + (size_t)(k0 - 64) * 512;
#pragma unroll
        for (int s2 = 0; s2 < 4; ++s2) kf[s2] = *(const s16x8*)(kp + 16 * s2);
#pragma unroll
        for (int i = 0; i < 4; ++i) vr[i] = *(const u32x4*)(vp + (size_t)(8 * i) * 512);
    }
    const bool edge = (kt == C.ktd) || (kt == 1);
    float sp[16], iss[16], gs[4];
#pragma unroll
    for (int r = 0; r < 16; ++r) {
        const float z = fminf(p[r], 100.f); p[r] = z;
        float v = lg2(1.f + ex2(z));
        if (edge) { const int key = k0 + (r & 3) + 8 * (r >> 2) + 4 * hi; if (!(key >= PADR && key < C.qrow)) v = 0.f; }
        sp[r] = v;
    }
#pragma unroll
    for (int g = 0; g < 4; ++g) { iss[4 * g + 3] = sp[4 * g + 3]; iss[4 * g + 2] = iss[4 * g + 3] + sp[4 * g + 2]; iss[4 * g + 1] = iss[4 * g + 2] + sp[4 * g + 1]; iss[4 * g] = iss[4 * g + 1] + sp[4 * g]; gs[g] = iss[4 * g]; }
    float sg[4], go[4];
#pragma unroll
    for (int g = 0; g < 4; ++g) { const auto rr = __builtin_amdgcn_permlane32_swap(__float_as_uint(gs[g]), __float_as_uint(gs[g]), false, false);
        sg[g] = __uint_as_float(rr[0]) + __uint_as_float(rr[1]); go[g] = hi ? 0.f : __uint_as_float(rr[1]); }
    float off[4];
    off[3] = T + go[3]; const float e2 = sg[3]; off[2] = T + e2 + go[2]; const float e1 = e2 + sg[2]; off[1] = T + e1 + go[1]; const float e0 = e1 + sg[1]; off[0] = T + e0 + go[0];
    T += e0 + sg[0];
    float a[16];
#pragma unroll
    for (int r = 0; r < 16; ++r) {
        float v = ex2(p[r] - (off[r >> 2] + iss[r]));
        if (edge) { const int key = k0 + (r & 3) + 8 * (r >> 2) + 4 * hi; if (!(key >= PADR && key < C.qrow)) v = 0.f; }
        a[r] = v;
    }
#pragma unroll
    for (int s2 = 0; s2 < 2; ++s2) {
        u32x4 w; w.x = pk2(a[8 * s2], a[8 * s2 + 1]); w.y = pk2(a[8 * s2 + 2], a[8 * s2 + 3]); w.z = pk2(a[8 * s2 + 4], a[8 * s2 + 5]); w.w = pk2(a[8 * s2 + 6], a[8 * s2 + 7]);
        const s16x8 pb = __builtin_bit_cast(s16x8, w);
        o0 = __builtin_amdgcn_mfma_f32_32x32x16_bf16(va[0][s2], pb, o0, 0, 0, 0);
        o1 = __builtin_amdgcn_mfma_f32_32x32x16_bf16(va[1][s2], pb, o1, 0, 0, 0);
    }
    return __all(T > STICK_THR) || kt == 1;
}
__device__ __forceinline__ void attn_phase(Frame& F, const Args& A) {
    const bf16* SQ = ((bf16*)(A.ws + WS_PROJ)) + 4 * ARR; const bf16* SK = ((bf16*)(A.ws + WS_PROJ)) + 5 * ARR; const bf16* SV = ((bf16*)(A.ws + WS_PROJ)) + 6 * ARR;
    const int r32 = F.lane & 31, hi = F.lane >> 5;
    AttnCtx C;
    C.vw = F.lds + F.wave * 4096 + (F.lane >> 3) * 128 + (F.lane & 7) * 16;
    C.vt = F.lds + F.wave * 4096 + (4 * hi + ((F.lane & 15) >> 2)) * 128 + ((F.lane >> 4) & 1) * 32 + (F.lane & 3) * 8;
    C.hi = hi;
    for (int wu = F.gw; wu < 64 * 128; wu += F.ngw) {
        const int bh = wu >> 7, qi = wu & 127, b = bh >> 3, h = bh & 7, q0 = TOK0 + 32 * qi;
        C.qrow = q0 + r32; C.ktd = q0 >> 5;
        s16x8 qf[4];
        { const bf16* qp = SQ + (size_t)(b * ROWS + C.qrow) * 512 + 64 * h + 8 * hi;
#pragma unroll
          for (int s2 = 0; s2 < 4; ++s2) qf[s2] = *(const s16x8*)(qp + 16 * s2); }
        C.kbase = SK + (size_t)(b * ROWS + r32) * 512 + 64 * h + 8 * hi;
        C.vbase = SV + (size_t)(b * ROWS + (F.lane >> 3)) * 512 + 64 * h + 8 * (F.lane & 7);
        f32x16 o0, o1;
#pragma unroll
        for (int r = 0; r < 16; ++r) { o0[r] = 0.f; o1[r] = 0.f; }
        float T = 0.f;
        s16x8 kfA[4], kfB[4]; u32x4 vrA[4], vrB[4];
        { const bf16* kp = C.kbase + (size_t)(32 * C.ktd) * 512; const bf16* vp = C.vbase + (size_t)(32 * C.ktd) * 512;
#pragma unroll
          for (int s2 = 0; s2 < 4; ++s2) { kfA[s2] = *(const s16x8*)(kp + 16 * s2); kfB[s2] = *(const s16x8*)(kp - (size_t)32 * 512 + 16 * s2); }
#pragma unroll
          for (int i = 0; i < 4; ++i) { vrA[i] = *(const u32x4*)(vp + (size_t)(8 * i) * 512); vrB[i] = *(const u32x4*)(vp - (size_t)32 * 512 + (size_t)(8 * i) * 512); } }
        for (int kt = C.ktd;; kt -= 2) {
            if (attn_tile(C, kt, qf, kfA, vrA, o0, o1, T)) break;
            if (attn_tile(C, kt - 1, qf, kfB, vrB, o0, o1, T)) break;
        }
        float ss = 0.f;
#pragma unroll
        for (int r = 0; r < 16; ++r) ss += o0[r] * o0[r] + o1[r] * o1[r];
        { const auto rr = __builtin_amdgcn_permlane32_swap(__float_as_uint(ss), __float_as_uint(ss), false, false); ss = __uint_as_float(rr[0]) + __uint_as_float(rr[1]); }
        const float rs = 1.0f / sqrtf(ss * (1.f / 64.f) + RMS_EPS);
        const float* gp = A.in[5] + 64 * h + 4 * hi;
        bf16* op = ((bf16*)(A.ws + WS_MIX)) + (size_t)(b * SEQ + C.qrow - TOK0) * DM + 512 + 64 * h + 4 * hi;
#pragma unroll
        for (int g = 0; g < 4; ++g) {
            const f32x4 g0 = *(const f32x4*)(gp + 8 * g), g1 = *(const f32x4*)(gp + 32 + 8 * g);
            u32x2 w0, w1;
            w0.x = pk2(o0[4 * g] * rs * g0[0], o0[4 * g + 1] * rs * g0[1]); w0.y = pk2(o0[4 * g + 2] * rs * g0[2], o0[4 * g + 3] * rs * g0[3]);
            w1.x = pk2(o1[4 * g] * rs * g1[0], o1[4 * g + 1] * rs * g1[1]); w1.y = pk2(o1[4 * g + 2] * rs * g1[2], o1[4 * g + 3] * rs * g1[3]);
            *(u32x2*)(op + 8 * g) = w0; *(u32x2*)(op + 32 + 8 * g) = w1;
        }
    }
}

__device__ __forceinline__ void hb_phase(Frame& F, const Args& A) {
    for (int g = blockIdx.x * NTHREADS + F.tid; g < 32 * 4096; g += F.G * NTHREADS) {
        const int bh = g >> 12, r = g & 4095, v = r >> 5, d4 = (r & 31) * 4;
        const bf16* up = ((bf16*)(A.ws + WS_U)) + (size_t)bh * 64 * 16384 + v * 128 + d4;
        const float* dp = ((float*)(A.ws + WS_DV)) + (size_t)bh * 64 * 128 + d4;
        bf16* sp = ((bf16*)(A.ws + WS_S)) + (size_t)bh * 64 * 16384 + v * 128 + d4;
        f32x4 s = (f32x4){0.f, 0.f, 0.f, 0.f};
#pragma unroll 16
        for (int c = 0; c < 64; ++c) {
            const u32x2 ub = *(const u32x2*)(up + (size_t)c * 16384); const f32x4 uu = (f32x4){bflo(ub.x), bfhi(ub.x), bflo(ub.y), bfhi(ub.y)}, dd = *(const f32x4*)(dp + c * 128);
            s = dd * s + uu;
            u32x2 w; w.x = pk2(s[0], s[1]); w.y = pk2(s[2], s[3]);
            *(u32x2*)(sp + (size_t)c * 16384) = w;
        }
    }
}

__device__ __forceinline__ void hc_phase(Frame& F, const Args& A) {
    const bf16* HQ = ((bf16*)(A.ws + WS_PROJ)); const bf16* LF = HQ + 1 * ARR; const bf16* HV = HQ + 2 * ARR; const bf16* HG = HQ + 3 * ARR;
    LAS unsigned char* RLF = F.lds;
    LAS unsigned char* RQ = RLF + 64 * PRAW;
    LAS unsigned char* VN = RQ + 64 * PRAW;
    LAS unsigned char* QT = VN + 64 * PRAW;
    LAS unsigned char* KI = QT + 64 * PRAW;
    LAS unsigned char* SC = KI + 64 * PRAW;
    LAS float* TOT = (LAS float*)(SC + 64 * PKT);
    LAS float* SSQ = TOT + 512;
    const int tid = F.tid, lane = F.lane, w = F.wave, fr = lane & 15, fq = lane >> 4;
    const int d = tid & 127, sq = tid >> 7;
    int u = blockIdx.x;
    RawTile rl, rq, rv;
    if (u < 32 * 64) { const int b = u >> 8, h = (u >> 6) & 3, cc = (u & 63) + 1; rl = raw_load(LF, b, h, cc, tid); rq = raw_load(HQ, b, h, cc, tid); rv = raw_load(HV, b, h, cc, tid); }
    for (; u < 32 * 64; u += F.G) {
        const int bh = u >> 6, b = bh >> 2, h = bh & 3, cc = (u & 63) + 1;
        raw_store(RLF, PRAW, rl, tid); raw_store(RQ, PRAW, rq, tid); raw_store(VN, PRAW, rv, tid);
        LBAR();
        { const int un = u + F.G; if (un < 32 * 64) { const int b2 = un >> 8, h2 = (un >> 6) & 3, c2 = (un & 63) + 1; rl = raw_load(LF, b2, h2, c2, tid); rq = raw_load(HQ, b2, h2, c2, tid); rv = raw_load(HV, b2, h2, c2, tid); } }
        s16x8 sa[4]; u32x2 gt[4];
        { const bf16* sp = ((bf16*)(A.ws + WS_S)) + (size_t)(bh * 64 + cc - 1) * 16384 + (size_t)(16 * w + fr) * 128 + 8 * fq;
#pragma unroll
          for (int ks = 0; ks < 4; ++ks) sa[ks] = *(const s16x8*)(sp + 32 * ks);
          const bf16* gp = HG + (size_t)(b * ROWS + 64 * cc + fr) * 512 + 128 * h + 16 * w + 4 * fq;
#pragma unroll
          for (int tt = 0; tt < 4; ++tt) gt[tt] = *(const u32x2*)(gp + (size_t)(16 * tt) * 512); }
        {
            float lf[16], pre[16], qv[16]; float run = 0.f;
#pragma unroll
            for (int i = 0; i < 16; ++i) { lf[i] = bf2f(*(const LAS unsigned short*)(RLF + (16 * sq + i) * PRAW + 2 * d)); qv[i] = bf2f(*(const LAS unsigned short*)(RQ + (16 * sq + i) * PRAW + 2 * d)); run += lf[i]; pre[i] = run; }
            TOT[sq * 128 + d] = run;
            LBAR();
            float off = 0.f;
#pragma unroll
            for (int q = 0; q < 4; ++q) { const float t = TOT[q * 128 + d]; off += (q < sq) ? t : 0.f; }
#pragma unroll
            for (int i = 0; i < 16; ++i) { const float bc = off + pre[i];
                *(LAS unsigned short*)(QT + (16 * sq + i) * PRAW + 2 * d) = (unsigned short)f2bf(qv[i] * ex2(bc));
                *(LAS unsigned short*)(KI + (16 * sq + i) * PRAW + 2 * d) = (unsigned short)f2bf((1.f - ex2(lf[i])) * ex2(-bc)); }
        }
        LBAR();
        {
            const int tt = w >> 1;
            s16x8 bq[4];
            const LAS unsigned char* qp = QT + (16 * tt + fr) * PRAW + 16 * fq;
#pragma unroll
            for (int ks = 0; ks < 4; ++ks) bq[ks] = *(const LAS s16x8*)(qp + 64 * ks);
#pragma unroll
            for (int j = 0; j < 2; ++j) {
                const int st = 2 * (w & 1) + j;
                const LAS unsigned char* kp = KI + (16 * st + fr) * PRAW + 16 * fq;
                f32x4 acc = (f32x4){0.f, 0.f, 0.f, 0.f};
#pragma unroll
                for (int ks = 0; ks < 4; ++ks) acc = __builtin_amdgcn_mfma_f32_16x16x32_bf16(*(const LAS s16x8*)(kp + 64 * ks), bq[ks], acc, 0, 0, 0);
                const int t = 16 * tt + fr, s0 = 16 * st + 4 * fq;
                u32x2 wv; wv.x = pk2(s0 <= t ? acc[0] : 0.f, s0 + 1 <= t ? acc[1] : 0.f); wv.y = pk2(s0 + 2 <= t ? acc[2] : 0.f, s0 + 3 <= t ? acc[3] : 0.f);
                *(LAS u32x2*)(SC + t * PKT + 2 * s0) = wv;
            }
        }
        LBAR();
        f32x4 acc[4];
        {
            const LAS unsigned char* vt = VN + (8 * fq + (fr >> 2)) * PRAW + (16 * w + 4 * (fr & 3)) * 2;
            const s16x8 av0 = tr8(vt, 4 * PRAW), av1 = tr8(vt + 32 * PRAW, 4 * PRAW);
#pragma unroll
            for (int tt = 0; tt < 4; ++tt) {
                const LAS unsigned char* scp = SC + (16 * tt + fr) * PKT + 16 * fq;
                const LAS unsigned char* qp = QT + (16 * tt + fr) * PRAW + 16 * fq;
                f32x4 c = (f32x4){0.f, 0.f, 0.f, 0.f};
                c = __builtin_amdgcn_mfma_f32_16x16x32_bf16(av0, *(const LAS s16x8*)scp, c, 0, 0, 0);
                c = __builtin_amdgcn_mfma_f32_16x16x32_bf16(av1, *(const LAS s16x8*)(scp + 64), c, 0, 0, 0);
#pragma unroll
                for (int ks = 0; ks < 4; ++ks) c = __builtin_amdgcn_mfma_f32_16x16x32_bf16(sa[ks], *(const LAS s16x8*)(qp + 64 * ks), c, 0, 0, 0);
                acc[tt] = c;
                float ss = (c[0] * c[0] + c[1] * c[1]) + (c[2] * c[2] + c[3] * c[3]);
                ss += __shfl_xor(ss, 16); ss += __shfl_xor(ss, 32);
                if (fq == 0) SSQ[w * 64 + 16 * tt + fr] = ss;
            }
        }
        LBAR();
        {
            const f32x4 ng = *(const f32x4*)(A.in[4] + 128 * h + 16 * w + 4 * fq);
            bf16* op = ((bf16*)(A.ws + WS_MIX)) + (size_t)(b * SEQ + 64 * (cc - 1) + fr) * DM + 128 * h + 16 * w + 4 * fq;
#pragma unroll
            for (int tt = 0; tt < 4; ++tt) {
                float tot = 0.f;
#pragma unroll
                for (int k = 0; k < 8; ++k) tot += SSQ[k * 64 + 16 * tt + fr];
                const float rs = 1.0f / sqrtf(tot * (1.f / 128.f) + RMS_EPS);
                u32x2 o;
                o.x = pk2(acc[tt][0] * rs * ng[0] * bflo(gt[tt].x), acc[tt][1] * rs * ng[1] * bfhi(gt[tt].x));
                o.y = pk2(acc[tt][2] * rs * ng[2] * bflo(gt[tt].y), acc[tt][3] * rs * ng[3] * bfhi(gt[tt].y));
                *(u32x2*)(op + (size_t)(16 * tt) * DM) = o;
            }
        }
        LBAR();
    }
}

__device__ __forceinline__ void ln_stats(const f32x4 (&v)[4], float& mean, float& rstd) {
    float s = 0.f;
#pragma unroll
    for (int j = 0; j < 4; ++j) s += (v[j][0] + v[j][1]) + (v[j][2] + v[j][3]);
    mean = wave_sum(s) * (1.f / DM);
    float s2 = 0.f;
#pragma unroll
    for (int j = 0; j < 4; ++j) { const f32x4 d = v[j] - mean; s2 += (d[0] * d[0] + d[1] * d[1]) + (d[2] * d[2] + d[3] * d[3]); }
    rstd = 1.0f / sqrtf(wave_sum(s2) * (1.f / DM) + LN_EPS);
}

__device__ __forceinline__ void route_row(Frame& F, const Args& A, const float (&lg)[20], int rl, LAS int* lcnt, LAS int* rec) {
    const float* brg = A.in[10];
    float g0 = lg[0] + brg[0], g1 = lg[1] + brg[1], g2 = lg[2] + brg[2], g3 = lg[3] + brg[3];
    int grp = 0; float gm = g0;
    if (g1 > gm) { gm = g1; grp = 1; } if (g2 > gm) { gm = g2; grp = 2; } if (g3 > gm) { gm = g3; grp = 3; }
    const float pg = 1.f / (__expf(g0 - gm) + __expf(g1 - gm) + __expf(g2 - gm) + __expf(g3 - gm));
    float in0, in1, in2, in3;
    if (grp == 0) { in0 = lg[4]; in1 = lg[5]; in2 = lg[6]; in3 = lg[7]; }
    else if (grp == 1) { in0 = lg[8]; in1 = lg[9]; in2 = lg[10]; in3 = lg[11]; }
    else if (grp == 2) { in0 = lg[12]; in1 = lg[13]; in2 = lg[14]; in3 = lg[15]; }
    else { in0 = lg[16]; in1 = lg[17]; in2 = lg[18]; in3 = lg[19]; }
    const float* be = A.in[12] + grp * 4;
    in0 += be[0]; in1 += be[1]; in2 += be[2]; in3 += be[3];
    int i0 = 0; float m0 = in0;
    if (in1 > m0) { m0 = in1; i0 = 1; } if (in2 > m0) { m0 = in2; i0 = 2; } if (in3 > m0) { m0 = in3; i0 = 3; }
    int i1 = -1; float m1 = 0.f;
    if (i0 != 0) { m1 = in0; i1 = 0; }
    if (i0 != 1 && (i1 < 0 || in1 > m1)) { m1 = in1; i1 = 1; }
    if (i0 != 2 && (i1 < 0 || in2 > m1)) { m1 = in2; i1 = 2; }
    if (i0 != 3 && (i1 < 0 || in3 > m1)) { m1 = in3; i1 = 3; }
    const float w0 = 1.f / (1.f + __expf(m1 - m0)), w1 = 1.f - w0;
    const int e0 = grp * 4 + i0, e1 = grp * 4 + i1;
    const int p0 = atomicAdd((int*)&lcnt[e0], 1), p1 = atomicAdd((int*)&lcnt[e1], 1);
    rec[rl * 6 + 0] = e0; rec[rl * 6 + 1] = p0; rec[rl * 6 + 2] = __float_as_int(pg * w0);
    rec[rl * 6 + 3] = e1; rec[rl * 6 + 4] = p1; rec[rl * 6 + 5] = __float_as_int(pg * w1);
}
__device__ __forceinline__ void p6_ln_router(Frame& F, const Args& A) {
    LAS int* lcnt = F.misc + 32; LAS int* lbase = F.misc + 48;
    LAS f32x4* WL = (LAS f32x4*)F.lds;
    LAS int* rec = (LAS int*)(F.lds + 81920);
    for (int it = F.tid; it < 1024 * 5; it += NTHREADS) {
        const int k = it / 5, c = it % 5, j = k >> 8, ln = (k >> 2) & 63, e = k & 3;
        const f32x4 w = (c == 0) ? *(const f32x4*)(A.in[9] + (size_t)k * 4) : *(const f32x4*)(A.in[11] + (size_t)k * 16 + 4 * (c - 1));
        WL[((j * 4 + e) * 5 + c) * 64 + ln] = w;
    }
    __syncthreads();
    const LAS f32x4* wl = WL + F.lane;
    for (int slab = blockIdx.x; slab < MTOK / 128; slab += F.G) {
        if (F.tid < 16) lcnt[F.tid] = 0;
        __syncthreads();
#pragma unroll 1
        for (int i = 0; i < 16; i += 2) {
            const int rl = F.wave * 16 + i, row = slab * 128 + rl;
            const f32x4* xr0 = (const f32x4*)(A.in[0] + (size_t)row * DM) + F.lane; const f32x4* xr1 = xr0 + DM / 4;
            const u32x2* yr0 = (const u32x2*)(((const bf16*)(A.ws + WS_Y1)) + (size_t)row * DM) + F.lane; const u32x2* yr1 = yr0 + DM / 4;
            u32x2* hb0 = (u32x2*)(((bf16*)(A.ws + WS_H1)) + (size_t)row * DM) + F.lane; u32x2* hb1 = hb0 + DM / 4;
            f32x4 v0[4], v1[4];
#pragma unroll
            for (int j = 0; j < 4; ++j) { const u32x2 y0 = yr0[64 * j], y1 = yr1[64 * j];
                v0[j] = xr0[64 * j] * ALPHA + (f32x4){bflo(y0.x), bfhi(y0.x), bflo(y0.y), bfhi(y0.y)};
                v1[j] = xr1[64 * j] * ALPHA + (f32x4){bflo(y1.x), bfhi(y1.x), bflo(y1.y), bfhi(y1.y)}; }
            float mean0, rstd0, mean1, rstd1; ln_stats(v0, mean0, rstd0); ln_stats(v1, mean1, rstd1);
#pragma unroll
            for (int j = 0; j < 4; ++j) {
                const f32x4 g = ((const f32x4*)A.in[7])[64 * j + F.lane], bb = ((const f32x4*)A.in[8])[64 * j + F.lane];
                v0[j] = (v0[j] - mean0) * rstd0 * g + bb; v1[j] = (v1[j] - mean1) * rstd1 * g + bb;
                { u32x2 o; o.x = pk2(v0[j][0], v0[j][1]); o.y = pk2(v0[j][2], v0[j][3]); hb0[64 * j] = o; o.x = pk2(v1[j][0], v1[j][1]); o.y = pk2(v1[j][2], v1[j][3]); hb1[64 * j] = o; }
            }
            float la[20], lb2[20];
#pragma unroll
            for (int e = 0; e < 20; ++e) { la[e] = 0.f; lb2[e] = 0.f; }
#pragma unroll 1
            for (int j = 0; j < 4; ++j) {
                const f32x4 s0 = (j == 0) ? v0[0] : (j == 1) ? v0[1] : (j == 2) ? v0[2] : v0[3];
                const f32x4 s1 = (j == 0) ? v1[0] : (j == 1) ? v1[1] : (j == 2) ? v1[2] : v1[3];
                const LAS f32x4* wj = wl + j * (20 * 64);
#pragma unroll
                for (int e = 0; e < 4; ++e) {
                    const float h0 = s0[e], h1 = s1[e];
#pragma unroll
                    for (int c = 0; c < 5; ++c) { const f32x4 w = wj[(e * 5 + c) * 64];
                        la[4 * c] += h0 * w[0]; la[4 * c + 1] += h0 * w[1]; la[4 * c + 2] += h0 * w[2]; la[4 * c + 3] += h0 * w[3];
                        lb2[4 * c] += h1 * w[0]; lb2[4 * c + 1] += h1 * w[1]; lb2[4 * c + 2] += h1 * w[2]; lb2[4 * c + 3] += h1 * w[3]; }
                }
            }
#pragma unroll
            for (int e = 0; e < 20; ++e) { la[e] = wave_sum(la[e]); lb2[e] = wave_sum(lb2[e]); }
            if (F.lane == 0) { route_row(F, A, la, rl, lcnt, rec); route_row(F, A, lb2, rl + 1, lcnt, rec); }
        }
        __syncthreads();
        if (F.tid < 16) lbase[F.tid] = (int)atomicAdd(((unsigned*)(A.ws + WS_CTL)) + CW_CNT + F.tid, (unsigned)lcnt[F.tid]);
        __syncthreads();
        if (F.tid < 128) {
            unsigned* mp = ((unsigned*)(A.ws + WS_META)) + (size_t)(slab * 128 + F.tid) * 8;
            const int e0 = rec[F.tid * 6 + 0], e1 = rec[F.tid * 6 + 3];
            u32x4 a, c;
            a.x = (unsigned)e0; a.y = (unsigned)(lbase[e0] + rec[F.tid * 6 + 1]); a.z = (unsigned)rec[F.tid * 6 + 2]; a.w = (unsigned)e1;
            c.x = (unsigned)(lbase[e1] + rec[F.tid * 6 + 4]); c.y = (unsigned)rec[F.tid * 6 + 5]; c.z = 0u; c.w = 0u;
            *(u32x4*)mp = a; *(u32x4*)(mp + 4) = c;
        }
        __syncthreads();
    }
}

__device__ __forceinline__ void build_toff(Frame& F, const Args& A) {
    __syncthreads();
    if (F.tid == 0) { int acc = 0;
        for (int e = 0; e < NEXP; ++e) { F.misc[e] = acc; const unsigned c = __hip_atomic_load(((unsigned*)(A.ws + WS_CTL)) + CW_CNT + e, __ATOMIC_RELAXED, __HIP_MEMORY_SCOPE_AGENT); acc += (int)((c + 255u) >> 8); }
        F.misc[NEXP] = acc; }
    __syncthreads();
}

__device__ __forceinline__ void p7_scatter(Frame& F, const Args& A) {
    build_toff(F, A);
    for (int row = F.gw; row < MTOK; row += F.ngw) {
        const unsigned* mp = ((unsigned*)(A.ws + WS_META)) + (size_t)row * 8;
        const int e0 = (int)mp[0], p0 = (int)mp[1], e1 = (int)mp[3], p1 = (int)mp[4];
        const size_t s0 = (size_t)F.misc[e0] * 256 + p0, s1 = (size_t)F.misc[e1] * 256 + p1;
        const u32x4* xr = (const u32x4*)(((bf16*)(A.ws + WS_H1)) + (size_t)row * DM) + F.lane;
        u32x4* o0 = (u32x4*)(((bf16*)(A.ws + WS_XS)) + s0 * DM) + F.lane; u32x4* o1 = (u32x4*)(((bf16*)(A.ws + WS_XS)) + s1 * DM) + F.lane;
#pragma unroll
        for (int j = 0; j < 2; ++j) { const u32x4 v = xr[64 * j]; o0[64 * j] = v; o1[64 * j] = v; }
    }
    LAS float* scr = (LAS float*)(F.lds + F.wave * 16384);
    constexpr int I13 = (DM / 64) * (DEXP / 32), I2 = (DEXP / 64) * (DM / 32);
    for (int it = F.gw; it < NEXP * (2 * I13 + I2); it += F.ngw) {
        const int e = it / (2 * I13 + I2), r = it % (2 * I13 + I2);
        if (r < I13) transpose_item<1>(A.in[13] + (size_t)e * DM * DEXP, DM, DEXP, ((bf16*)(A.ws + WS_W13)) + (size_t)e * 1024 * DM, scr, r, F.lane);
        else if (r < 2 * I13) transpose_item<2>(A.in[14] + (size_t)e * DM * DEXP, DM, DEXP, ((bf16*)(A.ws + WS_W13)) + (size_t)e * 1024 * DM, scr, r - I13, F.lane);
        else transpose_item<0>(A.in[15] + (size_t)e * DEXP * DM, DEXP, DM, ((bf16*)(A.ws + WS_W2)) + (size_t)e * DM * DEXP, scr, r - 2 * I13, F.lane);
    }
}

__device__ __forceinline__ void p10_final(Frame& F, const Args& A) {
    build_toff(F, A);
    for (int row = F.gw; row < MTOK; row += F.ngw) {
        const unsigned* mp = ((unsigned*)(A.ws + WS_META)) + (size_t)row * 8;
        const int e0 = (int)mp[0], p0 = (int)mp[1], e1 = (int)mp[3], p1 = (int)mp[4];
        const float g0 = __uint_as_float(mp[2]), g1 = __uint_as_float(mp[5]);
        const size_t s0 = (size_t)F.misc[e0] * 256 + p0, s1 = (size_t)F.misc[e1] * 256 + p1;
        f32x4* xr = (f32x4*)(A.out + (size_t)row * DM) + F.lane; const u32x2* hr = (const u32x2*)(((bf16*)(A.ws + WS_H1)) + (size_t)row * DM) + F.lane;
        const u32x2* y0 = (const u32x2*)(((bf16*)(A.ws + WS_YS)) + s0 * DM) + F.lane; const u32x2* y1 = (const u32x2*)(((bf16*)(A.ws + WS_YS)) + s1 * DM) + F.lane;
        f32x4 v[4];
#pragma unroll
        for (int j = 0; j < 4; ++j) { const u32x2 hw = hr[64 * j]; const f32x4 hv = (f32x4){bflo(hw.x), bfhi(hw.x), bflo(hw.y), bfhi(hw.y)}; const u32x2 a = y0[64 * j], c = y1[64 * j];
            v[j][0] = ALPHA * hv[0] + g0 * bflo(a.x) + g1 * bflo(c.x); v[j][1] = ALPHA * hv[1] + g0 * bfhi(a.x) + g1 * bfhi(c.x);
            v[j][2] = ALPHA * hv[2] + g0 * bflo(a.y) + g1 * bflo(c.y); v[j][3] = ALPHA * hv[3] + g0 * bfhi(a.y) + g1 * bfhi(c.y); }
        float mean, rstd; ln_stats(v, mean, rstd);
#pragma unroll
        for (int j = 0; j < 4; ++j) { const f32x4 g = ((const f32x4*)A.in[16])[64 * j + F.lane], bb = ((const f32x4*)A.in[17])[64 * j + F.lane]; xr[64 * j] = (v[j] - mean) * rstd * g + bb; }
    }
}

#define XB_TMO      128
#define XB_XCNT(j)  (256  + 64 * (j))
#define XB_XSUB(j)  (1280 + 64 * (j))
#define XB_XGEN(j)  (2304 + 64 * (j))
#define XB_TOP      3328
#define XB_TOPGEN   3392
#define XCD_BAR_WORDS 3456
#define XB_SPIN_CAP (1u << 18)

__device__ __forceinline__ unsigned xb_ld(unsigned* p)              { return __hip_atomic_load(p, __ATOMIC_RELAXED, __HIP_MEMORY_SCOPE_AGENT); }
__device__ __forceinline__ unsigned xb_add(unsigned* p, unsigned v) { return __hip_atomic_fetch_add(p, v, __ATOMIC_RELAXED, __HIP_MEMORY_SCOPE_AGENT); }
__device__ __forceinline__ unsigned xb_xcc_id() { return (unsigned)__builtin_amdgcn_s_getreg((3 << 11) | 20) & 0xFu; }
#define XB_SPIN(cond, bar) do { unsigned _sp = 0; while (cond) { __builtin_amdgcn_s_sleep(1); \
    if ((++_sp & 255u) == 0u) { if (xb_ld(&(bar)[XB_TMO])) break; if (_sp > XB_SPIN_CAP) { atomicAdd(&(bar)[XB_TMO], 1u); break; } } } } while (0)

struct XcdBarrier {
    unsigned* bar; unsigned x;
    volatile LAS unsigned* st;
};

__device__ __forceinline__ XcdBarrier xcd_barrier_post(unsigned* bar, volatile LAS unsigned* st) {
    XcdBarrier b; b.bar = bar; b.x = xb_xcc_id(); b.st = st;
    if (threadIdx.x == 0) (void)xb_add(&bar[XB_XCNT(b.x)], 1u);
    return b;
}
__device__ __forceinline__ void xcd_barrier_complete(unsigned* bar, unsigned x, unsigned& nloc, unsigned& nx) {
    const unsigned G = gridDim.x * gridDim.y * gridDim.z;
    unsigned sum, cnt, mine, sp = 0u;
    for (;;) {
        sum = 0u; cnt = 0u; mine = 0u;
#pragma unroll
        for (unsigned j = 0; j < 16; ++j) { const unsigned c = xb_ld(&bar[XB_XCNT(j)]); sum += c; cnt += (c > 0u) ? 1u : 0u; mine = (j == x) ? c : mine; }
        if (sum == G) break;
        __builtin_amdgcn_s_sleep(1);
        if ((++sp & 255u) == 0u) { if (xb_ld(&bar[XB_TMO])) break; if (sp > XB_SPIN_CAP) { atomicAdd(&bar[XB_TMO], 1u); break; } }
    }
    nloc = mine > 0u ? mine : 1u; nx = cnt > 0u ? cnt : 1u;
}

__device__ __forceinline__ void xcd_barrier(const XcdBarrier& b) {
    asm volatile("s_waitcnt vmcnt(0)" ::: "memory");
    __syncthreads();
    if (threadIdx.x == 0) {
        unsigned* bar = b.bar;
        __builtin_amdgcn_s_waitcnt(0);
        unsigned nloc = b.st[0], nx = b.st[1];
        if (nloc == 0u) { xcd_barrier_complete(bar, b.x, nloc, nx); b.st[0] = nloc; b.st[1] = nx; }
        const unsigned old = xb_add(&bar[XB_XSUB(b.x)], 1u);
        const unsigned gen = old / nloc;
        if (old + 1u == (gen + 1u) * nloc) {
            __builtin_amdgcn_fence(__ATOMIC_RELEASE, "agent");
            asm volatile("s_waitcnt vmcnt(0)" ::: "memory");
            const unsigned og = xb_add(&bar[XB_TOP], 1u);
            const unsigned tg = og / nx;
            if (og + 1u == (tg + 1u) * nx) xb_add(&bar[XB_TOPGEN], 1u);
            else XB_SPIN(xb_ld(&bar[XB_TOPGEN]) == tg, bar);
            __builtin_amdgcn_fence(__ATOMIC_ACQUIRE, "agent");
            xb_add(&bar[XB_XGEN(b.x)], 1u);
            asm volatile("s_waitcnt vmcnt(0)" ::: "memory");
        } else {
            XB_SPIN(xb_ld(&bar[XB_XGEN(b.x)]) == gen, bar);
            __builtin_amdgcn_fence(__ATOMIC_ACQUIRE, "agent");
            asm volatile("s_waitcnt vmcnt(0)" ::: "memory");
        }
    }
    __syncthreads();
}

constexpr int NPHASE = 11;
__global__ void __launch_bounds__(NTHREADS, 2) mega_fwd(Args args) {
    extern __shared__ __attribute__((aligned(16))) unsigned char lds[];
    Frame F;
    F.lds = (LAS unsigned char*)lds; F.misc = (LAS int*)(F.lds + MISC_OFF);
    F.tid = threadIdx.x; F.lane = F.tid & 63; F.wave = __builtin_amdgcn_readfirstlane(F.tid >> 6); F.G = gridDim.x;
    F.gw = blockIdx.x * NWAVES + F.wave; F.ngw = F.G * NWAVES;
    const Args& A = args;
    const int lo = args.ph_lo, hi = args.ph_hi;
    if (F.tid < 2) F.misc[MISC_BAR + F.tid] = 0;
    __syncthreads();
    XcdBarrier bar; bar.bar = (unsigned*)(args.ws + WS_CTL) + CW_BAR; bar.x = 0; bar.st = nullptr;
    if (MK_LAUNCHES == 1) bar = xcd_barrier_post((unsigned*)(args.ws + WS_CTL) + CW_BAR, (volatile LAS unsigned*)(F.misc + MISC_BAR));
#define IN(k) (lo <= (k) && (k) < hi)
#define SEAM(k) do { if (IN((k) + 1)) { xcd_barrier(bar); } } while (0)

    if (IN(0)) { p0_prep(F, A); SEAM(0); }
    if (IN(1)) {
        meta_finalize(F, A);
        pg8::Gemm g{((bf16*)(A.ws + WS_XB)), ((bf16*)(A.ws + WS_WIN)), MTOK, NIN, DM}; pg8::StaticOrder S; S.init(MTOK, NIN, F.G, (int)blockIdx.x);
        EpiProj E{((bf16*)(A.ws + WS_PROJ)), ((float*)(A.ws + WS_LB))};
        pg8::gemm_phase<EpiProj, pg8::StaticOrder, PG8_ALIGN, PG8_SP2>(F.lds, g, S, E);
        SEAM(1);
    }
    if (IN(2)) {
        ha_phase(F, A);
        attn_phase(F, A);
        SEAM(2);
    }
    if (IN(3)) { hb_phase(F, A); SEAM(3); }
    if (IN(4)) {
        hc_phase(F, A);
        SEAM(4);
    }
    if (IN(5)) {
        pg8::Gemm g{((bf16*)(A.ws + WS_MIX)), ((bf16*)(A.ws + WS_WOUT)), MTOK, DM, DM}; pg8::StaticOrder S; S.init(MTOK, DM, F.G, (int)blockIdx.x);
        EpiYs E{(bf16*)(A.ws + WS_Y1)};
        pg8::gemm_phase<EpiYs, pg8::StaticOrder, PG8_ALIGN, PG8_SP2>(F.lds, g, S, E);
        SEAM(5);
    }
    if (IN(6)) { p6_ln_router(F, A); SEAM(6); }
    if (IN(7)) { p7_scatter(F, A); SEAM(7); }
    if (IN(8)) {
        build_toff(F, A);
        pg8::Gemm g{((bf16*)(A.ws + WS_XS)), ((bf16*)(A.ws + WS_W13)), XS_ROWS, 1024, DM}; MoeOrder S{(const LAS int*)F.misc, F.G, (int)blockIdx.x, F.misc[NEXP]};
        EpiHid E{((bf16*)(A.ws + WS_HID))};
        pg8::gemm_phase<EpiHid, MoeOrder, PG8_ALIGN, PG8_SP2>(F.lds, g, S, E);
        SEAM(8);
    }
    if (IN(9)) {
        build_toff(F, A);
        pg8::Gemm g{((bf16*)(A.ws + WS_HID)), ((bf16*)(A.ws + WS_W2)), XS_ROWS, 1024, DEXP}; MoeOrder S{(const LAS int*)F.misc, F.G, (int)blockIdx.x, F.misc[NEXP]};
        EpiYs E{((bf16*)(A.ws + WS_YS))};
        pg8::gemm_phase<EpiYs, MoeOrder, PG8_ALIGN, PG8_SP2>(F.lds, g, S, E);
        SEAM(9);
    }
    if (IN(10)) { p10_final(F, A); }
#undef IN
#undef SEAM
}

extern "C" void kernel_launch(void* const* d_in, const int* in_sizes, int n_in, void* d_out, int out_size, void* d_ws, size_t ws_size, hipStream_t stream) {
    static int grid = 0;
    if (grid == 0) {
        if (n_in != 18 || in_sizes[0] != MTOK * DM || out_size != MTOK * DM || ws_size < WS_END) {
            fprintf(stderr, "kernel_launch: unexpected shapes (n_in %d, in0 %d, out %d, ws %zu); nothing launched\n", n_in, n_in > 0 ? in_sizes[0] : -1, out_size, ws_size); grid = -1; return; }
        int dev = 0, cus = 0, per_cu = 0;
        if (hipGetDevice(&dev) != hipSuccess || hipDeviceGetAttribute(&cus, hipDeviceAttributeMultiprocessorCount, dev) != hipSuccess) { grid = -1; return; }
        if (hipFuncSetAttribute((const void*)mega_fwd, hipFuncAttributeMaxDynamicSharedMemorySize, LDS_BYTES) != hipSuccess) { fprintf(stderr, "kernel_launch: hipFuncSetAttribute failed\n"); grid = -1; return; }
        if (hipOccupancyMaxActiveBlocksPerMultiprocessor(&per_cu, (const void*)mega_fwd, NTHREADS, LDS_BYTES) != hipSuccess || per_cu < 1) { fprintf(stderr, "kernel_launch: occupancy query says %d\n", per_cu); per_cu = 1; }
        (void)hipGetLastError();
        grid = cus;
    }
    if (grid < 0) return;
    (void)hipMemsetAsync((char*)d_ws + WS_CTL, 0, CTL_ZERO_BYTES, stream);
    Args a{};
    for (int i = 0; i < 18; ++i) a.in[i] = (const float*)d_in[i];
    a.out = (float*)d_out; a.ws = (unsigned char*)d_ws;
#if MK_LAUNCHES == 1
    a.ph_lo = 0; a.ph_hi = NPHASE;
    void* kargs[] = {&a};
    hipError_t e = hipLaunchCooperativeKernel((const void*)mega_fwd, dim3(grid), dim3(NTHREADS), kargs, LDS_BYTES, stream);
    if (e != hipSuccess) fprintf(stderr, "kernel_launch: cooperative launch failed: %s (grid %d)\n", hipGetErrorString(e), grid);
#else
    for (int p = 0; p < NPHASE; ++p) { a.ph_lo = p; a.ph_hi = p + 1; hipLaunchKernelGGL(mega_fwd, dim3(grid), dim3(NTHREADS), LDS_BYTES, stream, a); }
#endif
}
```

```cpp
#include <hip/hip_runtime.h>
#include <hip/hip_cooperative_groups.h>
#include <cstdio>
#include <cstdint>
namespace cg = cooperative_groups;
namespace pg8 {
#define PG8_LAS __attribute__((address_space(3)))
typedef unsigned short bf16_t;
typedef short bf16x8 __attribute__((ext_vector_type(8)));
typedef float f32x4 __attribute__((ext_vector_type(4)));
typedef unsigned u32x4 __attribute__((ext_vector_type(4)));
constexpr int BM = 256, BK = 64, HALF = 128, HTB = HALF * BK * 2  , STAGE_BYTES = 8 * HTB, NXCD = 8, WGM = 8;

__host__ __device__ __forceinline__ int lds_byte(int r, int c) { const int st = (r >> 4) * 2 + (c >> 5), rr = r & 15, cc = c & 31, ob = rr * 64 + cc * 2; return st * 1024 + (ob ^ (((ob >> 9) & 1) << 5)); }
__host__ __device__ __forceinline__ void stage_rc(int b, int& R, int& C) { const int st = b / 1024, sb = b % 1024, swz = sb ^ (((sb >> 9) & 1) << 5); R = (st >> 1) * 16 + swz / 64; C = (st & 1) * 32 + (swz % 64) / 2; }
__host__ __device__ __forceinline__ int perm32(int rho) { const int n = rho >> 4, i = rho & 15; return 8 * (i >> 2) + 4 * n + (i & 3); }

struct Unit { int pm, pn; };
struct Gemm { const bf16_t* A; const bf16_t* Bt; int M, N, K; };

struct StaticOrder {
    int nM, nN, nwg, G, c;
    __host__ __device__ void init(int M, int N, int G_, int c_) { nM = M / BM; nN = N / BM; nwg = nM * nN; G = G_; c = c_; }
    __host__ __device__ bool next(int i, Unit& u) const {
        const long L = (long)i * G + c; if (L >= nwg) return false;
        int wgid = (int)L; { const int q = nwg / NXCD, r = nwg % NXCD, xcd = wgid % NXCD, off = wgid / NXCD; wgid = (xcd < r ? xcd * (q + 1) : r * (q + 1) + (xcd - r) * q) + off; }
        const int nig = WGM * nN, gid = wgid / nig, fm = gid * WGM, gsz = (nM - fm) < WGM ? (nM - fm) : WGM;
        u.pm = fm + ((wgid % nig) % gsz); u.pn = (wgid % nig) / gsz; return true;
    }
    __device__ __forceinline__ void a_ready(const Unit&) const {}
    __device__ __forceinline__ void done(const Unit&) const {}
};

__device__ __forceinline__ unsigned cvt_pk_bf16(float lo, float hi) { unsigned r; asm volatile("v_cvt_pk_bf16_f32 %0, %1, %2" : "=v"(r) : "v"(lo), "v"(hi)); return r; }
template <class Epi, class Sched, bool ALIGN_EPI = false, bool SP2 = false>
__device__ __forceinline__ void gemm_phase(PG8_LAS unsigned char* lds, const Gemm g, const Sched& S, const Epi& E) {
    int tid_ = threadIdx.x; asm volatile("" : "+v"(tid_));
    const int tid = tid_, wid = __builtin_amdgcn_readfirstlane(tid >> 6), lane = tid & 63, wr = wid >> 2, wc = wid & 3, fr = lane & 15, fq = lane >> 4;
    const int K = g.K, nt = K / BK;
    unsigned voffA[2], voffB[2];
#pragma unroll
    for (int i = 0; i < 2; ++i) { int R, C; stage_rc(tid * 16 + i * 8192, R, C); const int Rb = Epi::PERM ? ((R & ~31) + perm32(R & 31)) : R;
        voffA[i] = (unsigned)(R * K + C) * 2u; voffB[i] = (unsigned)(Rb * K + C) * 2u; }
    const size_t kstep = (size_t)(BK * 2);
    const size_t hstep = (size_t)HALF * K * 2;
    const size_t tstep = 2 * hstep;
    const unsigned ldsw = (unsigned)wid * 1024u;
    const int aoff = lds_byte(wr * 64 + fr, fq * 8), boff = lds_byte(wc * 32 + fr, fq * 8);
#define PG8_SA(b, h) (((b) * 2 + (h)) * HTB)
#define PG8_SB(b, h) ((4 + (b) * 2 + (h)) * HTB)
#define PG8_STAGE(bufoff, gbase, voff) do { _Pragma("unroll") for (int _i = 0; _i < 2; ++_i) \
        __builtin_amdgcn_global_load_lds((const unsigned*)((const char*)(gbase) + (voff)[_i]), (PG8_LAS unsigned*)(lds + (bufoff) + ldsw + _i * 8192), 16, 0, 0); } while (0)
#define PG8_LDA(dst, b, h) do { _Pragma("unroll") for (int m = 0; m < 4; ++m) _Pragma("unroll") for (int k = 0; k < 2; ++k) dst[m][k] = *(const PG8_LAS bf16x8*)(lds + PG8_SA(b, h) + aoff + m * 2048 + k * 1024); } while (0)
#define PG8_LDB(dst, b, h) do { _Pragma("unroll") for (int n = 0; n < 2; ++n) _Pragma("unroll") for (int k = 0; k < 2; ++k) dst[n][k] = *(const PG8_LAS bf16x8*)(lds + PG8_SB(b, h) + boff + n * 2048 + k * 1024); } while (0)
#define PG8_MMA(ai, bj, At, Bt) do { __builtin_amdgcn_s_setprio(1); _Pragma("unroll") for (int m = 0; m < 4; ++m) _Pragma("unroll") for (int n = 0; n < 2; ++n) _Pragma("unroll") for (int k = 0; k < 2; ++k) \
        acc[ai][bj][m][n] = __builtin_amdgcn_mfma_f32_16x16x32_bf16(Bt[n][k], At[m][k], acc[ai][bj][m][n], 0, 0, 0); __builtin_amdgcn_s_setprio(0); } while (0)
#define PG8_WAIT_V(n) asm volatile("s_waitcnt vmcnt(" #n ")" ::: "memory")
#define PG8_WAIT_L(n) asm volatile("s_waitcnt lgkmcnt(" #n ")" ::: "memory")
#define PG8_BAR __builtin_amdgcn_s_barrier()
#define PG8_SCHED __builtin_amdgcn_sched_barrier(0)
    Unit cur, nxt; int ui = 0;
    if (!S.next(0, cur)) return;
    f32x4 acc[2][2][4][2];
#pragma unroll
    for (int a = 0; a < 2; ++a)
#pragma unroll
        for (int b = 0; b < 2; ++b)
#pragma unroll
            for (int m = 0; m < 4; ++m)
#pragma unroll
                for (int n = 0; n < 2; ++n) acc[a][b][m][n] = (f32x4){0.f, 0.f, 0.f, 0.f};
    bf16x8 At[4][2], B0[2][2], B1[2][2];
    const char* cA = (const char*)g.A + (size_t)cur.pm * tstep; const char* cB = (const char*)g.Bt + (size_t)cur.pn * tstep;
    S.a_ready(cur);
    if constexpr (SP2) {
        PG8_STAGE(PG8_SB(0, 0), cB, voffB); PG8_STAGE(PG8_SB(0, 1), cB + hstep, voffB); PG8_STAGE(PG8_SA(0, 0), cA, voffA); PG8_STAGE(PG8_SA(0, 1), cA + hstep, voffA);
        if (wr == 1) PG8_BAR;
        PG8_WAIT_V(2); PG8_BAR;
        PG8_STAGE(PG8_SB(1, 0), cB + kstep, voffB); PG8_STAGE(PG8_SA(1, 0), cA + kstep, voffA); PG8_STAGE(PG8_SB(1, 1), cB + hstep + kstep, voffB);
        PG8_WAIT_V(6); PG8_BAR;
    } else {
        PG8_STAGE(PG8_SB(0, 0), cB, voffB); PG8_STAGE(PG8_SA(0, 0), cA, voffA); PG8_STAGE(PG8_SB(0, 1), cB + hstep, voffB); PG8_STAGE(PG8_SA(0, 1), cA + hstep, voffA);
        if (wr == 1) PG8_BAR;
        PG8_WAIT_V(4); PG8_BAR;
        PG8_STAGE(PG8_SB(1, 0), cB + kstep, voffB); PG8_STAGE(PG8_SA(1, 0), cA + kstep, voffA); PG8_STAGE(PG8_SB(1, 1), cB + hstep + kstep, voffB);
        PG8_WAIT_V(6); PG8_BAR;
    }
    for (;;) {
        const bool has_next = S.next(ui + 1, nxt);
        const char* nA = has_next ? (const char*)g.A + (size_t)nxt.pm * tstep : cA; const char* nB = has_next ? (const char*)g.Bt + (size_t)nxt.pn * tstep : cB;
        for (int t = 0; t < nt; t += 2) {
            const bool last = (t == nt - 2);
            const char* a1 = cA + (size_t)(t + 1) * kstep;
            const char* a2 = last ? nA : cA + (size_t)(t + 2) * kstep; const char* b2 = last ? nB : cB + (size_t)(t + 2) * kstep;
            const char* a3 = a2 + kstep; const char* b3 = b2 + kstep;
            if (last && has_next) S.a_ready(nxt);
            if constexpr (SP2) {
            PG8_LDB(B0, 0, 0); PG8_LDB(B1, 0, 1); PG8_SCHED; PG8_LDA(At, 0, 0); PG8_STAGE(PG8_SA(1, 1), a1 + hstep, voffA);
            PG8_WAIT_V(8); PG8_WAIT_L(0); PG8_BAR; PG8_MMA(0, 0, At, B0); PG8_MMA(0, 1, At, B1); PG8_BAR; PG8_SCHED;
            PG8_LDA(At, 0, 1); PG8_STAGE(PG8_SB(0, 0), b2, voffB); PG8_STAGE(PG8_SB(0, 1), b2 + hstep, voffB); PG8_STAGE(PG8_SA(0, 0), a2, voffA);
            PG8_WAIT_V(8); PG8_WAIT_L(0); PG8_BAR; PG8_MMA(1, 0, At, B0); PG8_MMA(1, 1, At, B1); PG8_BAR; PG8_SCHED;
            PG8_LDB(B0, 1, 0); PG8_LDB(B1, 1, 1); PG8_SCHED; PG8_LDA(At, 1, 0); PG8_STAGE(PG8_SA(0, 1), a2 + hstep, voffA);
            PG8_WAIT_V(8); PG8_WAIT_L(0); PG8_BAR; PG8_MMA(0, 0, At, B0); PG8_MMA(0, 1, At, B1); PG8_BAR; PG8_SCHED;
            PG8_LDA(At, 1, 1); PG8_STAGE(PG8_SB(1, 0), b3, voffB); PG8_STAGE(PG8_SB(1, 1), b3 + hstep, voffB); PG8_STAGE(PG8_SA(1, 0), a3, voffA);
            PG8_WAIT_V(8); PG8_WAIT_L(0); PG8_BAR; PG8_MMA(1, 0, At, B0); PG8_MMA(1, 1, At, B1); PG8_BAR; PG8_SCHED;
            } else {
            PG8_LDB(B0, 0, 0); PG8_SCHED; PG8_LDA(At, 0, 0); PG8_STAGE(PG8_SA(1, 1), a1 + hstep, voffA);
            PG8_WAIT_L(8); PG8_BAR; PG8_WAIT_L(0); PG8_MMA(0, 0, At, B0); PG8_BAR; PG8_SCHED;
            PG8_LDB(B1, 0, 1); PG8_STAGE(PG8_SB(0, 0), b2, voffB);
            PG8_BAR; PG8_WAIT_L(0); PG8_MMA(0, 1, At, B1); PG8_BAR;
            PG8_LDA(At, 0, 1); PG8_STAGE(PG8_SA(0, 0), a2, voffA);
            PG8_BAR; PG8_WAIT_L(0); PG8_MMA(1, 0, At, B0); PG8_BAR; PG8_SCHED;
            PG8_STAGE(PG8_SB(0, 1), b2 + hstep, voffB);
            PG8_WAIT_V(6); PG8_BAR; PG8_MMA(1, 1, At, B1); PG8_BAR;
            PG8_LDB(B0, 1, 0); PG8_SCHED; PG8_LDA(At, 1, 0); PG8_STAGE(PG8_SA(0, 1), a2 + hstep, voffA);
            PG8_WAIT_L(8); PG8_BAR; PG8_WAIT_L(0); PG8_MMA(0, 0, At, B0); PG8_BAR; PG8_SCHED;
            PG8_LDB(B1, 1, 1); PG8_STAGE(PG8_SB(1, 0), b3, voffB);
            PG8_BAR; PG8_WAIT_L(0); PG8_MMA(0, 1, At, B1); PG8_BAR;
            PG8_LDA(At, 1, 1); PG8_STAGE(PG8_SA(1, 0), a3, voffA);
            PG8_BAR; PG8_WAIT_L(0); PG8_MMA(1, 0, At, B0); PG8_BAR; PG8_SCHED;
            PG8_STAGE(PG8_SB(1, 1), b3 + hstep, voffB);
            PG8_WAIT_V(6); PG8_BAR; PG8_MMA(1, 1, At, B1); PG8_BAR;
            }
        }
        if constexpr (ALIGN_EPI) { if (wr == 0) PG8_BAR; }
        if constexpr (!Epi::AFTER_DRAIN) { E(acc, cur, wr, wc, fr, fq); S.done(cur); }
        if (!has_next) break;
#pragma unroll
        for (int a = 0; a < 2; ++a)
#pragma unroll
            for (int b = 0; b < 2; ++b)
#pragma unroll
                for (int m = 0; m < 4; ++m)
#pragma unroll
                    for (int n = 0; n < 2; ++n) acc[a][b][m][n] = (f32x4){0.f, 0.f, 0.f, 0.f};
        cur = nxt; cA = nA; cB = nB; ++ui;
        if constexpr (ALIGN_EPI) { if (wr == 1) PG8_BAR; }
    }
    PG8_WAIT_V(0);
    if constexpr (!ALIGN_EPI) { if (wr == 0) PG8_BAR; }
    PG8_BAR;
    if constexpr (Epi::AFTER_DRAIN) { E.fused(acc, cur, wr, wc, fr, fq, lds, wid, lane); S.done(cur); }
#undef PG8_SA
#undef PG8_SB
#undef PG8_STAGE
#undef PG8_LDA
#undef PG8_LDB
#undef PG8_MMA
#undef PG8_WAIT_V
#undef PG8_WAIT_L
#undef PG8_BAR
#undef PG8_SCHED
}
}


#ifndef PG8_SP2
#define PG8_SP2 true
#endif
#ifndef PG8_ALIGN
#define PG8_ALIGN true
#endif
#ifndef MK_LAUNCHES
#define MK_LAUNCHES 1
#endif

#define GAS __attribute__((address_space(1)))
#define LAS __attribute__((address_space(3)))
typedef unsigned short bf16;
typedef float f32x4 __attribute__((ext_vector_type(4)));
typedef unsigned u32x4 __attribute__((ext_vector_type(4)));
typedef unsigned u32x2 __attribute__((ext_vector_type(2)));

constexpr int NB = 8, SEQ = 4096, DM = 1024, NMETA = 16;
constexpr int ROWS = 4160, PADR = 48, TOK0 = 64;
constexpr int MTOK = NB * SEQ;
constexpr int NIN = 3584;
constexpr int BROWS = NB * ROWS;
constexpr size_t ARR = (size_t)BROWS * 512;
constexpr int NCH = 64;
constexpr int NEXP = 16, DEXP = 512;
constexpr int XS_ROWS = 69632;
constexpr float ALPHA = 1.189207115002721f;
constexpr float LN_EPS = 1e-5f, RMS_EPS = 1e-6f;
constexpr float LOG2E = 1.4426950408889634f;
constexpr float C2Q = 0.125f * LOG2E;
constexpr float STICK_THR = 48.0f;

constexpr size_t MiB = 1u << 20;
constexpr size_t WS_CTL = 0, CTL_ZERO_BYTES = 1 * MiB;
constexpr size_t WS_WIN = 1 * MiB;
constexpr size_t WS_WOUT = 8 * MiB;
constexpr size_t WS_LB = 10 * MiB;
constexpr size_t WS_META = 11 * MiB;
constexpr size_t WS_DV = 12 * MiB;
constexpr size_t WS_XB = 16 * MiB;
constexpr size_t WS_S = 16 * MiB;
constexpr size_t WS_PROJ = 80 * MiB;
constexpr size_t WS_U = 308 * MiB;
constexpr size_t WS_MIX = 436 * MiB;
constexpr size_t WS_Y1 = 308 * MiB;
constexpr size_t WS_H1 = 16 * MiB;
constexpr size_t WS_W13 = 80 * MiB;
constexpr size_t WS_W2 = 112 * MiB;
constexpr size_t WS_XS = 128 * MiB;
constexpr size_t WS_HID = 264 * MiB;
constexpr size_t WS_YS = 332 * MiB;
constexpr size_t WS_END = 500 * MiB;
static_assert(WS_PROJ + 7 * ARR * 2 <= WS_U && WS_U + (size_t)32 * 64 * 16384 * 4 <= WS_MIX && WS_MIX + (size_t)MTOK * DM * 2 <= WS_END, "ws map A");
static_assert(WS_W13 + (size_t)16 * 1024 * 1024 * 2 <= WS_W2 && WS_W2 + (size_t)16 * 1024 * 512 * 2 <= WS_XS && WS_XS + (size_t)XS_ROWS * 1024 * 2 <= WS_HID &&
              WS_HID + (size_t)XS_ROWS * 512 * 2 <= WS_YS && WS_YS + (size_t)XS_ROWS * 1024 * 2 <= WS_END, "ws map B");
constexpr int CW_CNT = 64;
constexpr int CW_BAR = 4096;
constexpr int MISC_BAR = 100;

constexpr int RING_BYTES = 131072;
constexpr int MISC_OFF = RING_BYTES;
constexpr int LDS_BYTES = 147456;
constexpr int NWAVES = 8, NTHREADS = 512;

#define LBAR() do { asm volatile("s_waitcnt lgkmcnt(0)" ::: "memory"); __builtin_amdgcn_s_barrier(); asm volatile("" ::: "memory"); } while (0)
__device__ __forceinline__ unsigned f2bf(float f) { unsigned u = __builtin_bit_cast(unsigned, f); return (u + 0x7fffu + ((u >> 16) & 1u)) >> 16; }
typedef float f32x2_t __attribute__((ext_vector_type(2))); typedef __bf16 bf16x2_t __attribute__((ext_vector_type(2)));
__device__ __forceinline__ unsigned pk2(float lo, float hi) { f32x2_t v = {lo, hi}; bf16x2_t b = __builtin_convertvector(v, bf16x2_t); return __builtin_bit_cast(unsigned, b); }
__device__ __forceinline__ float bf2f(unsigned h) { return __builtin_bit_cast(float, h << 16); }
__device__ __forceinline__ float bflo(unsigned w) { return __builtin_bit_cast(float, w << 16); }
__device__ __forceinline__ float bfhi(unsigned w) { return __builtin_bit_cast(float, w & 0xffff0000u); }
__device__ __forceinline__ float ex2(float x) { return __builtin_amdgcn_exp2f(x); }
__device__ __forceinline__ float lg2(float x) { return __builtin_amdgcn_logf(x); }
__device__ __forceinline__ float rcpf_(float x) { return __builtin_amdgcn_rcpf(x); }
__device__ __forceinline__ float sigm(float v) { return rcpf_(1.f + ex2(-v * LOG2E)); }
__device__ __forceinline__ float wave_sum(float v) {
#pragma unroll
    for (int o = 1; o < 64; o <<= 1) v += __shfl_xor(v, o);
    return v;
}
template <int XF> __device__ __forceinline__ float xform(float v, float lb) {
    if (XF == 0) return v * sigm(v);
    if (XF == 1) return lg2(lb + (1.f - lb) * sigm(v));
    if (XF == 3) return sigm(v);
    if (XF == 4) return v * C2Q;
    return v;
}
__device__ __forceinline__ float xform_rt(int kind, float v, float lb) {
    switch (kind) { case 0: return xform<0>(v, lb); case 1: return xform<1>(v, lb); case 3: return xform<3>(v, lb); case 4: return xform<4>(v, lb); default: return v; }
}

using pg8::Unit;
struct EpiProj {
    static constexpr bool PERM = true, AFTER_DRAIN = false;
    bf16* proj; const float* lb;
    template <int XF> __device__ __forceinline__ void run(int kind, const f32x4 (&acc)[2][2][4][2], const Unit& u, int wr, int wc, int fr, int fq) const {
        const int b = u.pm >> 4;
        const int r0 = b * ROWS + TOK0 + (u.pm & 15) * 256 + wr * 64 + fr;
        const int c0 = (u.pn & 1) * 256 + wc * 32 + 8 * fq;
        bf16* base = proj + (size_t)kind * ARR;
        f32x4 l0[2], l1[2];
#pragma unroll
        for (int bj = 0; bj < 2; ++bj) {
            if (XF == 1) { l0[bj] = *(const f32x4*)(lb + c0 + bj * 128); l1[bj] = *(const f32x4*)(lb + c0 + bj * 128 + 4); }
            else { l0[bj] = (f32x4){0.f, 0.f, 0.f, 0.f}; l1[bj] = l0[bj]; }
        }
#pragma unroll
        for (int ai = 0; ai < 2; ++ai)
#pragma unroll
            for (int m = 0; m < 4; ++m) {
                bf16* rowp = base + (size_t)(r0 + ai * 128 + m * 16) * 512 + c0;
#pragma unroll
                for (int bj = 0; bj < 2; ++bj) {
                    const f32x4 v0 = acc[ai][bj][m][0], v1 = acc[ai][bj][m][1];
                    u32x4 w;
                    w.x = pk2(xform<XF>(v0[0], l0[bj][0]), xform<XF>(v0[1], l0[bj][1]));
                    w.y = pk2(xform<XF>(v0[2], l0[bj][2]), xform<XF>(v0[3], l0[bj][3]));
                    w.z = pk2(xform<XF>(v1[0], l1[bj][0]), xform<XF>(v1[1], l1[bj][1]));
                    w.w = pk2(xform<XF>(v1[2], l1[bj][2]), xform<XF>(v1[3], l1[bj][3]));
                    __builtin_nontemporal_store(w, (u32x4*)(rowp + bj * 128));
                }
            }
    }
    __device__ __forceinline__ void operator()(const f32x4 (&acc)[2][2][4][2], const Unit& u, int wr, int wc, int fr, int fq) const {
        const int kind = u.pn >> 1;
        if (kind == 0) run<0>(kind, acc, u, wr, wc, fr, fq);
        else if (kind == 1) run<1>(kind, acc, u, wr, wc, fr, fq);
        else if (kind == 3) run<3>(kind, acc, u, wr, wc, fr, fq);
        else if (kind == 4) run<4>(kind, acc, u, wr, wc, fr, fq);
        else run<2>(kind, acc, u, wr, wc, fr, fq);
    }
};
struct EpiOut {
    static constexpr bool PERM = false, AFTER_DRAIN = false;
    const float* x; float* out;
    __device__ __forceinline__ void operator()(const f32x4 (&acc)[2][2][4][2], const Unit& u, int wr, int wc, int fr, int fq) const {
        const int row0 = u.pm * 256 + wr * 64 + fr, col0 = u.pn * 256 + wc * 32 + 4 * fq;
#pragma unroll
        for (int ai = 0; ai < 2; ++ai)
#pragma unroll
            for (int m = 0; m < 4; ++m) {
                const size_t ro = (size_t)(row0 + ai * 128 + m * 16) * DM + col0;
#pragma unroll
                for (int bj = 0; bj < 2; ++bj)
#pragma unroll
                    for (int n = 0; n < 2; ++n) {
                        const f32x4 xv = *(const f32x4*)(x + ro + bj * 128 + 16 * n);
                        *(f32x4*)(out + ro + bj * 128 + 16 * n) = acc[ai][bj][m][n] + xv * ALPHA;
                    }
            }
    }
};
struct EpiHid {
    static constexpr bool PERM = true, AFTER_DRAIN = false;
    bf16* hid;
    __device__ __forceinline__ void operator()(const f32x4 (&acc)[2][2][4][2], const Unit& u, int wr, int wc, int fr, int fq) const {
        const int row0 = u.pm * 256 + wr * 64 + fr, hc0 = (u.pn & 3) * 128 + wc * 16 + 4 * fq;
#pragma unroll
        for (int ai = 0; ai < 2; ++ai)
#pragma unroll
            for (int m = 0; m < 4; ++m) {
                bf16* rowp = hid + (size_t)(row0 + ai * 128 + m * 16) * DEXP + hc0;
#pragma unroll
                for (int bj = 0; bj < 2; ++bj) {
                    const f32x4 g = acc[ai][bj][m][0], up = acc[ai][bj][m][1];
                    u32x2 w;
                    w.x = pk2(g[0] * sigm(g[0]) * up[0], g[1] * sigm(g[1]) * up[1]);
                    w.y = pk2(g[2] * sigm(g[2]) * up[2], g[3] * sigm(g[3]) * up[3]);
                    __builtin_nontemporal_store(w, (u32x2*)(rowp + bj * 64));
                }
            }
    }
};
struct EpiYs {
    static constexpr bool PERM = true, AFTER_DRAIN = false;
    bf16* ys;
    __device__ __forceinline__ void operator()(const f32x4 (&acc)[2][2][4][2], const Unit& u, int wr, int wc, int fr, int fq) const {
        const int row0 = u.pm * 256 + wr * 64 + fr, col0 = (u.pn & 3) * 256 + wc * 32 + 8 * fq;
#pragma unroll
        for (int ai = 0; ai < 2; ++ai)
#pragma unroll
            for (int m = 0; m < 4; ++m) {
                bf16* rowp = ys + (size_t)(row0 + ai * 128 + m * 16) * DM + col0;
#pragma unroll
                for (int bj = 0; bj < 2; ++bj) {
                    const f32x4 v0 = acc[ai][bj][m][0], v1 = acc[ai][bj][m][1];
                    u32x4 w; w.x = pk2(v0[0], v0[1]); w.y = pk2(v0[2], v0[3]); w.z = pk2(v1[0], v1[1]); w.w = pk2(v1[2], v1[3]);
                    __builtin_nontemporal_store(w, (u32x4*)(rowp + bj * 128));
                }
            }
    }
};
struct MoeOrder {
    const LAS int* toff; int G, c, ntot;
    __device__ __forceinline__ bool next(int i, Unit& u) const {
        const long L = (long)i * G + c; if (L >= (long)ntot * 4) return false;
        const int mt = (int)(L >> 2), pl = (int)(L & 3); int e = 0;
#pragma unroll
        for (int j = 1; j < NEXP; ++j) e += (mt >= toff[j]) ? 1 : 0;
        u.pm = mt; u.pn = e * 4 + pl; return true;
    }
    __device__ __forceinline__ void a_ready(const Unit&) const {}
    __device__ __forceinline__ void done(const Unit&) const {}
};

struct Args { const float* in[18]; float* out; unsigned char* ws; int ph_lo, ph_hi; };
struct Frame {
    LAS unsigned char* lds; LAS int* misc;
    int tid, lane, wave, G, gw, ngw;
};

template <int MODE> __device__ __forceinline__ int rowmap(int n) { return MODE == 0 ? n : ((n >> 2) * 8 + (n & 3) + (MODE == 2 ? 4 : 0)); }
template <int MODE> __device__ __forceinline__ void transpose_item(const float* W, int K, int N, bf16* WT, LAS float* scr, int item, int lane) {
    const int nblk = N / 32, kb = item / nblk, nb = item % nblk, k0 = 64 * kb, n0 = 32 * nb;
#pragma unroll
    for (int i = 0; i < 8; ++i) { const int kk = 8 * i + (lane >> 3), c4 = (lane & 7) * 4;
        const f32x4 v = __builtin_nontemporal_load((const f32x4*)(W + (size_t)(k0 + kk) * N + n0 + c4));
        LAS float* d = scr + kk * 33 + c4; d[0] = v[0]; d[1] = v[1]; d[2] = v[2]; d[3] = v[3]; }
    asm volatile("s_waitcnt lgkmcnt(0)" ::: "memory");
    const int c = lane & 7;
#pragma unroll
    for (int j = 0; j < 4; ++j) { const int n = (lane >> 3) + 8 * j; const LAS float* s = scr + (8 * c) * 33 + n;
        u32x4 o; o.x = pk2(s[0 * 33], s[1 * 33]); o.y = pk2(s[2 * 33], s[3 * 33]); o.z = pk2(s[4 * 33], s[5 * 33]); o.w = pk2(s[6 * 33], s[7 * 33]);
        *(u32x4*)(WT + (size_t)rowmap<MODE>(n0 + n) * K + k0 + 8 * c) = o; }
    asm volatile("s_waitcnt lgkmcnt(0)" ::: "memory");
}

__device__ __forceinline__ void p0_prep(Frame& F, const Args& A) {
    LAS float* scr = (LAS float*)(F.lds + F.wave * 16384);
    const int gtid = blockIdx.x * NTHREADS + F.tid, gthreads = F.G * NTHREADS;
    for (int i = gtid; i < 512; i += gthreads) ((float*)(A.ws + WS_LB))[i] = 1.f / (1.f + __expf(A.in[3][512 + i] - A.in[3][i]));
    for (int i = gtid; i < 7 * NB * 3072; i += gthreads) {
        const int a = i / (NB * 3072), r = i % (NB * 3072), b = r / 3072, o = r % 3072;
        *(u32x4*)(((bf16*)(A.ws + WS_PROJ)) + (size_t)a * ARR + (size_t)b * ROWS * 512 + (size_t)o * 8) = (u32x4){0u, 0u, 0u, 0u};
    }
    for (int job = F.gw; job < 56 * 16; job += F.ngw) {
        const int cgp = job >> 4, kq = job & 15, n = cgp * 64 + F.lane;
        float acc[16];
#pragma unroll
        for (int r = 0; r < 16; ++r) acc[r] = 0.f;
        const float* mt = A.in[1] + 64 * kq; const float* wp = A.in[2] + (size_t)(64 * kq) * NIN + n;
#pragma unroll 8
        for (int k = 0; k < 64; ++k) {
            const float w = wp[(size_t)k * NIN];
#pragma unroll
            for (int r = 0; r < 16; ++r) acc[r] += mt[r * DM + k] * w;
        }
        float* mp = ((float*)(A.ws + WS_U)) + (size_t)(kq * 16) * NIN + n;
#pragma unroll
        for (int r = 0; r < 16; ++r) mp[(size_t)r * NIN] = acc[r];
    }
    constexpr int I_IN = (DM / 64) * (NIN / 32), I_OUT = (DM / 64) * (DM / 32);
    for (int it = F.gw; it < I_IN + I_OUT; it += F.ngw) {
        if (it < I_IN) transpose_item<0>(A.in[2], DM, NIN, ((bf16*)(A.ws + WS_WIN)), scr, it, F.lane);
        else transpose_item<0>(A.in[6], DM, DM, ((bf16*)(A.ws + WS_WOUT)), scr, it - I_IN, F.lane);
    }
    for (int m = 2 * F.gw; m < MTOK; m += 2 * F.ngw) {
        const f32x4* xr = (const f32x4*)(A.in[0] + (size_t)m * DM) + F.lane;
        u32x2* o8 = (u32x2*)(((bf16*)(A.ws + WS_XB)) + (size_t)m * DM) + F.lane;
        f32x4 v[8];
#pragma unroll
        for (int j = 0; j < 8; ++j) v[j] = __builtin_nontemporal_load(xr + 64 * j);
#pragma unroll
        for (int j = 0; j < 8; ++j) { u32x2 w; w.x = pk2(v[j][0], v[j][1]); w.y = pk2(v[j][2], v[j][3]); o8[64 * j] = w; }
    }
}

__device__ __forceinline__ void meta_finalize(Frame& F, const Args& A) {
    const float* mp = (const float*)(A.ws + WS_U); const float* lb = (const float*)(A.ws + WS_LB);
    for (int idx = blockIdx.x * NTHREADS + F.tid; idx < 16 * NIN; idx += F.G * NTHREADS) {
        const int r = idx / NIN, n = idx % NIN, kind = n >> 9, col = n & 511;
        float v = 0.f;
#pragma unroll
        for (int kq = 0; kq < 16; ++kq) v += mp[(size_t)(kq * 16 + r) * NIN + n];
        const unsigned short o = (unsigned short)f2bf(xform_rt(kind, v, lb[col]));
        bf16* p = ((bf16*)(A.ws + WS_PROJ)) + (size_t)kind * ARR + (size_t)(PADR + r) * 512 + col;
#pragma unroll
        for (int b = 0; b < NB; ++b) p[(size_t)b * ROWS * 512] = o;
    }
}

typedef short s16x8 __attribute__((ext_vector_type(8)));
typedef short v4i16_t __attribute__((ext_vector_type(4)));
__device__ __forceinline__ s16x8 tr8(const LAS unsigned char* p, int rowskip) {
    const v4i16_t lo = __builtin_amdgcn_ds_read_tr16_b64_v4i16((LAS v4i16_t*)p);
    const v4i16_t hh = __builtin_amdgcn_ds_read_tr16_b64_v4i16((LAS v4i16_t*)(p + rowskip));
    return (s16x8){lo[0], lo[1], lo[2], lo[3], hh[0], hh[1], hh[2], hh[3]};
}
struct RawTile { u32x4 a, b; };
__device__ __forceinline__ RawTile raw_load(const bf16* arr, int b, int h, int c, int tid) {
    const bf16* p = arr + (size_t)(b * ROWS + 64 * c + (tid >> 4)) * 512 + 128 * h + 8 * (tid & 15);
    RawTile r; r.a = *(const u32x4*)p; r.b = *(const u32x4*)(p + (size_t)32 * 512); return r;
}
__device__ __forceinline__ void raw_store(LAS unsigned char* dst, int pitch, const RawTile& r, int tid) {
    LAS unsigned char* p = dst + (tid >> 4) * pitch + (tid & 15) * 16;
    *(LAS u32x4*)p = r.a; *(LAS u32x4*)(p + 32 * pitch) = r.b;
}
constexpr int PRAW = 272;
constexpr int PKT = 144;
__device__ __forceinline__ void ha_phase(Frame& F, const Args& A) {
    const bf16* LF = ((bf16*)(A.ws + WS_PROJ)) + 1 * ARR; const bf16* HV = ((bf16*)(A.ws + WS_PROJ)) + 2 * ARR;
    LAS unsigned char* RLF = F.lds;
    LAS unsigned char* VN = RLF + 64 * PRAW;
    LAS unsigned char* KT = VN + 64 * PRAW;
    LAS float* TOT = (LAS float*)(KT + 128 * PKT);
    const int tid = F.tid, lane = F.lane, w = F.wave, fr = lane & 15, fq = lane >> 4;
    const int d = tid & 127, sq = tid >> 7;
    int u = blockIdx.x;
    RawTile rl, rv;
    if (u < 32 * 64) { rl = raw_load(LF, u >> 8, (u >> 6) & 3, u & 63, tid); rv = raw_load(HV, u >> 8, (u >> 6) & 3, u & 63, tid); }
    for (; u < 32 * 64; u += F.G) {
        const int bh = u >> 6, c = u & 63;
        raw_store(RLF, PRAW, rl, tid); raw_store(VN, PRAW, rv, tid);
        LBAR();
        { const int un = u + F.G; if (un < 32 * 64) { rl = raw_load(LF, un >> 8, (un >> 6) & 3, un & 63, tid); rv = raw_load(HV, un >> 8, (un >> 6) & 3, un & 63, tid); } }
        float lf[16], pre[16]; float run = 0.f;
#pragma unroll
        for (int i = 0; i < 16; ++i) { lf[i] = bf2f(*(const LAS unsigned short*)(RLF + (16 * sq + i) * PRAW + 2 * d)); run += lf[i]; pre[i] = run; }
        TOT[sq * 128 + d] = run;
        LBAR();
        float off = 0.f, blast = 0.f;
#pragma unroll
        for (int q = 0; q < 4; ++q) { const float t = TOT[q * 128 + d]; off += (q < sq) ? t : 0.f; blast += t; }
        { unsigned kw[8];
#pragma unroll
          for (int i = 0; i < 8; ++i) { const float k0 = (1.f - ex2(lf[2 * i])) * ex2(blast - (off + pre[2 * i])), k1 = (1.f - ex2(lf[2 * i + 1])) * ex2(blast - (off + pre[2 * i + 1])); kw[i] = pk2(k0, k1); }
          LAS u32x4* kp = (LAS u32x4*)(KT + d * PKT + 32 * sq);
          kp[0] = (u32x4){kw[0], kw[1], kw[2], kw[3]}; kp[1] = (u32x4){kw[4], kw[5], kw[6], kw[7]}; }
        if (sq == 0) ((float*)(A.ws + WS_DV))[(size_t)(bh * 64 + c) * 128 + d] = ex2(blast);
        LBAR();
        const LAS unsigned char* vt = VN + (8 * fq + (fr >> 2)) * PRAW + (16 * w + 4 * (fr & 3)) * 2;
        const s16x8 b0 = tr8(vt, 4 * PRAW), b1 = tr8(vt + 32 * PRAW, 4 * PRAW);
        bf16* up = ((bf16*)(A.ws + WS_U)) + (size_t)(bh * 64 + c) * 16384 + (size_t)(16 * w + fr) * 128 + 4 * fq;
#pragma unroll
        for (int dt = 0; dt < 8; ++dt) {
            const LAS unsigned char* kp = KT + (16 * dt + fr) * PKT + 16 * fq;
            const s16x8 a0 = *(const LAS s16x8*)kp, a1 = *(const LAS s16x8*)(kp + 64);
            f32x4 acc = (f32x4){0.f, 0.f, 0.f, 0.f};
            acc = __builtin_amdgcn_mfma_f32_16x16x32_bf16(a0, b0, acc, 0, 0, 0);
            acc = __builtin_amdgcn_mfma_f32_16x16x32_bf16(a1, b1, acc, 0, 0, 0);
            { u32x2 o; o.x = pk2(acc[0], acc[1]); o.y = pk2(acc[2], acc[3]); *(u32x2*)(up + 16 * dt) = o; }
        }
        LBAR();
    }
}

typedef float f32x16 __attribute__((ext_vector_type(16)));
__device__ __forceinline__ s16x8 pack8(u32x2 a, u32x2 c) { const u32x4 w = (u32x4){a.x, a.y, c.x, c.y}; return __builtin_bit_cast(s16x8, w); }
struct AttnCtx { const bf16* kbase; const bf16* vbase; LAS unsigned char* vw; const LAS unsigned char* vt; int ktd, qrow, hi; };
__device__ __forceinline__ bool attn_tile(const AttnCtx& C, int kt, const s16x8 (&qf)[4], s16x8 (&kf)[4], u32x4 (&vr)[4], f32x16& o0, f32x16& o1, float& T) {
    const int k0 = 32 * kt, hi = C.hi;
    f32x16 p;
#pragma unroll
    for (int r = 0; r < 16; ++r) p[r] = 0.f;
#pragma unroll
    for (int s2 = 0; s2 < 4; ++s2) p = __builtin_amdgcn_mfma_f32_32x32x16_bf16(kf[s2], qf[s2], p, 0, 0, 0);
#pragma unroll
    for (int i = 0; i < 4; ++i) *(LAS u32x4*)(C.vw + i * 1024) = vr[i];
    s16x8 va[2][2];
#pragma unroll
    for (int dt = 0; dt < 2; ++dt)
#pragma unroll
        for (int s2 = 0; s2 < 2; ++s2) va[dt][s2] = tr8(C.vt + dt * 64 + s2 * 2048, 1024);
    if (kt > 2) {
        const bf16* kp = C.kbase + (size_t)(k0 - 64) * 512; const bf16* vp = C.vbase + (size_t)(k0 - 64) * 512;
#pragma unroll
        for (int s2 = 0; s2 < 4; ++s2) kf[s2] = *(const s16x8*)(kp + 16 * s2);
#pragma unroll
        for (int i = 0; i < 4; ++i) vr[i] = *(const u32x4*)(vp + (size_t)(8 * i) * 512);
    }
    const bool edge = (kt == C.ktd) || (kt == 1);
    float sp[16], iss[16], gs[4];
#pragma unroll
    for (int r = 0; r < 16; ++r) {
        const float z = fminf(p[r], 100.f); p[r] = z;
        float v = lg2(1.f + ex2(z));
        if (edge) { const int key = k0 + (r & 3) + 8 * (r >> 2) + 4 * hi; if (!(key >= PADR && key < C.qrow)) v = 0.f; }
        sp[r] = v;
    }
#pragma unroll
    for (int g = 0; g < 4; ++g) { iss[4 * g + 3] = sp[4 * g + 3]; iss[4 * g + 2] = iss[4 * g + 3] + sp[4 * g + 2]; iss[4 * g + 1] = iss[4 * g + 2] + sp[4 * g + 1]; iss[4 * g] = iss[4 * g + 1] + sp[4 * g]; gs[g] = iss[4 * g]; }
    float sg[4], go[4];
#pragma unroll
    for (int g = 0; g < 4; ++g) { const auto rr = __builtin_amdgcn_permlane32_swap(__float_as_uint(gs[g]), __float_as_uint(gs[g]), false, false);
        sg[g] = __uint_as_float(rr[0]) + __uint_as_float(rr[1]); go[g] = hi ? 0.f : __uint_as_float(rr[1]); }
    float off[4];
    off[3] = T + go[3]; const float e2 = sg[3]; off[2] = T + e2 + go[2]; const float e1 = e2 + sg[2]; off[1] = T + e1 + go[1]; const float e0 = e1 + sg[1]; off[0] = T + e0 + go[0];
    T += e0 + sg[0];
    float a[16];
#pragma unroll
    for (int r = 0; r < 16; ++r) {
        float v = ex2(p[r] - (off[r >> 2] + iss[r]));
        if (edge) { const int key = k0 + (r & 3) + 8 * (r >> 2) + 4 * hi; if (!(key >= PADR && key < C.qrow)) v = 0.f; }
        a[r] = v;
    }
#pragma unroll
    for (int s2 = 0; s2 < 2; ++s2) {
        u32x4 w; w.x = pk2(a[8 * s2], a[8 * s2 + 1]); w.y = pk2(a[8 * s2 + 2], a[8 * s2 + 3]); w.z = pk2(a[8 * s2 + 4], a[8 * s2 + 5]); w.w = pk2(a[8 * s2 + 6], a[8 * s2 + 7]);
        const s16x8 pb = __builtin_bit_cast(s16x8, w);
        o0 = __builtin_amdgcn_mfma_f32_32x32x16_bf16(va[0][s2], pb, o0, 0, 0, 0);
        o1 = __builtin_amdgcn_mfma_f32_32x32x16_bf16(va[1][s2], pb, o1, 0, 0, 0);
    }
    return __all(T > STICK_THR) || kt == 1;
}
__device__ __forceinline__ void attn_phase(Frame& F, const Args& A) {
    const bf16* SQ = ((bf16*)(A.ws + WS_PROJ)) + 4 * ARR; const bf16* SK = ((bf16*)(A.ws + WS_PROJ)) + 5 * ARR; const bf16* SV = ((bf16*)(A.ws + WS_PROJ)) + 6 * ARR;
    const int r32 = F.lane & 31, hi = F.lane >> 5;
    AttnCtx C;
    C.vw = F.lds + F.wave * 4096 + (F.lane >> 3) * 128 + (F.lane & 7) * 16;
    C.vt = F.lds + F.wave * 4096 + (4 * hi + ((F.lane & 15) >> 2)) * 128 + ((F.lane >> 4) & 1) * 32 + (F.lane & 3) * 8;
    C.hi = hi;
    for (int wu = F.gw; wu < 64 * 128; wu += F.ngw) {
        const int bh = wu >> 7, qi = wu & 127, b = bh >> 3, h = bh & 7, q0 = TOK0 + 32 * qi;
        C.qrow = q0 + r32; C.ktd = q0 >> 5;
        s16x8 qf[4];
        { const bf16* qp = SQ + (size_t)(b * ROWS + C.qrow) * 512 + 64 * h + 8 * hi;
#pragma unroll
          for (int s2 = 0; s2 < 4; ++s2) qf[s2] = *(const s16x8*)(qp + 16 * s2); }
        C.kbase = SK + (size_t)(b * ROWS + r32) * 512 + 64 * h + 8 * hi;
        C.vbase = SV + (size_t)(b * ROWS + (F.lane >> 3)) * 512 + 64 * h + 8 * (F.lane & 7);
        f32x16 o0, o1;
#pragma unroll
        for (int r = 0; r < 16; ++r) { o0[r] = 0.f; o1[r] = 0.f; }
        float T = 0.f;
        s16x8 kfA[4], kfB[4]; u32x4 vrA[4], vrB[4];
        { const bf16* kp = C.kbase + (size_t)(32 * C.ktd) * 512; const bf16* vp = C.vbase + (size_t)(32 * C.ktd) * 512;
#pragma unroll
          for (int s2 = 0; s2 < 4; ++s2) { kfA[s2] = *(const s16x8*)(kp + 16 * s2); kfB[s2] = *(const s16x8*)(kp - (size_t)32 * 512 + 16 * s2); }
#pragma unroll
          for (int i = 0; i < 4; ++i) { vrA[i] = *(const u32x4*)(vp + (size_t)(8 * i) * 512); vrB[i] = *(const u32x4*)(vp - (size_t)32 * 512 + (size_t)(8 * i) * 512); } }
        for (int kt = C.ktd;; kt -= 2) {
            if (attn_tile(C, kt, qf, kfA, vrA, o0, o1, T)) break;
            if (attn_tile(C, kt - 1, qf, kfB, vrB, o0, o1, T)) break;
        }
        float ss = 0.f;
#pragma unroll
        for (int r = 0; r < 16; ++r) ss += o0[r] * o0[r] + o1[r] * o1[r];
        { const auto rr = __builtin_amdgcn_permlane32_swap(__float_as_uint(ss), __float_as_uint(ss), false, false); ss = __uint_as_float(rr[0]) + __uint_as_float(rr[1]); }
        const float rs = 1.0f / sqrtf(ss * (1.f / 64.f) + RMS_EPS);
        const float* gp = A.in[5] + 64 * h + 4 * hi;
        bf16* op = ((bf16*)(A.ws + WS_MIX)) + (size_t)(b * SEQ + C.qrow - TOK0) * DM + 512 + 64 * h + 4 * hi;
#pragma unroll
        for (int g = 0; g < 4; ++g) {
            const f32x4 g0 = *(const f32x4*)(gp + 8 * g), g1 = *(const f32x4*)(gp + 32 + 8 * g);
            u32x2 w0, w1;
            w0.x = pk2(o0[4 * g] * rs * g0[0], o0[4 * g + 1] * rs * g0[1]); w0.y = pk2(o0[4 * g + 2] * rs * g0[2], o0[4 * g + 3] * rs * g0[3]);
            w1.x = pk2(o1[4 * g] * rs * g1[0], o1[4 * g + 1] * rs * g1[1]); w1.y = pk2(o1[4 * g + 2] * rs * g1[2], o1[4 * g + 3] * rs * g1[3]);
            *(u32x2*)(op + 8 * g) = w0; *(u32x2*)(op + 32 + 8 * g) = w1;
        }
    }
}

__device__ __forceinline__ void hb_phase(Frame& F, const Args& A) {
    LAS float* DVL = (LAS float*)F.lds;
    for (int job = blockIdx.x; job < 32 * 8; job += F.G) {
        const int bh = job >> 3, v = (job & 7) * 16 + (F.tid >> 5), d4 = (F.tid & 31) * 4;
        { const f32x4* src = (const f32x4*)(((const float*)(A.ws + WS_DV)) + (size_t)bh * 64 * 128);
#pragma unroll
          for (int i = 0; i < 4; ++i) ((LAS f32x4*)DVL)[F.tid + 512 * i] = src[F.tid + 512 * i]; }
        __syncthreads();
        const bf16* up = ((bf16*)(A.ws + WS_U)) + (size_t)bh * 64 * 16384 + v * 128 + d4;
        bf16* sp = ((bf16*)(A.ws + WS_S)) + (size_t)bh * 64 * 16384 + v * 128 + d4;
        f32x4 s = (f32x4){0.f, 0.f, 0.f, 0.f};
#pragma unroll 16
        for (int c = 0; c < 64; ++c) {
            const u32x2 ub = __builtin_nontemporal_load((const u32x2*)(up + (size_t)c * 16384));
            const f32x4 uu = (f32x4){bflo(ub.x), bfhi(ub.x), bflo(ub.y), bfhi(ub.y)}, dd = *(const LAS f32x4*)(DVL + c * 128 + d4);
            s = dd * s + uu;
            u32x2 w; w.x = pk2(s[0], s[1]); w.y = pk2(s[2], s[3]);
            *(u32x2*)(sp + (size_t)c * 16384) = w;
        }
        __syncthreads();
    }
}

__device__ __forceinline__ void hc_phase(Frame& F, const Args& A) {
    const bf16* HQ = ((bf16*)(A.ws + WS_PROJ)); const bf16* LF = HQ + 1 * ARR; const bf16* HV = HQ + 2 * ARR; const bf16* HG = HQ + 3 * ARR;
    LAS unsigned char* RLF = F.lds;
    LAS unsigned char* RQ = RLF + 64 * PRAW;
    LAS unsigned char* VN = RQ + 64 * PRAW;
    LAS unsigned char* QT = VN + 64 * PRAW;
    LAS unsigned char* KI = QT + 64 * PRAW;
    LAS unsigned char* SC = KI + 64 * PRAW;
    LAS float* TOT = (LAS float*)(SC + 64 * PKT);
    LAS float* SSQ = TOT + 512;
    const int tid = F.tid, lane = F.lane, w = F.wave, fr = lane & 15, fq = lane >> 4;
    const int d = tid & 127, sq = tid >> 7;
    int u = blockIdx.x;
    RawTile rl, rq, rv;
    if (u < 32 * 64) { const int b = u >> 8, h = (u >> 6) & 3, cc = (u & 63) + 1; rl = raw_load(LF, b, h, cc, tid); rq = raw_load(HQ, b, h, cc, tid); rv = raw_load(HV, b, h, cc, tid); }
    for (; u < 32 * 64; u += F.G) {
        const int bh = u >> 6, b = bh >> 2, h = bh & 3, cc = (u & 63) + 1;
        raw_store(RLF, PRAW, rl, tid); raw_store(RQ, PRAW, rq, tid); raw_store(VN, PRAW, rv, tid);
        LBAR();
        { const int un = u + F.G; if (un < 32 * 64) { const int b2 = un >> 8, h2 = (un >> 6) & 3, c2 = (un & 63) + 1; rl = raw_load(LF, b2, h2, c2, tid); rq = raw_load(HQ, b2, h2, c2, tid); rv = raw_load(HV, b2, h2, c2, tid); } }
        s16x8 sa[4]; u32x2 gt[4];
        { const bf16* sp = ((bf16*)(A.ws + WS_S)) + (size_t)(bh * 64 + cc - 1) * 16384 + (size_t)(16 * w + fr) * 128 + 8 * fq;
#pragma unroll
          for (int ks = 0; ks < 4; ++ks) sa[ks] = *(const s16x8*)(sp + 32 * ks);
          const bf16* gp = HG + (size_t)(b * ROWS + 64 * cc + fr) * 512 + 128 * h + 16 * w + 4 * fq;
#pragma unroll
          for (int tt = 0; tt < 4; ++tt) gt[tt] = *(const u32x2*)(gp + (size_t)(16 * tt) * 512); }
        {
            float lf[16], pre[16], qv[16]; float run = 0.f;
#pragma unroll
            for (int i = 0; i < 16; ++i) { lf[i] = bf2f(*(const LAS unsigned short*)(RLF + (16 * sq + i) * PRAW + 2 * d)); qv[i] = bf2f(*(const LAS unsigned short*)(RQ + (16 * sq + i) * PRAW + 2 * d)); run += lf[i]; pre[i] = run; }
            TOT[sq * 128 + d] = run;
            LBAR();
            float off = 0.f;
#pragma unroll
            for (int q = 0; q < 4; ++q) { const float t = TOT[q * 128 + d]; off += (q < sq) ? t : 0.f; }
#pragma unroll
            for (int i = 0; i < 16; ++i) { const float bc = off + pre[i];
                *(LAS unsigned short*)(QT + (16 * sq + i) * PRAW + 2 * d) = (unsigned short)f2bf(qv[i] * ex2(bc));
                *(LAS unsigned short*)(KI + (16 * sq + i) * PRAW + 2 * d) = (unsigned short)f2bf((1.f - ex2(lf[i])) * ex2(-bc)); }
        }
        LBAR();
        {
            const int tt = w >> 1;
            s16x8 bq[4];
            const LAS unsigned char* qp = QT + (16 * tt + fr) * PRAW + 16 * fq;
#pragma unroll
            for (int ks = 0; ks < 4; ++ks) bq[ks] = *(const LAS s16x8*)(qp + 64 * ks);
#pragma unroll
            for (int j = 0; j < 2; ++j) {
                const int st = 2 * (w & 1) + j;
                const LAS unsigned char* kp = KI + (16 * st + fr) * PRAW + 16 * fq;
                f32x4 acc = (f32x4){0.f, 0.f, 0.f, 0.f};
#pragma unroll
                for (int ks = 0; ks < 4; ++ks) acc = __builtin_amdgcn_mfma_f32_16x16x32_bf16(*(const LAS s16x8*)(kp + 64 * ks), bq[ks], acc, 0, 0, 0);
                const int t = 16 * tt + fr, s0 = 16 * st + 4 * fq;
                u32x2 wv; wv.x = pk2(s0 <= t ? acc[0] : 0.f, s0 + 1 <= t ? acc[1] : 0.f); wv.y = pk2(s0 + 2 <= t ? acc[2] : 0.f, s0 + 3 <= t ? acc[3] : 0.f);
                *(LAS u32x2*)(SC + t * PKT + 2 * s0) = wv;
            }
        }
        LBAR();
        f32x4 acc[4];
        {
            const LAS unsigned char* vt = VN + (8 * fq + (fr >> 2)) * PRAW + (16 * w + 4 * (fr & 3)) * 2;
            const s16x8 av0 = tr8(vt, 4 * PRAW), av1 = tr8(vt + 32 * PRAW, 4 * PRAW);
#pragma unroll
            for (int tt = 0; tt < 4; ++tt) {
                const LAS unsigned char* scp = SC + (16 * tt + fr) * PKT + 16 * fq;
                const LAS unsigned char* qp = QT + (16 * tt + fr) * PRAW + 16 * fq;
                f32x4 c = (f32x4){0.f, 0.f, 0.f, 0.f};
                c = __builtin_amdgcn_mfma_f32_16x16x32_bf16(av0, *(const LAS s16x8*)scp, c, 0, 0, 0);
                c = __builtin_amdgcn_mfma_f32_16x16x32_bf16(av1, *(const LAS s16x8*)(scp + 64), c, 0, 0, 0);
#pragma unroll
                for (int ks = 0; ks < 4; ++ks) c = __builtin_amdgcn_mfma_f32_16x16x32_bf16(sa[ks], *(const LAS s16x8*)(qp + 64 * ks), c, 0, 0, 0);
                acc[tt] = c;
                float ss = (c[0] * c[0] + c[1] * c[1]) + (c[2] * c[2] + c[3] * c[3]);
                ss += __shfl_xor(ss, 16); ss += __shfl_xor(ss, 32);
                if (fq == 0) SSQ[w * 64 + 16 * tt + fr] = ss;
            }
        }
        LBAR();
        {
            const f32x4 ng = *(const f32x4*)(A.in[4] + 128 * h + 16 * w + 4 * fq);
            bf16* op = ((bf16*)(A.ws + WS_MIX)) + (size_t)(b * SEQ + 64 * (cc - 1) + fr) * DM + 128 * h + 16 * w + 4 * fq;
#pragma unroll
            for (int tt = 0; tt < 4; ++tt) {
                float tot = 0.f;
#pragma unroll
                for (int k = 0; k < 8; ++k) tot += SSQ[k * 64 + 16 * tt + fr];
                const float rs = 1.0f / sqrtf(tot * (1.f / 128.f) + RMS_EPS);
                u32x2 o;
                o.x = pk2(acc[tt][0] * rs * ng[0] * bflo(gt[tt].x), acc[tt][1] * rs * ng[1] * bfhi(gt[tt].x));
                o.y = pk2(acc[tt][2] * rs * ng[2] * bflo(gt[tt].y), acc[tt][3] * rs * ng[3] * bfhi(gt[tt].y));
                *(u32x2*)(op + (size_t)(16 * tt) * DM) = o;
            }
        }
        LBAR();
    }
}

__device__ __forceinline__ void ln_stats(const f32x4 (&v)[4], float& mean, float& rstd) {
    float s = 0.f;
#pragma unroll
    for (int j = 0; j < 4; ++j) s += (v[j][0] + v[j][1]) + (v[j][2] + v[j][3]);
    mean = wave_sum(s) * (1.f / DM);
    float s2 = 0.f;
#pragma unroll
    for (int j = 0; j < 4; ++j) { const f32x4 d = v[j] - mean; s2 += (d[0] * d[0] + d[1] * d[1]) + (d[2] * d[2] + d[3] * d[3]); }
    rstd = 1.0f / sqrtf(wave_sum(s2) * (1.f / DM) + LN_EPS);
}

__device__ __forceinline__ void route_row(Frame& F, const Args& A, const float (&lg)[20], int rl, LAS int* lcnt, LAS int* rec) {
    const float* brg = A.in[10];
    float g0 = lg[0] + brg[0], g1 = lg[1] + brg[1], g2 = lg[2] + brg[2], g3 = lg[3] + brg[3];
    int grp = 0; float gm = g0;
    if (g1 > gm) { gm = g1; grp = 1; } if (g2 > gm) { gm = g2; grp = 2; } if (g3 > gm) { gm = g3; grp = 3; }
    const float pg = 1.f / (__expf(g0 - gm) + __expf(g1 - gm) + __expf(g2 - gm) + __expf(g3 - gm));
    float in0, in1, in2, in3;
    if (grp == 0) { in0 = lg[4]; in1 = lg[5]; in2 = lg[6]; in3 = lg[7]; }
    else if (grp == 1) { in0 = lg[8]; in1 = lg[9]; in2 = lg[10]; in3 = lg[11]; }
    else if (grp == 2) { in0 = lg[12]; in1 = lg[13]; in2 = lg[14]; in3 = lg[15]; }
    else { in0 = lg[16]; in1 = lg[17]; in2 = lg[18]; in3 = lg[19]; }
    const float* be = A.in[12] + grp * 4;
    in0 += be[0]; in1 += be[1]; in2 += be[2]; in3 += be[3];
    int i0 = 0; float m0 = in0;
    if (in1 > m0) { m0 = in1; i0 = 1; } if (in2 > m0) { m0 = in2; i0 = 2; } if (in3 > m0) { m0 = in3; i0 = 3; }
    int i1 = -1; float m1 = 0.f;
    if (i0 != 0) { m1 = in0; i1 = 0; }
    if (i0 != 1 && (i1 < 0 || in1 > m1)) { m1 = in1; i1 = 1; }
    if (i0 != 2 && (i1 < 0 || in2 > m1)) { m1 = in2; i1 = 2; }
    if (i0 != 3 && (i1 < 0 || in3 > m1)) { m1 = in3; i1 = 3; }
    const float w0 = 1.f / (1.f + __expf(m1 - m0)), w1 = 1.f - w0;
    const int e0 = grp * 4 + i0, e1 = grp * 4 + i1;
    const int p0 = atomicAdd((int*)&lcnt[e0], 1), p1 = atomicAdd((int*)&lcnt[e1], 1);
    rec[rl * 6 + 0] = e0; rec[rl * 6 + 1] = p0; rec[rl * 6 + 2] = __float_as_int(pg * w0);
    rec[rl * 6 + 3] = e1; rec[rl * 6 + 4] = p1; rec[rl * 6 + 5] = __float_as_int(pg * w1);
}
__device__ __forceinline__ void p6_ln_router(Frame& F, const Args& A) {
    LAS int* lcnt = F.misc + 32; LAS int* lbase = F.misc + 48;
    LAS f32x4* WL = (LAS f32x4*)F.lds;
    LAS int* rec = (LAS int*)(F.lds + 81920);
    for (int it = F.tid; it < 1024 * 5; it += NTHREADS) {
        const int k = it / 5, c = it % 5, j = k >> 8, ln = (k >> 2) & 63, e = k & 3;
        const f32x4 w = (c == 0) ? *(const f32x4*)(A.in[9] + (size_t)k * 4) : *(const f32x4*)(A.in[11] + (size_t)k * 16 + 4 * (c - 1));
        WL[((j * 4 + e) * 5 + c) * 64 + ln] = w;
    }
    __syncthreads();
    const LAS f32x4* wl = WL + F.lane;
    for (int slab = blockIdx.x; slab < MTOK / 128; slab += F.G) {
        if (F.tid < 16) lcnt[F.tid] = 0;
        __syncthreads();
#pragma unroll 1
        for (int i = 0; i < 16; i += 2) {
            const int rl = F.wave * 16 + i, row = slab * 128 + rl;
            const f32x4* xr0 = (const f32x4*)(A.in[0] + (size_t)row * DM) + F.lane; const f32x4* xr1 = xr0 + DM / 4;
            const u32x2* yr0 = (const u32x2*)(((const bf16*)(A.ws + WS_Y1)) + (size_t)row * DM) + F.lane; const u32x2* yr1 = yr0 + DM / 4;
            u32x2* hb0 = (u32x2*)(((bf16*)(A.ws + WS_H1)) + (size_t)row * DM) + F.lane; u32x2* hb1 = hb0 + DM / 4;
            f32x4 v0[4], v1[4];
#pragma unroll
            for (int j = 0; j < 4; ++j) { const u32x2 y0 = yr0[64 * j], y1 = yr1[64 * j];
                v0[j] = xr0[64 * j] * ALPHA + (f32x4){bflo(y0.x), bfhi(y0.x), bflo(y0.y), bfhi(y0.y)};
                v1[j] = xr1[64 * j] * ALPHA + (f32x4){bflo(y1.x), bfhi(y1.x), bflo(y1.y), bfhi(y1.y)}; }
            float mean0, rstd0, mean1, rstd1; ln_stats(v0, mean0, rstd0); ln_stats(v1, mean1, rstd1);
#pragma unroll
            for (int j = 0; j < 4; ++j) {
                const f32x4 g = ((const f32x4*)A.in[7])[64 * j + F.lane], bb = ((const f32x4*)A.in[8])[64 * j + F.lane];
                v0[j] = (v0[j] - mean0) * rstd0 * g + bb; v1[j] = (v1[j] - mean1) * rstd1 * g + bb;
                { u32x2 o; o.x = pk2(v0[j][0], v0[j][1]); o.y = pk2(v0[j][2], v0[j][3]); hb0[64 * j] = o; o.x = pk2(v1[j][0], v1[j][1]); o.y = pk2(v1[j][2], v1[j][3]); hb1[64 * j] = o; }
            }
            float la[20], lb2[20];
#pragma unroll
            for (int e = 0; e < 20; ++e) { la[e] = 0.f; lb2[e] = 0.f; }
#pragma unroll 1
            for (int j = 0; j < 4; ++j) {
                const f32x4 s0 = (j == 0) ? v0[0] : (j == 1) ? v0[1] : (j == 2) ? v0[2] : v0[3];
                const f32x4 s1 = (j == 0) ? v1[0] : (j == 1) ? v1[1] : (j == 2) ? v1[2] : v1[3];
                const LAS f32x4* wj = wl + j * (20 * 64);
#pragma unroll
                for (int e = 0; e < 4; ++e) {
                    const float h0 = s0[e], h1 = s1[e];
#pragma unroll
                    for (int c = 0; c < 5; ++c) { const f32x4 w = wj[(e * 5 + c) * 64];
                        la[4 * c] += h0 * w[0]; la[4 * c + 1] += h0 * w[1]; la[4 * c + 2] += h0 * w[2]; la[4 * c + 3] += h0 * w[3];
                        lb2[4 * c] += h1 * w[0]; lb2[4 * c + 1] += h1 * w[1]; lb2[4 * c + 2] += h1 * w[2]; lb2[4 * c + 3] += h1 * w[3]; }
                }
            }
#pragma unroll
            for (int e = 0; e < 20; ++e) { la[e] = wave_sum(la[e]); lb2[e] = wave_sum(lb2[e]); }
            if (F.lane == 0) { route_row(F, A, la, rl, lcnt, rec); route_row(F, A, lb2, rl + 1, lcnt, rec); }
        }
        __syncthreads();
        if (F.tid < 16) lbase[F.tid] = (int)atomicAdd(((unsigned*)(A.ws + WS_CTL)) + CW_CNT + F.tid, (unsigned)lcnt[F.tid]);
        __syncthreads();
        if (F.tid < 128) {
            unsigned* mp = ((unsigned*)(A.ws + WS_META)) + (size_t)(slab * 128 + F.tid) * 8;
            const int e0 = rec[F.tid * 6 + 0], e1 = rec[F.tid * 6 + 3];
            u32x4 a, c;
            a.x = (unsigned)e0; a.y = (unsigned)(lbase[e0] + rec[F.tid * 6 + 1]); a.z = (unsigned)rec[F.tid * 6 + 2]; a.w = (unsigned)e1;
            c.x = (unsigned)(lbase[e1] + rec[F.tid * 6 + 4]); c.y = (unsigned)rec[F.tid * 6 + 5]; c.z = 0u; c.w = 0u;
            *(u32x4*)mp = a; *(u32x4*)(mp + 4) = c;
        }
        __syncthreads();
    }
}

__device__ __forceinline__ void build_toff(Frame& F, const Args& A) {
    __syncthreads();
    if (F.tid == 0) { int acc = 0;
        for (int e = 0; e < NEXP; ++e) { F.misc[e] = acc; const unsigned c = __hip_atomic_load(((unsigned*)(A.ws + WS_CTL)) + CW_CNT + e, __ATOMIC_RELAXED, __HIP_MEMORY_SCOPE_AGENT); acc += (int)((c + 255u) >> 8); }
        F.misc[NEXP] = acc; }
    __syncthreads();
}

__device__ __forceinline__ void p7_scatter(Frame& F, const Args& A) {
    build_toff(F, A);
    for (int row = F.gw; row < MTOK; row += F.ngw) {
        const unsigned* mp = ((unsigned*)(A.ws + WS_META)) + (size_t)row * 8;
        const int e0 = (int)mp[0], p0 = (int)mp[1], e1 = (int)mp[3], p1 = (int)mp[4];
        const size_t s0 = (size_t)F.misc[e0] * 256 + p0, s1 = (size_t)F.misc[e1] * 256 + p1;
        const u32x4* xr = (const u32x4*)(((bf16*)(A.ws + WS_H1)) + (size_t)row * DM) + F.lane;
        u32x4* o0 = (u32x4*)(((bf16*)(A.ws + WS_XS)) + s0 * DM) + F.lane; u32x4* o1 = (u32x4*)(((bf16*)(A.ws + WS_XS)) + s1 * DM) + F.lane;
#pragma unroll
        for (int j = 0; j < 2; ++j) { const u32x4 v = xr[64 * j]; o0[64 * j] = v; o1[64 * j] = v; }
    }
    LAS float* scr = (LAS float*)(F.lds + F.wave * 16384);
    constexpr int I13 = (DM / 64) * (DEXP / 32), I2 = (DEXP / 64) * (DM / 32);
    for (int it = F.gw; it < NEXP * (2 * I13 + I2); it += F.ngw) {
        const int e = it / (2 * I13 + I2), r = it % (2 * I13 + I2);
        if (r < I13) transpose_item<1>(A.in[13] + (size_t)e * DM * DEXP, DM, DEXP, ((bf16*)(A.ws + WS_W13)) + (size_t)e * 1024 * DM, scr, r, F.lane);
        else if (r < 2 * I13) transpose_item<2>(A.in[14] + (size_t)e * DM * DEXP, DM, DEXP, ((bf16*)(A.ws + WS_W13)) + (size_t)e * 1024 * DM, scr, r - I13, F.lane);
        else transpose_item<0>(A.in[15] + (size_t)e * DEXP * DM, DEXP, DM, ((bf16*)(A.ws + WS_W2)) + (size_t)e * DM * DEXP, scr, r - 2 * I13, F.lane);
    }
}

__device__ __forceinline__ void p10_final(Frame& F, const Args& A) {
    build_toff(F, A);
    for (int row = F.gw; row < MTOK; row += F.ngw) {
        const unsigned* mp = ((unsigned*)(A.ws + WS_META)) + (size_t)row * 8;
        const int e0 = (int)mp[0], p0 = (int)mp[1], e1 = (int)mp[3], p1 = (int)mp[4];
        const float g0 = __uint_as_float(mp[2]), g1 = __uint_as_float(mp[5]);
        const size_t s0 = (size_t)F.misc[e0] * 256 + p0, s1 = (size_t)F.misc[e1] * 256 + p1;
        f32x4* xr = (f32x4*)(A.out + (size_t)row * DM) + F.lane; const u32x2* hr = (const u32x2*)(((bf16*)(A.ws + WS_H1)) + (size_t)row * DM) + F.lane;
        const u32x2* y0 = (const u32x2*)(((bf16*)(A.ws + WS_YS)) + s0 * DM) + F.lane; const u32x2* y1 = (const u32x2*)(((bf16*)(A.ws + WS_YS)) + s1 * DM) + F.lane;
        f32x4 v[4];
#pragma unroll
        for (int j = 0; j < 4; ++j) { const u32x2 hw = hr[64 * j]; const f32x4 hv = (f32x4){bflo(hw.x), bfhi(hw.x), bflo(hw.y), bfhi(hw.y)}; const u32x2 a = y0[64 * j], c = y1[64 * j];
            v[j][0] = ALPHA * hv[0] + g0 * bflo(a.x) + g1 * bflo(c.x); v[j][1] = ALPHA * hv[1] + g0 * bfhi(a.x) + g1 * bfhi(c.x);
            v[j][2] = ALPHA * hv[2] + g0 * bflo(a.y) + g1 * bflo(c.y); v[j][3] = ALPHA * hv[3] + g0 * bfhi(a.y) + g1 * bfhi(c.y); }
        float mean, rstd; ln_stats(v, mean, rstd);
#pragma unroll
        for (int j = 0; j < 4; ++j) { const f32x4 g = ((const f32x4*)A.in[16])[64 * j + F.lane], bb = ((const f32x4*)A.in[17])[64 * j + F.lane]; xr[64 * j] = (v[j] - mean) * rstd * g + bb; }
    }
}

#define XB_TMO      128
#define XB_XCNT(j)  (256  + 64 * (j))
#define XB_XSUB(j)  (1280 + 64 * (j))
#define XB_XGEN(j)  (2304 + 64 * (j))
#define XB_TOP      3328
#define XB_TOPGEN   3392
#define XCD_BAR_WORDS 3456
#define XB_SPIN_CAP (1u << 18)

__device__ __forceinline__ unsigned xb_ld(unsigned* p)              { return __hip_atomic_load(p, __ATOMIC_RELAXED, __HIP_MEMORY_SCOPE_AGENT); }
__device__ __forceinline__ unsigned xb_add(unsigned* p, unsigned v) { return __hip_atomic_fetch_add(p, v, __ATOMIC_RELAXED, __HIP_MEMORY_SCOPE_AGENT); }
__device__ __forceinline__ unsigned xb_xcc_id() { return (unsigned)__builtin_amdgcn_s_getreg((3 << 11) | 20) & 0xFu; }
#define XB_SPIN(cond, bar) do { unsigned _sp = 0; while (cond) { __builtin_amdgcn_s_sleep(1); \
    if ((++_sp & 255u) == 0u) { if (xb_ld(&(bar)[XB_TMO])) break; if (_sp > XB_SPIN_CAP) { atomicAdd(&(bar)[XB_TMO], 1u); break; } } } } while (0)

struct XcdBarrier {
    unsigned* bar; unsigned x;
    volatile LAS unsigned* st;
};

__device__ __forceinline__ XcdBarrier xcd_barrier_post(unsigned* bar, volatile LAS unsigned* st) {
    XcdBarrier b; b.bar = bar; b.x = xb_xcc_id(); b.st = st;
    if (threadIdx.x == 0) (void)xb_add(&bar[XB_XCNT(b.x)], 1u);
    return b;
}
__device__ __forceinline__ void xcd_barrier_complete(unsigned* bar, unsigned x, unsigned& nloc, unsigned& nx) {
    const unsigned G = gridDim.x * gridDim.y * gridDim.z;
    unsigned sum, cnt, mine, sp = 0u;
    for (;;) {
        sum = 0u; cnt = 0u; mine = 0u;
#pragma unroll
        for (unsigned j = 0; j < 16; ++j) { const unsigned c = xb_ld(&bar[XB_XCNT(j)]); sum += c; cnt += (c > 0u) ? 1u : 0u; mine = (j == x) ? c : mine; }
        if (sum == G) break;
        __builtin_amdgcn_s_sleep(1);
        if ((++sp & 255u) == 0u) { if (xb_ld(&bar[XB_TMO])) break; if (sp > XB_SPIN_CAP) { atomicAdd(&bar[XB_TMO], 1u); break; } }
    }
    nloc = mine > 0u ? mine : 1u; nx = cnt > 0u ? cnt : 1u;
}

__device__ __forceinline__ void xcd_barrier(const XcdBarrier& b) {
    asm volatile("s_waitcnt vmcnt(0)" ::: "memory");
    __syncthreads();
    if (threadIdx.x == 0) {
        unsigned* bar = b.bar;
        __builtin_amdgcn_s_waitcnt(0);
        unsigned nloc = b.st[0], nx = b.st[1];
        if (nloc == 0u) { xcd_barrier_complete(bar, b.x, nloc, nx); b.st[0] = nloc; b.st[1] = nx; }
        const unsigned old = xb_add(&bar[XB_XSUB(b.x)], 1u);
        const unsigned gen = old / nloc;
        if (old + 1u == (gen + 1u) * nloc) {
            __builtin_amdgcn_fence(__ATOMIC_RELEASE, "agent");
            asm volatile("s_waitcnt vmcnt(0)" ::: "memory");
            const unsigned og = xb_add(&bar[XB_TOP], 1u);
            const unsigned tg = og / nx;
            if (og + 1u == (tg + 1u) * nx) xb_add(&bar[XB_TOPGEN], 1u);
            else XB_SPIN(xb_ld(&bar[XB_TOPGEN]) == tg, bar);
            __builtin_amdgcn_fence(__ATOMIC_ACQUIRE, "agent");
            xb_add(&bar[XB_XGEN(b.x)], 1u);
            asm volatile("s_waitcnt vmcnt(0)" ::: "memory");
        } else {
            XB_SPIN(xb_ld(&bar[XB_XGEN(b.x)]) == gen, bar);
            __builtin_amdgcn_fence(__ATOMIC_ACQUIRE, "agent");
            asm volatile("s_waitcnt vmcnt(0)" ::: "memory");
        }
    }
    __syncthreads();
}

constexpr int NPHASE = 11;
__global__ void __launch_bounds__(NTHREADS, 2) mega_fwd(Args args) {
    extern __shared__ __attribute__((aligned(16))) unsigned char lds[];
    Frame F;
    F.lds = (LAS unsigned char*)lds; F.misc = (LAS int*)(F.lds + MISC_OFF);
    F.tid = threadIdx.x; F.lane = F.tid & 63; F.wave = __builtin_amdgcn_readfirstlane(F.tid >> 6); F.G = gridDim.x;
    F.gw = blockIdx.x * NWAVES + F.wave; F.ngw = F.G * NWAVES;
    const Args& A = args;
    const int lo = args.ph_lo, hi = args.ph_hi;
    if (F.tid < 2) F.misc[MISC_BAR + F.tid] = 0;
    __syncthreads();
    XcdBarrier bar; bar.bar = (unsigned*)(args.ws + WS_CTL) + CW_BAR; bar.x = 0; bar.st = nullptr;
    if (MK_LAUNCHES == 1) bar = xcd_barrier_post((unsigned*)(args.ws + WS_CTL) + CW_BAR, (volatile LAS unsigned*)(F.misc + MISC_BAR));
#define IN(k) (lo <= (k) && (k) < hi)
#define SEAM(k) do { if (IN((k) + 1)) { xcd_barrier(bar); } } while (0)

    if (IN(0)) { p0_prep(F, A); SEAM(0); }
    if (IN(1)) {
        meta_finalize(F, A);
        pg8::Gemm g{((bf16*)(A.ws + WS_XB)), ((bf16*)(A.ws + WS_WIN)), MTOK, NIN, DM}; pg8::StaticOrder S; S.init(MTOK, NIN, F.G, (int)blockIdx.x);
        EpiProj E{((bf16*)(A.ws + WS_PROJ)), ((float*)(A.ws + WS_LB))};
        pg8::gemm_phase<EpiProj, pg8::StaticOrder, PG8_ALIGN, PG8_SP2>(F.lds, g, S, E);
        SEAM(1);
    }
    if (IN(2)) {
        ha_phase(F, A);
        attn_phase(F, A);
        SEAM(2);
    }
    if (IN(3)) { hb_phase(F, A); SEAM(3); }
    if (IN(4)) {
        hc_phase(F, A);
        SEAM(4);
    }
    if (IN(5)) {
        pg8::Gemm g{((bf16*)(A.ws + WS_MIX)), ((bf16*)(A.ws + WS_WOUT)), MTOK, DM, DM}; pg8::StaticOrder S; S.init(MTOK, DM, F.G, (int)blockIdx.x);
        EpiYs E{(bf16*)(A.ws + WS_Y1)};
        pg8::gemm_phase<EpiYs, pg8::StaticOrder, PG8_ALIGN, PG8_SP2>(F.lds, g, S, E);
        SEAM(5);
    }
    if (IN(6)) { p6_ln_router(F, A); SEAM(6); }
    if (IN(7)) { p7_scatter(F, A); SEAM(7); }
    if (IN(8)) {
        build_toff(F, A);
        pg8::Gemm g{((bf16*)(A.ws + WS_XS)), ((bf16*)(A.ws + WS_W13)), XS_ROWS, 1024, DM}; MoeOrder S{(const LAS int*)F.misc, F.G, (int)blockIdx.x, F.misc[NEXP]};
        EpiHid E{((bf16*)(A.ws + WS_HID))};
        pg8::gemm_phase<EpiHid, MoeOrder, PG8_ALIGN, PG8_SP2>(F.lds, g, S, E);
        SEAM(8);
    }
    if (IN(9)) {
        build_toff(F, A);
        pg8::Gemm g{((bf16*)(A.ws + WS_HID)), ((bf16*)(A.ws + WS_W2)), XS_ROWS, 1024, DEXP}; MoeOrder S{(const LAS int*)F.misc, F.G, (int)blockIdx.x, F.misc[NEXP]};
        EpiYs E{((bf16*)(A.ws + WS_YS))};
        pg8::gemm_phase<EpiYs, MoeOrder, PG8_ALIGN, PG8_SP2>(F.lds, g, S, E);
        SEAM(9);
    }
    if (IN(10)) { p10_final(F, A); }
#undef IN
#undef SEAM
}

extern "C" void kernel_launch(void* const* d_in, const int* in_sizes, int n_in, void* d_out, int out_size, void* d_ws, size_t ws_size, hipStream_t stream) {
    static int grid = 0;
    if (grid == 0) {
        if (n_in != 18 || in_sizes[0] != MTOK * DM || out_size != MTOK * DM || ws_size < WS_END) {
            fprintf(stderr, "kernel_launch: unexpected shapes (n_in %d, in0 %d, out %d, ws %zu); nothing launched\n", n_in, n_in > 0 ? in_sizes[0] : -1, out_size, ws_size); grid = -1; return; }
        int dev = 0, cus = 0, per_cu = 0;
        if (hipGetDevice(&dev) != hipSuccess || hipDeviceGetAttribute(&cus, hipDeviceAttributeMultiprocessorCount, dev) != hipSuccess) { grid = -1; return; }
        if (hipFuncSetAttribute((const void*)mega_fwd, hipFuncAttributeMaxDynamicSharedMemorySize, LDS_BYTES) != hipSuccess) { fprintf(stderr, "kernel_launch: hipFuncSetAttribute failed\n"); grid = -1; return; }
        if (hipOccupancyMaxActiveBlocksPerMultiprocessor(&per_cu, (const void*)mega_fwd, NTHREADS, LDS_BYTES) != hipSuccess || per_cu < 1) { fprintf(stderr, "kernel_launch: occupancy query says %d\n", per_cu); per_cu = 1; }
        (void)hipGetLastError();
        grid = cus;
    }
    if (grid < 0) return;
    (void)hipMemsetAsync((char*)d_ws + WS_CTL, 0, CTL_ZERO_BYTES, stream);
    Args a{};
    for (int i = 0; i < 18; ++i) a.in[i] = (const float*)d_in[i];
    a.out = (float*)d_out; a.ws = (unsigned char*)d_ws;
#if MK_LAUNCHES == 1
    a.ph_lo = 0; a.ph_hi = NPHASE;
    void* kargs[] = {&a};
    hipError_t e = hipLaunchCooperativeKernel((const void*)mega_fwd, dim3(grid), dim3(NTHREADS), kargs, LDS_BYTES, stream);
    if (e != hipSuccess) fprintf(stderr, "kernel_launch: cooperative launch failed: %s (grid %d)\n", hipGetErrorString(e), grid);
#else
    for (int p = 0; p < NPHASE; ++p) { a.ph_lo = p; a.ph_hi = p + 1; hipLaunchKernelGGL(mega_fwd, dim3(grid), dim3(NTHREADS), LDS_BYTES, stream, a); }
#endif
}
```

```cpp
#include <hip/hip_runtime.h>
#include <hip/hip_cooperative_groups.h>
#include <cstdio>
#include <cstdint>
namespace cg = cooperative_groups;
namespace pg8 {
#define PG8_LAS __attribute__((address_space(3)))
typedef unsigned short bf16_t;
typedef short bf16x8 __attribute__((ext_vector_type(8)));
typedef float f32x4 __attribute__((ext_vector_type(4)));
typedef unsigned u32x4 __attribute__((ext_vector_type(4)));
constexpr int BM = 256, BK = 64, HALF = 128, HTB = HALF * BK * 2  , STAGE_BYTES = 8 * HTB, NXCD = 8, WGM = 8;

__host__ __device__ __forceinline__ int lds_byte(int r, int c) { const int st = (r >> 4) * 2 + (c >> 5), rr = r & 15, cc = c & 31, ob = rr * 64 + cc * 2; return st * 1024 + (ob ^ (((ob >> 9) & 1) << 5)); }
__host__ __device__ __forceinline__ void stage_rc(int b, int& R, int& C) { const int st = b / 1024, sb = b % 1024, swz = sb ^ (((sb >> 9) & 1) << 5); R = (st >> 1) * 16 + swz / 64; C = (st & 1) * 32 + (swz % 64) / 2; }
__host__ __device__ __forceinline__ int perm32(int rho) { const int n = rho >> 4, i = rho & 15; return 8 * (i >> 2) + 4 * n + (i & 3); }

struct Unit { int pm, pn; };
struct Gemm { const bf16_t* A; const bf16_t* Bt; int M, N, K; };

struct StaticOrder {
    int nM, nN, nwg, G, c;
    __host__ __device__ void init(int M, int N, int G_, int c_) { nM = M / BM; nN = N / BM; nwg = nM * nN; G = G_; c = c_; }
    __host__ __device__ bool next(int i, Unit& u) const {
        const long L = (long)i * G + c; if (L >= nwg) return false;
        int wgid = (int)L; { const int q = nwg / NXCD, r = nwg % NXCD, xcd = wgid % NXCD, off = wgid / NXCD; wgid = (xcd < r ? xcd * (q + 1) : r * (q + 1) + (xcd - r) * q) + off; }
        const int nig = WGM * nN, gid = wgid / nig, fm = gid * WGM, gsz = (nM - fm) < WGM ? (nM - fm) : WGM;
        u.pm = fm + ((wgid % nig) % gsz); u.pn = (wgid % nig) / gsz; return true;
    }
    __device__ __forceinline__ void a_ready(const Unit&) const {}
    __device__ __forceinline__ void done(const Unit&) const {}
};

__device__ __forceinline__ unsigned cvt_pk_bf16(float lo, float hi) { unsigned r; asm volatile("v_cvt_pk_bf16_f32 %0, %1, %2" : "=v"(r) : "v"(lo), "v"(hi)); return r; }
template <class Epi, class Sched, bool ALIGN_EPI = false, bool SP2 = false>
__device__ __forceinline__ void gemm_phase(PG8_LAS unsigned char* lds, const Gemm g, const Sched& S, const Epi& E) {
    int tid_ = threadIdx.x; asm volatile("" : "+v"(tid_));
    const int tid = tid_, wid = __builtin_amdgcn_readfirstlane(tid >> 6), lane = tid & 63, wr = wid >> 2, wc = wid & 3, fr = lane & 15, fq = lane >> 4;
    const int K = g.K, nt = K / BK;
    unsigned voffA[2], voffB[2];
#pragma unroll
    for (int i = 0; i < 2; ++i) { int R, C; stage_rc(tid * 16 + i * 8192, R, C); const int Rb = Epi::PERM ? ((R & ~31) + perm32(R & 31)) : R;
        voffA[i] = (unsigned)(R * K + C) * 2u; voffB[i] = (unsigned)(Rb * K + C) * 2u; }
    const size_t kstep = (size_t)(BK * 2);
    const size_t hstep = (size_t)HALF * K * 2;
    const size_t tstep = 2 * hstep;
    const unsigned ldsw = (unsigned)wid * 1024u;
    const int aoff = lds_byte(wr * 64 + fr, fq * 8), boff = lds_byte(wc * 32 + fr, fq * 8);
#define PG8_SA(b, h) (((b) * 2 + (h)) * HTB)
#define PG8_SB(b, h) ((4 + (b) * 2 + (h)) * HTB)
#define PG8_STAGE(bufoff, gbase, voff) do { _Pragma("unroll") for (int _i = 0; _i < 2; ++_i) \
        __builtin_amdgcn_global_load_lds((const unsigned*)((const char*)(gbase) + (voff)[_i]), (PG8_LAS unsigned*)(lds + (bufoff) + ldsw + _i * 8192), 16, 0, 0); } while (0)
#define PG8_LDA(dst, b, h) do { _Pragma("unroll") for (int m = 0; m < 4; ++m) _Pragma("unroll") for (int k = 0; k < 2; ++k) dst[m][k] = *(const PG8_LAS bf16x8*)(lds + PG8_SA(b, h) + aoff + m * 2048 + k * 1024); } while (0)
#define PG8_LDB(dst, b, h) do { _Pragma("unroll") for (int n = 0; n < 2; ++n) _Pragma("unroll") for (int k = 0; k < 2; ++k) dst[n][k] = *(const PG8_LAS bf16x8*)(lds + PG8_SB(b, h) + boff + n * 2048 + k * 1024); } while (0)
#define PG8_MMA(ai, bj, At, Bt) do { __builtin_amdgcn_s_setprio(1); _Pragma("unroll") for (int m = 0; m < 4; ++m) _Pragma("unroll") for (int n = 0; n < 2; ++n) _Pragma("unroll") for (int k = 0; k < 2; ++k) \
        acc[ai][bj][m][n] = __builtin_amdgcn_mfma_f32_16x16x32_bf16(Bt[n][k], At[m][k], acc[ai][bj][m][n], 0, 0, 0); __builtin_amdgcn_s_setprio(0); } while (0)
#define PG8_WAIT_V(n) asm volatile("s_waitcnt vmcnt(" #n ")" ::: "memory")
#define PG8_WAIT_L(n) asm volatile("s_waitcnt lgkmcnt(" #n ")" ::: "memory")
#define PG8_BAR __builtin_amdgcn_s_barrier()
#define PG8_SCHED __builtin_amdgcn_sched_barrier(0)
    Unit cur, nxt; int ui = 0;
    if (!S.next(0, cur)) return;
    f32x4 acc[2][2][4][2];
#pragma unroll
    for (int a = 0; a < 2; ++a)
#pragma unroll
        for (int b = 0; b < 2; ++b)
#pragma unroll
            for (int m = 0; m < 4; ++m)
#pragma unroll
                for (int n = 0; n < 2; ++n) acc[a][b][m][n] = (f32x4){0.f, 0.f, 0.f, 0.f};
    bf16x8 At[4][2], B0[2][2], B1[2][2];
    const char* cA = (const char*)g.A + (size_t)cur.pm * tstep; const char* cB = (const char*)g.Bt + (size_t)cur.pn * tstep;
    S.a_ready(cur);
    if constexpr (SP2) {
        PG8_STAGE(PG8_SB(0, 0), cB, voffB); PG8_STAGE(PG8_SB(0, 1), cB + hstep, voffB); PG8_STAGE(PG8_SA(0, 0), cA, voffA); PG8_STAGE(PG8_SA(0, 1), cA + hstep, voffA);
        if (wr == 1) PG8_BAR;
        PG8_WAIT_V(2); PG8_BAR;
        PG8_STAGE(PG8_SB(1, 0), cB + kstep, voffB); PG8_STAGE(PG8_SA(1, 0), cA + kstep, voffA); PG8_STAGE(PG8_SB(1, 1), cB + hstep + kstep, voffB);
        PG8_WAIT_V(6); PG8_BAR;
    } else {
        PG8_STAGE(PG8_SB(0, 0), cB, voffB); PG8_STAGE(PG8_SA(0, 0), cA, voffA); PG8_STAGE(PG8_SB(0, 1), cB + hstep, voffB); PG8_STAGE(PG8_SA(0, 1), cA + hstep, voffA);
        if (wr == 1) PG8_BAR;
        PG8_WAIT_V(4); PG8_BAR;
        PG8_STAGE(PG8_SB(1, 0), cB + kstep, voffB); PG8_STAGE(PG8_SA(1, 0), cA + kstep, voffA); PG8_STAGE(PG8_SB(1, 1), cB + hstep + kstep, voffB);
        PG8_WAIT_V(6); PG8_BAR;
    }
    for (;;) {
        const bool has_next = S.next(ui + 1, nxt);
        const char* nA = has_next ? (const char*)g.A + (size_t)nxt.pm * tstep : cA; const char* nB = has_next ? (const char*)g.Bt + (size_t)nxt.pn * tstep : cB;
        for (int t = 0; t < nt; t += 2) {
            const bool last = (t == nt - 2);
            const char* a1 = cA + (size_t)(t + 1) * kstep;
            const char* a2 = last ? nA : cA + (size_t)(t + 2) * kstep; const char* b2 = last ? nB : cB + (size_t)(t + 2) * kstep;
            const char* a3 = a2 + kstep; const char* b3 = b2 + kstep;
            if (last && has_next) S.a_ready(nxt);
            if constexpr (SP2) {
            PG8_LDB(B0, 0, 0); PG8_LDB(B1, 0, 1); PG8_SCHED; PG8_LDA(At, 0, 0); PG8_STAGE(PG8_SA(1, 1), a1 + hstep, voffA);
            PG8_WAIT_V(8); PG8_WAIT_L(0); PG8_BAR; PG8_MMA(0, 0, At, B0); PG8_MMA(0, 1, At, B1); PG8_BAR; PG8_SCHED;
            PG8_LDA(At, 0, 1); PG8_STAGE(PG8_SB(0, 0), b2, voffB); PG8_STAGE(PG8_SB(0, 1), b2 + hstep, voffB); PG8_STAGE(PG8_SA(0, 0), a2, voffA);
            PG8_WAIT_V(8); PG8_WAIT_L(0); PG8_BAR; PG8_MMA(1, 0, At, B0); PG8_MMA(1, 1, At, B1); PG8_BAR; PG8_SCHED;
            PG8_LDB(B0, 1, 0); PG8_LDB(B1, 1, 1); PG8_SCHED; PG8_LDA(At, 1, 0); PG8_STAGE(PG8_SA(0, 1), a2 + hstep, voffA);
            PG8_WAIT_V(8); PG8_WAIT_L(0); PG8_BAR; PG8_MMA(0, 0, At, B0); PG8_MMA(0, 1, At, B1); PG8_BAR; PG8_SCHED;
            PG8_LDA(At, 1, 1); PG8_STAGE(PG8_SB(1, 0), b3, voffB); PG8_STAGE(PG8_SB(1, 1), b3 + hstep, voffB); PG8_STAGE(PG8_SA(1, 0), a3, voffA);
            PG8_WAIT_V(8); PG8_WAIT_L(0); PG8_BAR; PG8_MMA(1, 0, At, B0); PG8_MMA(1, 1, At, B1); PG8_BAR; PG8_SCHED;
            } else {
            PG8_LDB(B0, 0, 0); PG8_SCHED; PG8_LDA(At, 0, 0); PG8_STAGE(PG8_SA(1, 1), a1 + hstep, voffA);
            PG8_WAIT_L(8); PG8_BAR; PG8_WAIT_L(0); PG8_MMA(0, 0, At, B0); PG8_BAR; PG8_SCHED;
            PG8_LDB(B1, 0, 1); PG8_STAGE(PG8_SB(0, 0), b2, voffB);
            PG8_BAR; PG8_WAIT_L(0); PG8_MMA(0, 1, At, B1); PG8_BAR;
            PG8_LDA(At, 0, 1); PG8_STAGE(PG8_SA(0, 0), a2, voffA);
            PG8_BAR; PG8_WAIT_L(0); PG8_MMA(1, 0, At, B0); PG8_BAR; PG8_SCHED;
            PG8_STAGE(PG8_SB(0, 1), b2 + hstep, voffB);
            PG8_WAIT_V(6); PG8_BAR; PG8_MMA(1, 1, At, B1); PG8_BAR;
            PG8_LDB(B0, 1, 0); PG8_SCHED; PG8_LDA(At, 1, 0); PG8_STAGE(PG8_SA(0, 1), a2 + hstep, voffA);
            PG8_WAIT_L(8); PG8_BAR; PG8_WAIT_L(0); PG8_MMA(0, 0, At, B0); PG8_BAR; PG8_SCHED;
            PG8_LDB(B1, 1, 1); PG8_STAGE(PG8_SB(1, 0), b3, voffB);
            PG8_BAR; PG8_WAIT_L(0); PG8_MMA(0, 1, At, B1); PG8_BAR;
            PG8_LDA(At, 1, 1); PG8_STAGE(PG8_SA(1, 0), a3, voffA);
            PG8_BAR; PG8_WAIT_L(0); PG8_MMA(1, 0, At, B0); PG8_BAR; PG8_SCHED;
            PG8_STAGE(PG8_SB(1, 1), b3 + hstep, voffB);
            PG8_WAIT_V(6); PG8_BAR; PG8_MMA(1, 1, At, B1); PG8_BAR;
            }
        }
        if constexpr (ALIGN_EPI) { if (wr == 0) PG8_BAR; }
        if constexpr (!Epi::AFTER_DRAIN) { E(acc, cur, wr, wc, fr, fq); S.done(cur); }
        if (!has_next) break;
#pragma unroll
        for (int a = 0; a < 2; ++a)
#pragma unroll
            for (int b = 0; b < 2; ++b)
#pragma unroll
                for (int m = 0; m < 4; ++m)
#pragma unroll
                    for (int n = 0; n < 2; ++n) acc[a][b][m][n] = (f32x4){0.f, 0.f, 0.f, 0.f};
        cur = nxt; cA = nA; cB = nB; ++ui;
        if constexpr (ALIGN_EPI) { if (wr == 1) PG8_BAR; }
    }
    PG8_WAIT_V(0);
    if constexpr (!ALIGN_EPI) { if (wr == 0) PG8_BAR; }
    PG8_BAR;
    if constexpr (Epi::AFTER_DRAIN) { E.fused(acc, cur, wr, wc, fr, fq, lds, wid, lane); S.done(cur); }
#undef PG8_SA
#undef PG8_SB
#undef PG8_STAGE
#undef PG8_LDA
#undef PG8_LDB
#undef PG8_MMA
#undef PG8_WAIT_V
#undef PG8_WAIT_L
#undef PG8_BAR
#undef PG8_SCHED
}

template <class Epi, class Sched, bool ALIGN_EPI = false, bool SP2 = false>
__device__ __forceinline__ void gemm_phase_gather(PG8_LAS unsigned char* lds, const Gemm g, const Sched& S, const Epi& E) {
    int tid_ = threadIdx.x; asm volatile("" : "+v"(tid_));
    const int tid = tid_, wid = __builtin_amdgcn_readfirstlane(tid >> 6), lane = tid & 63, wr = wid >> 2, wc = wid & 3, fr = lane & 15, fq = lane >> 4;
    const int K = g.K, nt = K / BK;
    unsigned voffA[2], voffB[2]; int rowA[2];
    unsigned oC[2][2], oN[2][2], o2[2][2];
#pragma unroll
    for (int i = 0; i < 2; ++i) { int R, C; stage_rc(tid * 16 + i * 8192, R, C); const int Rb = Epi::PERM ? ((R & ~31) + perm32(R & 31)) : R;
        voffA[i] = (unsigned)C * 2u; rowA[i] = R; voffB[i] = (unsigned)(Rb * K + C) * 2u; }
    const size_t kstep = (size_t)(BK * 2);
    const size_t hstep = (size_t)HALF * K * 2;
    const size_t tstep = 2 * hstep;
    const unsigned ldsw = (unsigned)wid * 1024u;
    const int aoff = lds_byte(wr * 64 + fr, fq * 8), boff = lds_byte(wc * 32 + fr, fq * 8);
#define PG8_SA(b, h) (((b) * 2 + (h)) * HTB)
#define PG8_SB(b, h) ((4 + (b) * 2 + (h)) * HTB)
#define PG8_STAGE(bufoff, gbase, voff) do { _Pragma("unroll") for (int _i = 0; _i < 2; ++_i) \
        __builtin_amdgcn_global_load_lds((const unsigned*)((const char*)(gbase) + (voff)[_i]), (PG8_LAS unsigned*)(lds + (bufoff) + ldsw + _i * 8192), 16, 0, 0); } while (0)
#define PG8_LDA(dst, b, h) do { _Pragma("unroll") for (int m = 0; m < 4; ++m) _Pragma("unroll") for (int k = 0; k < 2; ++k) dst[m][k] = *(const PG8_LAS bf16x8*)(lds + PG8_SA(b, h) + aoff + m * 2048 + k * 1024); } while (0)
#define PG8_LDB(dst, b, h) do { _Pragma("unroll") for (int n = 0; n < 2; ++n) _Pragma("unroll") for (int k = 0; k < 2; ++k) dst[n][k] = *(const PG8_LAS bf16x8*)(lds + PG8_SB(b, h) + boff + n * 2048 + k * 1024); } while (0)
#define PG8_MMA(ai, bj, At, Bt) do { __builtin_amdgcn_s_setprio(1); _Pragma("unroll") for (int m = 0; m < 4; ++m) _Pragma("unroll") for (int n = 0; n < 2; ++n) _Pragma("unroll") for (int k = 0; k < 2; ++k) \
        acc[ai][bj][m][n] = __builtin_amdgcn_mfma_f32_16x16x32_bf16(Bt[n][k], At[m][k], acc[ai][bj][m][n], 0, 0, 0); __builtin_amdgcn_s_setprio(0); } while (0)
#define PG8_WAIT_V(n) asm volatile("s_waitcnt vmcnt(" #n ")" ::: "memory")
#define PG8_WAIT_L(n) asm volatile("s_waitcnt lgkmcnt(" #n ")" ::: "memory")
#define PG8_BAR __builtin_amdgcn_s_barrier()
#define PG8_SCHED __builtin_amdgcn_sched_barrier(0)
    Unit cur, nxt; int ui = 0;
    if (!S.next(0, cur)) return;
    f32x4 acc[2][2][4][2];
#pragma unroll
    for (int a = 0; a < 2; ++a)
#pragma unroll
        for (int b = 0; b < 2; ++b)
#pragma unroll
            for (int m = 0; m < 4; ++m)
#pragma unroll
                for (int n = 0; n < 2; ++n) acc[a][b][m][n] = (f32x4){0.f, 0.f, 0.f, 0.f};
    bf16x8 At[4][2], B0[2][2], B1[2][2];
    const char* cA = (const char*)g.A; const char* cB = (const char*)g.Bt + (size_t)cur.pn * tstep;
#define PG8_ROWOFFS(dst, unit) do { _Pragma("unroll") for (int _h = 0; _h < 2; ++_h) _Pragma("unroll") for (int _i = 0; _i < 2; ++_i) \
        dst[_h][_i] = (unsigned)S.a_row(unit, _h * HALF + rowA[_i]) * (unsigned)(K * 2) + voffA[_i]; } while (0)
    PG8_ROWOFFS(oC, cur);
    S.a_ready(cur);
    if constexpr (SP2) {
        PG8_STAGE(PG8_SB(0, 0), cB, voffB); PG8_STAGE(PG8_SB(0, 1), cB + hstep, voffB); PG8_STAGE(PG8_SA(0, 0), cA, oC[0]); PG8_STAGE(PG8_SA(0, 1), cA, oC[1]);
        if (wr == 1) PG8_BAR;
        PG8_WAIT_V(2); PG8_BAR;
        PG8_STAGE(PG8_SB(1, 0), cB + kstep, voffB); PG8_STAGE(PG8_SA(1, 0), cA + kstep, oC[0]); PG8_STAGE(PG8_SB(1, 1), cB + hstep + kstep, voffB);
        PG8_WAIT_V(6); PG8_BAR;
    } else {
        PG8_STAGE(PG8_SB(0, 0), cB, voffB); PG8_STAGE(PG8_SA(0, 0), cA, oC[0]); PG8_STAGE(PG8_SB(0, 1), cB + hstep, voffB); PG8_STAGE(PG8_SA(0, 1), cA, oC[1]);
        if (wr == 1) PG8_BAR;
        PG8_WAIT_V(4); PG8_BAR;
        PG8_STAGE(PG8_SB(1, 0), cB + kstep, voffB); PG8_STAGE(PG8_SA(1, 0), cA + kstep, oC[0]); PG8_STAGE(PG8_SB(1, 1), cB + hstep + kstep, voffB);
        PG8_WAIT_V(6); PG8_BAR;
    }
    for (;;) {
        const bool has_next = S.next(ui + 1, nxt);
        const char* nB = has_next ? (const char*)g.Bt + (size_t)nxt.pn * tstep : cB;
        if (has_next) { PG8_ROWOFFS(oN, nxt); } else { _Pragma("unroll") for (int _h = 0; _h < 2; ++_h) _Pragma("unroll") for (int _i = 0; _i < 2; ++_i) oN[_h][_i] = oC[_h][_i]; }
        for (int t = 0; t < nt; t += 2) {
            const bool last = (t == nt - 2);
            const char* a1 = cA + (size_t)(t + 1) * kstep;
            const char* a2 = last ? cA : cA + (size_t)(t + 2) * kstep; const char* b2 = last ? nB : cB + (size_t)(t + 2) * kstep;
#pragma unroll
            for (int _h = 0; _h < 2; ++_h)
#pragma unroll
                for (int _i = 0; _i < 2; ++_i) o2[_h][_i] = last ? oN[_h][_i] : oC[_h][_i];
            const char* a3 = a2 + kstep; const char* b3 = b2 + kstep;
            if (last && has_next) S.a_ready(nxt);
            if constexpr (SP2) {
            PG8_LDB(B0, 0, 0); PG8_LDB(B1, 0, 1); PG8_SCHED; PG8_LDA(At, 0, 0); PG8_STAGE(PG8_SA(1, 1), a1, oC[1]);
            PG8_WAIT_V(8); PG8_WAIT_L(0); PG8_BAR; PG8_MMA(0, 0, At, B0); PG8_MMA(0, 1, At, B1); PG8_BAR; PG8_SCHED;
            PG8_LDA(At, 0, 1); PG8_STAGE(PG8_SB(0, 0), b2, voffB); PG8_STAGE(PG8_SB(0, 1), b2 + hstep, voffB); PG8_STAGE(PG8_SA(0, 0), a2, o2[0]);
            PG8_WAIT_V(8); PG8_WAIT_L(0); PG8_BAR; PG8_MMA(1, 0, At, B0); PG8_MMA(1, 1, At, B1); PG8_BAR; PG8_SCHED;
            PG8_LDB(B0, 1, 0); PG8_LDB(B1, 1, 1); PG8_SCHED; PG8_LDA(At, 1, 0); PG8_STAGE(PG8_SA(0, 1), a2, o2[1]);
            PG8_WAIT_V(8); PG8_WAIT_L(0); PG8_BAR; PG8_MMA(0, 0, At, B0); PG8_MMA(0, 1, At, B1); PG8_BAR; PG8_SCHED;
            PG8_LDA(At, 1, 1); PG8_STAGE(PG8_SB(1, 0), b3, voffB); PG8_STAGE(PG8_SB(1, 1), b3 + hstep, voffB); PG8_STAGE(PG8_SA(1, 0), a3, o2[0]);
            PG8_WAIT_V(8); PG8_WAIT_L(0); PG8_BAR; PG8_MMA(1, 0, At, B0); PG8_MMA(1, 1, At, B1); PG8_BAR; PG8_SCHED;
            } else {
            PG8_LDB(B0, 0, 0); PG8_SCHED; PG8_LDA(At, 0, 0); PG8_STAGE(PG8_SA(1, 1), a1, oC[1]);
            PG8_WAIT_L(8); PG8_BAR; PG8_WAIT_L(0); PG8_MMA(0, 0, At, B0); PG8_BAR; PG8_SCHED;
            PG8_LDB(B1, 0, 1); PG8_STAGE(PG8_SB(0, 0), b2, voffB);
            PG8_BAR; PG8_WAIT_L(0); PG8_MMA(0, 1, At, B1); PG8_BAR;
            PG8_LDA(At, 0, 1); PG8_STAGE(PG8_SA(0, 0), a2, o2[0]);
            PG8_BAR; PG8_WAIT_L(0); PG8_MMA(1, 0, At, B0); PG8_BAR; PG8_SCHED;
            PG8_STAGE(PG8_SB(0, 1), b2 + hstep, voffB);
            PG8_WAIT_V(6); PG8_BAR; PG8_MMA(1, 1, At, B1); PG8_BAR;
            PG8_LDB(B0, 1, 0); PG8_SCHED; PG8_LDA(At, 1, 0); PG8_STAGE(PG8_SA(0, 1), a2, o2[1]);
            PG8_WAIT_L(8); PG8_BAR; PG8_WAIT_L(0); PG8_MMA(0, 0, At, B0); PG8_BAR; PG8_SCHED;
            PG8_LDB(B1, 1, 1); PG8_STAGE(PG8_SB(1, 0), b3, voffB);
            PG8_BAR; PG8_WAIT_L(0); PG8_MMA(0, 1, At, B1); PG8_BAR;
            PG8_LDA(At, 1, 1); PG8_STAGE(PG8_SA(1, 0), a3, o2[0]);
            PG8_BAR; PG8_WAIT_L(0); PG8_MMA(1, 0, At, B0); PG8_BAR; PG8_SCHED;
            PG8_STAGE(PG8_SB(1, 1), b3 + hstep, voffB);
            PG8_WAIT_V(6); PG8_BAR; PG8_MMA(1, 1, At, B1); PG8_BAR;
            }
        }
        if constexpr (ALIGN_EPI) { if (wr == 0) PG8_BAR; }
        if constexpr (!Epi::AFTER_DRAIN) { E(acc, cur, wr, wc, fr, fq); S.done(cur); }
        if (!has_next) break;
#pragma unroll
        for (int a = 0; a < 2; ++a)
#pragma unroll
            for (int b = 0; b < 2; ++b)
#pragma unroll
                for (int m = 0; m < 4; ++m)
#pragma unroll
                    for (int n = 0; n < 2; ++n) acc[a][b][m][n] = (f32x4){0.f, 0.f, 0.f, 0.f};
        cur = nxt; cB = nB; ++ui;
#pragma unroll
        for (int _h = 0; _h < 2; ++_h)
#pragma unroll
            for (int _i = 0; _i < 2; ++_i) oC[_h][_i] = oN[_h][_i];
        if constexpr (ALIGN_EPI) { if (wr == 1) PG8_BAR; }
    }
    PG8_WAIT_V(0);
    if constexpr (!ALIGN_EPI) { if (wr == 0) PG8_BAR; }
    PG8_BAR;
    if constexpr (Epi::AFTER_DRAIN) { E.fused(acc, cur, wr, wc, fr, fq, lds, wid, lane); S.done(cur); }
#undef PG8_ROWOFFS
#undef PG8_SA
#undef PG8_SB
#undef PG8_STAGE
#undef PG8_LDA
#undef PG8_LDB
#undef PG8_MMA
#undef PG8_WAIT_V
#undef PG8_WAIT_L
#undef PG8_BAR
#undef PG8_SCHED
}
}


#ifndef PG8_SP2
#define PG8_SP2 true
#endif
#ifndef PG8_ALIGN
#define PG8_ALIGN true
#endif
#ifndef MK_LAUNCHES
#define MK_LAUNCHES 1
#endif

#define GAS __attribute__((address_space(1)))
#define LAS __attribute__((address_space(3)))
typedef unsigned short bf16;
typedef float f32x4 __attribute__((ext_vector_type(4)));
typedef unsigned u32x4 __attribute__((ext_vector_type(4)));
typedef unsigned u32x2 __attribute__((ext_vector_type(2)));

constexpr int NB = 8, SEQ = 4096, DM = 1024, NMETA = 16;
constexpr int ROWS = 4160, PADR = 48, TOK0 = 64;
constexpr int MTOK = NB * SEQ;
constexpr int NIN = 3584;
constexpr int BROWS = NB * ROWS;
constexpr size_t ARR = (size_t)BROWS * 512;
constexpr int NCH = 64;
constexpr int NEXP = 16, DEXP = 512;
constexpr int XS_ROWS = 69632;
constexpr float ALPHA = 1.189207115002721f;
constexpr float LN_EPS = 1e-5f, RMS_EPS = 1e-6f;
constexpr float LOG2E = 1.4426950408889634f;
constexpr float C2Q = 0.125f * LOG2E;
constexpr float STICK_THR = 48.0f;

constexpr size_t MiB = 1u << 20;
constexpr size_t WS_CTL = 0, CTL_ZERO_BYTES = 1 * MiB;
constexpr size_t WS_WIN = 1 * MiB;
constexpr size_t WS_WOUT = 8 * MiB;
constexpr size_t WS_LB = 10 * MiB;
constexpr size_t WS_META = 11 * MiB;
constexpr size_t WS_LIST = 13 * MiB;
constexpr size_t WS_DV = 12 * MiB;
constexpr size_t WS_XB = 16 * MiB;
constexpr size_t WS_S = 16 * MiB;
constexpr size_t WS_PROJ = 80 * MiB;
constexpr size_t WS_U = 308 * MiB;
constexpr size_t WS_MIX = 436 * MiB;
constexpr size_t WS_Y1 = 308 * MiB;
constexpr size_t WS_H1 = 16 * MiB;
constexpr size_t WS_W13 = 80 * MiB;
constexpr size_t WS_W2 = 112 * MiB;
constexpr size_t WS_XS = 128 * MiB;
constexpr size_t WS_HID = 264 * MiB;
constexpr size_t WS_YS = 332 * MiB;
constexpr size_t WS_END = 500 * MiB;
static_assert(WS_PROJ + 7 * ARR * 2 <= WS_U && WS_U + (size_t)32 * 64 * 16384 * 4 <= WS_MIX && WS_MIX + (size_t)MTOK * DM * 2 <= WS_END, "ws map A");
static_assert(WS_W13 + (size_t)16 * 1024 * 1024 * 2 <= WS_W2 && WS_W2 + (size_t)16 * 1024 * 512 * 2 <= WS_XS && WS_XS + (size_t)XS_ROWS * 1024 * 2 <= WS_HID &&
              WS_HID + (size_t)XS_ROWS * 512 * 2 <= WS_YS && WS_YS + (size_t)XS_ROWS * 1024 * 2 <= WS_END, "ws map B");
constexpr int CW_CNT = 64;
constexpr int CW_BAR = 4096;
constexpr int MISC_BAR = 100;

constexpr int RING_BYTES = 131072;
constexpr int MISC_OFF = RING_BYTES;
constexpr int LDS_BYTES = 147456;
constexpr int NWAVES = 8, NTHREADS = 512;

#define LBAR() do { asm volatile("s_waitcnt lgkmcnt(0)" ::: "memory"); __builtin_amdgcn_s_barrier(); asm volatile("" ::: "memory"); } while (0)
__device__ __forceinline__ unsigned f2bf(float f) { unsigned u = __builtin_bit_cast(unsigned, f); return (u + 0x7fffu + ((u >> 16) & 1u)) >> 16; }
typedef float f32x2_t __attribute__((ext_vector_type(2))); typedef __bf16 bf16x2_t __attribute__((ext_vector_type(2)));
__device__ __forceinline__ unsigned pk2(float lo, float hi) { f32x2_t v = {lo, hi}; bf16x2_t b = __builtin_convertvector(v, bf16x2_t); return __builtin_bit_cast(unsigned, b); }
__device__ __forceinline__ float bf2f(unsigned h) { return __builtin_bit_cast(float, h << 16); }
__device__ __forceinline__ float bflo(unsigned w) { return __builtin_bit_cast(float, w << 16); }
__device__ __forceinline__ float bfhi(unsigned w) { return __builtin_bit_cast(float, w & 0xffff0000u); }
__device__ __forceinline__ float ex2(float x) { return __builtin_amdgcn_exp2f(x); }
__device__ __forceinline__ float lg2(float x) { return __builtin_amdgcn_logf(x); }
__device__ __forceinline__ float rcpf_(float x) { return __builtin_amdgcn_rcpf(x); }
__device__ __forceinline__ float sigm(float v) { return rcpf_(1.f + ex2(-v * LOG2E)); }
__device__ __forceinline__ float wave_sum(float v) {
#pragma unroll
    for (int o = 1; o < 64; o <<= 1) v += __shfl_xor(v, o);
    return v;
}
template <int XF> __device__ __forceinline__ float xform(float v, float lb) {
    if (XF == 0) return v * sigm(v);
    if (XF == 1) return lg2(lb + (1.f - lb) * sigm(v));
    if (XF == 3) return sigm(v);
    if (XF == 4) return v * C2Q;
    return v;
}
__device__ __forceinline__ float xform_rt(int kind, float v, float lb) {
    switch (kind) { case 0: return xform<0>(v, lb); case 1: return xform<1>(v, lb); case 3: return xform<3>(v, lb); case 4: return xform<4>(v, lb); default: return v; }
}

using pg8::Unit;
struct EpiProj {
    static constexpr bool PERM = true, AFTER_DRAIN = false;
    bf16* proj; const float* lb;
    template <int XF> __device__ __forceinline__ void run(int kind, const f32x4 (&acc)[2][2][4][2], const Unit& u, int wr, int wc, int fr, int fq) const {
        const int b = u.pm >> 4;
        const int r0 = b * ROWS + TOK0 + (u.pm & 15) * 256 + wr * 64 + fr;
        const int c0 = (u.pn & 1) * 256 + wc * 32 + 8 * fq;
        bf16* base = proj + (size_t)kind * ARR;
        f32x4 l0[2], l1[2];
#pragma unroll
        for (int bj = 0; bj < 2; ++bj) {
            if (XF == 1) { l0[bj] = *(const f32x4*)(lb + c0 + bj * 128); l1[bj] = *(const f32x4*)(lb + c0 + bj * 128 + 4); }
            else { l0[bj] = (f32x4){0.f, 0.f, 0.f, 0.f}; l1[bj] = l0[bj]; }
        }
#pragma unroll
        for (int ai = 0; ai < 2; ++ai)
#pragma unroll
            for (int m = 0; m < 4; ++m) {
                bf16* rowp = base + (size_t)(r0 + ai * 128 + m * 16) * 512 + c0;
#pragma unroll
                for (int bj = 0; bj < 2; ++bj) {
                    const f32x4 v0 = acc[ai][bj][m][0], v1 = acc[ai][bj][m][1];
                    u32x4 w;
                    w.x = pk2(xform<XF>(v0[0], l0[bj][0]), xform<XF>(v0[1], l0[bj][1]));
                    w.y = pk2(xform<XF>(v0[2], l0[bj][2]), xform<XF>(v0[3], l0[bj][3]));
                    w.z = pk2(xform<XF>(v1[0], l1[bj][0]), xform<XF>(v1[1], l1[bj][1]));
                    w.w = pk2(xform<XF>(v1[2], l1[bj][2]), xform<XF>(v1[3], l1[bj][3]));
                    __builtin_nontemporal_store(w, (u32x4*)(rowp + bj * 128));
                }
            }
    }
    __device__ __forceinline__ void operator()(const f32x4 (&acc)[2][2][4][2], const Unit& u, int wr, int wc, int fr, int fq) const {
        const int kind = u.pn >> 1;
        if (kind == 0) run<0>(kind, acc, u, wr, wc, fr, fq);
        else if (kind == 1) run<1>(kind, acc, u, wr, wc, fr, fq);
        else if (kind == 3) run<3>(kind, acc, u, wr, wc, fr, fq);
        else if (kind == 4) run<4>(kind, acc, u, wr, wc, fr, fq);
        else run<2>(kind, acc, u, wr, wc, fr, fq);
    }
};
struct EpiOut {
    static constexpr bool PERM = false, AFTER_DRAIN = false;
    const float* x; float* out;
    __device__ __forceinline__ void operator()(const f32x4 (&acc)[2][2][4][2], const Unit& u, int wr, int wc, int fr, int fq) const {
        const int row0 = u.pm * 256 + wr * 64 + fr, col0 = u.pn * 256 + wc * 32 + 4 * fq;
#pragma unroll
        for (int ai = 0; ai < 2; ++ai)
#pragma unroll
            for (int m = 0; m < 4; ++m) {
                const size_t ro = (size_t)(row0 + ai * 128 + m * 16) * DM + col0;
#pragma unroll
                for (int bj = 0; bj < 2; ++bj)
#pragma unroll
                    for (int n = 0; n < 2; ++n) {
                        const f32x4 xv = *(const f32x4*)(x + ro + bj * 128 + 16 * n);
                        *(f32x4*)(out + ro + bj * 128 + 16 * n) = acc[ai][bj][m][n] + xv * ALPHA;
                    }
            }
    }
};
struct EpiHid {
    static constexpr bool PERM = true, AFTER_DRAIN = false;
    bf16* hid;
    __device__ __forceinline__ void operator()(const f32x4 (&acc)[2][2][4][2], const Unit& u, int wr, int wc, int fr, int fq) const {
        const int row0 = u.pm * 256 + wr * 64 + fr, hc0 = (u.pn & 3) * 128 + wc * 16 + 4 * fq;
#pragma unroll
        for (int ai = 0; ai < 2; ++ai)
#pragma unroll
            for (int m = 0; m < 4; ++m) {
                bf16* rowp = hid + (size_t)(row0 + ai * 128 + m * 16) * DEXP + hc0;
#pragma unroll
                for (int bj = 0; bj < 2; ++bj) {
                    const f32x4 g = acc[ai][bj][m][0], up = acc[ai][bj][m][1];
                    u32x2 w;
                    w.x = pk2(g[0] * sigm(g[0]) * up[0], g[1] * sigm(g[1]) * up[1]);
                    w.y = pk2(g[2] * sigm(g[2]) * up[2], g[3] * sigm(g[3]) * up[3]);
                    __builtin_nontemporal_store(w, (u32x2*)(rowp + bj * 64));
                }
            }
    }
};
struct EpiYs {
    static constexpr bool PERM = true, AFTER_DRAIN = false;
    bf16* ys;
    __device__ __forceinline__ void operator()(const f32x4 (&acc)[2][2][4][2], const Unit& u, int wr, int wc, int fr, int fq) const {
        const int row0 = u.pm * 256 + wr * 64 + fr, col0 = (u.pn & 3) * 256 + wc * 32 + 8 * fq;
#pragma unroll
        for (int ai = 0; ai < 2; ++ai)
#pragma unroll
            for (int m = 0; m < 4; ++m) {
                bf16* rowp = ys + (size_t)(row0 + ai * 128 + m * 16) * DM + col0;
#pragma unroll
                for (int bj = 0; bj < 2; ++bj) {
                    const f32x4 v0 = acc[ai][bj][m][0], v1 = acc[ai][bj][m][1];
                    u32x4 w; w.x = pk2(v0[0], v0[1]); w.y = pk2(v0[2], v0[3]); w.z = pk2(v1[0], v1[1]); w.w = pk2(v1[2], v1[3]);
                    __builtin_nontemporal_store(w, (u32x4*)(rowp + bj * 128));
                }
            }
    }
};
struct MoeOrder {
    const LAS int* toff; int G, c, ntot; const int* list;
    __device__ __forceinline__ int a_row(const Unit& u, int r) const {
        const int e = u.pn >> 2, pos = (u.pm - toff[e]) * 256 + r;
        return (pos < toff[64 + e]) ? list[e * 32768 + pos] : 0;
    }
    __device__ __forceinline__ bool next(int i, Unit& u) const {
        const long L = (long)i * G + c; if (L >= (long)ntot * 4) return false;
        const int mt = (int)(L >> 2), pl = (int)(L & 3); int e = 0;
#pragma unroll
        for (int j = 1; j < NEXP; ++j) e += (mt >= toff[j]) ? 1 : 0;
        u.pm = mt; u.pn = e * 4 + pl; return true;
    }
    __device__ __forceinline__ void a_ready(const Unit&) const {}
    __device__ __forceinline__ void done(const Unit&) const {}
};

struct Args { const float* in[18]; float* out; unsigned char* ws; int ph_lo, ph_hi; };
struct Frame {
    LAS unsigned char* lds; LAS int* misc;
    int tid, lane, wave, G, gw, ngw;
};

template <int MODE> __device__ __forceinline__ int rowmap(int n) { return MODE == 0 ? n : ((n >> 2) * 8 + (n & 3) + (MODE == 2 ? 4 : 0)); }
template <int MODE> __device__ __forceinline__ void transpose_item(const float* W, int K, int N, bf16* WT, LAS float* scr, int item, int lane) {
    const int nblk = N / 32, kb = item / nblk, nb = item % nblk, k0 = 64 * kb, n0 = 32 * nb;
#pragma unroll
    for (int i = 0; i < 8; ++i) { const int kk = 8 * i + (lane >> 3), c4 = (lane & 7) * 4;
        const f32x4 v = __builtin_nontemporal_load((const f32x4*)(W + (size_t)(k0 + kk) * N + n0 + c4));
        LAS float* d = scr + kk * 33 + c4; d[0] = v[0]; d[1] = v[1]; d[2] = v[2]; d[3] = v[3]; }
    asm volatile("s_waitcnt lgkmcnt(0)" ::: "memory");
    const int c = lane & 7;
#pragma unroll
    for (int j = 0; j < 4; ++j) { const int n = (lane >> 3) + 8 * j; const LAS float* s = scr + (8 * c) * 33 + n;
        u32x4 o; o.x = pk2(s[0 * 33], s[1 * 33]); o.y = pk2(s[2 * 33], s[3 * 33]); o.z = pk2(s[4 * 33], s[5 * 33]); o.w = pk2(s[6 * 33], s[7 * 33]);
        *(u32x4*)(WT + (size_t)rowmap<MODE>(n0 + n) * K + k0 + 8 * c) = o; }
    asm volatile("s_waitcnt lgkmcnt(0)" ::: "memory");
}

__device__ __forceinline__ void p0_prep(Frame& F, const Args& A) {
    LAS float* scr = (LAS float*)(F.lds + F.wave * 16384);
    const int gtid = blockIdx.x * NTHREADS + F.tid, gthreads = F.G * NTHREADS;
    for (int i = gtid; i < 512; i += gthreads) ((float*)(A.ws + WS_LB))[i] = 1.f / (1.f + __expf(A.in[3][512 + i] - A.in[3][i]));
    for (int i = gtid; i < 7 * NB * 3072; i += gthreads) {
        const int a = i / (NB * 3072), r = i % (NB * 3072), b = r / 3072, o = r % 3072;
        *(u32x4*)(((bf16*)(A.ws + WS_PROJ)) + (size_t)a * ARR + (size_t)b * ROWS * 512 + (size_t)o * 8) = (u32x4){0u, 0u, 0u, 0u};
    }
    for (int job = F.gw; job < 56 * 16; job += F.ngw) {
        const int cgp = job >> 4, kq = job & 15, n = cgp * 64 + F.lane;
        float acc[16];
#pragma unroll
        for (int r = 0; r < 16; ++r) acc[r] = 0.f;
        const float* mt = A.in[1] + 64 * kq; const float* wp = A.in[2] + (size_t)(64 * kq) * NIN + n;
#pragma unroll 8
        for (int k = 0; k < 64; ++k) {
            const float w = wp[(size_t)k * NIN];
#pragma unroll
            for (int r = 0; r < 16; ++r) acc[r] += mt[r * DM + k] * w;
        }
        float* mp = ((float*)(A.ws + WS_U)) + (size_t)(kq * 16) * NIN + n;
#pragma unroll
        for (int r = 0; r < 16; ++r) mp[(size_t)r * NIN] = acc[r];
    }
    constexpr int I_IN = (DM / 64) * (NIN / 32), I_OUT = (DM / 64) * (DM / 32);
    for (int it = F.gw; it < I_IN + I_OUT; it += F.ngw) {
        if (it < I_IN) transpose_item<0>(A.in[2], DM, NIN, ((bf16*)(A.ws + WS_WIN)), scr, it, F.lane);
        else transpose_item<0>(A.in[6], DM, DM, ((bf16*)(A.ws + WS_WOUT)), scr, it - I_IN, F.lane);
    }
    for (int m = 2 * F.gw; m < MTOK; m += 2 * F.ngw) {
        const f32x4* xr = (const f32x4*)(A.in[0] + (size_t)m * DM) + F.lane;
        u32x2* o8 = (u32x2*)(((bf16*)(A.ws + WS_XB)) + (size_t)m * DM) + F.lane;
        f32x4 v[8];
#pragma unroll
        for (int j = 0; j < 8; ++j) v[j] = __builtin_nontemporal_load(xr + 64 * j);
#pragma unroll
        for (int j = 0; j < 8; ++j) { u32x2 w; w.x = pk2(v[j][0], v[j][1]); w.y = pk2(v[j][2], v[j][3]); o8[64 * j] = w; }
    }
}

__device__ __forceinline__ void meta_finalize(Frame& F, const Args& A) {
    const float* mp = (const float*)(A.ws + WS_U); const float* lb = (const float*)(A.ws + WS_LB);
    for (int idx = blockIdx.x * NTHREADS + F.tid; idx < 16 * NIN; idx += F.G * NTHREADS) {
        const int r = idx / NIN, n = idx % NIN, kind = n >> 9, col = n & 511;
        float v = 0.f;
#pragma unroll
        for (int kq = 0; kq < 16; ++kq) v += mp[(size_t)(kq * 16 + r) * NIN + n];
        const unsigned short o = (unsigned short)f2bf(xform_rt(kind, v, lb[col]));
        bf16* p = ((bf16*)(A.ws + WS_PROJ)) + (size_t)kind * ARR + (size_t)(PADR + r) * 512 + col;
#pragma unroll
        for (int b = 0; b < NB; ++b) p[(size_t)b * ROWS * 512] = o;
    }
}

typedef short s16x8 __attribute__((ext_vector_type(8)));
typedef short v4i16_t __attribute__((ext_vector_type(4)));
__device__ __forceinline__ s16x8 tr8(const LAS unsigned char* p, int rowskip) {
    const v4i16_t lo = __builtin_amdgcn_ds_read_tr16_b64_v4i16((LAS v4i16_t*)p);
    const v4i16_t hh = __builtin_amdgcn_ds_read_tr16_b64_v4i16((LAS v4i16_t*)(p + rowskip));
    return (s16x8){lo[0], lo[1], lo[2], lo[3], hh[0], hh[1], hh[2], hh[3]};
}
struct RawTile { u32x4 a, b; };
__device__ __forceinline__ RawTile raw_load(const bf16* arr, int b, int h, int c, int tid) {
    const bf16* p = arr + (size_t)(b * ROWS + 64 * c + (tid >> 4)) * 512 + 128 * h + 8 * (tid & 15);
    RawTile r; r.a = *(const u32x4*)p; r.b = *(const u32x4*)(p + (size_t)32 * 512); return r;
}
__device__ __forceinline__ void raw_store(LAS unsigned char* dst, int pitch, const RawTile& r, int tid) {
    LAS unsigned char* p = dst + (tid >> 4) * pitch + (tid & 15) * 16;
    *(LAS u32x4*)p = r.a; *(LAS u32x4*)(p + 32 * pitch) = r.b;
}
constexpr int PRAW = 272;
constexpr int PKT = 144;
__device__ __forceinline__ void ha_phase(Frame& F, const Args& A) {
    const bf16* LF = ((bf16*)(A.ws + WS_PROJ)) + 1 * ARR; const bf16* HV = ((bf16*)(A.ws + WS_PROJ)) + 2 * ARR;
    LAS unsigned char* RLF = F.lds;
    LAS unsigned char* VN = RLF + 64 * PRAW;
    LAS unsigned char* KT = VN + 64 * PRAW;
    LAS float* TOT = (LAS float*)(KT + 128 * PKT);
    const int tid = F.tid, lane = F.lane, w = F.wave, fr = lane & 15, fq = lane >> 4;
    const int d = tid & 127, sq = tid >> 7;
    int u = blockIdx.x;
    RawTile rl, rv;
    if (u < 32 * 64) { rl = raw_load(LF, u >> 8, (u >> 6) & 3, u & 63, tid); rv = raw_load(HV, u >> 8, (u >> 6) & 3, u & 63, tid); }
    for (; u < 32 * 64; u += F.G) {
        const int bh = u >> 6, c = u & 63;
        raw_store(RLF, PRAW, rl, tid); raw_store(VN, PRAW, rv, tid);
        LBAR();
        { const int un = u + F.G; if (un < 32 * 64) { rl = raw_load(LF, un >> 8, (un >> 6) & 3, un & 63, tid); rv = raw_load(HV, un >> 8, (un >> 6) & 3, un & 63, tid); } }
        float lf[16], pre[16]; float run = 0.f;
#pragma unroll
        for (int i = 0; i < 16; ++i) { lf[i] = bf2f(*(const LAS unsigned short*)(RLF + (16 * sq + i) * PRAW + 2 * d)); run += lf[i]; pre[i] = run; }
        TOT[sq * 128 + d] = run;
        LBAR();
        float off = 0.f, blast = 0.f;
#pragma unroll
        for (int q = 0; q < 4; ++q) { const float t = TOT[q * 128 + d]; off += (q < sq) ? t : 0.f; blast += t; }
        { unsigned kw[8];
#pragma unroll
          for (int i = 0; i < 8; ++i) { const float k0 = (1.f - ex2(lf[2 * i])) * ex2(blast - (off + pre[2 * i])), k1 = (1.f - ex2(lf[2 * i + 1])) * ex2(blast - (off + pre[2 * i + 1])); kw[i] = pk2(k0, k1); }
          LAS u32x4* kp = (LAS u32x4*)(KT + d * PKT + 32 * sq);
          kp[0] = (u32x4){kw[0], kw[1], kw[2], kw[3]}; kp[1] = (u32x4){kw[4], kw[5], kw[6], kw[7]}; }
        if (sq == 0) ((float*)(A.ws + WS_DV))[(size_t)(bh * 64 + c) * 128 + d] = ex2(blast);
        LBAR();
        const LAS unsigned char* vt = VN + (8 * fq + (fr >> 2)) * PRAW + (16 * w + 4 * (fr & 3)) * 2;
        const s16x8 b0 = tr8(vt, 4 * PRAW), b1 = tr8(vt + 32 * PRAW, 4 * PRAW);
        bf16* up = ((bf16*)(A.ws + WS_U)) + (size_t)(bh * 64 + c) * 16384 + (size_t)(16 * w + fr) * 128 + 4 * fq;
#pragma unroll
        for (int dt = 0; dt < 8; ++dt) {
            const LAS unsigned char* kp = KT + (16 * dt + fr) * PKT + 16 * fq;
            const s16x8 a0 = *(const LAS s16x8*)kp, a1 = *(const LAS s16x8*)(kp + 64);
            f32x4 acc = (f32x4){0.f, 0.f, 0.f, 0.f};
            acc = __builtin_amdgcn_mfma_f32_16x16x32_bf16(a0, b0, acc, 0, 0, 0);
            acc = __builtin_amdgcn_mfma_f32_16x16x32_bf16(a1, b1, acc, 0, 0, 0);
            { u32x2 o; o.x = pk2(acc[0], acc[1]); o.y = pk2(acc[2], acc[3]); *(u32x2*)(up + 16 * dt) = o; }
        }
        LBAR();
    }
}

typedef float f32x16 __attribute__((ext_vector_type(16)));
__device__ __forceinline__ s16x8 pack8(u32x2 a, u32x2 c) { const u32x4 w = (u32x4){a.x, a.y, c.x, c.y}; return __builtin_bit_cast(s16x8, w); }
struct AttnCtx { const bf16* kbase; const bf16* vbase; LAS unsigned char* vw; const LAS unsigned char* vt; int ktd, qrow, hi; };
__device__ __forceinline__ bool attn_tile(const AttnCtx& C, int kt, const s16x8 (&qf)[4], s16x8 (&kf)[4], u32x4 (&vr)[4], f32x16& o0, f32x16& o1, float& T) {
    const int k0 = 32 * kt, hi = C.hi;
    f32x16 p;
#pragma unroll
    for (int r = 0; r < 16; ++r) p[r] = 0.f;
#pragma unroll
    for (int s2 = 0; s2 < 4; ++s2) p = __builtin_amdgcn_mfma_f32_32x32x16_bf16(kf[s2], qf[s2], p, 0, 0, 0);
#pragma unroll
    for (int i = 0; i < 4; ++i) *(LAS u32x4*)(C.vw + i * 1024) = vr[i];
    s16x8 va[2][2];
#pragma unroll
    for (int dt = 0; dt < 2; ++dt)
#pragma unroll
        for (int s2 = 0; s2 < 2; ++s2) va[dt][s2] = tr8(C.vt + dt * 64 + s2 * 2048, 1024);
    if (kt > 2) {
        const bf16* kp = C.kbase + (size_t)(k0 - 64) * 512; const bf16* vp = C.vbase + (size_t)(k0 - 64) * 512;
#pragma unroll
        for (int s2 = 0; s2 < 4; ++s2) kf[s2] = *(const s16x8*)(kp + 16 * s2);
#pragma unroll
        for (int i = 0; i < 4; ++i) vr[i] = *(const u32x4*)(vp + (size_t)(8 * i) * 512);
    }
    const bool edge = (kt == C.ktd) || (kt == 1);
    float sp[16], iss[16], gs[4];
#pragma unroll
    for (int r = 0; r < 16; ++r) {
        const float z = fminf(p[r], 100.f); p[r] = z;
        float v = lg2(1.f + ex2(z));
        if (edge) { const int key = k0 + (r & 3) + 8 * (r >> 2) + 4 * hi; if (!(key >= PADR && key < C.qrow)) v = 0.f; }
        sp[r] = v;
    }
#pragma unroll
    for (int g = 0; g < 4; ++g) { iss[4 * g + 3] = sp[4 * g + 3]; iss[4 * g + 2] = iss[4 * g + 3] + sp[4 * g + 2]; iss[4 * g + 1] = iss[4 * g + 2] + sp[4 * g + 1]; iss[4 * g] = iss[4 * g + 1] + sp[4 * g]; gs[g] = iss[4 * g]; }
    float sg[4], go[4];
#pragma unroll
    for (int g = 0; g < 4; ++g) { const auto rr = __builtin_amdgcn_permlane32_swap(__float_as_uint(gs[g]), __float_as_uint(gs[g]), false, false);
        sg[g] = __uint_as_float(rr[0]) + __uint_as_float(rr[1]); go[g] = hi ? 0.f : __uint_as_float(rr[1]); }
    float off[4];
    off[3] = T + go[3]; const float e2 = sg[3]; off[2] = T + e2 + go[2]; const float e1 = e2 + sg[2]; off[1] = T + e1 + go[1]; const float e0 = e1 + sg[1]; off[0] = T + e0 + go[0];
    T += e0 + sg[0];
    float a[16];
#pragma unroll
    for (int r = 0; r < 16; ++r) {
        float v = ex2(p[r] - (off[r >> 2] + iss[r]));
        if (edge) { const int key = k0 + (r & 3) + 8 * (r >> 2) + 4 * hi; if (!(key >= PADR && key < C.qrow)) v = 0.f; }
        a[r] = v;
    }
#pragma unroll
    for (int s2 = 0; s2 < 2; ++s2) {
        u32x4 w; w.x = pk2(a[8 * s2], a[8 * s2 + 1]); w.y = pk2(a[8 * s2 + 2], a[8 * s2 + 3]); w.z = pk2(a[8 * s2 + 4], a[8 * s2 + 5]); w.w = pk2(a[8 * s2 + 6], a[8 * s2 + 7]);
        const s16x8 pb = __builtin_bit_cast(s16x8, w);
        o0 = __builtin_amdgcn_mfma_f32_32x32x16_bf16(va[0][s2], pb, o0, 0, 0, 0);
        o1 = __builtin_amdgcn_mfma_f32_32x32x16_bf16(va[1][s2], pb, o1, 0, 0, 0);
    }
    return __all(T > STICK_THR) || kt == 1;
}
__device__ __forceinline__ void attn_phase(Frame& F, const Args& A) {
    const bf16* SQ = ((bf16*)(A.ws + WS_PROJ)) + 4 * ARR; const bf16* SK = ((bf16*)(A.ws + WS_PROJ)) + 5 * ARR; const bf16* SV = ((bf16*)(A.ws + WS_PROJ)) + 6 * ARR;
    const int r32 = F.lane & 31, hi = F.lane >> 5;
    AttnCtx C;
    C.vw = F.lds + F.wave * 4096 + (F.lane >> 3) * 128 + (F.lane & 7) * 16;
    C.vt = F.lds + F.wave * 4096 + (4 * hi + ((F.lane & 15) >> 2)) * 128 + ((F.lane >> 4) & 1) * 32 + (F.lane & 3) * 8;
    C.hi = hi;
    for (int wu = F.gw; wu < 64 * 128; wu += F.ngw) {
        const int bh = wu >> 7, qi = wu & 127, b = bh >> 3, h = bh & 7, q0 = TOK0 + 32 * qi;
        C.qrow = q0 + r32; C.ktd = q0 >> 5;
        s16x8 qf[4];
        { const bf16* qp = SQ + (size_t)(b * ROWS + C.qrow) * 512 + 64 * h + 8 * hi;
#pragma unroll
          for (int s2 = 0; s2 < 4; ++s2) qf[s2] = *(const s16x8*)(qp + 16 * s2); }
        C.kbase = SK + (size_t)(b * ROWS + r32) * 512 + 64 * h + 8 * hi;
        C.vbase = SV + (size_t)(b * ROWS + (F.lane >> 3)) * 512 + 64 * h + 8 * (F.lane & 7);
        f32x16 o0, o1;
#pragma unroll
        for (int r = 0; r < 16; ++r) { o0[r] = 0.f; o1[r] = 0.f; }
        float T = 0.f;
        s16x8 kfA[4], kfB[4]; u32x4 vrA[4], vrB[4];
        { const bf16* kp = C.kbase + (size_t)(32 * C.ktd) * 512; const bf16* vp = C.vbase + (size_t)(32 * C.ktd) * 512;
#pragma unroll
          for (int s2 = 0; s2 < 4; ++s2) { kfA[s2] = *(const s16x8*)(kp + 16 * s2); kfB[s2] = *(const s16x8*)(kp - (size_t)32 * 512 + 16 * s2); }
#pragma unroll
          for (int i = 0; i < 4; ++i) { vrA[i] = *(const u32x4*)(vp + (size_t)(8 * i) * 512); vrB[i] = *(const u32x4*)(vp - (size_t)32 * 512 + (size_t)(8 * i) * 512); } }
        for (int kt = C.ktd;; kt -= 2) {
            if (attn_tile(C, kt, qf, kfA, vrA, o0, o1, T)) break;
            if (attn_tile(C, kt - 1, qf, kfB, vrB, o0, o1, T)) break;
        }
        float ss = 0.f;
#pragma unroll
        for (int r = 0; r < 16; ++r) ss += o0[r] * o0[r] + o1[r] * o1[r];
        { const auto rr = __builtin_amdgcn_permlane32_swap(__float_as_uint(ss), __float_as_uint(ss), false, false); ss = __uint_as_float(rr[0]) + __uint_as_float(rr[1]); }
        const float rs = 1.0f / sqrtf(ss * (1.f / 64.f) + RMS_EPS);
        const float* gp = A.in[5] + 64 * h + 4 * hi;
        bf16* op = ((bf16*)(A.ws + WS_MIX)) + (size_t)(b * SEQ + C.qrow - TOK0) * DM + 512 + 64 * h + 4 * hi;
#pragma unroll
        for (int g = 0; g < 4; ++g) {
            const f32x4 g0 = *(const f32x4*)(gp + 8 * g), g1 = *(const f32x4*)(gp + 32 + 8 * g);
            u32x2 w0, w1;
            w0.x = pk2(o0[4 * g] * rs * g0[0], o0[4 * g + 1] * rs * g0[1]); w0.y = pk2(o0[4 * g + 2] * rs * g0[2], o0[4 * g + 3] * rs * g0[3]);
            w1.x = pk2(o1[4 * g] * rs * g1[0], o1[4 * g + 1] * rs * g1[1]); w1.y = pk2(o1[4 * g + 2] * rs * g1[2], o1[4 * g + 3] * rs * g1[3]);
            *(u32x2*)(op + 8 * g) = w0; *(u32x2*)(op + 32 + 8 * g) = w1;
        }
    }
}

__device__ __forceinline__ void hb_phase(Frame& F, const Args& A) {
    LAS float* DVL = (LAS float*)F.lds;
    for (int job = blockIdx.x; job < 32 * 8; job += F.G) {
        const int bh = job >> 3, v = (job & 7) * 16 + (F.tid >> 5), d4 = (F.tid & 31) * 4;
        { const f32x4* src = (const f32x4*)(((const float*)(A.ws + WS_DV)) + (size_t)bh * 64 * 128);
#pragma unroll
          for (int i = 0; i < 4; ++i) ((LAS f32x4*)DVL)[F.tid + 512 * i] = src[F.tid + 512 * i]; }
        __syncthreads();
        const bf16* up = ((bf16*)(A.ws + WS_U)) + (size_t)bh * 64 * 16384 + v * 128 + d4;
        bf16* sp = ((bf16*)(A.ws + WS_S)) + (size_t)bh * 64 * 16384 + v * 128 + d4;
        f32x4 s = (f32x4){0.f, 0.f, 0.f, 0.f};
#pragma unroll 16
        for (int c = 0; c < 64; ++c) {
            const u32x2 ub = __builtin_nontemporal_load((const u32x2*)(up + (size_t)c * 16384));
            const f32x4 uu = (f32x4){bflo(ub.x), bfhi(ub.x), bflo(ub.y), bfhi(ub.y)}, dd = *(const LAS f32x4*)(DVL + c * 128 + d4);
            s = dd * s + uu;
            u32x2 w; w.x = pk2(s[0], s[1]); w.y = pk2(s[2], s[3]);
            *(u32x2*)(sp + (size_t)c * 16384) = w;
        }
        __syncthreads();
    }
}

__device__ __forceinline__ void hc_phase(Frame& F, const Args& A) {
    const bf16* HQ = ((bf16*)(A.ws + WS_PROJ)); const bf16* LF = HQ + 1 * ARR; const bf16* HV = HQ + 2 * ARR; const bf16* HG = HQ + 3 * ARR;
    LAS unsigned char* RLF = F.lds;
    LAS unsigned char* RQ = RLF + 64 * PRAW;
    LAS unsigned char* VN = RQ + 64 * PRAW;
    LAS unsigned char* QT = VN + 64 * PRAW;
    LAS unsigned char* KI = QT + 64 * PRAW;
    LAS unsigned char* SC = KI + 64 * PRAW;
    LAS float* TOT = (LAS float*)(SC + 64 * PKT);
    LAS float* SSQ = TOT + 512;
    const int tid = F.tid, lane = F.lane, w = F.wave, fr = lane & 15, fq = lane >> 4;
    const int d = tid & 127, sq = tid >> 7;
    int u = blockIdx.x;
    RawTile rl, rq, rv;
    if (u < 32 * 64) { const int b = u >> 8, h = (u >> 6) & 3, cc = (u & 63) + 1; rl = raw_load(LF, b, h, cc, tid); rq = raw_load(HQ, b, h, cc, tid); rv = raw_load(HV, b, h, cc, tid); }
    for (; u < 32 * 64; u += F.G) {
        const int bh = u >> 6, b = bh >> 2, h = bh & 3, cc = (u & 63) + 1;
        raw_store(RLF, PRAW, rl, tid); raw_store(RQ, PRAW, rq, tid); raw_store(VN, PRAW, rv, tid);
        LBAR();
        { const int un = u + F.G; if (un < 32 * 64) { const int b2 = un >> 8, h2 = (un >> 6) & 3, c2 = (un & 63) + 1; rl = raw_load(LF, b2, h2, c2, tid); rq = raw_load(HQ, b2, h2, c2, tid); rv = raw_load(HV, b2, h2, c2, tid); } }
        s16x8 sa[4]; u32x2 gt[4];
        { const bf16* sp = ((bf16*)(A.ws + WS_S)) + (size_t)(bh * 64 + cc - 1) * 16384 + (size_t)(16 * w + fr) * 128 + 8 * fq;
#pragma unroll
          for (int ks = 0; ks < 4; ++ks) sa[ks] = *(const s16x8*)(sp + 32 * ks);
          const bf16* gp = HG + (size_t)(b * ROWS + 64 * cc + fr) * 512 + 128 * h + 16 * w + 4 * fq;
#pragma unroll
          for (int tt = 0; tt < 4; ++tt) gt[tt] = *(const u32x2*)(gp + (size_t)(16 * tt) * 512); }
        {
            float lf[16], pre[16], qv[16]; float run = 0.f;
#pragma unroll
            for (int i = 0; i < 16; ++i) { lf[i] = bf2f(*(const LAS unsigned short*)(RLF + (16 * sq + i) * PRAW + 2 * d)); qv[i] = bf2f(*(const LAS unsigned short*)(RQ + (16 * sq + i) * PRAW + 2 * d)); run += lf[i]; pre[i] = run; }
            TOT[sq * 128 + d] = run;
            LBAR();
            float off = 0.f;
#pragma unroll
            for (int q = 0; q < 4; ++q) { const float t = TOT[q * 128 + d]; off += (q < sq) ? t : 0.f; }
#pragma unroll
            for (int i = 0; i < 16; ++i) { const float bc = off + pre[i];
                *(LAS unsigned short*)(QT + (16 * sq + i) * PRAW + 2 * d) = (unsigned short)f2bf(qv[i] * ex2(bc));
                *(LAS unsigned short*)(KI + (16 * sq + i) * PRAW + 2 * d) = (unsigned short)f2bf((1.f - ex2(lf[i])) * ex2(-bc)); }
        }
        LBAR();
        {
            const int tt = w >> 1;
            s16x8 bq[4];
            const LAS unsigned char* qp = QT + (16 * tt + fr) * PRAW + 16 * fq;
#pragma unroll
            for (int ks = 0; ks < 4; ++ks) bq[ks] = *(const LAS s16x8*)(qp + 64 * ks);
#pragma unroll
            for (int j = 0; j < 2; ++j) {
                const int st = 2 * (w & 1) + j;
                const LAS unsigned char* kp = KI + (16 * st + fr) * PRAW + 16 * fq;
                f32x4 acc = (f32x4){0.f, 0.f, 0.f, 0.f};
#pragma unroll
                for (int ks = 0; ks < 4; ++ks) acc = __builtin_amdgcn_mfma_f32_16x16x32_bf16(*(const LAS s16x8*)(kp + 64 * ks), bq[ks], acc, 0, 0, 0);
                const int t = 16 * tt + fr, s0 = 16 * st + 4 * fq;
                u32x2 wv; wv.x = pk2(s0 <= t ? acc[0] : 0.f, s0 + 1 <= t ? acc[1] : 0.f); wv.y = pk2(s0 + 2 <= t ? acc[2] : 0.f, s0 + 3 <= t ? acc[3] : 0.f);
                *(LAS u32x2*)(SC + t * PKT + 2 * s0) = wv;
            }
        }
        LBAR();
        f32x4 acc[4];
        {
            const LAS unsigned char* vt = VN + (8 * fq + (fr >> 2)) * PRAW + (16 * w + 4 * (fr & 3)) * 2;
            const s16x8 av0 = tr8(vt, 4 * PRAW), av1 = tr8(vt + 32 * PRAW, 4 * PRAW);
#pragma unroll
            for (int tt = 0; tt < 4; ++tt) {
                const LAS unsigned char* scp = SC + (16 * tt + fr) * PKT + 16 * fq;
                const LAS unsigned char* qp = QT + (16 * tt + fr) * PRAW + 16 * fq;
                f32x4 c = (f32x4){0.f, 0.f, 0.f, 0.f};
                c = __builtin_amdgcn_mfma_f32_16x16x32_bf16(av0, *(const LAS s16x8*)scp, c, 0, 0, 0);
                c = __builtin_amdgcn_mfma_f32_16x16x32_bf16(av1, *(const LAS s16x8*)(scp + 64), c, 0, 0, 0);
#pragma unroll
                for (int ks = 0; ks < 4; ++ks) c = __builtin_amdgcn_mfma_f32_16x16x32_bf16(sa[ks], *(const LAS s16x8*)(qp + 64 * ks), c, 0, 0, 0);
                acc[tt] = c;
                float ss = (c[0] * c[0] + c[1] * c[1]) + (c[2] * c[2] + c[3] * c[3]);
                ss += __shfl_xor(ss, 16); ss += __shfl_xor(ss, 32);
                if (fq == 0) SSQ[w * 64 + 16 * tt + fr] = ss;
            }
        }
        LBAR();
        {
            const f32x4 ng = *(const f32x4*)(A.in[4] + 128 * h + 16 * w + 4 * fq);
            bf16* op = ((bf16*)(A.ws + WS_MIX)) + (size_t)(b * SEQ + 64 * (cc - 1) + fr) * DM + 128 * h + 16 * w + 4 * fq;
#pragma unroll
            for (int tt = 0; tt < 4; ++tt) {
                float tot = 0.f;
#pragma unroll
                for (int k = 0; k < 8; ++k) tot += SSQ[k * 64 + 16 * tt + fr];
                const float rs = 1.0f / sqrtf(tot * (1.f / 128.f) + RMS_EPS);
                u32x2 o;
                o.x = pk2(acc[tt][0] * rs * ng[0] * bflo(gt[tt].x), acc[tt][1] * rs * ng[1] * bfhi(gt[tt].x));
                o.y = pk2(acc[tt][2] * rs * ng[2] * bflo(gt[tt].y), acc[tt][3] * rs * ng[3] * bfhi(gt[tt].y));
                *(u32x2*)(op + (size_t)(16 * tt) * DM) = o;
            }
        }
        LBAR();
    }
}

__device__ __forceinline__ void ln_stats(const f32x4 (&v)[4], float& mean, float& rstd) {
    float s = 0.f;
#pragma unroll
    for (int j = 0; j < 4; ++j) s += (v[j][0] + v[j][1]) + (v[j][2] + v[j][3]);
    mean = wave_sum(s) * (1.f / DM);
    float s2 = 0.f;
#pragma unroll
    for (int j = 0; j < 4; ++j) { const f32x4 d = v[j] - mean; s2 += (d[0] * d[0] + d[1] * d[1]) + (d[2] * d[2] + d[3] * d[3]); }
    rstd = 1.0f / sqrtf(wave_sum(s2) * (1.f / DM) + LN_EPS);
}

__device__ __forceinline__ void route_row(Frame& F, const Args& A, const float (&lg)[20], int rl, LAS int* lcnt, LAS int* rec) {
    const float* brg = A.in[10];
    float g0 = lg[0] + brg[0], g1 = lg[1] + brg[1], g2 = lg[2] + brg[2], g3 = lg[3] + brg[3];
    int grp = 0; float gm = g0;
    if (g1 > gm) { gm = g1; grp = 1; } if (g2 > gm) { gm = g2; grp = 2; } if (g3 > gm) { gm = g3; grp = 3; }
    const float pg = 1.f / (__expf(g0 - gm) + __expf(g1 - gm) + __expf(g2 - gm) + __expf(g3 - gm));
    float in0, in1, in2, in3;
    if (grp == 0) { in0 = lg[4]; in1 = lg[5]; in2 = lg[6]; in3 = lg[7]; }
    else if (grp == 1) { in0 = lg[8]; in1 = lg[9]; in2 = lg[10]; in3 = lg[11]; }
    else if (grp == 2) { in0 = lg[12]; in1 = lg[13]; in2 = lg[14]; in3 = lg[15]; }
    else { in0 = lg[16]; in1 = lg[17]; in2 = lg[18]; in3 = lg[19]; }
    const float* be = A.in[12] + grp * 4;
    in0 += be[0]; in1 += be[1]; in2 += be[2]; in3 += be[3];
    int i0 = 0; float m0 = in0;
    if (in1 > m0) { m0 = in1; i0 = 1; } if (in2 > m0) { m0 = in2; i0 = 2; } if (in3 > m0) { m0 = in3; i0 = 3; }
    int i1 = -1; float m1 = 0.f;
    if (i0 != 0) { m1 = in0; i1 = 0; }
    if (i0 != 1 && (i1 < 0 || in1 > m1)) { m1 = in1; i1 = 1; }
    if (i0 != 2 && (i1 < 0 || in2 > m1)) { m1 = in2; i1 = 2; }
    if (i0 != 3 && (i1 < 0 || in3 > m1)) { m1 = in3; i1 = 3; }
    const float w0 = 1.f / (1.f + __expf(m1 - m0)), w1 = 1.f - w0;
    const int e0 = grp * 4 + i0, e1 = grp * 4 + i1;
    const int p0 = atomicAdd((int*)&lcnt[e0], 1), p1 = atomicAdd((int*)&lcnt[e1], 1);
    rec[rl * 6 + 0] = e0; rec[rl * 6 + 1] = p0; rec[rl * 6 + 2] = __float_as_int(pg * w0);
    rec[rl * 6 + 3] = e1; rec[rl * 6 + 4] = p1; rec[rl * 6 + 5] = __float_as_int(pg * w1);
}
__device__ __forceinline__ void p6_ln_router(Frame& F, const Args& A) {
    LAS int* lcnt = F.misc + 32; LAS int* lbase = F.misc + 48;
    LAS f32x4* WL = (LAS f32x4*)F.lds;
    LAS int* rec = (LAS int*)(F.lds + 81920);
    for (int it = F.tid; it < 1024 * 5; it += NTHREADS) {
        const int k = it / 5, c = it % 5, j = k >> 8, ln = (k >> 2) & 63, e = k & 3;
        const f32x4 w = (c == 0) ? *(const f32x4*)(A.in[9] + (size_t)k * 4) : *(const f32x4*)(A.in[11] + (size_t)k * 16 + 4 * (c - 1));
        WL[((j * 4 + e) * 5 + c) * 64 + ln] = w;
    }
    __syncthreads();
    const LAS f32x4* wl = WL + F.lane;
    for (int slab = blockIdx.x; slab < MTOK / 128; slab += F.G) {
        if (F.tid < 16) lcnt[F.tid] = 0;
        __syncthreads();
#pragma unroll 1
        for (int i = 0; i < 16; i += 2) {
            const int rl = F.wave * 16 + i, row = slab * 128 + rl;
            const f32x4* xr0 = (const f32x4*)(A.in[0] + (size_t)row * DM) + F.lane; const f32x4* xr1 = xr0 + DM / 4;
            const u32x2* yr0 = (const u32x2*)(((const bf16*)(A.ws + WS_Y1)) + (size_t)row * DM) + F.lane; const u32x2* yr1 = yr0 + DM / 4;
            u32x2* hb0 = (u32x2*)(((bf16*)(A.ws + WS_H1)) + (size_t)row * DM) + F.lane; u32x2* hb1 = hb0 + DM / 4;
            f32x4 v0[4], v1[4];
#pragma unroll
            for (int j = 0; j < 4; ++j) { const u32x2 y0 = yr0[64 * j], y1 = yr1[64 * j];
                v0[j] = xr0[64 * j] * ALPHA + (f32x4){bflo(y0.x), bfhi(y0.x), bflo(y0.y), bfhi(y0.y)};
                v1[j] = xr1[64 * j] * ALPHA + (f32x4){bflo(y1.x), bfhi(y1.x), bflo(y1.y), bfhi(y1.y)}; }
            float mean0, rstd0, mean1, rstd1; ln_stats(v0, mean0, rstd0); ln_stats(v1, mean1, rstd1);
#pragma unroll
            for (int j = 0; j < 4; ++j) {
                const f32x4 g = ((const f32x4*)A.in[7])[64 * j + F.lane], bb = ((const f32x4*)A.in[8])[64 * j + F.lane];
                v0[j] = (v0[j] - mean0) * rstd0 * g + bb; v1[j] = (v1[j] - mean1) * rstd1 * g + bb;
                { u32x2 o; o.x = pk2(v0[j][0], v0[j][1]); o.y = pk2(v0[j][2], v0[j][3]); hb0[64 * j] = o; o.x = pk2(v1[j][0], v1[j][1]); o.y = pk2(v1[j][2], v1[j][3]); hb1[64 * j] = o; }
            }
            float la[20], lb2[20];
#pragma unroll
            for (int e = 0; e < 20; ++e) { la[e] = 0.f; lb2[e] = 0.f; }
#pragma unroll 1
            for (int j = 0; j < 4; ++j) {
                const f32x4 s0 = (j == 0) ? v0[0] : (j == 1) ? v0[1] : (j == 2) ? v0[2] : v0[3];
                const f32x4 s1 = (j == 0) ? v1[0] : (j == 1) ? v1[1] : (j == 2) ? v1[2] : v1[3];
                const LAS f32x4* wj = wl + j * (20 * 64);
#pragma unroll
                for (int e = 0; e < 4; ++e) {
                    const float h0 = s0[e], h1 = s1[e];
#pragma unroll
                    for (int c = 0; c < 5; ++c) { const f32x4 w = wj[(e * 5 + c) * 64];
                        la[4 * c] += h0 * w[0]; la[4 * c + 1] += h0 * w[1]; la[4 * c + 2] += h0 * w[2]; la[4 * c + 3] += h0 * w[3];
                        lb2[4 * c] += h1 * w[0]; lb2[4 * c + 1] += h1 * w[1]; lb2[4 * c + 2] += h1 * w[2]; lb2[4 * c + 3] += h1 * w[3]; }
                }
            }
#pragma unroll
            for (int e = 0; e < 20; ++e) { la[e] = wave_sum(la[e]); lb2[e] = wave_sum(lb2[e]); }
            if (F.lane == 0) { route_row(F, A, la, rl, lcnt, rec); route_row(F, A, lb2, rl + 1, lcnt, rec); }
        }
        __syncthreads();
        if (F.tid < 16) lbase[F.tid] = (int)atomicAdd(((unsigned*)(A.ws + WS_CTL)) + CW_CNT + F.tid, (unsigned)lcnt[F.tid]);
        __syncthreads();
        if (F.tid < 128) {
            unsigned* mp = ((unsigned*)(A.ws + WS_META)) + (size_t)(slab * 128 + F.tid) * 8;
            const int e0 = rec[F.tid * 6 + 0], e1 = rec[F.tid * 6 + 3];
            u32x4 a, c;
            a.x = (unsigned)e0; a.y = (unsigned)(lbase[e0] + rec[F.tid * 6 + 1]); a.z = (unsigned)rec[F.tid * 6 + 2]; a.w = (unsigned)e1;
            c.x = (unsigned)(lbase[e1] + rec[F.tid * 6 + 4]); c.y = (unsigned)rec[F.tid * 6 + 5]; c.z = 0u; c.w = 0u;
            *(u32x4*)mp = a; *(u32x4*)(mp + 4) = c;
            int* list = (int*)(A.ws + WS_LIST);
            list[e0 * 32768 + (int)a.y] = slab * 128 + F.tid; list[e1 * 32768 + (int)c.x] = slab * 128 + F.tid;
        }
        __syncthreads();
    }
}

__device__ __forceinline__ void build_toff(Frame& F, const Args& A) {
    __syncthreads();
    if (F.tid == 0) { int acc = 0;
        for (int e = 0; e < NEXP; ++e) { F.misc[e] = acc; const unsigned c = __hip_atomic_load(((unsigned*)(A.ws + WS_CTL)) + CW_CNT + e, __ATOMIC_RELAXED, __HIP_MEMORY_SCOPE_AGENT); F.misc[64 + e] = (int)c; acc += (int)((c + 255u) >> 8); }
        F.misc[NEXP] = acc; }
    __syncthreads();
}

__device__ __forceinline__ void p7_weights(Frame& F, const Args& A) {
    LAS float* scr = (LAS float*)(F.lds + F.wave * 16384);
    constexpr int I13 = (DM / 64) * (DEXP / 32), I2 = (DEXP / 64) * (DM / 32);
    for (int it = F.gw; it < NEXP * (2 * I13 + I2); it += F.ngw) {
        const int e = it / (2 * I13 + I2), r = it % (2 * I13 + I2);
        if (r < I13) transpose_item<1>(A.in[13] + (size_t)e * DM * DEXP, DM, DEXP, ((bf16*)(A.ws + WS_W13)) + (size_t)e * 1024 * DM, scr, r, F.lane);
        else if (r < 2 * I13) transpose_item<2>(A.in[14] + (size_t)e * DM * DEXP, DM, DEXP, ((bf16*)(A.ws + WS_W13)) + (size_t)e * 1024 * DM, scr, r - I13, F.lane);
        else transpose_item<0>(A.in[15] + (size_t)e * DEXP * DM, DEXP, DM, ((bf16*)(A.ws + WS_W2)) + (size_t)e * DM * DEXP, scr, r - 2 * I13, F.lane);
    }
}

__device__ __forceinline__ void p10_final(Frame& F, const Args& A) {
    build_toff(F, A);
    for (int row = F.gw; row < MTOK; row += F.ngw) {
        const unsigned* mp = ((unsigned*)(A.ws + WS_META)) + (size_t)row * 8;
        const int e0 = (int)mp[0], p0 = (int)mp[1], e1 = (int)mp[3], p1 = (int)mp[4];
        const float g0 = __uint_as_float(mp[2]), g1 = __uint_as_float(mp[5]);
        const size_t s0 = (size_t)F.misc[e0] * 256 + p0, s1 = (size_t)F.misc[e1] * 256 + p1;
        f32x4* xr = (f32x4*)(A.out + (size_t)row * DM) + F.lane; const u32x2* hr = (const u32x2*)(((bf16*)(A.ws + WS_H1)) + (size_t)row * DM) + F.lane;
        const u32x2* y0 = (const u32x2*)(((bf16*)(A.ws + WS_YS)) + s0 * DM) + F.lane; const u32x2* y1 = (const u32x2*)(((bf16*)(A.ws + WS_YS)) + s1 * DM) + F.lane;
        f32x4 v[4];
#pragma unroll
        for (int j = 0; j < 4; ++j) { const u32x2 hw = hr[64 * j]; const f32x4 hv = (f32x4){bflo(hw.x), bfhi(hw.x), bflo(hw.y), bfhi(hw.y)}; const u32x2 a = y0[64 * j], c = y1[64 * j];
            v[j][0] = ALPHA * hv[0] + g0 * bflo(a.x) + g1 * bflo(c.x); v[j][1] = ALPHA * hv[1] + g0 * bfhi(a.x) + g1 * bfhi(c.x);
            v[j][2] = ALPHA * hv[2] + g0 * bflo(a.y) + g1 * bflo(c.y); v[j][3] = ALPHA * hv[3] + g0 * bfhi(a.y) + g1 * bfhi(c.y); }
        float mean, rstd; ln_stats(v, mean, rstd);
#pragma unroll
        for (int j = 0; j < 4; ++j) { const f32x4 g = ((const f32x4*)A.in[16])[64 * j + F.lane], bb = ((const f32x4*)A.in[17])[64 * j + F.lane]; xr[64 * j] = (v[j] - mean) * rstd * g + bb; }
    }
}

#define XB_TMO      128
#define XB_XCNT(j)  (256  + 64 * (j))
#define XB_XSUB(j)  (1280 + 64 * (j))
#define XB_XGEN(j)  (2304 + 64 * (j))
#define XB_TOP      3328
#define XB_TOPGEN   3392
#define XCD_BAR_WORDS 3456
#define XB_SPIN_CAP (1u << 18)

__device__ __forceinline__ unsigned xb_ld(unsigned* p)              { return __hip_atomic_load(p, __ATOMIC_RELAXED, __HIP_MEMORY_SCOPE_AGENT); }
__device__ __forceinline__ unsigned xb_add(unsigned* p, unsigned v) { return __hip_atomic_fetch_add(p, v, __ATOMIC_RELAXED, __HIP_MEMORY_SCOPE_AGENT); }
__device__ __forceinline__ unsigned xb_xcc_id() { return (unsigned)__builtin_amdgcn_s_getreg((3 << 11) | 20) & 0xFu; }
#define XB_SPIN(cond, bar) do { unsigned _sp = 0; while (cond) { __builtin_amdgcn_s_sleep(1); \
    if ((++_sp & 255u) == 0u) { if (xb_ld(&(bar)[XB_TMO])) break; if (_sp > XB_SPIN_CAP) { atomicAdd(&(bar)[XB_TMO], 1u); break; } } } } while (0)

struct XcdBarrier {
    unsigned* bar; unsigned x;
    volatile LAS unsigned* st;
};

__device__ __forceinline__ XcdBarrier xcd_barrier_post(unsigned* bar, volatile LAS unsigned* st) {
    XcdBarrier b; b.bar = bar; b.x = xb_xcc_id(); b.st = st;
    if (threadIdx.x == 0) (void)xb_add(&bar[XB_XCNT(b.x)], 1u);
    return b;
}
__device__ __forceinline__ void xcd_barrier_complete(unsigned* bar, unsigned x, unsigned& nloc, unsigned& nx) {
    const unsigned G = gridDim.x * gridDim.y * gridDim.z;
    unsigned sum, cnt, mine, sp = 0u;
    for (;;) {
        sum = 0u; cnt = 0u; mine = 0u;
#pragma unroll
        for (unsigned j = 0; j < 16; ++j) { const unsigned c = xb_ld(&bar[XB_XCNT(j)]); sum += c; cnt += (c > 0u) ? 1u : 0u; mine = (j == x) ? c : mine; }
        if (sum == G) break;
        __builtin_amdgcn_s_sleep(1);
        if ((++sp & 255u) == 0u) { if (xb_ld(&bar[XB_TMO])) break; if (sp > XB_SPIN_CAP) { atomicAdd(&bar[XB_TMO], 1u); break; } }
    }
    nloc = mine > 0u ? mine : 1u; nx = cnt > 0u ? cnt : 1u;
}

__device__ __forceinline__ void xcd_barrier(const XcdBarrier& b) {
    asm volatile("s_waitcnt vmcnt(0)" ::: "memory");
    __syncthreads();
    if (threadIdx.x == 0) {
        unsigned* bar = b.bar;
        __builtin_amdgcn_s_waitcnt(0);
        unsigned nloc = b.st[0], nx = b.st[1];
        if (nloc == 0u) { xcd_barrier_complete(bar, b.x, nloc, nx); b.st[0] = nloc; b.st[1] = nx; }
        const unsigned old = xb_add(&bar[XB_XSUB(b.x)], 1u);
        const unsigned gen = old / nloc;
        if (old + 1u == (gen + 1u) * nloc) {
            __builtin_amdgcn_fence(__ATOMIC_RELEASE, "agent");
            asm volatile("s_waitcnt vmcnt(0)" ::: "memory");
            const unsigned og = xb_add(&bar[XB_TOP], 1u);
            const unsigned tg = og / nx;
            if (og + 1u == (tg + 1u) * nx) xb_add(&bar[XB_TOPGEN], 1u);
            else XB_SPIN(xb_ld(&bar[XB_TOPGEN]) == tg, bar);
            __builtin_amdgcn_fence(__ATOMIC_ACQUIRE, "agent");
            xb_add(&bar[XB_XGEN(b.x)], 1u);
            asm volatile("s_waitcnt vmcnt(0)" ::: "memory");
        } else {
            XB_SPIN(xb_ld(&bar[XB_XGEN(b.x)]) == gen, bar);
            __builtin_amdgcn_fence(__ATOMIC_ACQUIRE, "agent");
            asm volatile("s_waitcnt vmcnt(0)" ::: "memory");
        }
    }
    __syncthreads();
}

constexpr int NPHASE = 11;
__global__ void __launch_bounds__(NTHREADS, 2) mega_fwd(Args args) {
    extern __shared__ __attribute__((aligned(16))) unsigned char lds[];
    Frame F;
    F.lds = (LAS unsigned char*)lds; F.misc = (LAS int*)(F.lds + MISC_OFF);
    F.tid = threadIdx.x; F.lane = F.tid & 63; F.wave = __builtin_amdgcn_readfirstlane(F.tid >> 6); F.G = gridDim.x;
    F.gw = blockIdx.x * NWAVES + F.wave; F.ngw = F.G * NWAVES;
    const Args& A = args;
    const int lo = args.ph_lo, hi = args.ph_hi;
    if (F.tid < 2) F.misc[MISC_BAR + F.tid] = 0;
    __syncthreads();
    XcdBarrier bar; bar.bar = (unsigned*)(args.ws + WS_CTL) + CW_BAR; bar.x = 0; bar.st = nullptr;
    if (MK_LAUNCHES == 1) bar = xcd_barrier_post((unsigned*)(args.ws + WS_CTL) + CW_BAR, (volatile LAS unsigned*)(F.misc + MISC_BAR));
#define IN(k) (lo <= (k) && (k) < hi)
#define SEAM(k) do { if (IN((k) + 1)) { xcd_barrier(bar); } } while (0)

    if (IN(0)) { p0_prep(F, A); SEAM(0); }
    if (IN(1)) {
        meta_finalize(F, A);
        pg8::Gemm g{((bf16*)(A.ws + WS_XB)), ((bf16*)(A.ws + WS_WIN)), MTOK, NIN, DM}; pg8::StaticOrder S; S.init(MTOK, NIN, F.G, (int)blockIdx.x);
        EpiProj E{((bf16*)(A.ws + WS_PROJ)), ((float*)(A.ws + WS_LB))};
        pg8::gemm_phase<EpiProj, pg8::StaticOrder, PG8_ALIGN, PG8_SP2>(F.lds, g, S, E);
        SEAM(1);
    }
    if (IN(2)) {
        ha_phase(F, A);
        attn_phase(F, A);
        SEAM(2);
    }
    if (IN(3)) { hb_phase(F, A); SEAM(3); }
    if (IN(4)) {
        hc_phase(F, A);
        SEAM(4);
    }
    if (IN(5)) {
        pg8::Gemm g{((bf16*)(A.ws + WS_MIX)), ((bf16*)(A.ws + WS_WOUT)), MTOK, DM, DM}; pg8::StaticOrder S; S.init(MTOK, DM, F.G, (int)blockIdx.x);
        EpiYs E{(bf16*)(A.ws + WS_Y1)};
        pg8::gemm_phase<EpiYs, pg8::StaticOrder, PG8_ALIGN, PG8_SP2>(F.lds, g, S, E);
        SEAM(5);
    }
    if (IN(6)) { p6_ln_router(F, A); p7_weights(F, A); SEAM(6); }
    if (IN(8)) {
        build_toff(F, A);
        pg8::Gemm g{((bf16*)(A.ws + WS_H1)), ((bf16*)(A.ws + WS_W13)), XS_ROWS, 1024, DM}; MoeOrder S{(const LAS int*)F.misc, F.G, (int)blockIdx.x, F.misc[NEXP], (const int*)(A.ws + WS_LIST)};
        EpiHid E{((bf16*)(A.ws + WS_HID))};
        pg8::gemm_phase_gather<EpiHid, MoeOrder, PG8_ALIGN, PG8_SP2>(F.lds, g, S, E);
        SEAM(8);
    }
    if (IN(9)) {
        build_toff(F, A);
        pg8::Gemm g{((bf16*)(A.ws + WS_HID)), ((bf16*)(A.ws + WS_W2)), XS_ROWS, 1024, DEXP}; MoeOrder S{(const LAS int*)F.misc, F.G, (int)blockIdx.x, F.misc[NEXP], (const int*)(A.ws + WS_LIST)};
        EpiYs E{((bf16*)(A.ws + WS_YS))};
        pg8::gemm_phase<EpiYs, MoeOrder, PG8_ALIGN, PG8_SP2>(F.lds, g, S, E);
        SEAM(9);
    }
    if (IN(10)) { p10_final(F, A); }
#undef IN
#undef SEAM
}

extern "C" void kernel_launch(void* const* d_in, const int* in_sizes, int n_in, void* d_out, int out_size, void* d_ws, size_t ws_size, hipStream_t stream) {
    static int grid = 0;
    if (grid == 0) {
        if (n_in != 18 || in_sizes[0] != MTOK * DM || out_size != MTOK * DM || ws_size < WS_END) {
            fprintf(stderr, "kernel_launch: unexpected shapes (n_in %d, in0 %d, out %d, ws %zu); nothing launched\n", n_in, n_in > 0 ? in_sizes[0] : -1, out_size, ws_size); grid = -1; return; }
        int dev = 0, cus = 0, per_cu = 0;
        if (hipGetDevice(&dev) != hipSuccess || hipDeviceGetAttribute(&cus, hipDeviceAttributeMultiprocessorCount, dev) != hipSuccess) { grid = -1; return; }
        if (hipFuncSetAttribute((const void*)mega_fwd, hipFuncAttributeMaxDynamicSharedMemorySize, LDS_BYTES) != hipSuccess) { fprintf(stderr, "kernel_launch: hipFuncSetAttribute failed\n"); grid = -1; return; }
        if (hipOccupancyMaxActiveBlocksPerMultiprocessor(&per_cu, (const void*)mega_fwd, NTHREADS, LDS_BYTES) != hipSuccess || per_cu < 1) { fprintf(stderr, "kernel_launch: occupancy query says %d\n", per_cu); per_cu = 1; }
        (void)hipGetLastError();
        grid = cus;
    }
    if (grid < 0) return;
    (void)hipMemsetAsync((char*)d_ws + WS_CTL, 0, CTL_ZERO_BYTES, stream);
    Args a{};
    for (int i = 0; i < 18; ++i) a.in[i] = (const float*)d_in[i];
    a.out = (float*)d_out; a.ws = (unsigned char*)d_ws;
#if MK_LAUNCHES == 1
    a.ph_lo = 0; a.ph_hi = NPHASE;
    void* kargs[] = {&a};
    hipError_t e = hipLaunchCooperativeKernel((const void*)mega_fwd, dim3(grid), dim3(NTHREADS), kargs, LDS_BYTES, stream);
    if (e != hipSuccess) fprintf(stderr, "kernel_launch: cooperative launch failed: %s (grid %d)\n", hipGetErrorString(e), grid);
#else
    for (int p = 0; p < NPHASE; ++p) { a.ph_lo = p; a.ph_hi = p + 1; hipLaunchKernelGGL(mega_fwd, dim3(grid), dim3(NTHREADS), LDS_BYTES, stream, a); }
#endif
}
```

```cpp
#include <hip/hip_runtime.h>
#include <hip/hip_cooperative_groups.h>
#include <cstdio>
#include <cstdint>
namespace cg = cooperative_groups;
namespace pg8 {
#define PG8_LAS __attribute__((address_space(3)))
typedef unsigned short bf16_t;
typedef short bf16x8 __attribute__((ext_vector_type(8)));
typedef float f32x4 __attribute__((ext_vector_type(4)));
typedef unsigned u32x4 __attribute__((ext_vector_type(4)));
constexpr int BM = 256, BK = 64, HALF = 128, HTB = HALF * BK * 2  , STAGE_BYTES = 8 * HTB, NXCD = 8, WGM = 8;

__host__ __device__ __forceinline__ int lds_byte(int r, int c) { const int st = (r >> 4) * 2 + (c >> 5), rr = r & 15, cc = c & 31, ob = rr * 64 + cc * 2; return st * 1024 + (ob ^ (((ob >> 9) & 1) << 5)); }
__host__ __device__ __forceinline__ void stage_rc(int b, int& R, int& C) { const int st = b / 1024, sb = b % 1024, swz = sb ^ (((sb >> 9) & 1) << 5); R = (st >> 1) * 16 + swz / 64; C = (st & 1) * 32 + (swz % 64) / 2; }
__host__ __device__ __forceinline__ int perm32(int rho) { const int n = rho >> 4, i = rho & 15; return 8 * (i >> 2) + 4 * n + (i & 3); }

struct Unit { int pm, pn; };
struct Gemm { const bf16_t* A; const bf16_t* Bt; int M, N, K; };

struct StaticOrder {
    int nM, nN, nwg, G, c;
    __host__ __device__ void init(int M, int N, int G_, int c_) { nM = M / BM; nN = N / BM; nwg = nM * nN; G = G_; c = c_; }
    __host__ __device__ bool next(int i, Unit& u) const {
        const long L = (long)i * G + c; if (L >= nwg) return false;
        int wgid = (int)L; { const int q = nwg / NXCD, r = nwg % NXCD, xcd = wgid % NXCD, off = wgid / NXCD; wgid = (xcd < r ? xcd * (q + 1) : r * (q + 1) + (xcd - r) * q) + off; }
        const int nig = WGM * nN, gid = wgid / nig, fm = gid * WGM, gsz = (nM - fm) < WGM ? (nM - fm) : WGM;
        u.pm = fm + ((wgid % nig) % gsz); u.pn = (wgid % nig) / gsz; return true;
    }
    __device__ __forceinline__ void a_ready(const Unit&) const {}
    __device__ __forceinline__ void done(const Unit&) const {}
};

__device__ __forceinline__ unsigned cvt_pk_bf16(float lo, float hi) { unsigned r; asm volatile("v_cvt_pk_bf16_f32 %0, %1, %2" : "=v"(r) : "v"(lo), "v"(hi)); return r; }
template <class Epi, class Sched, bool ALIGN_EPI = false, bool SP2 = false>
__device__ __forceinline__ void gemm_phase(PG8_LAS unsigned char* lds, const Gemm g, const Sched& S, const Epi& E) {
    int tid_ = threadIdx.x; asm volatile("" : "+v"(tid_));
    const int tid = tid_, wid = __builtin_amdgcn_readfirstlane(tid >> 6), lane = tid & 63, wr = wid >> 2, wc = wid & 3, fr = lane & 15, fq = lane >> 4;
    const int K = g.K, nt = K / BK;
    unsigned voffA[2], voffB[2];
#pragma unroll
    for (int i = 0; i < 2; ++i) { int R, C; stage_rc(tid * 16 + i * 8192, R, C); const int Rb = Epi::PERM ? ((R & ~31) + perm32(R & 31)) : R;
        voffA[i] = (unsigned)(R * K + C) * 2u; voffB[i] = (unsigned)(Rb * K + C) * 2u; }
    const size_t kstep = (size_t)(BK * 2);
    const size_t hstep = (size_t)HALF * K * 2;
    const size_t tstep = 2 * hstep;
    const unsigned ldsw = (unsigned)wid * 1024u;
    const int aoff = lds_byte(wr * 64 + fr, fq * 8), boff = lds_byte(wc * 32 + fr, fq * 8);
#define PG8_SA(b, h) (((b) * 2 + (h)) * HTB)
#define PG8_SB(b, h) ((4 + (b) * 2 + (h)) * HTB)
#define PG8_STAGE(bufoff, gbase, voff) do { _Pragma("unroll") for (int _i = 0; _i < 2; ++_i) \
        __builtin_amdgcn_global_load_lds((const unsigned*)((const char*)(gbase) + (voff)[_i]), (PG8_LAS unsigned*)(lds + (bufoff) + ldsw + _i * 8192), 16, 0, 0); } while (0)
#define PG8_LDA(dst, b, h) do { _Pragma("unroll") for (int m = 0; m < 4; ++m) _Pragma("unroll") for (int k = 0; k < 2; ++k) dst[m][k] = *(const PG8_LAS bf16x8*)(lds + PG8_SA(b, h) + aoff + m * 2048 + k * 1024); } while (0)
#define PG8_LDB(dst, b, h) do { _Pragma("unroll") for (int n = 0; n < 2; ++n) _Pragma("unroll") for (int k = 0; k < 2; ++k) dst[n][k] = *(const PG8_LAS bf16x8*)(lds + PG8_SB(b, h) + boff + n * 2048 + k * 1024); } while (0)
#define PG8_MMA(ai, bj, At, Bt) do { __builtin_amdgcn_s_setprio(1); _Pragma("unroll") for (int m = 0; m < 4; ++m) _Pragma("unroll") for (int n = 0; n < 2; ++n) _Pragma("unroll") for (int k = 0; k < 2; ++k) \
        acc[ai][bj][m][n] = __builtin_amdgcn_mfma_f32_16x16x32_bf16(Bt[n][k], At[m][k], acc[ai][bj][m][n], 0, 0, 0); __builtin_amdgcn_s_setprio(0); } while (0)
#define PG8_WAIT_V(n) asm volatile("s_waitcnt vmcnt(" #n ")" ::: "memory")
#define PG8_WAIT_L(n) asm volatile("s_waitcnt lgkmcnt(" #n ")" ::: "memory")
#define PG8_BAR __builtin_amdgcn_s_barrier()
#define PG8_SCHED __builtin_amdgcn_sched_barrier(0)
    Unit cur, nxt; int ui = 0;
    if (!S.next(0, cur)) return;
    f32x4 acc[2][2][4][2];
#pragma unroll
    for (int a = 0; a < 2; ++a)
#pragma unroll
        for (int b = 0; b < 2; ++b)
#pragma unroll
            for (int m = 0; m < 4; ++m)
#pragma unroll
                for (int n = 0; n < 2; ++n) acc[a][b][m][n] = (f32x4){0.f, 0.f, 0.f, 0.f};
    bf16x8 At[4][2], B0[2][2], B1[2][2];
    const char* cA = (const char*)g.A + (size_t)cur.pm * tstep; const char* cB = (const char*)g.Bt + (size_t)cur.pn * tstep;
    S.a_ready(cur);
    if constexpr (SP2) {
        PG8_STAGE(PG8_SB(0, 0), cB, voffB); PG8_STAGE(PG8_SB(0, 1), cB + hstep, voffB); PG8_STAGE(PG8_SA(0, 0), cA, voffA); PG8_STAGE(PG8_SA(0, 1), cA + hstep, voffA);
        if (wr == 1) PG8_BAR;
        PG8_WAIT_V(2); PG8_BAR;
        PG8_STAGE(PG8_SB(1, 0), cB + kstep, voffB); PG8_STAGE(PG8_SA(1, 0), cA + kstep, voffA); PG8_STAGE(PG8_SB(1, 1), cB + hstep + kstep, voffB);
        PG8_WAIT_V(6); PG8_BAR;
    } else {
        PG8_STAGE(PG8_SB(0, 0), cB, voffB); PG8_STAGE(PG8_SA(0, 0), cA, voffA); PG8_STAGE(PG8_SB(0, 1), cB + hstep, voffB); PG8_STAGE(PG8_SA(0, 1), cA + hstep, voffA);
        if (wr == 1) PG8_BAR;
        PG8_WAIT_V(4); PG8_BAR;
        PG8_STAGE(PG8_SB(1, 0), cB + kstep, voffB); PG8_STAGE(PG8_SA(1, 0), cA + kstep, voffA); PG8_STAGE(PG8_SB(1, 1), cB + hstep + kstep, voffB);
        PG8_WAIT_V(6); PG8_BAR;
    }
    for (;;) {
        const bool has_next = S.next(ui + 1, nxt);
        const char* nA = has_next ? (const char*)g.A + (size_t)nxt.pm * tstep : cA; const char* nB = has_next ? (const char*)g.Bt + (size_t)nxt.pn * tstep : cB;
        for (int t = 0; t < nt; t += 2) {
            const bool last = (t == nt - 2);
            const char* a1 = cA + (size_t)(t + 1) * kstep;
            const char* a2 = last ? nA : cA + (size_t)(t + 2) * kstep; const char* b2 = last ? nB : cB + (size_t)(t + 2) * kstep;
            const char* a3 = a2 + kstep; const char* b3 = b2 + kstep;
            if (last && has_next) S.a_ready(nxt);
            if constexpr (SP2) {
            PG8_LDB(B0, 0, 0); PG8_LDB(B1, 0, 1); PG8_SCHED; PG8_LDA(At, 0, 0); PG8_STAGE(PG8_SA(1, 1), a1 + hstep, voffA);
            PG8_WAIT_V(8); PG8_WAIT_L(0); PG8_BAR; PG8_MMA(0, 0, At, B0); PG8_MMA(0, 1, At, B1); PG8_BAR; PG8_SCHED;
            PG8_LDA(At, 0, 1); PG8_STAGE(PG8_SB(0, 0), b2, voffB); PG8_STAGE(PG8_SB(0, 1), b2 + hstep, voffB); PG8_STAGE(PG8_SA(0, 0), a2, voffA);
            PG8_WAIT_V(8); PG8_WAIT_L(0); PG8_BAR; PG8_MMA(1, 0, At, B0); PG8_MMA(1, 1, At, B1); PG8_BAR; PG8_SCHED;
            PG8_LDB(B0, 1, 0); PG8_LDB(B1, 1, 1); PG8_SCHED; PG8_LDA(At, 1, 0); PG8_STAGE(PG8_SA(0, 1), a2 + hstep, voffA);
            PG8_WAIT_V(8); PG8_WAIT_L(0); PG8_BAR; PG8_MMA(0, 0, At, B0); PG8_MMA(0, 1, At, B1); PG8_BAR; PG8_SCHED;
            PG8_LDA(At, 1, 1); PG8_STAGE(PG8_SB(1, 0), b3, voffB); PG8_STAGE(PG8_SB(1, 1), b3 + hstep, voffB); PG8_STAGE(PG8_SA(1, 0), a3, voffA);
            PG8_WAIT_V(8); PG8_WAIT_L(0); PG8_BAR; PG8_MMA(1, 0, At, B0); PG8_MMA(1, 1, At, B1); PG8_BAR; PG8_SCHED;
            } else {
            PG8_LDB(B0, 0, 0); PG8_SCHED; PG8_LDA(At, 0, 0); PG8_STAGE(PG8_SA(1, 1), a1 + hstep, voffA);
            PG8_WAIT_L(8); PG8_BAR; PG8_WAIT_L(0); PG8_MMA(0, 0, At, B0); PG8_BAR; PG8_SCHED;
            PG8_LDB(B1, 0, 1); PG8_STAGE(PG8_SB(0, 0), b2, voffB);
            PG8_BAR; PG8_WAIT_L(0); PG8_MMA(0, 1, At, B1); PG8_BAR;
            PG8_LDA(At, 0, 1); PG8_STAGE(PG8_SA(0, 0), a2, voffA);
            PG8_BAR; PG8_WAIT_L(0); PG8_MMA(1, 0, At, B0); PG8_BAR; PG8_SCHED;
            PG8_STAGE(PG8_SB(0, 1), b2 + hstep, voffB);
            PG8_WAIT_V(6); PG8_BAR; PG8_MMA(1, 1, At, B1); PG8_BAR;
            PG8_LDB(B0, 1, 0); PG8_SCHED; PG8_LDA(At, 1, 0); PG8_STAGE(PG8_SA(0, 1), a2 + hstep, voffA);
            PG8_WAIT_L(8); PG8_BAR; PG8_WAIT_L(0); PG8_MMA(0, 0, At, B0); PG8_BAR; PG8_SCHED;
            PG8_LDB(B1, 1, 1); PG8_STAGE(PG8_SB(1, 0), b3, voffB);
            PG8_BAR; PG8_WAIT_L(0); PG8_MMA(0, 1, At, B1); PG8_BAR;
            PG8_LDA(At, 1, 1); PG8_STAGE(PG8_SA(1, 0), a3, voffA);
            PG8_BAR; PG8_WAIT_L(0); PG8_MMA(1, 0, At, B0); PG8_BAR; PG8_SCHED;
            PG8_STAGE(PG8_SB(1, 1), b3 + hstep, voffB);
            PG8_WAIT_V(6); PG8_BAR; PG8_MMA(1, 1, At, B1); PG8_BAR;
            }
        }
        if constexpr (ALIGN_EPI) { if (wr == 0) PG8_BAR; }
        if constexpr (!Epi::AFTER_DRAIN) { E(acc, cur, wr, wc, fr, fq); S.done(cur); }
        if (!has_next) break;
#pragma unroll
        for (int a = 0; a < 2; ++a)
#pragma unroll
            for (int b = 0; b < 2; ++b)
#pragma unroll
                for (int m = 0; m < 4; ++m)
#pragma unroll
                    for (int n = 0; n < 2; ++n) acc[a][b][m][n] = (f32x4){0.f, 0.f, 0.f, 0.f};
        cur = nxt; cA = nA; cB = nB; ++ui;
        if constexpr (ALIGN_EPI) { if (wr == 1) PG8_BAR; }
    }
    PG8_WAIT_V(0);
    if constexpr (!ALIGN_EPI) { if (wr == 0) PG8_BAR; }
    PG8_BAR;
    if constexpr (Epi::AFTER_DRAIN) { E.fused(acc, cur, wr, wc, fr, fq, lds, wid, lane); S.done(cur); }
#undef PG8_SA
#undef PG8_SB
#undef PG8_STAGE
#undef PG8_LDA
#undef PG8_LDB
#undef PG8_MMA
#undef PG8_WAIT_V
#undef PG8_WAIT_L
#undef PG8_BAR
#undef PG8_SCHED
}

template <class Epi, class Sched, bool ALIGN_EPI = false, bool SP2 = false>
__device__ __forceinline__ void gemm_phase_gather(PG8_LAS unsigned char* lds, const Gemm g, const Sched& S, const Epi& E) {
    int tid_ = threadIdx.x; asm volatile("" : "+v"(tid_));
    const int tid = tid_, wid = __builtin_amdgcn_readfirstlane(tid >> 6), lane = tid & 63, wr = wid >> 2, wc = wid & 3, fr = lane & 15, fq = lane >> 4;
    const int K = g.K, nt = K / BK;
    unsigned voffA[2], voffB[2]; int rowA[2];
    unsigned oC[2][2], oN[2][2], o2[2][2];
#pragma unroll
    for (int i = 0; i < 2; ++i) { int R, C; stage_rc(tid * 16 + i * 8192, R, C); const int Rb = Epi::PERM ? ((R & ~31) + perm32(R & 31)) : R;
        voffA[i] = (unsigned)C * 2u; rowA[i] = R; voffB[i] = (unsigned)(Rb * K + C) * 2u; }
    const size_t kstep = (size_t)(BK * 2);
    const size_t hstep = (size_t)HALF * K * 2;
    const size_t tstep = 2 * hstep;
    const unsigned ldsw = (unsigned)wid * 1024u;
    const int aoff = lds_byte(wr * 64 + fr, fq * 8), boff = lds_byte(wc * 32 + fr, fq * 8);
#define PG8_SA(b, h) (((b) * 2 + (h)) * HTB)
#define PG8_SB(b, h) ((4 + (b) * 2 + (h)) * HTB)
#define PG8_STAGE(bufoff, gbase, voff) do { _Pragma("unroll") for (int _i = 0; _i < 2; ++_i) \
        __builtin_amdgcn_global_load_lds((const unsigned*)((const char*)(gbase) + (voff)[_i]), (PG8_LAS unsigned*)(lds + (bufoff) + ldsw + _i * 8192), 16, 0, 0); } while (0)
#define PG8_LDA(dst, b, h) do { _Pragma("unroll") for (int m = 0; m < 4; ++m) _Pragma("unroll") for (int k = 0; k < 2; ++k) dst[m][k] = *(const PG8_LAS bf16x8*)(lds + PG8_SA(b, h) + aoff + m * 2048 + k * 1024); } while (0)
#define PG8_LDB(dst, b, h) do { _Pragma("unroll") for (int n = 0; n < 2; ++n) _Pragma("unroll") for (int k = 0; k < 2; ++k) dst[n][k] = *(const PG8_LAS bf16x8*)(lds + PG8_SB(b, h) + boff + n * 2048 + k * 1024); } while (0)
#define PG8_MMA(ai, bj, At, Bt) do { __builtin_amdgcn_s_setprio(1); _Pragma("unroll") for (int m = 0; m < 4; ++m) _Pragma("unroll") for (int n = 0; n < 2; ++n) _Pragma("unroll") for (int k = 0; k < 2; ++k) \
        acc[ai][bj][m][n] = __builtin_amdgcn_mfma_f32_16x16x32_bf16(Bt[n][k], At[m][k], acc[ai][bj][m][n], 0, 0, 0); __builtin_amdgcn_s_setprio(0); } while (0)
#define PG8_WAIT_V(n) asm volatile("s_waitcnt vmcnt(" #n ")" ::: "memory")
#define PG8_WAIT_L(n) asm volatile("s_waitcnt lgkmcnt(" #n ")" ::: "memory")
#define PG8_BAR __builtin_amdgcn_s_barrier()
#define PG8_SCHED __builtin_amdgcn_sched_barrier(0)
    Unit cur, nxt; int ui = 0;
    if (!S.next(0, cur)) return;
    f32x4 acc[2][2][4][2];
#pragma unroll
    for (int a = 0; a < 2; ++a)
#pragma unroll
        for (int b = 0; b < 2; ++b)
#pragma unroll
            for (int m = 0; m < 4; ++m)
#pragma unroll
                for (int n = 0; n < 2; ++n) acc[a][b][m][n] = (f32x4){0.f, 0.f, 0.f, 0.f};
    bf16x8 At[4][2], B0[2][2], B1[2][2];
    const char* cA = (const char*)g.A; const char* cB = (const char*)g.Bt + (size_t)cur.pn * tstep;
#define PG8_ROWOFFS(dst, unit) do { _Pragma("unroll") for (int _h = 0; _h < 2; ++_h) _Pragma("unroll") for (int _i = 0; _i < 2; ++_i) \
        dst[_h][_i] = (unsigned)S.a_row(unit, _h * HALF + rowA[_i]) * (unsigned)(K * 2) + voffA[_i]; } while (0)
    PG8_ROWOFFS(oC, cur);
    S.a_ready(cur);
    if constexpr (SP2) {
        PG8_STAGE(PG8_SB(0, 0), cB, voffB); PG8_STAGE(PG8_SB(0, 1), cB + hstep, voffB); PG8_STAGE(PG8_SA(0, 0), cA, oC[0]); PG8_STAGE(PG8_SA(0, 1), cA, oC[1]);
        if (wr == 1) PG8_BAR;
        PG8_WAIT_V(2); PG8_BAR;
        PG8_STAGE(PG8_SB(1, 0), cB + kstep, voffB); PG8_STAGE(PG8_SA(1, 0), cA + kstep, oC[0]); PG8_STAGE(PG8_SB(1, 1), cB + hstep + kstep, voffB);
        PG8_WAIT_V(6); PG8_BAR;
    } else {
        PG8_STAGE(PG8_SB(0, 0), cB, voffB); PG8_STAGE(PG8_SA(0, 0), cA, oC[0]); PG8_STAGE(PG8_SB(0, 1), cB + hstep, voffB); PG8_STAGE(PG8_SA(0, 1), cA, oC[1]);
        if (wr == 1) PG8_BAR;
        PG8_WAIT_V(4); PG8_BAR;
        PG8_STAGE(PG8_SB(1, 0), cB + kstep, voffB); PG8_STAGE(PG8_SA(1, 0), cA + kstep, oC[0]); PG8_STAGE(PG8_SB(1, 1), cB + hstep + kstep, voffB);
        PG8_WAIT_V(6); PG8_BAR;
    }
    for (;;) {
        const bool has_next = S.next(ui + 1, nxt);
        const char* nB = has_next ? (const char*)g.Bt + (size_t)nxt.pn * tstep : cB;
        if (has_next) { PG8_ROWOFFS(oN, nxt); } else { _Pragma("unroll") for (int _h = 0; _h < 2; ++_h) _Pragma("unroll") for (int _i = 0; _i < 2; ++_i) oN[_h][_i] = oC[_h][_i]; }
        for (int t = 0; t < nt; t += 2) {
            const bool last = (t == nt - 2);
            const char* a1 = cA + (size_t)(t + 1) * kstep;
            const char* a2 = last ? cA : cA + (size_t)(t + 2) * kstep; const char* b2 = last ? nB : cB + (size_t)(t + 2) * kstep;
#pragma unroll
            for (int _h = 0; _h < 2; ++_h)
#pragma unroll
                for (int _i = 0; _i < 2; ++_i) o2[_h][_i] = last ? oN[_h][_i] : oC[_h][_i];
            const char* a3 = a2 + kstep; const char* b3 = b2 + kstep;
            if (last && has_next) S.a_ready(nxt);
            if constexpr (SP2) {
            PG8_LDB(B0, 0, 0); PG8_LDB(B1, 0, 1); PG8_SCHED; PG8_LDA(At, 0, 0); PG8_STAGE(PG8_SA(1, 1), a1, oC[1]);
            PG8_WAIT_V(8); PG8_WAIT_L(0); PG8_BAR; PG8_MMA(0, 0, At, B0); PG8_MMA(0, 1, At, B1); PG8_BAR; PG8_SCHED;
            PG8_LDA(At, 0, 1); PG8_STAGE(PG8_SB(0, 0), b2, voffB); PG8_STAGE(PG8_SB(0, 1), b2 + hstep, voffB); PG8_STAGE(PG8_SA(0, 0), a2, o2[0]);
            PG8_WAIT_V(8); PG8_WAIT_L(0); PG8_BAR; PG8_MMA(1, 0, At, B0); PG8_MMA(1, 1, At, B1); PG8_BAR; PG8_SCHED;
            PG8_LDB(B0, 1, 0); PG8_LDB(B1, 1, 1); PG8_SCHED; PG8_LDA(At, 1, 0); PG8_STAGE(PG8_SA(0, 1), a2, o2[1]);
            PG8_WAIT_V(8); PG8_WAIT_L(0); PG8_BAR; PG8_MMA(0, 0, At, B0); PG8_MMA(0, 1, At, B1); PG8_BAR; PG8_SCHED;
            PG8_LDA(At, 1, 1); PG8_STAGE(PG8_SB(1, 0), b3, voffB); PG8_STAGE(PG8_SB(1, 1), b3 + hstep, voffB); PG8_STAGE(PG8_SA(1, 0), a3, o2[0]);
            PG8_WAIT_V(8); PG8_WAIT_L(0); PG8_BAR; PG8_MMA(1, 0, At, B0); PG8_MMA(1, 1, At, B1); PG8_BAR; PG8_SCHED;
            } else {
            PG8_LDB(B0, 0, 0); PG8_SCHED; PG8_LDA(At, 0, 0); PG8_STAGE(PG8_SA(1, 1), a1, oC[1]);
            PG8_WAIT_L(8); PG8_BAR; PG8_WAIT_L(0); PG8_MMA(0, 0, At, B0); PG8_BAR; PG8_SCHED;
            PG8_LDB(B1, 0, 1); PG8_STAGE(PG8_SB(0, 0), b2, voffB);
            PG8_BAR; PG8_WAIT_L(0); PG8_MMA(0, 1, At, B1); PG8_BAR;
            PG8_LDA(At, 0, 1); PG8_STAGE(PG8_SA(0, 0), a2, o2[0]);
            PG8_BAR; PG8_WAIT_L(0); PG8_MMA(1, 0, At, B0); PG8_BAR; PG8_SCHED;
            PG8_STAGE(PG8_SB(0, 1), b2 + hstep, voffB);
            PG8_WAIT_V(6); PG8_BAR; PG8_MMA(1, 1, At, B1); PG8_BAR;
            PG8_LDB(B0, 1, 0); PG8_SCHED; PG8_LDA(At, 1, 0); PG8_STAGE(PG8_SA(0, 1), a2, o2[1]);
            PG8_WAIT_L(8); PG8_BAR; PG8_WAIT_L(0); PG8_MMA(0, 0, At, B0); PG8_BAR; PG8_SCHED;
            PG8_LDB(B1, 1, 1); PG8_STAGE(PG8_SB(1, 0), b3, voffB);
            PG8_BAR; PG8_WAIT_L(0); PG8_MMA(0, 1, At, B1); PG8_BAR;
            PG8_LDA(At, 1, 1); PG8_STAGE(PG8_SA(1, 0), a3, o2[0]);
            PG8_BAR; PG8_WAIT_L(0); PG8_MMA(1, 0, At, B0); PG8_BAR; PG8_SCHED;
            PG8_STAGE(PG8_SB(1, 1), b3 + hstep, voffB);
            PG8_WAIT_V(6); PG8_BAR; PG8_MMA(1, 1, At, B1); PG8_BAR;
            }
        }
        if constexpr (ALIGN_EPI) { if (wr == 0) PG8_BAR; }
        if constexpr (!Epi::AFTER_DRAIN) { E(acc, cur, wr, wc, fr, fq); S.done(cur); }
        if (!has_next) break;
#pragma unroll
        for (int a = 0; a < 2; ++a)
#pragma unroll
            for (int b = 0; b < 2; ++b)
#pragma unroll
                for (int m = 0; m < 4; ++m)
#pragma unroll
                    for (int n = 0; n < 2; ++n) acc[a][b][m][n] = (f32x4){0.f, 0.f, 0.f, 0.f};
        cur = nxt; cB = nB; ++ui;
#pragma unroll
        for (int _h = 0; _h < 2; ++_h)
#pragma unroll
            for (int _i = 0; _i < 2; ++_i) oC[_h][_i] = oN[_h][_i];
        if constexpr (ALIGN_EPI) { if (wr == 1) PG8_BAR; }
    }
    PG8_WAIT_V(0);
    if constexpr (!ALIGN_EPI) { if (wr == 0) PG8_BAR; }
    PG8_BAR;
    if constexpr (Epi::AFTER_DRAIN) { E.fused(acc, cur, wr, wc, fr, fq, lds, wid, lane); S.done(cur); }
#undef PG8_ROWOFFS
#undef PG8_SA
#undef PG8_SB
#undef PG8_STAGE
#undef PG8_LDA
#undef PG8_LDB
#undef PG8_MMA
#undef PG8_WAIT_V
#undef PG8_WAIT_L
#undef PG8_BAR
#undef PG8_SCHED
}
}


#ifndef PG8_SP2
#define PG8_SP2 true
#endif
#ifndef PG8_ALIGN
#define PG8_ALIGN true
#endif
#ifndef MK_LAUNCHES
#define MK_LAUNCHES 1
#endif

#define GAS __attribute__((address_space(1)))
#define LAS __attribute__((address_space(3)))
typedef unsigned short bf16;
typedef float f32x4 __attribute__((ext_vector_type(4)));
typedef unsigned u32x4 __attribute__((ext_vector_type(4)));
typedef unsigned u32x2 __attribute__((ext_vector_type(2)));

constexpr int NB = 8, SEQ = 4096, DM = 1024, NMETA = 16;
constexpr int ROWS = 4160, PADR = 48, TOK0 = 64;
constexpr int MTOK = NB * SEQ;
constexpr int NIN = 3584;
constexpr int BROWS = NB * ROWS;
constexpr size_t ARR = (size_t)BROWS * 512;
constexpr int NCH = 64;
constexpr int NEXP = 16, DEXP = 512;
constexpr int XS_ROWS = 69632;
constexpr float ALPHA = 1.189207115002721f;
constexpr float LN_EPS = 1e-5f, RMS_EPS = 1e-6f;
constexpr float LOG2E = 1.4426950408889634f;
constexpr float C2Q = 0.125f * LOG2E;
constexpr float STICK_THR = 48.0f;

constexpr size_t MiB = 1u << 20;
constexpr size_t WS_CTL = 0, CTL_ZERO_BYTES = 1 * MiB;
constexpr size_t WS_WIN = 1 * MiB;
constexpr size_t WS_WOUT = 8 * MiB;
constexpr size_t WS_LB = 10 * MiB;
constexpr size_t WS_META = 11 * MiB;
constexpr size_t WS_LIST = 13 * MiB;
constexpr size_t WS_DV = 12 * MiB;
constexpr size_t WS_XB = 16 * MiB;
constexpr size_t WS_S = 16 * MiB;
constexpr size_t WS_PROJ = 80 * MiB;
constexpr size_t WS_U = 308 * MiB;
constexpr size_t WS_MIX = 436 * MiB;
constexpr size_t WS_Y1 = 308 * MiB;
constexpr size_t WS_H1 = 16 * MiB;
constexpr size_t WS_W13 = 80 * MiB;
constexpr size_t WS_W2 = 112 * MiB;
constexpr size_t WS_XS = 128 * MiB;
constexpr size_t WS_HID = 264 * MiB;
constexpr size_t WS_YS = 332 * MiB;
constexpr size_t WS_END = 500 * MiB;
static_assert(WS_PROJ + 7 * ARR * 2 <= WS_U && WS_U + (size_t)32 * 64 * 16384 * 4 <= WS_MIX && WS_MIX + (size_t)MTOK * DM * 2 <= WS_END, "ws map A");
static_assert(WS_W13 + (size_t)16 * 1024 * 1024 * 2 <= WS_W2 && WS_W2 + (size_t)16 * 1024 * 512 * 2 <= WS_XS && WS_XS + (size_t)XS_ROWS * 1024 * 2 <= WS_HID &&
              WS_HID + (size_t)XS_ROWS * 512 * 2 <= WS_YS && WS_YS + (size_t)XS_ROWS * 1024 * 2 <= WS_END, "ws map B");
constexpr int CW_CNT = 64;
constexpr int CW_BAR = 4096;
constexpr int MISC_BAR = 100;

constexpr int RING_BYTES = 131072;
constexpr int MISC_OFF = RING_BYTES;
constexpr int LDS_BYTES = 147456;
constexpr int NWAVES = 8, NTHREADS = 512;

#define LBAR() do { asm volatile("s_waitcnt lgkmcnt(0)" ::: "memory"); __builtin_amdgcn_s_barrier(); asm volatile("" ::: "memory"); } while (0)
__device__ __forceinline__ unsigned f2bf(float f) { unsigned u = __builtin_bit_cast(unsigned, f); return (u + 0x7fffu + ((u >> 16) & 1u)) >> 16; }
typedef float f32x2_t __attribute__((ext_vector_type(2))); typedef __bf16 bf16x2_t __attribute__((ext_vector_type(2)));
__device__ __forceinline__ unsigned pk2(float lo, float hi) { f32x2_t v = {lo, hi}; bf16x2_t b = __builtin_convertvector(v, bf16x2_t); return __builtin_bit_cast(unsigned, b); }
__device__ __forceinline__ float bf2f(unsigned h) { return __builtin_bit_cast(float, h << 16); }
__device__ __forceinline__ float bflo(unsigned w) { return __builtin_bit_cast(float, w << 16); }
__device__ __forceinline__ float bfhi(unsigned w) { return __builtin_bit_cast(float, w & 0xffff0000u); }
__device__ __forceinline__ float ex2(float x) { return __builtin_amdgcn_exp2f(x); }
__device__ __forceinline__ float lg2(float x) { return __builtin_amdgcn_logf(x); }
__device__ __forceinline__ float rcpf_(float x) { return __builtin_amdgcn_rcpf(x); }
__device__ __forceinline__ float sigm(float v) { return rcpf_(1.f + ex2(-v * LOG2E)); }
__device__ __forceinline__ float wave_sum(float v) {
#pragma unroll
    for (int o = 1; o < 64; o <<= 1) v += __shfl_xor(v, o);
    return v;
}
__device__ __forceinline__ size_t pidx(int kind, int b, int r, int col) {
    const int sh = (kind < 4) ? 7 : 6;
    return (size_t)kind * ARR + ((size_t)((b * (512 >> sh) + (col >> sh)) * ROWS + r) << sh) + (col & ((1 << sh) - 1));
}
template <int XF> __device__ __forceinline__ float xform(float v, float lb) {
    if (XF == 0) return v * sigm(v);
    if (XF == 1) return lg2(lb + (1.f - lb) * sigm(v));
    if (XF == 3) return sigm(v);
    if (XF == 4) return v * C2Q;
    return v;
}
__device__ __forceinline__ float xform_rt(int kind, float v, float lb) {
    switch (kind) { case 0: return xform<0>(v, lb); case 1: return xform<1>(v, lb); case 3: return xform<3>(v, lb); case 4: return xform<4>(v, lb); default: return v; }
}

using pg8::Unit;
struct EpiProj {
    static constexpr bool PERM = true, AFTER_DRAIN = false;
    bf16* proj; const float* lb;
    template <int XF> __device__ __forceinline__ void run(int kind, const f32x4 (&acc)[2][2][4][2], const Unit& u, int wr, int wc, int fr, int fq) const {
        const int b = u.pm >> 4;
        const int rb = TOK0 + (u.pm & 15) * 256 + wr * 64 + fr;
        const int c0 = (u.pn & 1) * 256 + wc * 32 + 8 * fq;
        const int sh = (kind < 4) ? 7 : 6;
        bf16* pb0 = proj + pidx(kind, b, rb, c0); bf16* pb1 = proj + pidx(kind, b, rb, c0 + 128);
        f32x4 l0[2], l1[2];
#pragma unroll
        for (int bj = 0; bj < 2; ++bj) {
            if (XF == 1) { l0[bj] = *(const f32x4*)(lb + c0 + bj * 128); l1[bj] = *(const f32x4*)(lb + c0 + bj * 128 + 4); }
            else { l0[bj] = (f32x4){0.f, 0.f, 0.f, 0.f}; l1[bj] = l0[bj]; }
        }
#pragma unroll
        for (int ai = 0; ai < 2; ++ai)
#pragma unroll
            for (int m = 0; m < 4; ++m) {
                const size_t ro = (size_t)(ai * 128 + m * 16) << sh;
#pragma unroll
                for (int bj = 0; bj < 2; ++bj) {
                    const f32x4 v0 = acc[ai][bj][m][0], v1 = acc[ai][bj][m][1];
                    u32x4 w;
                    w.x = pk2(xform<XF>(v0[0], l0[bj][0]), xform<XF>(v0[1], l0[bj][1]));
                    w.y = pk2(xform<XF>(v0[2], l0[bj][2]), xform<XF>(v0[3], l0[bj][3]));
                    w.z = pk2(xform<XF>(v1[0], l1[bj][0]), xform<XF>(v1[1], l1[bj][1]));
                    w.w = pk2(xform<XF>(v1[2], l1[bj][2]), xform<XF>(v1[3], l1[bj][3]));
                    __builtin_nontemporal_store(w, (u32x4*)((bj ? pb1 : pb0) + ro));
                }
            }
    }
    __device__ __forceinline__ void operator()(const f32x4 (&acc)[2][2][4][2], const Unit& u, int wr, int wc, int fr, int fq) const {
        const int kind = u.pn >> 1;
        if (kind == 0) run<0>(kind, acc, u, wr, wc, fr, fq);
        else if (kind == 1) run<1>(kind, acc, u, wr, wc, fr, fq);
        else if (kind == 3) run<3>(kind, acc, u, wr, wc, fr, fq);
        else if (kind == 4) run<4>(kind, acc, u, wr, wc, fr, fq);
        else run<2>(kind, acc, u, wr, wc, fr, fq);
    }
};
struct EpiOut {
    static constexpr bool PERM = false, AFTER_DRAIN = false;
    const float* x; float* out;
    __device__ __forceinline__ void operator()(const f32x4 (&acc)[2][2][4][2], const Unit& u, int wr, int wc, int fr, int fq) const {
        const int row0 = u.pm * 256 + wr * 64 + fr, col0 = u.pn * 256 + wc * 32 + 4 * fq;
#pragma unroll
        for (int ai = 0; ai < 2; ++ai)
#pragma unroll
            for (int m = 0; m < 4; ++m) {
                const size_t ro = (size_t)(row0 + ai * 128 + m * 16) * DM + col0;
#pragma unroll
                for (int bj = 0; bj < 2; ++bj)
#pragma unroll
                    for (int n = 0; n < 2; ++n) {
                        const f32x4 xv = *(const f32x4*)(x + ro + bj * 128 + 16 * n);
                        *(f32x4*)(out + ro + bj * 128 + 16 * n) = acc[ai][bj][m][n] + xv * ALPHA;
                    }
            }
    }
};
struct EpiHid {
    static constexpr bool PERM = true, AFTER_DRAIN = false;
    bf16* hid;
    __device__ __forceinline__ void operator()(const f32x4 (&acc)[2][2][4][2], const Unit& u, int wr, int wc, int fr, int fq) const {
        const int row0 = u.pm * 256 + wr * 64 + fr, hc0 = (u.pn & 3) * 128 + wc * 16 + 4 * fq;
#pragma unroll
        for (int ai = 0; ai < 2; ++ai)
#pragma unroll
            for (int m = 0; m < 4; ++m) {
                bf16* rowp = hid + (size_t)(row0 + ai * 128 + m * 16) * DEXP + hc0;
#pragma unroll
                for (int bj = 0; bj < 2; ++bj) {
                    const f32x4 g = acc[ai][bj][m][0], up = acc[ai][bj][m][1];
                    u32x2 w;
                    w.x = pk2(g[0] * sigm(g[0]) * up[0], g[1] * sigm(g[1]) * up[1]);
                    w.y = pk2(g[2] * sigm(g[2]) * up[2], g[3] * sigm(g[3]) * up[3]);
                    __builtin_nontemporal_store(w, (u32x2*)(rowp + bj * 64));
                }
            }
    }
};
struct EpiYs {
    static constexpr bool PERM = true, AFTER_DRAIN = false;
    bf16* ys;
    __device__ __forceinline__ void operator()(const f32x4 (&acc)[2][2][4][2], const Unit& u, int wr, int wc, int fr, int fq) const {
        const int row0 = u.pm * 256 + wr * 64 + fr, col0 = (u.pn & 3) * 256 + wc * 32 + 8 * fq;
#pragma unroll
        for (int ai = 0; ai < 2; ++ai)
#pragma unroll
            for (int m = 0; m < 4; ++m) {
                bf16* rowp = ys + (size_t)(row0 + ai * 128 + m * 16) * DM + col0;
#pragma unroll
                for (int bj = 0; bj < 2; ++bj) {
                    const f32x4 v0 = acc[ai][bj][m][0], v1 = acc[ai][bj][m][1];
                    u32x4 w; w.x = pk2(v0[0], v0[1]); w.y = pk2(v0[2], v0[3]); w.z = pk2(v1[0], v1[1]); w.w = pk2(v1[2], v1[3]);
                    __builtin_nontemporal_store(w, (u32x4*)(rowp + bj * 128));
                }
            }
    }
};
struct MoeOrder {
    const LAS int* toff; int G, c, ntot; const int* list;
    __device__ __forceinline__ int a_row(const Unit& u, int r) const {
        const int e = u.pn >> 2, pos = (u.pm - toff[e]) * 256 + r;
        return (pos < toff[64 + e]) ? list[e * 32768 + pos] : 0;
    }
    __device__ __forceinline__ bool next(int i, Unit& u) const {
        const long L = (long)i * G + c; if (L >= (long)ntot * 4) return false;
        const int mt = (int)(L >> 2), pl = (int)(L & 3); int e = 0;
#pragma unroll
        for (int j = 1; j < NEXP; ++j) e += (mt >= toff[j]) ? 1 : 0;
        u.pm = mt; u.pn = e * 4 + pl; return true;
    }
    __device__ __forceinline__ void a_ready(const Unit&) const {}
    __device__ __forceinline__ void done(const Unit&) const {}
};

struct Args { const float* in[18]; float* out; unsigned char* ws; int ph_lo, ph_hi; };
struct Frame {
    LAS unsigned char* lds; LAS int* misc;
    int tid, lane, wave, G, gw, ngw;
};

template <int MODE> __device__ __forceinline__ int rowmap(int n) { return MODE == 0 ? n : ((n >> 2) * 8 + (n & 3) + (MODE == 2 ? 4 : 0)); }
template <int MODE> __device__ __forceinline__ void transpose_item(const float* W, int K, int N, bf16* WT, LAS float* scr, int item, int lane) {
    const int nblk = N / 32, kb = item / nblk, nb = item % nblk, k0 = 64 * kb, n0 = 32 * nb;
#pragma unroll
    for (int i = 0; i < 8; ++i) { const int kk = 8 * i + (lane >> 3), c4 = (lane & 7) * 4;
        const f32x4 v = __builtin_nontemporal_load((const f32x4*)(W + (size_t)(k0 + kk) * N + n0 + c4));
        LAS float* d = scr + kk * 33 + c4; d[0] = v[0]; d[1] = v[1]; d[2] = v[2]; d[3] = v[3]; }
    asm volatile("s_waitcnt lgkmcnt(0)" ::: "memory");
    const int c = lane & 7;
#pragma unroll
    for (int j = 0; j < 4; ++j) { const int n = (lane >> 3) + 8 * j; const LAS float* s = scr + (8 * c) * 33 + n;
        u32x4 o; o.x = pk2(s[0 * 33], s[1 * 33]); o.y = pk2(s[2 * 33], s[3 * 33]); o.z = pk2(s[4 * 33], s[5 * 33]); o.w = pk2(s[6 * 33], s[7 * 33]);
        *(u32x4*)(WT + (size_t)rowmap<MODE>(n0 + n) * K + k0 + 8 * c) = o; }
    asm volatile("s_waitcnt lgkmcnt(0)" ::: "memory");
}

__device__ __forceinline__ void p0_prep(Frame& F, const Args& A) {
    LAS float* scr = (LAS float*)(F.lds + F.wave * 16384);
    const int gtid = blockIdx.x * NTHREADS + F.tid, gthreads = F.G * NTHREADS;
    for (int i = gtid; i < 512; i += gthreads) ((float*)(A.ws + WS_LB))[i] = 1.f / (1.f + __expf(A.in[3][512 + i] - A.in[3][i]));
    for (int i = gtid; i < 7 * NB * 3072; i += gthreads) {
        const int a = i / (NB * 3072), r = i % (NB * 3072), b = r / 3072, o = r % 3072;
        const int sh = (a < 4) ? 7 : 6, per_head = 48 << (sh - 3), h = o / per_head, rem = o % per_head;
        *(u32x4*)(((bf16*)(A.ws + WS_PROJ)) + (size_t)a * ARR + ((size_t)((b * (512 >> sh) + h) * ROWS) << sh) + (size_t)rem * 8) = (u32x4){0u, 0u, 0u, 0u};
    }
    for (int job = F.gw; job < 56 * 16; job += F.ngw) {
        const int cgp = job >> 4, kq = job & 15, n = cgp * 64 + F.lane;
        float acc[16];
#pragma unroll
        for (int r = 0; r < 16; ++r) acc[r] = 0.f;
        const float* mt = A.in[1] + 64 * kq; const float* wp = A.in[2] + (size_t)(64 * kq) * NIN + n;
#pragma unroll 8
        for (int k = 0; k < 64; ++k) {
            const float w = wp[(size_t)k * NIN];
#pragma unroll
            for (int r = 0; r < 16; ++r) acc[r] += mt[r * DM + k] * w;
        }
        float* mp = ((float*)(A.ws + WS_U)) + (size_t)(kq * 16) * NIN + n;
#pragma unroll
        for (int r = 0; r < 16; ++r) mp[(size_t)r * NIN] = acc[r];
    }
    constexpr int I_IN = (DM / 64) * (NIN / 32), I_OUT = (DM / 64) * (DM / 32);
    for (int it = F.gw; it < I_IN + I_OUT; it += F.ngw) {
        if (it < I_IN) transpose_item<0>(A.in[2], DM, NIN, ((bf16*)(A.ws + WS_WIN)), scr, it, F.lane);
        else transpose_item<0>(A.in[6], DM, DM, ((bf16*)(A.ws + WS_WOUT)), scr, it - I_IN, F.lane);
    }
    for (int m = 2 * F.gw; m < MTOK; m += 2 * F.ngw) {
        const f32x4* xr = (const f32x4*)(A.in[0] + (size_t)m * DM) + F.lane;
        u32x2* o8 = (u32x2*)(((bf16*)(A.ws + WS_XB)) + (size_t)m * DM) + F.lane;
        f32x4 v[8];
#pragma unroll
        for (int j = 0; j < 8; ++j) v[j] = __builtin_nontemporal_load(xr + 64 * j);
#pragma unroll
        for (int j = 0; j < 8; ++j) { u32x2 w; w.x = pk2(v[j][0], v[j][1]); w.y = pk2(v[j][2], v[j][3]); o8[64 * j] = w; }
    }
}

__device__ __forceinline__ void meta_finalize(Frame& F, const Args& A) {
    const float* mp = (const float*)(A.ws + WS_U); const float* lb = (const float*)(A.ws + WS_LB);
    for (int idx = blockIdx.x * NTHREADS + F.tid; idx < 16 * NIN; idx += F.G * NTHREADS) {
        const int r = idx / NIN, n = idx % NIN, kind = n >> 9, col = n & 511;
        float v = 0.f;
#pragma unroll
        for (int kq = 0; kq < 16; ++kq) v += mp[(size_t)(kq * 16 + r) * NIN + n];
        const unsigned short o = (unsigned short)f2bf(xform_rt(kind, v, lb[col]));
#pragma unroll
        for (int b = 0; b < NB; ++b) ((bf16*)(A.ws + WS_PROJ))[pidx(kind, b, PADR + r, col)] = o;
    }
}

typedef short s16x8 __attribute__((ext_vector_type(8)));
typedef short v4i16_t __attribute__((ext_vector_type(4)));
__device__ __forceinline__ s16x8 tr8(const LAS unsigned char* p, int rowskip) {
    const v4i16_t lo = __builtin_amdgcn_ds_read_tr16_b64_v4i16((LAS v4i16_t*)p);
    const v4i16_t hh = __builtin_amdgcn_ds_read_tr16_b64_v4i16((LAS v4i16_t*)(p + rowskip));
    return (s16x8){lo[0], lo[1], lo[2], lo[3], hh[0], hh[1], hh[2], hh[3]};
}
struct RawTile { u32x4 a, b; };
__device__ __forceinline__ RawTile raw_load(const bf16* arr, int b, int h, int c, int tid) {
    const bf16* p = arr + (size_t)((b * 4 + h) * ROWS + 64 * c + (tid >> 4)) * 128 + 8 * (tid & 15);
    RawTile r; r.a = *(const u32x4*)p; r.b = *(const u32x4*)(p + (size_t)32 * 128); return r;
}
__device__ __forceinline__ void raw_store(LAS unsigned char* dst, int pitch, const RawTile& r, int tid) {
    LAS unsigned char* p = dst + (tid >> 4) * pitch + (tid & 15) * 16;
    *(LAS u32x4*)p = r.a; *(LAS u32x4*)(p + 32 * pitch) = r.b;
}
constexpr int PRAW = 272;
constexpr int PKT = 144;
__device__ __forceinline__ void ha_phase(Frame& F, const Args& A) {
    const bf16* LF = ((bf16*)(A.ws + WS_PROJ)) + 1 * ARR; const bf16* HV = ((bf16*)(A.ws + WS_PROJ)) + 2 * ARR;
    LAS unsigned char* RLF = F.lds;
    LAS unsigned char* VN = RLF + 64 * PRAW;
    LAS unsigned char* KT = VN + 64 * PRAW;
    LAS float* TOT = (LAS float*)(KT + 128 * PKT);
    const int tid = F.tid, lane = F.lane, w = F.wave, fr = lane & 15, fq = lane >> 4;
    const int d = tid & 127, sq = tid >> 7;
    int u = blockIdx.x;
    RawTile rl, rv;
    if (u < 32 * 64) { rl = raw_load(LF, u >> 8, (u >> 6) & 3, u & 63, tid); rv = raw_load(HV, u >> 8, (u >> 6) & 3, u & 63, tid); }
    for (; u < 32 * 64; u += F.G) {
        const int bh = u >> 6, c = u & 63;
        raw_store(RLF, PRAW, rl, tid); raw_store(VN, PRAW, rv, tid);
        LBAR();
        { const int un = u + F.G; if (un < 32 * 64) { rl = raw_load(LF, un >> 8, (un >> 6) & 3, un & 63, tid); rv = raw_load(HV, un >> 8, (un >> 6) & 3, un & 63, tid); } }
        float lf[16], pre[16]; float run = 0.f;
#pragma unroll
        for (int i = 0; i < 16; ++i) { lf[i] = bf2f(*(const LAS unsigned short*)(RLF + (16 * sq + i) * PRAW + 2 * d)); run += lf[i]; pre[i] = run; }
        TOT[sq * 128 + d] = run;
        LBAR();
        float off = 0.f, blast = 0.f;
#pragma unroll
        for (int q = 0; q < 4; ++q) { const float t = TOT[q * 128 + d]; off += (q < sq) ? t : 0.f; blast += t; }
        { unsigned kw[8];
#pragma unroll
          for (int i = 0; i < 8; ++i) { const float k0 = (1.f - ex2(lf[2 * i])) * ex2(blast - (off + pre[2 * i])), k1 = (1.f - ex2(lf[2 * i + 1])) * ex2(blast - (off + pre[2 * i + 1])); kw[i] = pk2(k0, k1); }
          LAS u32x4* kp = (LAS u32x4*)(KT + d * PKT + 32 * sq);
          kp[0] = (u32x4){kw[0], kw[1], kw[2], kw[3]}; kp[1] = (u32x4){kw[4], kw[5], kw[6], kw[7]}; }
        if (sq == 0) ((float*)(A.ws + WS_DV))[(size_t)(bh * 64 + c) * 128 + d] = ex2(blast);
        LBAR();
        const LAS unsigned char* vt = VN + (8 * fq + (fr >> 2)) * PRAW + (16 * w + 4 * (fr & 3)) * 2;
        const s16x8 b0 = tr8(vt, 4 * PRAW), b1 = tr8(vt + 32 * PRAW, 4 * PRAW);
        bf16* up = ((bf16*)(A.ws + WS_U)) + (size_t)(bh * 64 + c) * 16384 + (size_t)(16 * w + fr) * 128 + 4 * fq;
#pragma unroll
        for (int dt = 0; dt < 8; ++dt) {
            const LAS unsigned char* kp = KT + (16 * dt + fr) * PKT + 16 * fq;
            const s16x8 a0 = *(const LAS s16x8*)kp, a1 = *(const LAS s16x8*)(kp + 64);
            f32x4 acc = (f32x4){0.f, 0.f, 0.f, 0.f};
            acc = __builtin_amdgcn_mfma_f32_16x16x32_bf16(a0, b0, acc, 0, 0, 0);
            acc = __builtin_amdgcn_mfma_f32_16x16x32_bf16(a1, b1, acc, 0, 0, 0);
            { u32x2 o; o.x = pk2(acc[0], acc[1]); o.y = pk2(acc[2], acc[3]); *(u32x2*)(up + 16 * dt) = o; }
        }
        LBAR();
    }
}

typedef float f32x16 __attribute__((ext_vector_type(16)));
__device__ __forceinline__ s16x8 pack8(u32x2 a, u32x2 c) { const u32x4 w = (u32x4){a.x, a.y, c.x, c.y}; return __builtin_bit_cast(s16x8, w); }
struct AttnCtx { const bf16* kbase; const bf16* vbase; LAS unsigned char* vw; const LAS unsigned char* vt; int ktd, qrow, hi; };
struct KVSet { s16x8 kf[4]; u32x4 vr[4]; };
__device__ __forceinline__ void kv_load(KVSet& x, const bf16* kbase, const bf16* vbase, int kt) {
    const bf16* kp = kbase + (size_t)(32 * kt) * 64; const bf16* vp = vbase + (size_t)(32 * kt) * 64;
#pragma unroll
    for (int s2 = 0; s2 < 4; ++s2) x.kf[s2] = *(const s16x8*)(kp + 16 * s2);
#pragma unroll
    for (int i = 0; i < 4; ++i) x.vr[i] = *(const u32x4*)(vp + (size_t)(8 * i) * 64);
}
__device__ __forceinline__ bool attn_tile(const AttnCtx& C, int kt, const s16x8 (&qf)[4], const KVSet& x, f32x16& o0, f32x16& o1, float& T) {
    const int k0 = 32 * kt, hi = C.hi;
    f32x16 p;
#pragma unroll
    for (int r = 0; r < 16; ++r) p[r] = 0.f;
#pragma unroll
    for (int s2 = 0; s2 < 4; ++s2) p = __builtin_amdgcn_mfma_f32_32x32x16_bf16(x.kf[s2], qf[s2], p, 0, 0, 0);
#pragma unroll
    for (int i = 0; i < 4; ++i) *(LAS u32x4*)(C.vw + i * 1024) = x.vr[i];
    s16x8 va[2][2];
#pragma unroll
    for (int dt = 0; dt < 2; ++dt)
#pragma unroll
        for (int s2 = 0; s2 < 2; ++s2) va[dt][s2] = tr8(C.vt + dt * 64 + s2 * 2048, 1024);
    const bool edge = (kt == C.ktd) || (kt == 1);
    float sp[16], iss[16], gs[4];
#pragma unroll
    for (int r = 0; r < 16; ++r) {
        const float z = fminf(p[r], 100.f); p[r] = z;
        float v = lg2(1.f + ex2(z));
        if (edge) { const int key = k0 + (r & 3) + 8 * (r >> 2) + 4 * hi; if (!(key >= PADR && key < C.qrow)) v = 0.f; }
        sp[r] = v;
    }
#pragma unroll
    for (int g = 0; g < 4; ++g) { iss[4 * g + 3] = sp[4 * g + 3]; iss[4 * g + 2] = iss[4 * g + 3] + sp[4 * g + 2]; iss[4 * g + 1] = iss[4 * g + 2] + sp[4 * g + 1]; iss[4 * g] = iss[4 * g + 1] + sp[4 * g]; gs[g] = iss[4 * g]; }
    float sg[4], go[4];
#pragma unroll
    for (int g = 0; g < 4; ++g) { const auto rr = __builtin_amdgcn_permlane32_swap(__float_as_uint(gs[g]), __float_as_uint(gs[g]), false, false);
        sg[g] = __uint_as_float(rr[0]) + __uint_as_float(rr[1]); go[g] = hi ? 0.f : __uint_as_float(rr[1]); }
    float off[4];
    off[3] = T + go[3]; const float e2 = sg[3]; off[2] = T + e2 + go[2]; const float e1 = e2 + sg[2]; off[1] = T + e1 + go[1]; const float e0 = e1 + sg[1]; off[0] = T + e0 + go[0];
    T += e0 + sg[0];
    float a[16];
#pragma unroll
    for (int r = 0; r < 16; ++r) {
        float v = ex2(p[r] - (off[r >> 2] + iss[r]));
        if (edge) { const int key = k0 + (r & 3) + 8 * (r >> 2) + 4 * hi; if (!(key >= PADR && key < C.qrow)) v = 0.f; }
        a[r] = v;
    }
#pragma unroll
    for (int s2 = 0; s2 < 2; ++s2) {
        u32x4 w; w.x = pk2(a[8 * s2], a[8 * s2 + 1]); w.y = pk2(a[8 * s2 + 2], a[8 * s2 + 3]); w.z = pk2(a[8 * s2 + 4], a[8 * s2 + 5]); w.w = pk2(a[8 * s2 + 6], a[8 * s2 + 7]);
        const s16x8 pb = __builtin_bit_cast(s16x8, w);
        o0 = __builtin_amdgcn_mfma_f32_32x32x16_bf16(va[0][s2], pb, o0, 0, 0, 0);
        o1 = __builtin_amdgcn_mfma_f32_32x32x16_bf16(va[1][s2], pb, o1, 0, 0, 0);
    }
    return __all(T > STICK_THR) || kt == 1;
}
__device__ __forceinline__ void attn_phase(Frame& F, const Args& A) {
    const bf16* SQ = ((bf16*)(A.ws + WS_PROJ)) + 4 * ARR; const bf16* SK = ((bf16*)(A.ws + WS_PROJ)) + 5 * ARR; const bf16* SV = ((bf16*)(A.ws + WS_PROJ)) + 6 * ARR;
    const int r32 = F.lane & 31, hi = F.lane >> 5;
    AttnCtx C;
    C.vw = F.lds + F.wave * 4096 + (F.lane >> 3) * 128 + (F.lane & 7) * 16;
    C.vt = F.lds + F.wave * 4096 + (4 * hi + ((F.lane & 15) >> 2)) * 128 + ((F.lane >> 4) & 1) * 32 + (F.lane & 3) * 8;
    C.hi = hi;
    constexpr int NU = 64 * 128;
    LAS float* GL = (LAS float*)(F.lds + 32768);
    GL[F.tid] = A.in[5][F.tid];
    LBAR();
    int wu = F.gw;
    if (wu >= NU) return;
    s16x8 qf[4]; KVSet SA, SB, SC;
#define ATT_SETUP(wuv, kb, vb, q0v, bv, hv) const int bv = (wuv) >> 10, hv = ((wuv) >> 7) & 7, q0v = TOK0 + 32 * ((wuv) & 127); \
        const bf16* kb = SK + (size_t)((bv * 8 + hv) * ROWS + r32) * 64 + 8 * hi; const bf16* vb = SV + (size_t)((bv * 8 + hv) * ROWS + (F.lane >> 3)) * 64 + 8 * (F.lane & 7);
    { ATT_SETUP(wu, kb, vb, q0, b, h)
      const bf16* qp = SQ + (size_t)((b * 8 + h) * ROWS + q0 + r32) * 64 + 8 * hi;
#pragma unroll
      for (int s2 = 0; s2 < 4; ++s2) qf[s2] = *(const s16x8*)(qp + 16 * s2);
      kv_load(SA, kb, vb, q0 >> 5); kv_load(SB, kb, vb, (q0 >> 5) - 1); kv_load(SC, kb, vb, (q0 >> 5) - 2); }
    for (;;) {
        ATT_SETUP(wu, kb, vb, q0, b, h)
        C.kbase = kb; C.vbase = vb; C.qrow = q0 + r32; C.ktd = q0 >> 5;
        const int wn = wu + F.ngw; const bool has_next = wn < NU;
        ATT_SETUP(has_next ? wn : wu, kbn, vbn, q0n, bn, hn)
        s16x8 qn[4];
        f32x16 o0, o1;
#pragma unroll
        for (int r = 0; r < 16; ++r) { o0[r] = 0.f; o1[r] = 0.f; }
        float T = 0.f;
        bool done = attn_tile(C, C.ktd, qf, SA, o0, o1, T);
        if (has_next) { const bf16* qp = SQ + (size_t)((bn * 8 + hn) * ROWS + q0n + r32) * 64 + 8 * hi;
#pragma unroll
            for (int s2 = 0; s2 < 4; ++s2) qn[s2] = *(const s16x8*)(qp + 16 * s2);
            kv_load(SA, kbn, vbn, q0n >> 5); }
        if (!done) done = attn_tile(C, C.ktd - 1, qf, SB, o0, o1, T);
        if (has_next) kv_load(SB, kbn, vbn, (q0n >> 5) - 1);
        if (!done) done = attn_tile(C, C.ktd - 2, qf, SC, o0, o1, T);
        for (int kt = C.ktd - 3; !done; --kt) { kv_load(SC, kb, vb, kt); done = attn_tile(C, kt, qf, SC, o0, o1, T); }
        if (has_next) kv_load(SC, kbn, vbn, (q0n >> 5) - 2);
        float ss = 0.f;
#pragma unroll
        for (int r = 0; r < 16; ++r) ss += o0[r] * o0[r] + o1[r] * o1[r];
        { const auto rr = __builtin_amdgcn_permlane32_swap(__float_as_uint(ss), __float_as_uint(ss), false, false); ss = __uint_as_float(rr[0]) + __uint_as_float(rr[1]); }
        const float rs = __builtin_amdgcn_rsqf(ss * (1.f / 64.f) + RMS_EPS);
        const LAS float* gp = GL + 64 * h + 4 * hi;
        bf16* op = ((bf16*)(A.ws + WS_MIX)) + (size_t)(b * SEQ + C.qrow - TOK0) * DM + 512 + 64 * h + 4 * hi;
#pragma unroll
        for (int g = 0; g < 4; ++g) {
            const f32x4 g0 = *(const LAS f32x4*)(gp + 8 * g), g1 = *(const LAS f32x4*)(gp + 32 + 8 * g);
            u32x2 w0, w1;
            w0.x = pk2(o0[4 * g] * rs * g0[0], o0[4 * g + 1] * rs * g0[1]); w0.y = pk2(o0[4 * g + 2] * rs * g0[2], o0[4 * g + 3] * rs * g0[3]);
            w1.x = pk2(o1[4 * g] * rs * g1[0], o1[4 * g + 1] * rs * g1[1]); w1.y = pk2(o1[4 * g + 2] * rs * g1[2], o1[4 * g + 3] * rs * g1[3]);
            *(u32x2*)(op + 8 * g) = w0; *(u32x2*)(op + 32 + 8 * g) = w1;
        }
        if (!has_next) break;
        wu = wn;
#pragma unroll
        for (int s2 = 0; s2 < 4; ++s2) qf[s2] = qn[s2];
    }
#undef ATT_SETUP
}

__device__ __forceinline__ void hb_phase(Frame& F, const Args& A) {
    LAS float* DVL = (LAS float*)F.lds;
    for (int job = blockIdx.x; job < 32 * 8; job += F.G) {
        const int bh = job >> 3, v = (job & 7) * 16 + (F.tid >> 5), d4 = (F.tid & 31) * 4;
        { const f32x4* src = (const f32x4*)(((const float*)(A.ws + WS_DV)) + (size_t)bh * 64 * 128);
#pragma unroll
          for (int i = 0; i < 4; ++i) ((LAS f32x4*)DVL)[F.tid + 512 * i] = src[F.tid + 512 * i]; }
        __syncthreads();
        const bf16* up = ((bf16*)(A.ws + WS_U)) + (size_t)bh * 64 * 16384 + v * 128 + d4;
        bf16* sp = ((bf16*)(A.ws + WS_S)) + (size_t)bh * 64 * 16384 + v * 128 + d4;
        f32x4 s = (f32x4){0.f, 0.f, 0.f, 0.f};
#pragma unroll 16
        for (int c = 0; c < 64; ++c) {
            const u32x2 ub = __builtin_nontemporal_load((const u32x2*)(up + (size_t)c * 16384));
            const f32x4 uu = (f32x4){bflo(ub.x), bfhi(ub.x), bflo(ub.y), bfhi(ub.y)}, dd = *(const LAS f32x4*)(DVL + c * 128 + d4);
            s = dd * s + uu;
            u32x2 w; w.x = pk2(s[0], s[1]); w.y = pk2(s[2], s[3]);
            *(u32x2*)(sp + (size_t)c * 16384) = w;
        }
        __syncthreads();
    }
}

__device__ __forceinline__ void hc_phase(Frame& F, const Args& A) {
    const bf16* HQ = ((bf16*)(A.ws + WS_PROJ)); const bf16* LF = HQ + 1 * ARR; const bf16* HV = HQ + 2 * ARR; const bf16* HG = HQ + 3 * ARR;
    LAS unsigned char* RLF = F.lds;
    LAS unsigned char* RQ = RLF + 64 * PRAW;
    LAS unsigned char* VN = RQ + 64 * PRAW;
    LAS unsigned char* QT = VN + 64 * PRAW;
    LAS unsigned char* KI = QT + 64 * PRAW;
    LAS unsigned char* SC = KI + 64 * PRAW;
    LAS float* TOT = (LAS float*)(SC + 64 * PKT);
    LAS float* SSQ = TOT + 512;
    LAS float* NGL = SSQ + 512;
    const int tid = F.tid, lane = F.lane, w = F.wave, fr = lane & 15, fq = lane >> 4;
    const int d = tid & 127, sq = tid >> 7;
    NGL[tid] = A.in[4][tid];
    int u = blockIdx.x;
    RawTile rl, rq, rv;
    if (u < 32 * 64) { const int b = u >> 8, h = (u >> 6) & 3, cc = (u & 63) + 1; rl = raw_load(LF, b, h, cc, tid); rq = raw_load(HQ, b, h, cc, tid); rv = raw_load(HV, b, h, cc, tid); }
    for (; u < 32 * 64; u += F.G) {
        const int bh = u >> 6, b = bh >> 2, h = bh & 3, cc = (u & 63) + 1;
        raw_store(RLF, PRAW, rl, tid); raw_store(RQ, PRAW, rq, tid); raw_store(VN, PRAW, rv, tid);
        LBAR();
        { const int un = u + F.G; if (un < 32 * 64) { const int b2 = un >> 8, h2 = (un >> 6) & 3, c2 = (un & 63) + 1; rl = raw_load(LF, b2, h2, c2, tid); rq = raw_load(HQ, b2, h2, c2, tid); rv = raw_load(HV, b2, h2, c2, tid); } }
        s16x8 sa[4]; u32x2 gt[4];
        { const bf16* sp = ((bf16*)(A.ws + WS_S)) + (size_t)(bh * 64 + cc - 1) * 16384 + (size_t)(16 * w + fr) * 128 + 8 * fq;
#pragma unroll
          for (int ks = 0; ks < 4; ++ks) sa[ks] = *(const s16x8*)(sp + 32 * ks);
          const bf16* gp = HG + (size_t)((b * 4 + h) * ROWS + 64 * cc + fr) * 128 + 16 * w + 4 * fq;
#pragma unroll
          for (int tt = 0; tt < 4; ++tt) gt[tt] = *(const u32x2*)(gp + (size_t)(16 * tt) * 128); }
        {
            float lf[16], pre[16], qv[16]; float run = 0.f;
#pragma unroll
            for (int i = 0; i < 16; ++i) { lf[i] = bf2f(*(const LAS unsigned short*)(RLF + (16 * sq + i) * PRAW + 2 * d)); qv[i] = bf2f(*(const LAS unsigned short*)(RQ + (16 * sq + i) * PRAW + 2 * d)); run += lf[i]; pre[i] = run; }
            TOT[sq * 128 + d] = run;
            LBAR();
            float off = 0.f;
#pragma unroll
            for (int q = 0; q < 4; ++q) { const float t = TOT[q * 128 + d]; off += (q < sq) ? t : 0.f; }
#pragma unroll
            for (int i = 0; i < 16; ++i) { const float bc = off + pre[i];
                *(LAS unsigned short*)(QT + (16 * sq + i) * PRAW + 2 * d) = (unsigned short)f2bf(qv[i] * ex2(bc));
                *(LAS unsigned short*)(KI + (16 * sq + i) * PRAW + 2 * d) = (unsigned short)f2bf((1.f - ex2(lf[i])) * ex2(-bc)); }
        }
        LBAR();
        {
            const int tt = w >> 1;
            s16x8 bq[4];
            const LAS unsigned char* qp = QT + (16 * tt + fr) * PRAW + 16 * fq;
#pragma unroll
            for (int ks = 0; ks < 4; ++ks) bq[ks] = *(const LAS s16x8*)(qp + 64 * ks);
#pragma unroll
            for (int j = 0; j < 2; ++j) {
                const int st = 2 * (w & 1) + j;
                const LAS unsigned char* kp = KI + (16 * st + fr) * PRAW + 16 * fq;
                f32x4 acc = (f32x4){0.f, 0.f, 0.f, 0.f};
#pragma unroll
                for (int ks = 0; ks < 4; ++ks) acc = __builtin_amdgcn_mfma_f32_16x16x32_bf16(*(const LAS s16x8*)(kp + 64 * ks), bq[ks], acc, 0, 0, 0);
                const int t = 16 * tt + fr, s0 = 16 * st + 4 * fq;
                u32x2 wv; wv.x = pk2(s0 <= t ? acc[0] : 0.f, s0 + 1 <= t ? acc[1] : 0.f); wv.y = pk2(s0 + 2 <= t ? acc[2] : 0.f, s0 + 3 <= t ? acc[3] : 0.f);
                *(LAS u32x2*)(SC + t * PKT + 2 * s0) = wv;
            }
        }
        LBAR();
        f32x4 acc[4];
        {
            const LAS unsigned char* vt = VN + (8 * fq + (fr >> 2)) * PRAW + (16 * w + 4 * (fr & 3)) * 2;
            const s16x8 av0 = tr8(vt, 4 * PRAW), av1 = tr8(vt + 32 * PRAW, 4 * PRAW);
#pragma unroll
            for (int tt = 0; tt < 4; ++tt) {
                const LAS unsigned char* scp = SC + (16 * tt + fr) * PKT + 16 * fq;
                const LAS unsigned char* qp = QT + (16 * tt + fr) * PRAW + 16 * fq;
                f32x4 c = (f32x4){0.f, 0.f, 0.f, 0.f};
                c = __builtin_amdgcn_mfma_f32_16x16x32_bf16(av0, *(const LAS s16x8*)scp, c, 0, 0, 0);
                c = __builtin_amdgcn_mfma_f32_16x16x32_bf16(av1, *(const LAS s16x8*)(scp + 64), c, 0, 0, 0);
#pragma unroll
                for (int ks = 0; ks < 4; ++ks) c = __builtin_amdgcn_mfma_f32_16x16x32_bf16(sa[ks], *(const LAS s16x8*)(qp + 64 * ks), c, 0, 0, 0);
                acc[tt] = c;
                float ss = (c[0] * c[0] + c[1] * c[1]) + (c[2] * c[2] + c[3] * c[3]);
                ss += __shfl_xor(ss, 16); ss += __shfl_xor(ss, 32);
                if (fq == 0) SSQ[w * 64 + 16 * tt + fr] = ss;
            }
        }
        LBAR();
        {
            const f32x4 ng = *(const LAS f32x4*)(NGL + 128 * h + 16 * w + 4 * fq);
            bf16* op = ((bf16*)(A.ws + WS_MIX)) + (size_t)(b * SEQ + 64 * (cc - 1) + fr) * DM + 128 * h + 16 * w + 4 * fq;
#pragma unroll
            for (int tt = 0; tt < 4; ++tt) {
                float tot = 0.f;
#pragma unroll
                for (int k = 0; k < 8; ++k) tot += SSQ[k * 64 + 16 * tt + fr];
                const float rs = __builtin_amdgcn_rsqf(tot * (1.f / 128.f) + RMS_EPS);
                u32x2 o;
                o.x = pk2(acc[tt][0] * rs * ng[0] * bflo(gt[tt].x), acc[tt][1] * rs * ng[1] * bfhi(gt[tt].x));
                o.y = pk2(acc[tt][2] * rs * ng[2] * bflo(gt[tt].y), acc[tt][3] * rs * ng[3] * bfhi(gt[tt].y));
                *(u32x2*)(op + (size_t)(16 * tt) * DM) = o;
            }
        }
        LBAR();
    }
}

__device__ __forceinline__ void ln_stats(const f32x4 (&v)[4], float& mean, float& rstd) {
    float s = 0.f;
#pragma unroll
    for (int j = 0; j < 4; ++j) s += (v[j][0] + v[j][1]) + (v[j][2] + v[j][3]);
    mean = wave_sum(s) * (1.f / DM);
    float s2 = 0.f;
#pragma unroll
    for (int j = 0; j < 4; ++j) { const f32x4 d = v[j] - mean; s2 += (d[0] * d[0] + d[1] * d[1]) + (d[2] * d[2] + d[3] * d[3]); }
    rstd = 1.0f / sqrtf(wave_sum(s2) * (1.f / DM) + LN_EPS);
}

__device__ __forceinline__ void route_row(Frame& F, const Args& A, const float (&lg)[20], int rl, LAS int* lcnt, LAS int* rec) {
    const float* brg = A.in[10];
    float g0 = lg[0] + brg[0], g1 = lg[1] + brg[1], g2 = lg[2] + brg[2], g3 = lg[3] + brg[3];
    int grp = 0; float gm = g0;
    if (g1 > gm) { gm = g1; grp = 1; } if (g2 > gm) { gm = g2; grp = 2; } if (g3 > gm) { gm = g3; grp = 3; }
    const float pg = 1.f / (__expf(g0 - gm) + __expf(g1 - gm) + __expf(g2 - gm) + __expf(g3 - gm));
    float in0, in1, in2, in3;
    if (grp == 0) { in0 = lg[4]; in1 = lg[5]; in2 = lg[6]; in3 = lg[7]; }
    else if (grp == 1) { in0 = lg[8]; in1 = lg[9]; in2 = lg[10]; in3 = lg[11]; }
    else if (grp == 2) { in0 = lg[12]; in1 = lg[13]; in2 = lg[14]; in3 = lg[15]; }
    else { in0 = lg[16]; in1 = lg[17]; in2 = lg[18]; in3 = lg[19]; }
    const float* be = A.in[12] + grp * 4;
    in0 += be[0]; in1 += be[1]; in2 += be[2]; in3 += be[3];
    int i0 = 0; float m0 = in0;
    if (in1 > m0) { m0 = in1; i0 = 1; } if (in2 > m0) { m0 = in2; i0 = 2; } if (in3 > m0) { m0 = in3; i0 = 3; }
    int i1 = -1; float m1 = 0.f;
    if (i0 != 0) { m1 = in0; i1 = 0; }
    if (i0 != 1 && (i1 < 0 || in1 > m1)) { m1 = in1; i1 = 1; }
    if (i0 != 2 && (i1 < 0 || in2 > m1)) { m1 = in2; i1 = 2; }
    if (i0 != 3 && (i1 < 0 || in3 > m1)) { m1 = in3; i1 = 3; }
    const float w0 = 1.f / (1.f + __expf(m1 - m0)), w1 = 1.f - w0;
    const int e0 = grp * 4 + i0, e1 = grp * 4 + i1;
    const int p0 = atomicAdd((int*)&lcnt[e0], 1), p1 = atomicAdd((int*)&lcnt[e1], 1);
    rec[rl * 6 + 0] = e0; rec[rl * 6 + 1] = p0; rec[rl * 6 + 2] = __float_as_int(pg * w0);
    rec[rl * 6 + 3] = e1; rec[rl * 6 + 4] = p1; rec[rl * 6 + 5] = __float_as_int(pg * w1);
}
__device__ __forceinline__ void p6_ln_router(Frame& F, const Args& A) {
    LAS int* lcnt = F.misc + 32; LAS int* lbase = F.misc + 48;
    LAS f32x4* WL = (LAS f32x4*)F.lds;
    LAS int* rec = (LAS int*)(F.lds + 81920);
    for (int it = F.tid; it < 1024 * 5; it += NTHREADS) {
        const int k = it / 5, c = it % 5, j = k >> 8, ln = (k >> 2) & 63, e = k & 3;
        const f32x4 w = (c == 0) ? *(const f32x4*)(A.in[9] + (size_t)k * 4) : *(const f32x4*)(A.in[11] + (size_t)k * 16 + 4 * (c - 1));
        WL[((j * 4 + e) * 5 + c) * 64 + ln] = w;
    }
    __syncthreads();
    const LAS f32x4* wl = WL + F.lane;
    for (int slab = blockIdx.x; slab < MTOK / 128; slab += F.G) {
        if (F.tid < 16) lcnt[F.tid] = 0;
        __syncthreads();
#pragma unroll 1
        for (int i = 0; i < 16; i += 2) {
            const int rl = F.wave * 16 + i, row = slab * 128 + rl;
            const f32x4* xr0 = (const f32x4*)(A.in[0] + (size_t)row * DM) + F.lane; const f32x4* xr1 = xr0 + DM / 4;
            const u32x2* yr0 = (const u32x2*)(((const bf16*)(A.ws + WS_Y1)) + (size_t)row * DM) + F.lane; const u32x2* yr1 = yr0 + DM / 4;
            u32x2* hb0 = (u32x2*)(((bf16*)(A.ws + WS_H1)) + (size_t)row * DM) + F.lane; u32x2* hb1 = hb0 + DM / 4;
            f32x4 v0[4], v1[4];
#pragma unroll
            for (int j = 0; j < 4; ++j) { const u32x2 y0 = yr0[64 * j], y1 = yr1[64 * j];
                v0[j] = xr0[64 * j] * ALPHA + (f32x4){bflo(y0.x), bfhi(y0.x), bflo(y0.y), bfhi(y0.y)};
                v1[j] = xr1[64 * j] * ALPHA + (f32x4){bflo(y1.x), bfhi(y1.x), bflo(y1.y), bfhi(y1.y)}; }
            float mean0, rstd0, mean1, rstd1; ln_stats(v0, mean0, rstd0); ln_stats(v1, mean1, rstd1);
#pragma unroll
            for (int j = 0; j < 4; ++j) {
                const f32x4 g = ((const f32x4*)A.in[7])[64 * j + F.lane], bb = ((const f32x4*)A.in[8])[64 * j + F.lane];
                v0[j] = (v0[j] - mean0) * rstd0 * g + bb; v1[j] = (v1[j] - mean1) * rstd1 * g + bb;
                { u32x2 o; o.x = pk2(v0[j][0], v0[j][1]); o.y = pk2(v0[j][2], v0[j][3]); hb0[64 * j] = o; o.x = pk2(v1[j][0], v1[j][1]); o.y = pk2(v1[j][2], v1[j][3]); hb1[64 * j] = o; }
            }
            float la[20], lb2[20];
#pragma unroll
            for (int e = 0; e < 20; ++e) { la[e] = 0.f; lb2[e] = 0.f; }
#pragma unroll 1
            for (int j = 0; j < 4; ++j) {
                const f32x4 s0 = (j == 0) ? v0[0] : (j == 1) ? v0[1] : (j == 2) ? v0[2] : v0[3];
                const f32x4 s1 = (j == 0) ? v1[0] : (j == 1) ? v1[1] : (j == 2) ? v1[2] : v1[3];
                const LAS f32x4* wj = wl + j * (20 * 64);
#pragma unroll
                for (int e = 0; e < 4; ++e) {
                    const float h0 = s0[e], h1 = s1[e];
#pragma unroll
                    for (int c = 0; c < 5; ++c) { const f32x4 w = wj[(e * 5 + c) * 64];
                        la[4 * c] += h0 * w[0]; la[4 * c + 1] += h0 * w[1]; la[4 * c + 2] += h0 * w[2]; la[4 * c + 3] += h0 * w[3];
                        lb2[4 * c] += h1 * w[0]; lb2[4 * c + 1] += h1 * w[1]; lb2[4 * c + 2] += h1 * w[2]; lb2[4 * c + 3] += h1 * w[3]; }
                }
            }
#pragma unroll
            for (int e = 0; e < 20; ++e) { la[e] = wave_sum(la[e]); lb2[e] = wave_sum(lb2[e]); }
            if (F.lane == 0) { route_row(F, A, la, rl, lcnt, rec); route_row(F, A, lb2, rl + 1, lcnt, rec); }
        }
        __syncthreads();
        if (F.tid < 16) lbase[F.tid] = (int)atomicAdd(((unsigned*)(A.ws + WS_CTL)) + CW_CNT + F.tid, (unsigned)lcnt[F.tid]);
        __syncthreads();
        if (F.tid < 128) {
            unsigned* mp = ((unsigned*)(A.ws + WS_META)) + (size_t)(slab * 128 + F.tid) * 8;
            const int e0 = rec[F.tid * 6 + 0], e1 = rec[F.tid * 6 + 3];
            u32x4 a, c;
            a.x = (unsigned)e0; a.y = (unsigned)(lbase[e0] + rec[F.tid * 6 + 1]); a.z = (unsigned)rec[F.tid * 6 + 2]; a.w = (unsigned)e1;
            c.x = (unsigned)(lbase[e1] + rec[F.tid * 6 + 4]); c.y = (unsigned)rec[F.tid * 6 + 5]; c.z = 0u; c.w = 0u;
            *(u32x4*)mp = a; *(u32x4*)(mp + 4) = c;
            int* list = (int*)(A.ws + WS_LIST);
            list[e0 * 32768 + (int)a.y] = slab * 128 + F.tid; list[e1 * 32768 + (int)c.x] = slab * 128 + F.tid;
        }
        __syncthreads();
    }
}

__device__ __forceinline__ void build_toff(Frame& F, const Args& A) {
    __syncthreads();
    if (F.tid == 0) { int acc = 0;
        for (int e = 0; e < NEXP; ++e) { F.misc[e] = acc; const unsigned c = __hip_atomic_load(((unsigned*)(A.ws + WS_CTL)) + CW_CNT + e, __ATOMIC_RELAXED, __HIP_MEMORY_SCOPE_AGENT); F.misc[64 + e] = (int)c; acc += (int)((c + 255u) >> 8); }
        F.misc[NEXP] = acc; }
    __syncthreads();
}

__device__ __forceinline__ void p7_weights(Frame& F, const Args& A) {
    LAS float* scr = (LAS float*)(F.lds + F.wave * 16384);
    constexpr int I13 = (DM / 64) * (DEXP / 32), I2 = (DEXP / 64) * (DM / 32);
    for (int it = F.gw; it < NEXP * (2 * I13 + I2); it += F.ngw) {
        const int e = it / (2 * I13 + I2), r = it % (2 * I13 + I2);
        if (r < I13) transpose_item<1>(A.in[13] + (size_t)e * DM * DEXP, DM, DEXP, ((bf16*)(A.ws + WS_W13)) + (size_t)e * 1024 * DM, scr, r, F.lane);
        else if (r < 2 * I13) transpose_item<2>(A.in[14] + (size_t)e * DM * DEXP, DM, DEXP, ((bf16*)(A.ws + WS_W13)) + (size_t)e * 1024 * DM, scr, r - I13, F.lane);
        else transpose_item<0>(A.in[15] + (size_t)e * DEXP * DM, DEXP, DM, ((bf16*)(A.ws + WS_W2)) + (size_t)e * DM * DEXP, scr, r - 2 * I13, F.lane);
    }
}

__device__ __forceinline__ void p10_final(Frame& F, const Args& A) {
    build_toff(F, A);
    for (int row = F.gw; row < MTOK; row += F.ngw) {
        const unsigned* mp = ((unsigned*)(A.ws + WS_META)) + (size_t)row * 8;
        const int e0 = (int)mp[0], p0 = (int)mp[1], e1 = (int)mp[3], p1 = (int)mp[4];
        const float g0 = __uint_as_float(mp[2]), g1 = __uint_as_float(mp[5]);
        const size_t s0 = (size_t)F.misc[e0] * 256 + p0, s1 = (size_t)F.misc[e1] * 256 + p1;
        f32x4* xr = (f32x4*)(A.out + (size_t)row * DM) + F.lane; const u32x2* hr = (const u32x2*)(((bf16*)(A.ws + WS_H1)) + (size_t)row * DM) + F.lane;
        const u32x2* y0 = (const u32x2*)(((bf16*)(A.ws + WS_YS)) + s0 * DM) + F.lane; const u32x2* y1 = (const u32x2*)(((bf16*)(A.ws + WS_YS)) + s1 * DM) + F.lane;
        f32x4 v[4];
#pragma unroll
        for (int j = 0; j < 4; ++j) { const u32x2 hw = hr[64 * j]; const f32x4 hv = (f32x4){bflo(hw.x), bfhi(hw.x), bflo(hw.y), bfhi(hw.y)}; const u32x2 a = y0[64 * j], c = y1[64 * j];
            v[j][0] = ALPHA * hv[0] + g0 * bflo(a.x) + g1 * bflo(c.x); v[j][1] = ALPHA * hv[1] + g0 * bfhi(a.x) + g1 * bfhi(c.x);
            v[j][2] = ALPHA * hv[2] + g0 * bflo(a.y) + g1 * bflo(c.y); v[j][3] = ALPHA * hv[3] + g0 * bfhi(a.y) + g1 * bfhi(c.y); }
        float mean, rstd; ln_stats(v, mean, rstd);
#pragma unroll
        for (int j = 0; j < 4; ++j) { const f32x4 g = ((const f32x4*)A.in[16])[64 * j + F.lane], bb = ((const f32x4*)A.in[17])[64 * j + F.lane]; xr[64 * j] = (v[j] - mean) * rstd * g + bb; }
    }
}

#define XB_TMO      128
#define XB_XCNT(j)  (256  + 64 * (j))
#define XB_XSUB(j)  (1280 + 64 * (j))
#define XB_XGEN(j)  (2304 + 64 * (j))
#define XB_TOP      3328
#define XB_TOPGEN   3392
#define XCD_BAR_WORDS 3456
#define XB_SPIN_CAP (1u << 18)

__device__ __forceinline__ unsigned xb_ld(unsigned* p)              { return __hip_atomic_load(p, __ATOMIC_RELAXED, __HIP_MEMORY_SCOPE_AGENT); }
__device__ __forceinline__ unsigned xb_add(unsigned* p, unsigned v) { return __hip_atomic_fetch_add(p, v, __ATOMIC_RELAXED, __HIP_MEMORY_SCOPE_AGENT); }
__device__ __forceinline__ unsigned xb_xcc_id() { return (unsigned)__builtin_amdgcn_s_getreg((3 << 11) | 20) & 0xFu; }
#define XB_SPIN(cond, bar) do { unsigned _sp = 0; while (cond) { __builtin_amdgcn_s_sleep(1); \
    if ((++_sp & 255u) == 0u) { if (xb_ld(&(bar)[XB_TMO])) break; if (_sp > XB_SPIN_CAP) { atomicAdd(&(bar)[XB_TMO], 1u); break; } } } } while (0)

struct XcdBarrier {
    unsigned* bar; unsigned x;
    volatile LAS unsigned* st;
};

__device__ __forceinline__ XcdBarrier xcd_barrier_post(unsigned* bar, volatile LAS unsigned* st) {
    XcdBarrier b; b.bar = bar; b.x = xb_xcc_id(); b.st = st;
    if (threadIdx.x == 0) (void)xb_add(&bar[XB_XCNT(b.x)], 1u);
    return b;
}
__device__ __forceinline__ void xcd_barrier_complete(unsigned* bar, unsigned x, unsigned& nloc, unsigned& nx) {
    const unsigned G = gridDim.x * gridDim.y * gridDim.z;
    unsigned sum, cnt, mine, sp = 0u;
    for (;;) {
        sum = 0u; cnt = 0u; mine = 0u;
#pragma unroll
        for (unsigned j = 0; j < 16; ++j) { const unsigned c = xb_ld(&bar[XB_XCNT(j)]); sum += c; cnt += (c > 0u) ? 1u : 0u; mine = (j == x) ? c : mine; }
        if (sum == G) break;
        __builtin_amdgcn_s_sleep(1);
        if ((++sp & 255u) == 0u) { if (xb_ld(&bar[XB_TMO])) break; if (sp > XB_SPIN_CAP) { atomicAdd(&bar[XB_TMO], 1u); break; } }
    }
    nloc = mine > 0u ? mine : 1u; nx = cnt > 0u ? cnt : 1u;
}

__device__ __forceinline__ void xcd_barrier(const XcdBarrier& b) {
    asm volatile("s_waitcnt vmcnt(0)" ::: "memory");
    __syncthreads();
    if (threadIdx.x == 0) {
        unsigned* bar = b.bar;
        __builtin_amdgcn_s_waitcnt(0);
        unsigned nloc = b.st[0], nx = b.st[1];
        if (nloc == 0u) { xcd_barrier_complete(bar, b.x, nloc, nx); b.st[0] = nloc; b.st[1] = nx; }
        const unsigned old = xb_add(&bar[XB_XSUB(b.x)], 1u);
        const unsigned gen = old / nloc;
        if (old + 1u == (gen + 1u) * nloc) {
            __builtin_amdgcn_fence(__ATOMIC_RELEASE, "agent");
            asm volatile("s_waitcnt vmcnt(0)" ::: "memory");
            const unsigned og = xb_add(&bar[XB_TOP], 1u);
            const unsigned tg = og / nx;
            if (og + 1u == (tg + 1u) * nx) xb_add(&bar[XB_TOPGEN], 1u);
            else XB_SPIN(xb_ld(&bar[XB_TOPGEN]) == tg, bar);
            __builtin_amdgcn_fence(__ATOMIC_ACQUIRE, "agent");
            xb_add(&bar[XB_XGEN(b.x)], 1u);
            asm volatile("s_waitcnt vmcnt(0)" ::: "memory");
        } else {
            XB_SPIN(xb_ld(&bar[XB_XGEN(b.x)]) == gen, bar);
            __builtin_amdgcn_fence(__ATOMIC_ACQUIRE, "agent");
            asm volatile("s_waitcnt vmcnt(0)" ::: "memory");
        }
    }
    __syncthreads();
}

constexpr int NPHASE = 11;
__global__ void __launch_bounds__(NTHREADS, 2) mega_fwd(Args args) {
    extern __shared__ __attribute__((aligned(16))) unsigned char lds[];
    Frame F;
    F.lds = (LAS unsigned char*)lds; F.misc = (LAS int*)(F.lds + MISC_OFF);
    F.tid = threadIdx.x; F.lane = F.tid & 63; F.wave = __builtin_amdgcn_readfirstlane(F.tid >> 6); F.G = gridDim.x;
    F.gw = blockIdx.x * NWAVES + F.wave; F.ngw = F.G * NWAVES;
    const Args& A = args;
    const int lo = args.ph_lo, hi = args.ph_hi;
    const int vcu = (F.G % 8 == 0) ? (int)(blockIdx.x % 8) * (F.G / 8) + (int)(blockIdx.x / 8) : (int)blockIdx.x;
    if (F.tid < 2) F.misc[MISC_BAR + F.tid] = 0;
    __syncthreads();
    XcdBarrier bar; bar.bar = (unsigned*)(args.ws + WS_CTL) + CW_BAR; bar.x = 0; bar.st = nullptr;
    if (MK_LAUNCHES == 1) bar = xcd_barrier_post((unsigned*)(args.ws + WS_CTL) + CW_BAR, (volatile LAS unsigned*)(F.misc + MISC_BAR));
#define IN(k) (lo <= (k) && (k) < hi)
#define SEAM(k) do { if (IN((k) + 1)) { xcd_barrier(bar); } } while (0)

    if (IN(0)) { p0_prep(F, A); SEAM(0); }
    if (IN(1)) {
        meta_finalize(F, A);
        pg8::Gemm g{((bf16*)(A.ws + WS_XB)), ((bf16*)(A.ws + WS_WIN)), MTOK, NIN, DM}; pg8::StaticOrder S; S.init(MTOK, NIN, F.G, (int)blockIdx.x);
        EpiProj E{((bf16*)(A.ws + WS_PROJ)), ((float*)(A.ws + WS_LB))};
        pg8::gemm_phase<EpiProj, pg8::StaticOrder, PG8_ALIGN, PG8_SP2>(F.lds, g, S, E);
        SEAM(1);
    }
    if (IN(2)) {
        ha_phase(F, A);
        attn_phase(F, A);
        SEAM(2);
    }
    if (IN(3)) { hb_phase(F, A); SEAM(3); }
    if (IN(4)) {
        hc_phase(F, A);
        SEAM(4);
    }
    if (IN(5)) {
        pg8::Gemm g{((bf16*)(A.ws + WS_MIX)), ((bf16*)(A.ws + WS_WOUT)), MTOK, DM, DM}; pg8::StaticOrder S; S.init(MTOK, DM, F.G, (int)blockIdx.x);
        EpiYs E{(bf16*)(A.ws + WS_Y1)};
        pg8::gemm_phase<EpiYs, pg8::StaticOrder, PG8_ALIGN, PG8_SP2>(F.lds, g, S, E);
        SEAM(5);
    }
    if (IN(6)) { p6_ln_router(F, A); p7_weights(F, A); SEAM(6); }
    if (IN(8)) {
        build_toff(F, A);
        pg8::Gemm g{((bf16*)(A.ws + WS_H1)), ((bf16*)(A.ws + WS_W13)), XS_ROWS, 1024, DM}; MoeOrder S{(const LAS int*)F.misc, F.G, vcu, F.misc[NEXP], (const int*)(A.ws + WS_LIST)};
        EpiHid E{((bf16*)(A.ws + WS_HID))};
        pg8::gemm_phase_gather<EpiHid, MoeOrder, PG8_ALIGN, PG8_SP2>(F.lds, g, S, E);
        SEAM(8);
    }
    if (IN(9)) {
        build_toff(F, A);
        pg8::Gemm g{((bf16*)(A.ws + WS_HID)), ((bf16*)(A.ws + WS_W2)), XS_ROWS, 1024, DEXP}; MoeOrder S{(const LAS int*)F.misc, F.G, vcu, F.misc[NEXP], (const int*)(A.ws + WS_LIST)};
        EpiYs E{((bf16*)(A.ws + WS_YS))};
        pg8::gemm_phase<EpiYs, MoeOrder, PG8_ALIGN, PG8_SP2>(F.lds, g, S, E);
        SEAM(9);
    }
    if (IN(10)) { p10_final(F, A); }
#undef IN
#undef SEAM
}

extern "C" void kernel_launch(void* const* d_in, const int* in_sizes, int n_in, void* d_out, int out_size, void* d_ws, size_t ws_size, hipStream_t stream) {
    static int grid = 0;
    if (grid == 0) {
        if (n_in != 18 || in_sizes[0] != MTOK * DM || out_size != MTOK * DM || ws_size < WS_END) {
            fprintf(stderr, "kernel_launch: unexpected shapes (n_in %d, in0 %d, out %d, ws %zu); nothing launched\n", n_in, n_in > 0 ? in_sizes[0] : -1, out_size, ws_size); grid = -1; return; }
        int dev = 0, cus = 0, per_cu = 0;
        if (hipGetDevice(&dev) != hipSuccess || hipDeviceGetAttribute(&cus, hipDeviceAttributeMultiprocessorCount, dev) != hipSuccess) { grid = -1; return; }
        if (hipFuncSetAttribute((const void*)mega_fwd, hipFuncAttributeMaxDynamicSharedMemorySize, LDS_BYTES) != hipSuccess) { fprintf(stderr, "kernel_launch: hipFuncSetAttribute failed\n"); grid = -1; return; }
        if (hipOccupancyMaxActiveBlocksPerMultiprocessor(&per_cu, (const void*)mega_fwd, NTHREADS, LDS_BYTES) != hipSuccess || per_cu < 1) { fprintf(stderr, "kernel_launch: occupancy query says %d\n", per_cu); per_cu = 1; }
        (void)hipGetLastError();
        grid = cus;
    }
    if (grid < 0) return;
    (void)hipMemsetAsync((char*)d_ws + WS_CTL, 0, CTL_ZERO_BYTES, stream);
    Args a{};
    for (int i = 0; i < 18; ++i) a.in[i] = (const float*)d_in[i];
    a.out = (float*)d_out; a.ws = (unsigned char*)d_ws;
#if MK_LAUNCHES == 1
    a.ph_lo = 0; a.ph_hi = NPHASE;
    void* kargs[] = {&a};
    hipError_t e = hipLaunchCooperativeKernel((const void*)mega_fwd, dim3(grid), dim3(NTHREADS), kargs, LDS_BYTES, stream);
    if (e != hipSuccess) fprintf(stderr, "kernel_launch: cooperative launch failed: %s (grid %d)\n", hipGetErrorString(e), grid);
#else
    for (int p = 0; p < NPHASE; ++p) { a.ph_lo = p; a.ph_hi = p + 1; hipLaunchKernelGGL(mega_fwd, dim3(grid), dim3(NTHREADS), LDS_BYTES, stream, a); }
#endif
}
```

```cpp
#include <hip/hip_runtime.h>
#include <hip/hip_cooperative_groups.h>
#include <cstdio>
#include <cstdint>
namespace cg = cooperative_groups;
namespace pg8 {
#define PG8_LAS __attribute__((address_space(3)))
typedef unsigned short bf16_t;
typedef short bf16x8 __attribute__((ext_vector_type(8)));
typedef float f32x4 __attribute__((ext_vector_type(4)));
typedef unsigned u32x4 __attribute__((ext_vector_type(4)));
constexpr int BM = 256, BK = 64, HALF = 128, HTB = HALF * BK * 2  , STAGE_BYTES = 8 * HTB, NXCD = 8, WGM = 8;

__host__ __device__ __forceinline__ int lds_byte(int r, int c) { const int st = (r >> 4) * 2 + (c >> 5), rr = r & 15, cc = c & 31, ob = rr * 64 + cc * 2; return st * 1024 + (ob ^ (((ob >> 9) & 1) << 5)); }
__host__ __device__ __forceinline__ void stage_rc(int b, int& R, int& C) { const int st = b / 1024, sb = b % 1024, swz = sb ^ (((sb >> 9) & 1) << 5); R = (st >> 1) * 16 + swz / 64; C = (st & 1) * 32 + (swz % 64) / 2; }
__host__ __device__ __forceinline__ int perm32(int rho) { const int n = rho >> 4, i = rho & 15; return 8 * (i >> 2) + 4 * n + (i & 3); }

struct Unit { int pm, pn; };
struct Gemm { const bf16_t* A; const bf16_t* Bt; int M, N, K; };

struct StaticOrder {
    int nM, nN, nwg, G, c;
    __host__ __device__ void init(int M, int N, int G_, int c_) { nM = M / BM; nN = N / BM; nwg = nM * nN; G = G_; c = c_; }
    __host__ __device__ bool next(int i, Unit& u) const {
        const long L = (long)i * G + c; if (L >= nwg) return false;
        int wgid = (int)L; { const int q = nwg / NXCD, r = nwg % NXCD, xcd = wgid % NXCD, off = wgid / NXCD; wgid = (xcd < r ? xcd * (q + 1) : r * (q + 1) + (xcd - r) * q) + off; }
        const int nig = WGM * nN, gid = wgid / nig, fm = gid * WGM, gsz = (nM - fm) < WGM ? (nM - fm) : WGM;
        u.pm = fm + ((wgid % nig) % gsz); u.pn = (wgid % nig) / gsz; return true;
    }
    __device__ __forceinline__ void a_ready(const Unit&) const {}
    __device__ __forceinline__ void done(const Unit&) const {}
};

__device__ __forceinline__ unsigned cvt_pk_bf16(float lo, float hi) { unsigned r; asm volatile("v_cvt_pk_bf16_f32 %0, %1, %2" : "=v"(r) : "v"(lo), "v"(hi)); return r; }
template <class Epi, class Sched, bool ALIGN_EPI = false, bool SP2 = false>
__device__ __forceinline__ void gemm_phase(PG8_LAS unsigned char* lds, const Gemm g, const Sched& S, const Epi& E) {
    int tid_ = threadIdx.x; asm volatile("" : "+v"(tid_));
    const int tid = tid_, wid = __builtin_amdgcn_readfirstlane(tid >> 6), lane = tid & 63, wr = wid >> 2, wc = wid & 3, fr = lane & 15, fq = lane >> 4;
    const int K = g.K, nt = K / BK;
    unsigned voffA[2], voffB[2];
#pragma unroll
    for (int i = 0; i < 2; ++i) { int R, C; stage_rc(tid * 16 + i * 8192, R, C); const int Rb = Epi::PERM ? ((R & ~31) + perm32(R & 31)) : R;
        voffA[i] = (unsigned)(R * K + C) * 2u; voffB[i] = (unsigned)(Rb * K + C) * 2u; }
    const size_t kstep = (size_t)(BK * 2);
    const size_t hstep = (size_t)HALF * K * 2;
    const size_t tstep = 2 * hstep;
    const unsigned ldsw = (unsigned)wid * 1024u;
    const int aoff = lds_byte(wr * 64 + fr, fq * 8), boff = lds_byte(wc * 32 + fr, fq * 8);
#define PG8_SA(b, h) (((b) * 2 + (h)) * HTB)
#define PG8_SB(b, h) ((4 + (b) * 2 + (h)) * HTB)
#define PG8_STAGE(bufoff, gbase, voff) do { _Pragma("unroll") for (int _i = 0; _i < 2; ++_i) \
        __builtin_amdgcn_global_load_lds((const unsigned*)((const char*)(gbase) + (voff)[_i]), (PG8_LAS unsigned*)(lds + (bufoff) + ldsw + _i * 8192), 16, 0, 0); } while (0)
#define PG8_LDA(dst, b, h) do { _Pragma("unroll") for (int m = 0; m < 4; ++m) _Pragma("unroll") for (int k = 0; k < 2; ++k) dst[m][k] = *(const PG8_LAS bf16x8*)(lds + PG8_SA(b, h) + aoff + m * 2048 + k * 1024); } while (0)
#define PG8_LDB(dst, b, h) do { _Pragma("unroll") for (int n = 0; n < 2; ++n) _Pragma("unroll") for (int k = 0; k < 2; ++k) dst[n][k] = *(const PG8_LAS bf16x8*)(lds + PG8_SB(b, h) + boff + n * 2048 + k * 1024); } while (0)
#define PG8_MMA(ai, bj, At, Bt) do { __builtin_amdgcn_s_setprio(1); _Pragma("unroll") for (int m = 0; m < 4; ++m) _Pragma("unroll") for (int n = 0; n < 2; ++n) _Pragma("unroll") for (int k = 0; k < 2; ++k) \
        acc[ai][bj][m][n] = __builtin_amdgcn_mfma_f32_16x16x32_bf16(Bt[n][k], At[m][k], acc[ai][bj][m][n], 0, 0, 0); __builtin_amdgcn_s_setprio(0); } while (0)
#define PG8_WAIT_V(n) asm volatile("s_waitcnt vmcnt(" #n ")" ::: "memory")
#define PG8_WAIT_L(n) asm volatile("s_waitcnt lgkmcnt(" #n ")" ::: "memory")
#define PG8_BAR __builtin_amdgcn_s_barrier()
#define PG8_SCHED __builtin_amdgcn_sched_barrier(0)
    Unit cur, nxt; int ui = 0;
    if (!S.next(0, cur)) return;
    f32x4 acc[2][2][4][2];
#pragma unroll
    for (int a = 0; a < 2; ++a)
#pragma unroll
        for (int b = 0; b < 2; ++b)
#pragma unroll
            for (int m = 0; m < 4; ++m)
#pragma unroll
                for (int n = 0; n < 2; ++n) acc[a][b][m][n] = (f32x4){0.f, 0.f, 0.f, 0.f};
    bf16x8 At[4][2], B0[2][2], B1[2][2];
    const char* cA = (const char*)g.A + (size_t)cur.pm * tstep; const char* cB = (const char*)g.Bt + (size_t)cur.pn * tstep;
    S.a_ready(cur);
    if constexpr (SP2) {
        PG8_STAGE(PG8_SB(0, 0), cB, voffB); PG8_STAGE(PG8_SB(0, 1), cB + hstep, voffB); PG8_STAGE(PG8_SA(0, 0), cA, voffA); PG8_STAGE(PG8_SA(0, 1), cA + hstep, voffA);
        if (wr == 1) PG8_BAR;
        PG8_WAIT_V(2); PG8_BAR;
        PG8_STAGE(PG8_SB(1, 0), cB + kstep, voffB); PG8_STAGE(PG8_SA(1, 0), cA + kstep, voffA); PG8_STAGE(PG8_SB(1, 1), cB + hstep + kstep, voffB);
        PG8_WAIT_V(6); PG8_BAR;
    } else {
        PG8_STAGE(PG8_SB(0, 0), cB, voffB); PG8_STAGE(PG8_SA(0, 0), cA, voffA); PG8_STAGE(PG8_SB(0, 1), cB + hstep, voffB); PG8_STAGE(PG8_SA(0, 1), cA + hstep, voffA);
        if (wr == 1) PG8_BAR;
        PG8_WAIT_V(4); PG8_BAR;
        PG8_STAGE(PG8_SB(1, 0), cB + kstep, voffB); PG8_STAGE(PG8_SA(1, 0), cA + kstep, voffA); PG8_STAGE(PG8_SB(1, 1), cB + hstep + kstep, voffB);
        PG8_WAIT_V(6); PG8_BAR;
    }
    for (;;) {
        const bool has_next = S.next(ui + 1, nxt);
        const char* nA = has_next ? (const char*)g.A + (size_t)nxt.pm * tstep : cA; const char* nB = has_next ? (const char*)g.Bt + (size_t)nxt.pn * tstep : cB;
        for (int t = 0; t < nt; t += 2) {
            const bool last = (t == nt - 2);
            const char* a1 = cA + (size_t)(t + 1) * kstep;
            const char* a2 = last ? nA : cA + (size_t)(t + 2) * kstep; const char* b2 = last ? nB : cB + (size_t)(t + 2) * kstep;
            const char* a3 = a2 + kstep; const char* b3 = b2 + kstep;
            if (last && has_next) S.a_ready(nxt);
            if constexpr (SP2) {
            PG8_LDB(B0, 0, 0); PG8_LDB(B1, 0, 1); PG8_SCHED; PG8_LDA(At, 0, 0); PG8_STAGE(PG8_SA(1, 1), a1 + hstep, voffA);
            PG8_WAIT_V(8); PG8_WAIT_L(0); PG8_BAR; PG8_MMA(0, 0, At, B0); PG8_MMA(0, 1, At, B1); PG8_BAR; PG8_SCHED;
            PG8_LDA(At, 0, 1); PG8_STAGE(PG8_SB(0, 0), b2, voffB); PG8_STAGE(PG8_SB(0, 1), b2 + hstep, voffB); PG8_STAGE(PG8_SA(0, 0), a2, voffA);
            PG8_WAIT_V(8); PG8_WAIT_L(0); PG8_BAR; PG8_MMA(1, 0, At, B0); PG8_MMA(1, 1, At, B1); PG8_BAR; PG8_SCHED;
            PG8_LDB(B0, 1, 0); PG8_LDB(B1, 1, 1); PG8_SCHED; PG8_LDA(At, 1, 0); PG8_STAGE(PG8_SA(0, 1), a2 + hstep, voffA);
            PG8_WAIT_V(8); PG8_WAIT_L(0); PG8_BAR; PG8_MMA(0, 0, At, B0); PG8_MMA(0, 1, At, B1); PG8_BAR; PG8_SCHED;
            PG8_LDA(At, 1, 1); PG8_STAGE(PG8_SB(1, 0), b3, voffB); PG8_STAGE(PG8_SB(1, 1), b3 + hstep, voffB); PG8_STAGE(PG8_SA(1, 0), a3, voffA);
            PG8_WAIT_V(8); PG8_WAIT_L(0); PG8_BAR; PG8_MMA(1, 0, At, B0); PG8_MMA(1, 1, At, B1); PG8_BAR; PG8_SCHED;
            } else {
            PG8_LDB(B0, 0, 0); PG8_SCHED; PG8_LDA(At, 0, 0); PG8_STAGE(PG8_SA(1, 1), a1 + hstep, voffA);
            PG8_WAIT_L(8); PG8_BAR; PG8_WAIT_L(0); PG8_MMA(0, 0, At, B0); PG8_BAR; PG8_SCHED;
            PG8_LDB(B1, 0, 1); PG8_STAGE(PG8_SB(0, 0), b2, voffB);
            PG8_BAR; PG8_WAIT_L(0); PG8_MMA(0, 1, At, B1); PG8_BAR;
            PG8_LDA(At, 0, 1); PG8_STAGE(PG8_SA(0, 0), a2, voffA);
            PG8_BAR; PG8_WAIT_L(0); PG8_MMA(1, 0, At, B0); PG8_BAR; PG8_SCHED;
            PG8_STAGE(PG8_SB(0, 1), b2 + hstep, voffB);
            PG8_WAIT_V(6); PG8_BAR; PG8_MMA(1, 1, At, B1); PG8_BAR;
            PG8_LDB(B0, 1, 0); PG8_SCHED; PG8_LDA(At, 1, 0); PG8_STAGE(PG8_SA(0, 1), a2 + hstep, voffA);
            PG8_WAIT_L(8); PG8_BAR; PG8_WAIT_L(0); PG8_MMA(0, 0, At, B0); PG8_BAR; PG8_SCHED;
            PG8_LDB(B1, 1, 1); PG8_STAGE(PG8_SB(1, 0), b3, voffB);
            PG8_BAR; PG8_WAIT_L(0); PG8_MMA(0, 1, At, B1); PG8_BAR;
            PG8_LDA(At, 1, 1); PG8_STAGE(PG8_SA(1, 0), a3, voffA);
            PG8_BAR; PG8_WAIT_L(0); PG8_MMA(1, 0, At, B0); PG8_BAR; PG8_SCHED;
            PG8_STAGE(PG8_SB(1, 1), b3 + hstep, voffB);
            PG8_WAIT_V(6); PG8_BAR; PG8_MMA(1, 1, At, B1); PG8_BAR;
            }
        }
        if constexpr (ALIGN_EPI) { if (wr == 0) PG8_BAR; }
        if constexpr (!Epi::AFTER_DRAIN) { E(acc, cur, wr, wc, fr, fq); S.done(cur); }
        if (!has_next) break;
#pragma unroll
        for (int a = 0; a < 2; ++a)
#pragma unroll
            for (int b = 0; b < 2; ++b)
#pragma unroll
                for (int m = 0; m < 4; ++m)
#pragma unroll
                    for (int n = 0; n < 2; ++n) acc[a][b][m][n] = (f32x4){0.f, 0.f, 0.f, 0.f};
        cur = nxt; cA = nA; cB = nB; ++ui;
        if constexpr (ALIGN_EPI) { if (wr == 1) PG8_BAR; }
    }
    PG8_WAIT_V(0);
    if constexpr (!ALIGN_EPI) { if (wr == 0) PG8_BAR; }
    PG8_BAR;
    if constexpr (Epi::AFTER_DRAIN) { E.fused(acc, cur, wr, wc, fr, fq, lds, wid, lane); S.done(cur); }
#undef PG8_SA
#undef PG8_SB
#undef PG8_STAGE
#undef PG8_LDA
#undef PG8_LDB
#undef PG8_MMA
#undef PG8_WAIT_V
#undef PG8_WAIT_L
#undef PG8_BAR
#undef PG8_SCHED
}

template <class Epi, class Sched, bool ALIGN_EPI = false, bool SP2 = false>
__device__ __forceinline__ void gemm_phase_gather(PG8_LAS unsigned char* lds, const Gemm g, const Sched& S, const Epi& E) {
    int tid_ = threadIdx.x; asm volatile("" : "+v"(tid_));
    const int tid = tid_, wid = __builtin_amdgcn_readfirstlane(tid >> 6), lane = tid & 63, wr = wid >> 2, wc = wid & 3, fr = lane & 15, fq = lane >> 4;
    const int K = g.K, nt = K / BK;
    unsigned voffA[2], voffB[2]; int rowA[2];
    unsigned oC[2][2], oN[2][2], o2[2][2];
#pragma unroll
    for (int i = 0; i < 2; ++i) { int R, C; stage_rc(tid * 16 + i * 8192, R, C); const int Rb = Epi::PERM ? ((R & ~31) + perm32(R & 31)) : R;
        voffA[i] = (unsigned)C * 2u; rowA[i] = R; voffB[i] = (unsigned)(Rb * K + C) * 2u; }
    const size_t kstep = (size_t)(BK * 2);
    const size_t hstep = (size_t)HALF * K * 2;
    const size_t tstep = 2 * hstep;
    const unsigned ldsw = (unsigned)wid * 1024u;
    const int aoff = lds_byte(wr * 64 + fr, fq * 8), boff = lds_byte(wc * 32 + fr, fq * 8);
#define PG8_SA(b, h) (((b) * 2 + (h)) * HTB)
#define PG8_SB(b, h) ((4 + (b) * 2 + (h)) * HTB)
#define PG8_STAGE(bufoff, gbase, voff) do { _Pragma("unroll") for (int _i = 0; _i < 2; ++_i) \
        __builtin_amdgcn_global_load_lds((const unsigned*)((const char*)(gbase) + (voff)[_i]), (PG8_LAS unsigned*)(lds + (bufoff) + ldsw + _i * 8192), 16, 0, 0); } while (0)
#define PG8_LDA(dst, b, h) do { _Pragma("unroll") for (int m = 0; m < 4; ++m) _Pragma("unroll") for (int k = 0; k < 2; ++k) dst[m][k] = *(const PG8_LAS bf16x8*)(lds + PG8_SA(b, h) + aoff + m * 2048 + k * 1024); } while (0)
#define PG8_LDB(dst, b, h) do { _Pragma("unroll") for (int n = 0; n < 2; ++n) _Pragma("unroll") for (int k = 0; k < 2; ++k) dst[n][k] = *(const PG8_LAS bf16x8*)(lds + PG8_SB(b, h) + boff + n * 2048 + k * 1024); } while (0)
#define PG8_MMA(ai, bj, At, Bt) do { __builtin_amdgcn_s_setprio(1); _Pragma("unroll") for (int m = 0; m < 4; ++m) _Pragma("unroll") for (int n = 0; n < 2; ++n) _Pragma("unroll") for (int k = 0; k < 2; ++k) \
        acc[ai][bj][m][n] = __builtin_amdgcn_mfma_f32_16x16x32_bf16(Bt[n][k], At[m][k], acc[ai][bj][m][n], 0, 0, 0); __builtin_amdgcn_s_setprio(0); } while (0)
#define PG8_WAIT_V(n) asm volatile("s_waitcnt vmcnt(" #n ")" ::: "memory")
#define PG8_WAIT_L(n) asm volatile("s_waitcnt lgkmcnt(" #n ")" ::: "memory")
#define PG8_BAR __builtin_amdgcn_s_barrier()
#define PG8_SCHED __builtin_amdgcn_sched_barrier(0)
    Unit cur, nxt; int ui = 0;
    if (!S.next(0, cur)) return;
    f32x4 acc[2][2][4][2];
#pragma unroll
    for (int a = 0; a < 2; ++a)
#pragma unroll
        for (int b = 0; b < 2; ++b)
#pragma unroll
            for (int m = 0; m < 4; ++m)
#pragma unroll
                for (int n = 0; n < 2; ++n) acc[a][b][m][n] = (f32x4){0.f, 0.f, 0.f, 0.f};
    bf16x8 At[4][2], B0[2][2], B1[2][2];
    const char* cA = (const char*)g.A; const char* cB = (const char*)g.Bt + (size_t)cur.pn * tstep;
#define PG8_ROWOFFS(dst, unit) do { _Pragma("unroll") for (int _h = 0; _h < 2; ++_h) _Pragma("unroll") for (int _i = 0; _i < 2; ++_i) \
        dst[_h][_i] = (unsigned)S.a_row(unit, _h * HALF + rowA[_i]) * (unsigned)(K * 2) + voffA[_i]; } while (0)
    PG8_ROWOFFS(oC, cur);
    S.a_ready(cur);
    if constexpr (SP2) {
        PG8_STAGE(PG8_SB(0, 0), cB, voffB); PG8_STAGE(PG8_SB(0, 1), cB + hstep, voffB); PG8_STAGE(PG8_SA(0, 0), cA, oC[0]); PG8_STAGE(PG8_SA(0, 1), cA, oC[1]);
        if (wr == 1) PG8_BAR;
        PG8_WAIT_V(2); PG8_BAR;
        PG8_STAGE(PG8_SB(1, 0), cB + kstep, voffB); PG8_STAGE(PG8_SA(1, 0), cA + kstep, oC[0]); PG8_STAGE(PG8_SB(1, 1), cB + hstep + kstep, voffB);
        PG8_WAIT_V(6); PG8_BAR;
    } else {
        PG8_STAGE(PG8_SB(0, 0), cB, voffB); PG8_STAGE(PG8_SA(0, 0), cA, oC[0]); PG8_STAGE(PG8_SB(0, 1), cB + hstep, voffB); PG8_STAGE(PG8_SA(0, 1), cA, oC[1]);
        if (wr == 1) PG8_BAR;
        PG8_WAIT_V(4); PG8_BAR;
        PG8_STAGE(PG8_SB(1, 0), cB + kstep, voffB); PG8_STAGE(PG8_SA(1, 0), cA + kstep, oC[0]); PG8_STAGE(PG8_SB(1, 1), cB + hstep + kstep, voffB);
        PG8_WAIT_V(6); PG8_BAR;
    }
    for (;;) {
        const bool has_next = S.next(ui + 1, nxt);
        const char* nB = has_next ? (const char*)g.Bt + (size_t)nxt.pn * tstep : cB;
        if (has_next) { PG8_ROWOFFS(oN, nxt); } else { _Pragma("unroll") for (int _h = 0; _h < 2; ++_h) _Pragma("unroll") for (int _i = 0; _i < 2; ++_i) oN[_h][_i] = oC[_h][_i]; }
        for (int t = 0; t < nt; t += 2) {
            const bool last = (t == nt - 2);
            const char* a1 = cA + (size_t)(t + 1) * kstep;
            const char* a2 = last ? cA : cA + (size_t)(t + 2) * kstep; const char* b2 = last ? nB : cB + (size_t)(t + 2) * kstep;
#pragma unroll
            for (int _h = 0; _h < 2; ++_h)
#pragma unroll
                for (int _i = 0; _i < 2; ++_i) o2[_h][_i] = last ? oN[_h][_i] : oC[_h][_i];
            const char* a3 = a2 + kstep; const char* b3 = b2 + kstep;
            if (last && has_next) S.a_ready(nxt);
            if constexpr (SP2) {
            PG8_LDB(B0, 0, 0); PG8_LDB(B1, 0, 1); PG8_SCHED; PG8_LDA(At, 0, 0); PG8_STAGE(PG8_SA(1, 1), a1, oC[1]);
            PG8_WAIT_V(8); PG8_WAIT_L(0); PG8_BAR; PG8_MMA(0, 0, At, B0); PG8_MMA(0, 1, At, B1); PG8_BAR; PG8_SCHED;
            PG8_LDA(At, 0, 1); PG8_STAGE(PG8_SB(0, 0), b2, voffB); PG8_STAGE(PG8_SB(0, 1), b2 + hstep, voffB); PG8_STAGE(PG8_SA(0, 0), a2, o2[0]);
            PG8_WAIT_V(8); PG8_WAIT_L(0); PG8_BAR; PG8_MMA(1, 0, At, B0); PG8_MMA(1, 1, At, B1); PG8_BAR; PG8_SCHED;
            PG8_LDB(B0, 1, 0); PG8_LDB(B1, 1, 1); PG8_SCHED; PG8_LDA(At, 1, 0); PG8_STAGE(PG8_SA(0, 1), a2, o2[1]);
            PG8_WAIT_V(8); PG8_WAIT_L(0); PG8_BAR; PG8_MMA(0, 0, At, B0); PG8_MMA(0, 1, At, B1); PG8_BAR; PG8_SCHED;
            PG8_LDA(At, 1, 1); PG8_STAGE(PG8_SB(1, 0), b3, voffB); PG8_STAGE(PG8_SB(1, 1), b3 + hstep, voffB); PG8_STAGE(PG8_SA(1, 0), a3, o2[0]);
            PG8_WAIT_V(8); PG8_WAIT_L(0); PG8_BAR; PG8_MMA(1, 0, At, B0); PG8_MMA(1, 1, At, B1); PG8_BAR; PG8_SCHED;
            } else {
            PG8_LDB(B0, 0, 0); PG8_SCHED; PG8_LDA(At, 0, 0); PG8_STAGE(PG8_SA(1, 1), a1, oC[1]);
            PG8_WAIT_L(8); PG8_BAR; PG8_WAIT_L(0); PG8_MMA(0, 0, At, B0); PG8_BAR; PG8_SCHED;
            PG8_LDB(B1, 0, 1); PG8_STAGE(PG8_SB(0, 0), b2, voffB);
            PG8_BAR; PG8_WAIT_L(0); PG8_MMA(0, 1, At, B1); PG8_BAR;
            PG8_LDA(At, 0, 1); PG8_STAGE(PG8_SA(0, 0), a2, o2[0]);
            PG8_BAR; PG8_WAIT_L(0); PG8_MMA(1, 0, At, B0); PG8_BAR; PG8_SCHED;
            PG8_STAGE(PG8_SB(0, 1), b2 + hstep, voffB);
            PG8_WAIT_V(6); PG8_BAR; PG8_MMA(1, 1, At, B1); PG8_BAR;
            PG8_LDB(B0, 1, 0); PG8_SCHED; PG8_LDA(At, 1, 0); PG8_STAGE(PG8_SA(0, 1), a2, o2[1]);
            PG8_WAIT_L(8); PG8_BAR; PG8_WAIT_L(0); PG8_MMA(0, 0, At, B0); PG8_BAR; PG8_SCHED;
            PG8_LDB(B1, 1, 1); PG8_STAGE(PG8_SB(1, 0), b3, voffB);
            PG8_BAR; PG8_WAIT_L(0); PG8_MMA(0, 1, At, B1); PG8_BAR;
            PG8_LDA(At, 1, 1); PG8_STAGE(PG8_SA(1, 0), a3, o2[0]);
            PG8_BAR; PG8_WAIT_L(0); PG8_MMA(1, 0, At, B0); PG8_BAR; PG8_SCHED;
            PG8_STAGE(PG8_SB(1, 1), b3 + hstep, voffB);
            PG8_WAIT_V(6); PG8_BAR; PG8_MMA(1, 1, At, B1); PG8_BAR;
            }
        }
        if constexpr (ALIGN_EPI) { if (wr == 0) PG8_BAR; }
        if constexpr (!Epi::AFTER_DRAIN) { E(acc, cur, wr, wc, fr, fq); S.done(cur); }
        if (!has_next) break;
#pragma unroll
        for (int a = 0; a < 2; ++a)
#pragma unroll
            for (int b = 0; b < 2; ++b)
#pragma unroll
                for (int m = 0; m < 4; ++m)
#pragma unroll
                    for (int n = 0; n < 2; ++n) acc[a][b][m][n] = (f32x4){0.f, 0.f, 0.f, 0.f};
        cur = nxt; cB = nB; ++ui;
#pragma unroll
        for (int _h = 0; _h < 2; ++_h)
#pragma unroll
            for (int _i = 0; _i < 2; ++_i) oC[_h][_i] = oN[_h][_i];
        if constexpr (ALIGN_EPI) { if (wr == 1) PG8_BAR; }
    }
    PG8_WAIT_V(0);
    if constexpr (!ALIGN_EPI) { if (wr == 0) PG8_BAR; }
    PG8_BAR;
    if constexpr (Epi::AFTER_DRAIN) { E.fused(acc, cur, wr, wc, fr, fq, lds, wid, lane); S.done(cur); }
#undef PG8_ROWOFFS
#undef PG8_SA
#undef PG8_SB
#undef PG8_STAGE
#undef PG8_LDA
#undef PG8_LDB
#undef PG8_MMA
#undef PG8_WAIT_V
#undef PG8_WAIT_L
#undef PG8_BAR
#undef PG8_SCHED
}
}


#ifndef PG8_SP2
#define PG8_SP2 true
#endif
#ifndef PG8_ALIGN
#define PG8_ALIGN true
#endif
#ifndef MK_LAUNCHES
#define MK_LAUNCHES 1
#endif

#define GAS __attribute__((address_space(1)))
#define LAS __attribute__((address_space(3)))
typedef unsigned short bf16;
typedef float f32x4 __attribute__((ext_vector_type(4)));
typedef unsigned u32x4 __attribute__((ext_vector_type(4)));
typedef unsigned u32x2 __attribute__((ext_vector_type(2)));

constexpr int NB = 8, SEQ = 4096, DM = 1024, NMETA = 16;
constexpr int ROWS = 4160, PADR = 48, TOK0 = 64;
constexpr int MTOK = NB * SEQ;
constexpr int NIN = 3584;
constexpr int BROWS = NB * ROWS;
constexpr size_t ARR = (size_t)BROWS * 512;
constexpr int NCH = 64;
constexpr int NEXP = 16, DEXP = 512;
constexpr int XS_ROWS = 69632;
constexpr float ALPHA = 1.189207115002721f;
constexpr float LN_EPS = 1e-5f, RMS_EPS = 1e-6f;
constexpr float LOG2E = 1.4426950408889634f;
constexpr float C2Q = 0.125f * LOG2E;
constexpr float STICK_THR = 48.0f;

constexpr size_t MiB = 1u << 20;
constexpr size_t WS_CTL = 0, CTL_ZERO_BYTES = 1 * MiB;
constexpr size_t WS_WIN = 1 * MiB;
constexpr size_t WS_WOUT = 8 * MiB;
constexpr size_t WS_LB = 10 * MiB;
constexpr size_t WS_META = 11 * MiB;
constexpr size_t WS_LIST = 13 * MiB;
constexpr size_t WS_DV = 12 * MiB;
constexpr size_t WS_XB = 16 * MiB;
constexpr size_t WS_S = 16 * MiB;
constexpr size_t WS_PROJ = 80 * MiB;
constexpr size_t WS_U = 308 * MiB;
constexpr size_t WS_MIX = 436 * MiB;
constexpr size_t WS_Y1 = 308 * MiB;
constexpr size_t WS_H1 = 16 * MiB;
constexpr size_t WS_W13 = 80 * MiB;
constexpr size_t WS_W2 = 112 * MiB;
constexpr size_t WS_XS = 128 * MiB;
constexpr size_t WS_HID = 264 * MiB;
constexpr size_t WS_YS = 332 * MiB;
constexpr size_t WS_END = 500 * MiB;
static_assert(WS_PROJ + 7 * ARR * 2 <= WS_U && WS_U + (size_t)32 * 64 * 16384 * 4 <= WS_MIX && WS_MIX + (size_t)MTOK * DM * 2 <= WS_END, "ws map A");
static_assert(WS_W13 + (size_t)16 * 1024 * 1024 * 2 <= WS_W2 && WS_W2 + (size_t)16 * 1024 * 512 * 2 <= WS_XS && WS_XS + (size_t)XS_ROWS * 1024 * 2 <= WS_HID &&
              WS_HID + (size_t)XS_ROWS * 512 * 2 <= WS_YS && WS_YS + (size_t)XS_ROWS * 1024 * 2 <= WS_END, "ws map B");
constexpr int CW_CNT = 64;
constexpr int CW_BAR = 4096;
constexpr int MISC_BAR = 100;

constexpr int RING_BYTES = 131072;
constexpr int MISC_OFF = RING_BYTES;
constexpr int LDS_BYTES = 147456;
constexpr int NWAVES = 8, NTHREADS = 512;

#define LBAR() do { asm volatile("s_waitcnt lgkmcnt(0)" ::: "memory"); __builtin_amdgcn_s_barrier(); asm volatile("" ::: "memory"); } while (0)
__device__ __forceinline__ unsigned f2bf(float f) { unsigned u = __builtin_bit_cast(unsigned, f); return (u + 0x7fffu + ((u >> 16) & 1u)) >> 16; }
typedef float f32x2_t __attribute__((ext_vector_type(2))); typedef __bf16 bf16x2_t __attribute__((ext_vector_type(2)));
__device__ __forceinline__ unsigned pk2(float lo, float hi) { f32x2_t v = {lo, hi}; bf16x2_t b = __builtin_convertvector(v, bf16x2_t); return __builtin_bit_cast(unsigned, b); }
__device__ __forceinline__ float bf2f(unsigned h) { return __builtin_bit_cast(float, h << 16); }
__device__ __forceinline__ float bflo(unsigned w) { return __builtin_bit_cast(float, w << 16); }
__device__ __forceinline__ float bfhi(unsigned w) { return __builtin_bit_cast(float, w & 0xffff0000u); }
__device__ __forceinline__ float ex2(float x) { return __builtin_amdgcn_exp2f(x); }
__device__ __forceinline__ float lg2(float x) { return __builtin_amdgcn_logf(x); }
__device__ __forceinline__ float rcpf_(float x) { return __builtin_amdgcn_rcpf(x); }
__device__ __forceinline__ float sigm(float v) { return rcpf_(1.f + ex2(-v * LOG2E)); }
template <int CTRL, int ROWMASK, bool BOUND> __device__ __forceinline__ float dpp_mov(float x) {
    return __builtin_bit_cast(float, __builtin_amdgcn_update_dpp(0, __builtin_bit_cast(int, x), CTRL, ROWMASK, 0xf, BOUND));
}
__device__ __forceinline__ float wave_sum_to63(float x) {
    x += dpp_mov<0x111, 0xf, true>(x); x += dpp_mov<0x112, 0xf, true>(x); x += dpp_mov<0x114, 0xf, true>(x); x += dpp_mov<0x118, 0xf, true>(x);
    x += dpp_mov<0x142, 0xa, false>(x); x += dpp_mov<0x143, 0xc, false>(x);
    return x;
}
__device__ __forceinline__ float wave_sum_all(float x) { return __builtin_bit_cast(float, __builtin_amdgcn_readlane(__builtin_bit_cast(int, wave_sum_to63(x)), 63)); }
__device__ __forceinline__ float wave_sum(float v) {
#pragma unroll
    for (int o = 1; o < 64; o <<= 1) v += __shfl_xor(v, o);
    return v;
}
__device__ __forceinline__ size_t pidx(int kind, int b, int r, int col) {
    const int sh = (kind < 4) ? 7 : 6;
    return (size_t)kind * ARR + ((size_t)((b * (512 >> sh) + (col >> sh)) * ROWS + r) << sh) + (col & ((1 << sh) - 1));
}
template <int XF> __device__ __forceinline__ float xform(float v, float lb) {
    if (XF == 0) return v * sigm(v);
    if (XF == 1) return lg2(lb + (1.f - lb) * sigm(v));
    if (XF == 3) return sigm(v);
    if (XF == 4) return v * C2Q;
    return v;
}
__device__ __forceinline__ float xform_rt(int kind, float v, float lb) {
    switch (kind) { case 0: return xform<0>(v, lb); case 1: return xform<1>(v, lb); case 3: return xform<3>(v, lb); case 4: return xform<4>(v, lb); default: return v; }
}

using pg8::Unit;
struct EpiProj {
    static constexpr bool PERM = true, AFTER_DRAIN = false;
    bf16* proj; const float* lb;
    template <int XF> __device__ __forceinline__ void run(int kind, const f32x4 (&acc)[2][2][4][2], const Unit& u, int wr, int wc, int fr, int fq) const {
        const int b = u.pm >> 4;
        const int rb = TOK0 + (u.pm & 15) * 256 + wr * 64 + fr;
        const int c0 = (u.pn & 1) * 256 + wc * 32 + 8 * fq;
        const int sh = (kind < 4) ? 7 : 6;
        bf16* pb0 = proj + pidx(kind, b, rb, c0); bf16* pb1 = proj + pidx(kind, b, rb, c0 + 128);
        f32x4 l0[2], l1[2];
#pragma unroll
        for (int bj = 0; bj < 2; ++bj) {
            if (XF == 1) { l0[bj] = *(const f32x4*)(lb + c0 + bj * 128); l1[bj] = *(const f32x4*)(lb + c0 + bj * 128 + 4); }
            else { l0[bj] = (f32x4){0.f, 0.f, 0.f, 0.f}; l1[bj] = l0[bj]; }
        }
#pragma unroll
        for (int ai = 0; ai < 2; ++ai)
#pragma unroll
            for (int m = 0; m < 4; ++m) {
                const size_t ro = (size_t)(ai * 128 + m * 16) << sh;
#pragma unroll
                for (int bj = 0; bj < 2; ++bj) {
                    const f32x4 v0 = acc[ai][bj][m][0], v1 = acc[ai][bj][m][1];
                    u32x4 w;
                    w.x = pk2(xform<XF>(v0[0], l0[bj][0]), xform<XF>(v0[1], l0[bj][1]));
                    w.y = pk2(xform<XF>(v0[2], l0[bj][2]), xform<XF>(v0[3], l0[bj][3]));
                    w.z = pk2(xform<XF>(v1[0], l1[bj][0]), xform<XF>(v1[1], l1[bj][1]));
                    w.w = pk2(xform<XF>(v1[2], l1[bj][2]), xform<XF>(v1[3], l1[bj][3]));
                    __builtin_nontemporal_store(w, (u32x4*)((bj ? pb1 : pb0) + ro));
                }
            }
    }
    __device__ __forceinline__ void operator()(const f32x4 (&acc)[2][2][4][2], const Unit& u, int wr, int wc, int fr, int fq) const {
        const int kind = u.pn >> 1;
        if (kind == 0) run<0>(kind, acc, u, wr, wc, fr, fq);
        else if (kind == 1) run<1>(kind, acc, u, wr, wc, fr, fq);
        else if (kind == 3) run<3>(kind, acc, u, wr, wc, fr, fq);
        else if (kind == 4) run<4>(kind, acc, u, wr, wc, fr, fq);
        else run<2>(kind, acc, u, wr, wc, fr, fq);
    }
};
struct EpiOut {
    static constexpr bool PERM = false, AFTER_DRAIN = false;
    const float* x; float* out;
    __device__ __forceinline__ void operator()(const f32x4 (&acc)[2][2][4][2], const Unit& u, int wr, int wc, int fr, int fq) const {
        const int row0 = u.pm * 256 + wr * 64 + fr, col0 = u.pn * 256 + wc * 32 + 4 * fq;
#pragma unroll
        for (int ai = 0; ai < 2; ++ai)
#pragma unroll
            for (int m = 0; m < 4; ++m) {
                const size_t ro = (size_t)(row0 + ai * 128 + m * 16) * DM + col0;
#pragma unroll
                for (int bj = 0; bj < 2; ++bj)
#pragma unroll
                    for (int n = 0; n < 2; ++n) {
                        const f32x4 xv = *(const f32x4*)(x + ro + bj * 128 + 16 * n);
                        *(f32x4*)(out + ro + bj * 128 + 16 * n) = acc[ai][bj][m][n] + xv * ALPHA;
                    }
            }
    }
};
struct EpiHid {
    static constexpr bool PERM = true, AFTER_DRAIN = false;
    bf16* hid;
    __device__ __forceinline__ void operator()(const f32x4 (&acc)[2][2][4][2], const Unit& u, int wr, int wc, int fr, int fq) const {
        const int row0 = u.pm * 256 + wr * 64 + fr, hc0 = (u.pn & 3) * 128 + wc * 16 + 4 * fq;
#pragma unroll
        for (int ai = 0; ai < 2; ++ai)
#pragma unroll
            for (int m = 0; m < 4; ++m) {
                bf16* rowp = hid + (size_t)(row0 + ai * 128 + m * 16) * DEXP + hc0;
#pragma unroll
                for (int bj = 0; bj < 2; ++bj) {
                    const f32x4 g = acc[ai][bj][m][0], up = acc[ai][bj][m][1];
                    u32x2 w;
                    w.x = pk2(g[0] * sigm(g[0]) * up[0], g[1] * sigm(g[1]) * up[1]);
                    w.y = pk2(g[2] * sigm(g[2]) * up[2], g[3] * sigm(g[3]) * up[3]);
                    __builtin_nontemporal_store(w, (u32x2*)(rowp + bj * 64));
                }
            }
    }
};
struct EpiYs {
    static constexpr bool PERM = true, AFTER_DRAIN = false;
    bf16* ys;
    __device__ __forceinline__ void operator()(const f32x4 (&acc)[2][2][4][2], const Unit& u, int wr, int wc, int fr, int fq) const {
        const int row0 = u.pm * 256 + wr * 64 + fr, col0 = (u.pn & 3) * 256 + wc * 32 + 8 * fq;
#pragma unroll
        for (int ai = 0; ai < 2; ++ai)
#pragma unroll
            for (int m = 0; m < 4; ++m) {
                bf16* rowp = ys + (size_t)(row0 + ai * 128 + m * 16) * DM + col0;
#pragma unroll
                for (int bj = 0; bj < 2; ++bj) {
                    const f32x4 v0 = acc[ai][bj][m][0], v1 = acc[ai][bj][m][1];
                    u32x4 w; w.x = pk2(v0[0], v0[1]); w.y = pk2(v0[2], v0[3]); w.z = pk2(v1[0], v1[1]); w.w = pk2(v1[2], v1[3]);
                    __builtin_nontemporal_store(w, (u32x4*)(rowp + bj * 128));
                }
            }
    }
};
struct MoeOrder {
    const LAS int* toff; int G, c, ntot; const int* list;
    __device__ __forceinline__ int a_row(const Unit& u, int r) const {
        const int e = u.pn >> 2, pos = (u.pm - toff[e]) * 256 + r;
        return (pos < toff[64 + e]) ? list[e * 32768 + pos] : 0;
    }
    __device__ __forceinline__ bool next(int i, Unit& u) const {
        const long L = (long)i * G + c; if (L >= (long)ntot * 4) return false;
        const int mt = (int)(L >> 2), pl = (int)(L & 3); int e = 0;
#pragma unroll
        for (int j = 1; j < NEXP; ++j) e += (mt >= toff[j]) ? 1 : 0;
        u.pm = mt; u.pn = e * 4 + pl; return true;
    }
    __device__ __forceinline__ void a_ready(const Unit&) const {}
    __device__ __forceinline__ void done(const Unit&) const {}
};

struct Args { const float* in[18]; float* out; unsigned char* ws; int ph_lo, ph_hi; };
struct Frame {
    LAS unsigned char* lds; LAS int* misc;
    int tid, lane, wave, G, gw, ngw;
};

template <int MODE> __device__ __forceinline__ int rowmap(int n) { return MODE == 0 ? n : ((n >> 2) * 8 + (n & 3) + (MODE == 2 ? 4 : 0)); }
template <int MODE> __device__ __forceinline__ void transpose_item(const float* W, int K, int N, bf16* WT, LAS float* scr, int item, int lane) {
    const int nblk = N / 32, kb = item / nblk, nb = item % nblk, k0 = 64 * kb, n0 = 32 * nb;
#pragma unroll
    for (int i = 0; i < 8; ++i) { const int kk = 8 * i + (lane >> 3), c4 = (lane & 7) * 4;
        const f32x4 v = __builtin_nontemporal_load((const f32x4*)(W + (size_t)(k0 + kk) * N + n0 + c4));
        LAS float* d = scr + kk * 33 + c4; d[0] = v[0]; d[1] = v[1]; d[2] = v[2]; d[3] = v[3]; }
    asm volatile("s_waitcnt lgkmcnt(0)" ::: "memory");
    const int c = lane & 7;
#pragma unroll
    for (int j = 0; j < 4; ++j) { const int n = (lane >> 3) + 8 * j; const LAS float* s = scr + (8 * c) * 33 + n;
        u32x4 o; o.x = pk2(s[0 * 33], s[1 * 33]); o.y = pk2(s[2 * 33], s[3 * 33]); o.z = pk2(s[4 * 33], s[5 * 33]); o.w = pk2(s[6 * 33], s[7 * 33]);
        *(u32x4*)(WT + (size_t)rowmap<MODE>(n0 + n) * K + k0 + 8 * c) = o; }
    asm volatile("s_waitcnt lgkmcnt(0)" ::: "memory");
}

__device__ __forceinline__ void p0_prep(Frame& F, const Args& A) {
    LAS float* scr = (LAS float*)(F.lds + F.wave * 16384);
    const int gtid = blockIdx.x * NTHREADS + F.tid, gthreads = F.G * NTHREADS;
    for (int i = gtid; i < 512; i += gthreads) ((float*)(A.ws + WS_LB))[i] = 1.f / (1.f + __expf(A.in[3][512 + i] - A.in[3][i]));
    for (int i = gtid; i < 7 * NB * 3072; i += gthreads) {
        const int a = i / (NB * 3072), r = i % (NB * 3072), b = r / 3072, o = r % 3072;
        const int sh = (a < 4) ? 7 : 6, per_head = 48 << (sh - 3), h = o / per_head, rem = o % per_head;
        *(u32x4*)(((bf16*)(A.ws + WS_PROJ)) + (size_t)a * ARR + ((size_t)((b * (512 >> sh) + h) * ROWS) << sh) + (size_t)rem * 8) = (u32x4){0u, 0u, 0u, 0u};
    }
    for (int job = F.gw; job < 56 * 16; job += F.ngw) {
        const int cgp = job >> 4, kq = job & 15, n = cgp * 64 + F.lane;
        float acc[16];
#pragma unroll
        for (int r = 0; r < 16; ++r) acc[r] = 0.f;
        const float* mt = A.in[1] + 64 * kq; const float* wp = A.in[2] + (size_t)(64 * kq) * NIN + n;
#pragma unroll 8
        for (int k = 0; k < 64; ++k) {
            const float w = wp[(size_t)k * NIN];
#pragma unroll
            for (int r = 0; r < 16; ++r) acc[r] += mt[r * DM + k] * w;
        }
        float* mp = ((float*)(A.ws + WS_U)) + (size_t)(kq * 16) * NIN + n;
#pragma unroll
        for (int r = 0; r < 16; ++r) mp[(size_t)r * NIN] = acc[r];
    }
    constexpr int I_IN = (DM / 64) * (NIN / 32), I_OUT = (DM / 64) * (DM / 32);
    for (int it = F.gw; it < I_IN + I_OUT; it += F.ngw) {
        if (it < I_IN) transpose_item<0>(A.in[2], DM, NIN, ((bf16*)(A.ws + WS_WIN)), scr, it, F.lane);
        else transpose_item<0>(A.in[6], DM, DM, ((bf16*)(A.ws + WS_WOUT)), scr, it - I_IN, F.lane);
    }
    for (int m = 4 * F.gw; m < MTOK; m += 4 * F.ngw) {
        const f32x4* xr = (const f32x4*)(A.in[0] + (size_t)m * DM) + F.lane;
        u32x2* o8 = (u32x2*)(((bf16*)(A.ws + WS_XB)) + (size_t)m * DM) + F.lane;
        f32x4 v[16];
#pragma unroll
        for (int j = 0; j < 16; ++j) v[j] = __builtin_nontemporal_load(xr + 64 * j);
#pragma unroll
        for (int j = 0; j < 16; ++j) { u32x2 w; w.x = pk2(v[j][0], v[j][1]); w.y = pk2(v[j][2], v[j][3]); o8[64 * j] = w; }
    }
}

__device__ __forceinline__ void meta_finalize(Frame& F, const Args& A) {
    const float* mp = (const float*)(A.ws + WS_U); const float* lb = (const float*)(A.ws + WS_LB);
    for (int idx = blockIdx.x * NTHREADS + F.tid; idx < 16 * NIN; idx += F.G * NTHREADS) {
        const int r = idx / NIN, n = idx % NIN, kind = n >> 9, col = n & 511;
        float v = 0.f;
#pragma unroll
        for (int kq = 0; kq < 16; ++kq) v += mp[(size_t)(kq * 16 + r) * NIN + n];
        const unsigned short o = (unsigned short)f2bf(xform_rt(kind, v, lb[col]));
#pragma unroll
        for (int b = 0; b < NB; ++b) ((bf16*)(A.ws + WS_PROJ))[pidx(kind, b, PADR + r, col)] = o;
    }
}

typedef short s16x8 __attribute__((ext_vector_type(8)));
typedef short v4i16_t __attribute__((ext_vector_type(4)));
__device__ __forceinline__ s16x8 tr8(const LAS unsigned char* p, int rowskip) {
    const v4i16_t lo = __builtin_amdgcn_ds_read_tr16_b64_v4i16((LAS v4i16_t*)p);
    const v4i16_t hh = __builtin_amdgcn_ds_read_tr16_b64_v4i16((LAS v4i16_t*)(p + rowskip));
    return (s16x8){lo[0], lo[1], lo[2], lo[3], hh[0], hh[1], hh[2], hh[3]};
}
struct RawTile { u32x4 a, b; };
__device__ __forceinline__ RawTile raw_load(const bf16* arr, int b, int h, int c, int tid) {
    const bf16* p = arr + (size_t)((b * 4 + h) * ROWS + 64 * c + (tid >> 4)) * 128 + 8 * (tid & 15);
    RawTile r; r.a = *(const u32x4*)p; r.b = *(const u32x4*)(p + (size_t)32 * 128); return r;
}
__device__ __forceinline__ void raw_store(LAS unsigned char* dst, int pitch, const RawTile& r, int tid) {
    LAS unsigned char* p = dst + (tid >> 4) * pitch + (tid & 15) * 16;
    *(LAS u32x4*)p = r.a; *(LAS u32x4*)(p + 32 * pitch) = r.b;
}
constexpr int PRAW = 272;
constexpr int PKT = 144;
__device__ __forceinline__ void ha_phase(Frame& F, const Args& A) {
    const bf16* LF = ((bf16*)(A.ws + WS_PROJ)) + 1 * ARR; const bf16* HV = ((bf16*)(A.ws + WS_PROJ)) + 2 * ARR;
    LAS unsigned char* RLF = F.lds;
    LAS unsigned char* VN = RLF + 64 * PRAW;
    LAS unsigned char* KT = VN + 64 * PRAW;
    LAS float* TOT = (LAS float*)(KT + 128 * PKT);
    const int tid = F.tid, lane = F.lane, w = F.wave, fr = lane & 15, fq = lane >> 4;
    const int d = tid & 127, sq = tid >> 7;
    int u = blockIdx.x;
    RawTile rl, rv;
    if (u < 32 * 64) { rl = raw_load(LF, u >> 8, (u >> 6) & 3, u & 63, tid); rv = raw_load(HV, u >> 8, (u >> 6) & 3, u & 63, tid); }
    for (; u < 32 * 64; u += F.G) {
        const int bh = u >> 6, c = u & 63;
        raw_store(RLF, PRAW, rl, tid); raw_store(VN, PRAW, rv, tid);
        LBAR();
        { const int un = u + F.G; if (un < 32 * 64) { rl = raw_load(LF, un >> 8, (un >> 6) & 3, un & 63, tid); rv = raw_load(HV, un >> 8, (un >> 6) & 3, un & 63, tid); } }
        float lf[16], pre[16]; float run = 0.f;
#pragma unroll
        for (int i = 0; i < 16; ++i) { lf[i] = bf2f(*(const LAS unsigned short*)(RLF + (16 * sq + i) * PRAW + 2 * d)); run += lf[i]; pre[i] = run; }
        TOT[sq * 128 + d] = run;
        LBAR();
        float off = 0.f, blast = 0.f;
#pragma unroll
        for (int q = 0; q < 4; ++q) { const float t = TOT[q * 128 + d]; off += (q < sq) ? t : 0.f; blast += t; }
        { unsigned kw[8];
#pragma unroll
          for (int i = 0; i < 8; ++i) { const float k0 = (1.f - ex2(lf[2 * i])) * ex2(blast - (off + pre[2 * i])), k1 = (1.f - ex2(lf[2 * i + 1])) * ex2(blast - (off + pre[2 * i + 1])); kw[i] = pk2(k0, k1); }
          LAS u32x4* kp = (LAS u32x4*)(KT + d * PKT + 32 * sq);
          kp[0] = (u32x4){kw[0], kw[1], kw[2], kw[3]}; kp[1] = (u32x4){kw[4], kw[5], kw[6], kw[7]}; }
        if (sq == 0) ((float*)(A.ws + WS_DV))[(size_t)(bh * 64 + c) * 128 + d] = ex2(blast);
        LBAR();
        const LAS unsigned char* vt = VN + (8 * fq + (fr >> 2)) * PRAW + (16 * w + 4 * (fr & 3)) * 2;
        const s16x8 b0 = tr8(vt, 4 * PRAW), b1 = tr8(vt + 32 * PRAW, 4 * PRAW);
        bf16* up = ((bf16*)(A.ws + WS_U)) + (size_t)(bh * 64 + c) * 16384 + (size_t)(16 * w + fr) * 128 + 4 * fq;
#pragma unroll
        for (int dt = 0; dt < 8; ++dt) {
            const LAS unsigned char* kp = KT + (16 * dt + fr) * PKT + 16 * fq;
            const s16x8 a0 = *(const LAS s16x8*)kp, a1 = *(const LAS s16x8*)(kp + 64);
            f32x4 acc = (f32x4){0.f, 0.f, 0.f, 0.f};
            acc = __builtin_amdgcn_mfma_f32_16x16x32_bf16(a0, b0, acc, 0, 0, 0);
            acc = __builtin_amdgcn_mfma_f32_16x16x32_bf16(a1, b1, acc, 0, 0, 0);
            { u32x2 o; o.x = pk2(acc[0], acc[1]); o.y = pk2(acc[2], acc[3]); *(u32x2*)(up + 16 * dt) = o; }
        }
        LBAR();
    }
}

typedef float f32x16 __attribute__((ext_vector_type(16)));
__device__ __forceinline__ s16x8 pack8(u32x2 a, u32x2 c) { const u32x4 w = (u32x4){a.x, a.y, c.x, c.y}; return __builtin_bit_cast(s16x8, w); }
struct AttnCtx { const bf16* kbase; const bf16* vbase; LAS unsigned char* vw; const LAS unsigned char* vt; int ktd, qrow, hi; };
struct KVSet { s16x8 kf[4]; u32x4 vr[4]; };
__device__ __forceinline__ void kv_load(KVSet& x, const bf16* kbase, const bf16* vbase, int kt) {
    const bf16* kp = kbase + (size_t)(32 * kt) * 64; const bf16* vp = vbase + (size_t)(32 * kt) * 64;
#pragma unroll
    for (int s2 = 0; s2 < 4; ++s2) x.kf[s2] = *(const s16x8*)(kp + 16 * s2);
#pragma unroll
    for (int i = 0; i < 4; ++i) x.vr[i] = *(const u32x4*)(vp + (size_t)(8 * i) * 64);
}
__device__ __forceinline__ bool attn_tile(const AttnCtx& C, int kt, const s16x8 (&qf)[4], const KVSet& x, f32x16& o0, f32x16& o1, float& T) {
    const int k0 = 32 * kt, hi = C.hi;
    f32x16 p;
#pragma unroll
    for (int r = 0; r < 16; ++r) p[r] = 0.f;
#pragma unroll
    for (int s2 = 0; s2 < 4; ++s2) p = __builtin_amdgcn_mfma_f32_32x32x16_bf16(x.kf[s2], qf[s2], p, 0, 0, 0);
#pragma unroll
    for (int i = 0; i < 4; ++i) *(LAS u32x4*)(C.vw + i * 1024) = x.vr[i];
    s16x8 va[2][2];
#pragma unroll
    for (int dt = 0; dt < 2; ++dt)
#pragma unroll
        for (int s2 = 0; s2 < 2; ++s2) va[dt][s2] = tr8(C.vt + dt * 64 + s2 * 2048, 1024);
    const bool edge = (kt == C.ktd) || (kt == 1);
    float sp[16], iss[16], gs[4];
#pragma unroll
    for (int r = 0; r < 16; ++r) {
        const float z = fminf(p[r], 100.f); p[r] = z;
        float v = lg2(1.f + ex2(z));
        if (edge) { const int key = k0 + (r & 3) + 8 * (r >> 2) + 4 * hi; if (!(key >= PADR && key < C.qrow)) v = 0.f; }
        sp[r] = v;
    }
#pragma unroll
    for (int g = 0; g < 4; ++g) { iss[4 * g + 3] = sp[4 * g + 3]; iss[4 * g + 2] = iss[4 * g + 3] + sp[4 * g + 2]; iss[4 * g + 1] = iss[4 * g + 2] + sp[4 * g + 1]; iss[4 * g] = iss[4 * g + 1] + sp[4 * g]; gs[g] = iss[4 * g]; }
    float sg[4], go[4];
#pragma unroll
    for (int g = 0; g < 4; ++g) { const auto rr = __builtin_amdgcn_permlane32_swap(__float_as_uint(gs[g]), __float_as_uint(gs[g]), false, false);
        sg[g] = __uint_as_float(rr[0]) + __uint_as_float(rr[1]); go[g] = hi ? 0.f : __uint_as_float(rr[1]); }
    float off[4];
    off[3] = T + go[3]; const float e2 = sg[3]; off[2] = T + e2 + go[2]; const float e1 = e2 + sg[2]; off[1] = T + e1 + go[1]; const float e0 = e1 + sg[1]; off[0] = T + e0 + go[0];
    T += e0 + sg[0];
    float a[16];
#pragma unroll
    for (int r = 0; r < 16; ++r) {
        float v = ex2(p[r] - (off[r >> 2] + iss[r]));
        if (edge) { const int key = k0 + (r & 3) + 8 * (r >> 2) + 4 * hi; if (!(key >= PADR && key < C.qrow)) v = 0.f; }
        a[r] = v;
    }
#pragma unroll
    for (int s2 = 0; s2 < 2; ++s2) {
        u32x4 w; w.x = pk2(a[8 * s2], a[8 * s2 + 1]); w.y = pk2(a[8 * s2 + 2], a[8 * s2 + 3]); w.z = pk2(a[8 * s2 + 4], a[8 * s2 + 5]); w.w = pk2(a[8 * s2 + 6], a[8 * s2 + 7]);
        const s16x8 pb = __builtin_bit_cast(s16x8, w);
        o0 = __builtin_amdgcn_mfma_f32_32x32x16_bf16(va[0][s2], pb, o0, 0, 0, 0);
        o1 = __builtin_amdgcn_mfma_f32_32x32x16_bf16(va[1][s2], pb, o1, 0, 0, 0);
    }
    return __all(T > STICK_THR) || kt == 1;
}
__device__ __forceinline__ void attn_phase(Frame& F, const Args& A) {
    const bf16* SQ = ((bf16*)(A.ws + WS_PROJ)) + 4 * ARR; const bf16* SK = ((bf16*)(A.ws + WS_PROJ)) + 5 * ARR; const bf16* SV = ((bf16*)(A.ws + WS_PROJ)) + 6 * ARR;
    const int r32 = F.lane & 31, hi = F.lane >> 5;
    AttnCtx C;
    C.vw = F.lds + F.wave * 4096 + (F.lane >> 3) * 128 + (F.lane & 7) * 16;
    C.vt = F.lds + F.wave * 4096 + (4 * hi + ((F.lane & 15) >> 2)) * 128 + ((F.lane >> 4) & 1) * 32 + (F.lane & 3) * 8;
    C.hi = hi;
    constexpr int NU = 64 * 128;
    LAS float* GL = (LAS float*)(F.lds + 32768);
    GL[F.tid] = A.in[5][F.tid];
    LBAR();
    int wu = F.gw;
    if (wu >= NU) return;
    s16x8 qf[4]; KVSet SA, SB, SC;
#define ATT_SETUP(wuv, kb, vb, q0v, bv, hv) const int bv = (wuv) >> 10, hv = ((wuv) >> 7) & 7, q0v = TOK0 + 32 * ((wuv) & 127); \
        const bf16* kb = SK + (size_t)((bv * 8 + hv) * ROWS + r32) * 64 + 8 * hi; const bf16* vb = SV + (size_t)((bv * 8 + hv) * ROWS + (F.lane >> 3)) * 64 + 8 * (F.lane & 7);
    { ATT_SETUP(wu, kb, vb, q0, b, h)
      const bf16* qp = SQ + (size_t)((b * 8 + h) * ROWS + q0 + r32) * 64 + 8 * hi;
#pragma unroll
      for (int s2 = 0; s2 < 4; ++s2) qf[s2] = *(const s16x8*)(qp + 16 * s2);
      kv_load(SA, kb, vb, q0 >> 5); kv_load(SB, kb, vb, (q0 >> 5) - 1); kv_load(SC, kb, vb, (q0 >> 5) - 2); }
    for (;;) {
        ATT_SETUP(wu, kb, vb, q0, b, h)
        C.kbase = kb; C.vbase = vb; C.qrow = q0 + r32; C.ktd = q0 >> 5;
        const int wn = wu + F.ngw; const bool has_next = wn < NU;
        ATT_SETUP(has_next ? wn : wu, kbn, vbn, q0n, bn, hn)
        s16x8 qn[4];
        f32x16 o0, o1;
#pragma unroll
        for (int r = 0; r < 16; ++r) { o0[r] = 0.f; o1[r] = 0.f; }
        float T = 0.f;
        bool done = attn_tile(C, C.ktd, qf, SA, o0, o1, T);
        if (has_next) { const bf16* qp = SQ + (size_t)((bn * 8 + hn) * ROWS + q0n + r32) * 64 + 8 * hi;
#pragma unroll
            for (int s2 = 0; s2 < 4; ++s2) qn[s2] = *(const s16x8*)(qp + 16 * s2);
            kv_load(SA, kbn, vbn, q0n >> 5); }
        if (!done) done = attn_tile(C, C.ktd - 1, qf, SB, o0, o1, T);
        if (has_next) kv_load(SB, kbn, vbn, (q0n >> 5) - 1);
        if (!done) done = attn_tile(C, C.ktd - 2, qf, SC, o0, o1, T);
        for (int kt = C.ktd - 3; !done; --kt) { kv_load(SC, kb, vb, kt); done = attn_tile(C, kt, qf, SC, o0, o1, T); }
        if (has_next) kv_load(SC, kbn, vbn, (q0n >> 5) - 2);
        float ss = 0.f;
#pragma unroll
        for (int r = 0; r < 16; ++r) ss += o0[r] * o0[r] + o1[r] * o1[r];
        { const auto rr = __builtin_amdgcn_permlane32_swap(__float_as_uint(ss), __float_as_uint(ss), false, false); ss = __uint_as_float(rr[0]) + __uint_as_float(rr[1]); }
        const float rs = __builtin_amdgcn_rsqf(ss * (1.f / 64.f) + RMS_EPS);
        const LAS float* gp = GL + 64 * h + 4 * hi;
        bf16* op = ((bf16*)(A.ws + WS_MIX)) + (size_t)(b * SEQ + C.qrow - TOK0) * DM + 512 + 64 * h + 4 * hi;
#pragma unroll
        for (int g = 0; g < 4; ++g) {
            const f32x4 g0 = *(const LAS f32x4*)(gp + 8 * g), g1 = *(const LAS f32x4*)(gp + 32 + 8 * g);
            u32x2 w0, w1;
            w0.x = pk2(o0[4 * g] * rs * g0[0], o0[4 * g + 1] * rs * g0[1]); w0.y = pk2(o0[4 * g + 2] * rs * g0[2], o0[4 * g + 3] * rs * g0[3]);
            w1.x = pk2(o1[4 * g] * rs * g1[0], o1[4 * g + 1] * rs * g1[1]); w1.y = pk2(o1[4 * g + 2] * rs * g1[2], o1[4 * g + 3] * rs * g1[3]);
            *(u32x2*)(op + 8 * g) = w0; *(u32x2*)(op + 32 + 8 * g) = w1;
        }
        if (!has_next) break;
        wu = wn;
#pragma unroll
        for (int s2 = 0; s2 < 4; ++s2) qf[s2] = qn[s2];
    }
#undef ATT_SETUP
}

__device__ __forceinline__ void hb_phase(Frame& F, const Args& A) {
    LAS float* DVL = (LAS float*)F.lds;
    for (int job = blockIdx.x; job < 32 * 8; job += F.G) {
        const int bh = job >> 3, v = (job & 7) * 16 + (F.tid >> 5), d4 = (F.tid & 31) * 4;
        { const f32x4* src = (const f32x4*)(((const float*)(A.ws + WS_DV)) + (size_t)bh * 64 * 128);
#pragma unroll
          for (int i = 0; i < 4; ++i) ((LAS f32x4*)DVL)[F.tid + 512 * i] = src[F.tid + 512 * i]; }
        __syncthreads();
        const bf16* up = ((bf16*)(A.ws + WS_U)) + (size_t)bh * 64 * 16384 + v * 128 + d4;
        bf16* sp = ((bf16*)(A.ws + WS_S)) + (size_t)bh * 64 * 16384 + v * 128 + d4;
        f32x4 s = (f32x4){0.f, 0.f, 0.f, 0.f};
#pragma unroll 16
        for (int c = 0; c < 64; ++c) {
            const u32x2 ub = __builtin_nontemporal_load((const u32x2*)(up + (size_t)c * 16384));
            const f32x4 uu = (f32x4){bflo(ub.x), bfhi(ub.x), bflo(ub.y), bfhi(ub.y)}, dd = *(const LAS f32x4*)(DVL + c * 128 + d4);
            s = dd * s + uu;
            u32x2 w; w.x = pk2(s[0], s[1]); w.y = pk2(s[2], s[3]);
            *(u32x2*)(sp + (size_t)c * 16384) = w;
        }
        __syncthreads();
    }
}

__device__ __forceinline__ void hc_phase(Frame& F, const Args& A) {
    const bf16* HQ = ((bf16*)(A.ws + WS_PROJ)); const bf16* LF = HQ + 1 * ARR; const bf16* HV = HQ + 2 * ARR; const bf16* HG = HQ + 3 * ARR;
    LAS unsigned char* RLF = F.lds;
    LAS unsigned char* RQ = RLF + 64 * PRAW;
    LAS unsigned char* VN = RQ + 64 * PRAW;
    LAS unsigned char* QT = VN + 64 * PRAW;
    LAS unsigned char* KI = QT + 64 * PRAW;
    LAS unsigned char* SC = KI + 64 * PRAW;
    LAS float* TOT = (LAS float*)(SC + 64 * PKT);
    LAS float* SSQ = TOT + 512;
    LAS float* NGL = SSQ + 512;
    const int tid = F.tid, lane = F.lane, w = F.wave, fr = lane & 15, fq = lane >> 4;
    const int d = tid & 127, sq = tid >> 7;
    NGL[tid] = A.in[4][tid];
    int u = blockIdx.x;
    RawTile rl, rq, rv;
    if (u < 32 * 64) { const int b = u >> 8, h = (u >> 6) & 3, cc = (u & 63) + 1; rl = raw_load(LF, b, h, cc, tid); rq = raw_load(HQ, b, h, cc, tid); rv = raw_load(HV, b, h, cc, tid); }
    for (; u < 32 * 64; u += F.G) {
        const int bh = u >> 6, b = bh >> 2, h = bh & 3, cc = (u & 63) + 1;
        raw_store(RLF, PRAW, rl, tid); raw_store(RQ, PRAW, rq, tid); raw_store(VN, PRAW, rv, tid);
        LBAR();
        s16x8 sa[4]; u32x2 gt[4];
        { const bf16* sp = ((bf16*)(A.ws + WS_S)) + (size_t)(bh * 64 + cc - 1) * 16384 + (size_t)(16 * w + fr) * 128 + 8 * fq;
#pragma unroll
          for (int ks = 0; ks < 4; ++ks) sa[ks] = *(const s16x8*)(sp + 32 * ks);
          const bf16* gp = HG + (size_t)((b * 4 + h) * ROWS + 64 * cc + fr) * 128 + 16 * w + 4 * fq;
#pragma unroll
          for (int tt = 0; tt < 4; ++tt) gt[tt] = *(const u32x2*)(gp + (size_t)(16 * tt) * 128); }
        { const int un = u + F.G; if (un < 32 * 64) { const int b2 = un >> 8, h2 = (un >> 6) & 3, c2 = (un & 63) + 1; rl = raw_load(LF, b2, h2, c2, tid); rq = raw_load(HQ, b2, h2, c2, tid); rv = raw_load(HV, b2, h2, c2, tid); } }
        {
            float lf[16], pre[16], qv[16]; float run = 0.f;
#pragma unroll
            for (int i = 0; i < 16; ++i) { lf[i] = bf2f(*(const LAS unsigned short*)(RLF + (16 * sq + i) * PRAW + 2 * d)); qv[i] = bf2f(*(const LAS unsigned short*)(RQ + (16 * sq + i) * PRAW + 2 * d)); run += lf[i]; pre[i] = run; }
            TOT[sq * 128 + d] = run;
            LBAR();
            float off = 0.f;
#pragma unroll
            for (int q = 0; q < 4; ++q) { const float t = TOT[q * 128 + d]; off += (q < sq) ? t : 0.f; }
#pragma unroll
            for (int i = 0; i < 16; ++i) { const float bc = off + pre[i];
                *(LAS unsigned short*)(QT + (16 * sq + i) * PRAW + 2 * d) = (unsigned short)f2bf(qv[i] * ex2(bc));
                *(LAS unsigned short*)(KI + (16 * sq + i) * PRAW + 2 * d) = (unsigned short)f2bf((1.f - ex2(lf[i])) * ex2(-bc)); }
        }
        LBAR();
        {
            const int tt = w >> 1;
            s16x8 bq[4];
            const LAS unsigned char* qp = QT + (16 * tt + fr) * PRAW + 16 * fq;
#pragma unroll
            for (int ks = 0; ks < 4; ++ks) bq[ks] = *(const LAS s16x8*)(qp + 64 * ks);
#pragma unroll
            for (int j = 0; j < 2; ++j) {
                const int st = 2 * (w & 1) + j;
                const LAS unsigned char* kp = KI + (16 * st + fr) * PRAW + 16 * fq;
                f32x4 acc = (f32x4){0.f, 0.f, 0.f, 0.f};
#pragma unroll
                for (int ks = 0; ks < 4; ++ks) acc = __builtin_amdgcn_mfma_f32_16x16x32_bf16(*(const LAS s16x8*)(kp + 64 * ks), bq[ks], acc, 0, 0, 0);
                const int t = 16 * tt + fr, s0 = 16 * st + 4 * fq;
                u32x2 wv; wv.x = pk2(s0 <= t ? acc[0] : 0.f, s0 + 1 <= t ? acc[1] : 0.f); wv.y = pk2(s0 + 2 <= t ? acc[2] : 0.f, s0 + 3 <= t ? acc[3] : 0.f);
                *(LAS u32x2*)(SC + t * PKT + 2 * s0) = wv;
            }
        }
        LBAR();
        f32x4 acc[4];
        {
            const LAS unsigned char* vt = VN + (8 * fq + (fr >> 2)) * PRAW + (16 * w + 4 * (fr & 3)) * 2;
            const s16x8 av0 = tr8(vt, 4 * PRAW), av1 = tr8(vt + 32 * PRAW, 4 * PRAW);
#pragma unroll
            for (int tt = 0; tt < 4; ++tt) {
                const LAS unsigned char* scp = SC + (16 * tt + fr) * PKT + 16 * fq;
                const LAS unsigned char* qp = QT + (16 * tt + fr) * PRAW + 16 * fq;
                f32x4 c = (f32x4){0.f, 0.f, 0.f, 0.f};
                c = __builtin_amdgcn_mfma_f32_16x16x32_bf16(av0, *(const LAS s16x8*)scp, c, 0, 0, 0);
                c = __builtin_amdgcn_mfma_f32_16x16x32_bf16(av1, *(const LAS s16x8*)(scp + 64), c, 0, 0, 0);
#pragma unroll
                for (int ks = 0; ks < 4; ++ks) c = __builtin_amdgcn_mfma_f32_16x16x32_bf16(sa[ks], *(const LAS s16x8*)(qp + 64 * ks), c, 0, 0, 0);
                acc[tt] = c;
                float ss = (c[0] * c[0] + c[1] * c[1]) + (c[2] * c[2] + c[3] * c[3]);
                ss += __shfl_xor(ss, 16); ss += __shfl_xor(ss, 32);
                if (fq == 0) SSQ[w * 64 + 16 * tt + fr] = ss;
            }
        }
        LBAR();
        {
            const f32x4 ng = *(const LAS f32x4*)(NGL + 128 * h + 16 * w + 4 * fq);
            bf16* op = ((bf16*)(A.ws + WS_MIX)) + (size_t)(b * SEQ + 64 * (cc - 1) + fr) * DM + 128 * h + 16 * w + 4 * fq;
#pragma unroll
            for (int tt = 0; tt < 4; ++tt) {
                float tot = 0.f;
#pragma unroll
                for (int k = 0; k < 8; ++k) tot += SSQ[k * 64 + 16 * tt + fr];
                const float rs = __builtin_amdgcn_rsqf(tot * (1.f / 128.f) + RMS_EPS);
                u32x2 o;
                o.x = pk2(acc[tt][0] * rs * ng[0] * bflo(gt[tt].x), acc[tt][1] * rs * ng[1] * bfhi(gt[tt].x));
                o.y = pk2(acc[tt][2] * rs * ng[2] * bflo(gt[tt].y), acc[tt][3] * rs * ng[3] * bfhi(gt[tt].y));
                *(u32x2*)(op + (size_t)(16 * tt) * DM) = o;
            }
        }
        LBAR();
    }
}

__device__ __forceinline__ void ln_stats(const f32x4 (&v)[4], float& mean, float& rstd) {
    float s = 0.f;
#pragma unroll
    for (int j = 0; j < 4; ++j) s += (v[j][0] + v[j][1]) + (v[j][2] + v[j][3]);
    mean = wave_sum_all(s) * (1.f / DM);
    float s2 = 0.f;
#pragma unroll
    for (int j = 0; j < 4; ++j) { const f32x4 d = v[j] - mean; s2 += (d[0] * d[0] + d[1] * d[1]) + (d[2] * d[2] + d[3] * d[3]); }
    rstd = 1.0f / sqrtf(wave_sum_all(s2) * (1.f / DM) + LN_EPS);
}

__device__ __forceinline__ void route_row(const Args& A, const float (&lg)[20], int& e0, int& e1, float& w0g, float& w1g) {
    const float* brg = A.in[10];
    float g0 = lg[0] + brg[0], g1 = lg[1] + brg[1], g2 = lg[2] + brg[2], g3 = lg[3] + brg[3];
    int grp = 0; float gm = g0;
    if (g1 > gm) { gm = g1; grp = 1; } if (g2 > gm) { gm = g2; grp = 2; } if (g3 > gm) { gm = g3; grp = 3; }
    const float pg = 1.f / (__expf(g0 - gm) + __expf(g1 - gm) + __expf(g2 - gm) + __expf(g3 - gm));
    float in0, in1, in2, in3;
    if (grp == 0) { in0 = lg[4]; in1 = lg[5]; in2 = lg[6]; in3 = lg[7]; }
    else if (grp == 1) { in0 = lg[8]; in1 = lg[9]; in2 = lg[10]; in3 = lg[11]; }
    else if (grp == 2) { in0 = lg[12]; in1 = lg[13]; in2 = lg[14]; in3 = lg[15]; }
    else { in0 = lg[16]; in1 = lg[17]; in2 = lg[18]; in3 = lg[19]; }
    const f32x4 be = *(const f32x4*)(A.in[12] + grp * 4);
    in0 += be[0]; in1 += be[1]; in2 += be[2]; in3 += be[3];
    int i0 = 0; float m0 = in0;
    if (in1 > m0) { m0 = in1; i0 = 1; } if (in2 > m0) { m0 = in2; i0 = 2; } if (in3 > m0) { m0 = in3; i0 = 3; }
    int i1 = -1; float m1 = 0.f;
    if (i0 != 0) { m1 = in0; i1 = 0; }
    if (i0 != 1 && (i1 < 0 || in1 > m1)) { m1 = in1; i1 = 1; }
    if (i0 != 2 && (i1 < 0 || in2 > m1)) { m1 = in2; i1 = 2; }
    if (i0 != 3 && (i1 < 0 || in3 > m1)) { m1 = in3; i1 = 3; }
    const float w0 = 1.f / (1.f + __expf(m1 - m0)), w1 = 1.f - w0;
    e0 = grp * 4 + i0; e1 = grp * 4 + i1; w0g = pg * w0; w1g = pg * w1;
}
__device__ __forceinline__ void p6_ln_router(Frame& F, const Args& A) {
    LAS int* lcnt = F.misc + 32; LAS int* lbase = F.misc + 48;
    LAS f32x4* WL = (LAS f32x4*)F.lds;
    LAS float* LG = (LAS float*)(F.lds + 81920);
    LAS f32x4* GBL = (LAS f32x4*)(F.lds + 92160);
    for (int it = F.tid; it < 1024 * 5; it += NTHREADS) {
        const int k = it / 5, c = it % 5, j = k >> 8, ln = (k >> 2) & 63, e = k & 3;
        const f32x4 w = (c == 0) ? *(const f32x4*)(A.in[9] + (size_t)k * 4) : *(const f32x4*)(A.in[11] + (size_t)k * 16 + 4 * (c - 1));
        WL[((j * 4 + e) * 5 + c) * 64 + ln] = w;
    }
    if (F.tid < 256) GBL[F.tid] = ((const f32x4*)A.in[7])[F.tid]; else GBL[F.tid] = ((const f32x4*)A.in[8])[F.tid - 256];
    __syncthreads();
    const LAS f32x4* wl = WL + F.lane;
    for (int slab = blockIdx.x; slab < MTOK / 128; slab += F.G) {
        if (F.tid < 16) lcnt[F.tid] = 0;
        const int row0 = slab * 128 + F.wave * 16;
        f32x4 x0[4], x1[4]; u32x2 y0[4], y1[4];
        { const f32x4* xr = (const f32x4*)(A.in[0] + (size_t)row0 * DM) + F.lane; const u32x2* yr = (const u32x2*)(((const bf16*)(A.ws + WS_Y1)) + (size_t)row0 * DM) + F.lane;
#pragma unroll
          for (int j = 0; j < 4; ++j) { x0[j] = xr[64 * j]; x1[j] = xr[DM / 4 + 64 * j]; y0[j] = yr[64 * j]; y1[j] = yr[DM / 4 + 64 * j]; } }
#pragma unroll 1
        for (int i = 0; i < 16; i += 2) {
            const int rl = F.wave * 16 + i, row = slab * 128 + rl;
            u32x2* hb0 = (u32x2*)(((bf16*)(A.ws + WS_H1)) + (size_t)row * DM) + F.lane; u32x2* hb1 = hb0 + DM / 4;
            f32x4 v0[4], v1[4];
#pragma unroll
            for (int j = 0; j < 4; ++j) {
                v0[j] = x0[j] * ALPHA + (f32x4){bflo(y0[j].x), bfhi(y0[j].x), bflo(y0[j].y), bfhi(y0[j].y)};
                v1[j] = x1[j] * ALPHA + (f32x4){bflo(y1[j].x), bfhi(y1[j].x), bflo(y1[j].y), bfhi(y1[j].y)}; }
            if (i + 2 < 16) {
                const f32x4* xr = (const f32x4*)(A.in[0] + (size_t)(row + 2) * DM) + F.lane; const u32x2* yr = (const u32x2*)(((const bf16*)(A.ws + WS_Y1)) + (size_t)(row + 2) * DM) + F.lane;
#pragma unroll
                for (int j = 0; j < 4; ++j) { x0[j] = xr[64 * j]; x1[j] = xr[DM / 4 + 64 * j]; y0[j] = yr[64 * j]; y1[j] = yr[DM / 4 + 64 * j]; }
            }
            float mean0, rstd0, mean1, rstd1; ln_stats(v0, mean0, rstd0); ln_stats(v1, mean1, rstd1);
#pragma unroll
            for (int j = 0; j < 4; ++j) {
                const f32x4 g = GBL[64 * j + F.lane], bb = GBL[256 + 64 * j + F.lane];
                v0[j] = (v0[j] - mean0) * rstd0 * g + bb; v1[j] = (v1[j] - mean1) * rstd1 * g + bb;
                { u32x2 o; o.x = pk2(v0[j][0], v0[j][1]); o.y = pk2(v0[j][2], v0[j][3]); hb0[64 * j] = o; o.x = pk2(v1[j][0], v1[j][1]); o.y = pk2(v1[j][2], v1[j][3]); hb1[64 * j] = o; }
            }
            float la[20], lb2[20];
#pragma unroll
            for (int e = 0; e < 20; ++e) { la[e] = 0.f; lb2[e] = 0.f; }
#pragma unroll 1
            for (int j = 0; j < 4; ++j) {
                const f32x4 s0 = (j == 0) ? v0[0] : (j == 1) ? v0[1] : (j == 2) ? v0[2] : v0[3];
                const f32x4 s1 = (j == 0) ? v1[0] : (j == 1) ? v1[1] : (j == 2) ? v1[2] : v1[3];
                const LAS f32x4* wj = wl + j * (20 * 64);
#pragma unroll
                for (int e = 0; e < 4; ++e) {
                    const float h0 = s0[e], h1 = s1[e];
#pragma unroll
                    for (int c = 0; c < 5; ++c) { const f32x4 w = wj[(e * 5 + c) * 64];
                        la[4 * c] += h0 * w[0]; la[4 * c + 1] += h0 * w[1]; la[4 * c + 2] += h0 * w[2]; la[4 * c + 3] += h0 * w[3];
                        lb2[4 * c] += h1 * w[0]; lb2[4 * c + 1] += h1 * w[1]; lb2[4 * c + 2] += h1 * w[2]; lb2[4 * c + 3] += h1 * w[3]; }
                }
            }
#pragma unroll
            for (int e = 0; e < 20; ++e) { la[e] = wave_sum_to63(la[e]); lb2[e] = wave_sum_to63(lb2[e]); }
            if (F.lane == 63) {
                LAS f32x4* lp = (LAS f32x4*)(LG + rl * 20);
#pragma unroll
                for (int c = 0; c < 5; ++c) { lp[c] = (f32x4){la[4 * c], la[4 * c + 1], la[4 * c + 2], la[4 * c + 3]}; lp[5 + c] = (f32x4){lb2[4 * c], lb2[4 * c + 1], lb2[4 * c + 2], lb2[4 * c + 3]}; }
            }
        }
        __syncthreads();
        int e0 = 0, e1 = 0, p0 = 0, p1 = 0; float g0 = 0.f, g1 = 0.f;
        if (F.tid < 128) {
            float lg[20];
#pragma unroll
            for (int c = 0; c < 5; ++c) { const f32x4 t = *(const LAS f32x4*)(LG + F.tid * 20 + 4 * c); lg[4 * c] = t[0]; lg[4 * c + 1] = t[1]; lg[4 * c + 2] = t[2]; lg[4 * c + 3] = t[3]; }
            route_row(A, lg, e0, e1, g0, g1);
            p0 = atomicAdd((int*)&lcnt[e0], 1); p1 = atomicAdd((int*)&lcnt[e1], 1);
        }
        __syncthreads();
        if (F.tid < 16) lbase[F.tid] = (int)atomicAdd(((unsigned*)(A.ws + WS_CTL)) + CW_CNT + F.tid, (unsigned)lcnt[F.tid]);
        __syncthreads();
        if (F.tid < 128) {
            unsigned* mp = ((unsigned*)(A.ws + WS_META)) + (size_t)(slab * 128 + F.tid) * 8;
            u32x4 a, c;
            a.x = (unsigned)e0; a.y = (unsigned)(lbase[e0] + p0); a.z = __float_as_uint(g0); a.w = (unsigned)e1;
            c.x = (unsigned)(lbase[e1] + p1); c.y = __float_as_uint(g1); c.z = 0u; c.w = 0u;
            *(u32x4*)mp = a; *(u32x4*)(mp + 4) = c;
            int* list = (int*)(A.ws + WS_LIST);
            list[e0 * 32768 + (int)a.y] = slab * 128 + F.tid; list[e1 * 32768 + (int)c.x] = slab * 128 + F.tid;
        }
        __syncthreads();
    }
}

__device__ __forceinline__ void build_toff(Frame& F, const Args& A) {
    __syncthreads();
    if (F.tid == 0) { int acc = 0;
        for (int e = 0; e < NEXP; ++e) { F.misc[e] = acc; const unsigned c = __hip_atomic_load(((unsigned*)(A.ws + WS_CTL)) + CW_CNT + e, __ATOMIC_RELAXED, __HIP_MEMORY_SCOPE_AGENT); F.misc[64 + e] = (int)c; acc += (int)((c + 255u) >> 8); }
        F.misc[NEXP] = acc; }
    __syncthreads();
}

__device__ __forceinline__ void p7_weights(Frame& F, const Args& A) {
    LAS float* scr = (LAS float*)(F.lds + F.wave * 16384);
    constexpr int I13 = (DM / 64) * (DEXP / 32), I2 = (DEXP / 64) * (DM / 32);
    for (int it = F.gw; it < NEXP * (2 * I13 + I2); it += F.ngw) {
        const int e = it / (2 * I13 + I2), r = it % (2 * I13 + I2);
        if (r < I13) transpose_item<1>(A.in[13] + (size_t)e * DM * DEXP, DM, DEXP, ((bf16*)(A.ws + WS_W13)) + (size_t)e * 1024 * DM, scr, r, F.lane);
        else if (r < 2 * I13) transpose_item<2>(A.in[14] + (size_t)e * DM * DEXP, DM, DEXP, ((bf16*)(A.ws + WS_W13)) + (size_t)e * 1024 * DM, scr, r - I13, F.lane);
        else transpose_item<0>(A.in[15] + (size_t)e * DEXP * DM, DEXP, DM, ((bf16*)(A.ws + WS_W2)) + (size_t)e * DM * DEXP, scr, r - 2 * I13, F.lane);
    }
}

__device__ __forceinline__ void p10_final(Frame& F, const Args& A) {
    build_toff(F, A);
    const unsigned* meta = (const unsigned*)(A.ws + WS_META);
    for (int r0 = 4 * F.gw; r0 < MTOK; r0 += 4 * F.ngw) {
        size_t s0[4], s1[4]; float g0[4], g1[4];
#pragma unroll
        for (int q = 0; q < 4; ++q) { const unsigned* mp = meta + (size_t)(r0 + q) * 8;
            const int e0 = (int)mp[0], p0 = (int)mp[1], e1 = (int)mp[3], p1 = (int)mp[4];
            g0[q] = __uint_as_float(mp[2]); g1[q] = __uint_as_float(mp[5]);
            s0[q] = (size_t)F.misc[e0] * 256 + p0; s1[q] = (size_t)F.misc[e1] * 256 + p1; }
        u32x2 hw[4][4], ya[4][4], yc[4][4];
#pragma unroll
        for (int q = 0; q < 4; ++q) {
            const u32x2* hr = (const u32x2*)(((const bf16*)(A.ws + WS_H1)) + (size_t)(r0 + q) * DM) + F.lane;
            const u32x2* y0 = (const u32x2*)(((const bf16*)(A.ws + WS_YS)) + s0[q] * DM) + F.lane; const u32x2* y1 = (const u32x2*)(((const bf16*)(A.ws + WS_YS)) + s1[q] * DM) + F.lane;
#pragma unroll
            for (int j = 0; j < 4; ++j) { hw[q][j] = hr[64 * j]; ya[q][j] = y0[64 * j]; yc[q][j] = y1[64 * j]; }
        }
#pragma unroll
        for (int q = 0; q < 4; ++q) {
            f32x4 v[4];
#pragma unroll
            for (int j = 0; j < 4; ++j) { const u32x2 h = hw[q][j], a = ya[q][j], c = yc[q][j];
                v[j][0] = ALPHA * bflo(h.x) + g0[q] * bflo(a.x) + g1[q] * bflo(c.x); v[j][1] = ALPHA * bfhi(h.x) + g0[q] * bfhi(a.x) + g1[q] * bfhi(c.x);
                v[j][2] = ALPHA * bflo(h.y) + g0[q] * bflo(a.y) + g1[q] * bflo(c.y); v[j][3] = ALPHA * bfhi(h.y) + g0[q] * bfhi(a.y) + g1[q] * bfhi(c.y); }
            float mean, rstd; ln_stats(v, mean, rstd);
            f32x4* xr = (f32x4*)(A.out + (size_t)(r0 + q) * DM) + F.lane;
#pragma unroll
            for (int j = 0; j < 4; ++j) { const f32x4 g = ((const f32x4*)A.in[16])[64 * j + F.lane], bb = ((const f32x4*)A.in[17])[64 * j + F.lane]; __builtin_nontemporal_store((v[j] - mean) * rstd * g + bb, xr + 64 * j); }
        }
    }
}

#define XB_TMO      128
#define XB_XCNT(j)  (256  + 64 * (j))
#define XB_XSUB(j)  (1280 + 64 * (j))
#define XB_XGEN(j)  (2304 + 64 * (j))
#define XB_TOP      3328
#define XB_TOPGEN   3392
#define XCD_BAR_WORDS 3456
#define XB_SPIN_CAP (1u << 18)

__device__ __forceinline__ unsigned xb_ld(unsigned* p)              { return __hip_atomic_load(p, __ATOMIC_RELAXED, __HIP_MEMORY_SCOPE_AGENT); }
__device__ __forceinline__ unsigned xb_add(unsigned* p, unsigned v) { return __hip_atomic_fetch_add(p, v, __ATOMIC_RELAXED, __HIP_MEMORY_SCOPE_AGENT); }
__device__ __forceinline__ unsigned xb_xcc_id() { return (unsigned)__builtin_amdgcn_s_getreg((3 << 11) | 20) & 0xFu; }
#define XB_SPIN(cond, bar) do { unsigned _sp = 0; while (cond) { __builtin_amdgcn_s_sleep(1); \
    if ((++_sp & 255u) == 0u) { if (xb_ld(&(bar)[XB_TMO])) break; if (_sp > XB_SPIN_CAP) { atomicAdd(&(bar)[XB_TMO], 1u); break; } } } } while (0)

struct XcdBarrier {
    unsigned* bar; unsigned x;
    volatile LAS unsigned* st;
};

__device__ __forceinline__ XcdBarrier xcd_barrier_post(unsigned* bar, volatile LAS unsigned* st) {
    XcdBarrier b; b.bar = bar; b.x = xb_xcc_id(); b.st = st;
    if (threadIdx.x == 0) (void)xb_add(&bar[XB_XCNT(b.x)], 1u);
    return b;
}
__device__ __forceinline__ void xcd_barrier_complete(unsigned* bar, unsigned x, unsigned& nloc, unsigned& nx) {
    const unsigned G = gridDim.x * gridDim.y * gridDim.z;
    unsigned sum, cnt, mine, sp = 0u;
    for (;;) {
        sum = 0u; cnt = 0u; mine = 0u;
#pragma unroll
        for (unsigned j = 0; j < 16; ++j) { const unsigned c = xb_ld(&bar[XB_XCNT(j)]); sum += c; cnt += (c > 0u) ? 1u : 0u; mine = (j == x) ? c : mine; }
        if (sum == G) break;
        __builtin_amdgcn_s_sleep(1);
        if ((++sp & 255u) == 0u) { if (xb_ld(&bar[XB_TMO])) break; if (sp > XB_SPIN_CAP) { atomicAdd(&bar[XB_TMO], 1u); break; } }
    }
    nloc = mine > 0u ? mine : 1u; nx = cnt > 0u ? cnt : 1u;
}

__device__ __forceinline__ void xcd_barrier(const XcdBarrier& b) {
    asm volatile("s_waitcnt vmcnt(0)" ::: "memory");
    __syncthreads();
    if (threadIdx.x == 0) {
        unsigned* bar = b.bar;
        __builtin_amdgcn_s_waitcnt(0);
        unsigned nloc = b.st[0], nx = b.st[1];
        if (nloc == 0u) { xcd_barrier_complete(bar, b.x, nloc, nx); b.st[0] = nloc; b.st[1] = nx; }
        const unsigned old = xb_add(&bar[XB_XSUB(b.x)], 1u);
        const unsigned gen = old / nloc;
        if (old + 1u == (gen + 1u) * nloc) {
            __builtin_amdgcn_fence(__ATOMIC_RELEASE, "agent");
            asm volatile("s_waitcnt vmcnt(0)" ::: "memory");
            const unsigned og = xb_add(&bar[XB_TOP], 1u);
            const unsigned tg = og / nx;
            if (og + 1u == (tg + 1u) * nx) xb_add(&bar[XB_TOPGEN], 1u);
            else XB_SPIN(xb_ld(&bar[XB_TOPGEN]) == tg, bar);
            __builtin_amdgcn_fence(__ATOMIC_ACQUIRE, "agent");
            xb_add(&bar[XB_XGEN(b.x)], 1u);
            asm volatile("s_waitcnt vmcnt(0)" ::: "memory");
        } else {
            XB_SPIN(xb_ld(&bar[XB_XGEN(b.x)]) == gen, bar);
            __builtin_amdgcn_fence(__ATOMIC_ACQUIRE, "agent");
            asm volatile("s_waitcnt vmcnt(0)" ::: "memory");
        }
    }
    __syncthreads();
}

constexpr int NPHASE = 11;
__global__ void __launch_bounds__(NTHREADS, 2) mega_fwd(Args args) {
    extern __shared__ __attribute__((aligned(16))) unsigned char lds[];
    Frame F;
    F.lds = (LAS unsigned char*)lds; F.misc = (LAS int*)(F.lds + MISC_OFF);
    F.tid = threadIdx.x; F.lane = F.tid & 63; F.wave = __builtin_amdgcn_readfirstlane(F.tid >> 6); F.G = gridDim.x;
    F.gw = blockIdx.x * NWAVES + F.wave; F.ngw = F.G * NWAVES;
    const Args& A = args;
    const int lo = args.ph_lo, hi = args.ph_hi;
    const int vcu = (F.G % 8 == 0) ? (int)(blockIdx.x % 8) * (F.G / 8) + (int)(blockIdx.x / 8) : (int)blockIdx.x;
    if (F.tid < 2) F.misc[MISC_BAR + F.tid] = 0;
    __syncthreads();
    XcdBarrier bar; bar.bar = (unsigned*)(args.ws + WS_CTL) + CW_BAR; bar.x = 0; bar.st = nullptr;
    if (MK_LAUNCHES == 1) bar = xcd_barrier_post((unsigned*)(args.ws + WS_CTL) + CW_BAR, (volatile LAS unsigned*)(F.misc + MISC_BAR));
#define IN(k) (lo <= (k) && (k) < hi)
#define SEAM(k) do { if (IN((k) + 1)) { xcd_barrier(bar); } } while (0)

    if (IN(0)) { p0_prep(F, A); SEAM(0); }
    if (IN(1)) {
        meta_finalize(F, A);
        pg8::Gemm g{((bf16*)(A.ws + WS_XB)), ((bf16*)(A.ws + WS_WIN)), MTOK, NIN, DM}; pg8::StaticOrder S; S.init(MTOK, NIN, F.G, (int)blockIdx.x);
        EpiProj E{((bf16*)(A.ws + WS_PROJ)), ((float*)(A.ws + WS_LB))};
        pg8::gemm_phase<EpiProj, pg8::StaticOrder, PG8_ALIGN, PG8_SP2>(F.lds, g, S, E);
        SEAM(1);
    }
    if (IN(2)) {
        ha_phase(F, A);
        attn_phase(F, A);
        SEAM(2);
    }
    if (IN(3)) { hb_phase(F, A); SEAM(3); }
    if (IN(4)) {
        hc_phase(F, A);
        SEAM(4);
    }
    if (IN(5)) {
        pg8::Gemm g{((bf16*)(A.ws + WS_MIX)), ((bf16*)(A.ws + WS_WOUT)), MTOK, DM, DM}; pg8::StaticOrder S; S.init(MTOK, DM, F.G, (int)blockIdx.x);
        EpiYs E{(bf16*)(A.ws + WS_Y1)};
        pg8::gemm_phase<EpiYs, pg8::StaticOrder, PG8_ALIGN, PG8_SP2>(F.lds, g, S, E);
        SEAM(5);
    }
    if (IN(6)) { p6_ln_router(F, A); p7_weights(F, A); SEAM(6); }
    if (IN(8)) {
        build_toff(F, A);
        pg8::Gemm g{((bf16*)(A.ws + WS_H1)), ((bf16*)(A.ws + WS_W13)), XS_ROWS, 1024, DM}; MoeOrder S{(const LAS int*)F.misc, F.G, vcu, F.misc[NEXP], (const int*)(A.ws + WS_LIST)};
        EpiHid E{((bf16*)(A.ws + WS_HID))};
        pg8::gemm_phase_gather<EpiHid, MoeOrder, PG8_ALIGN, PG8_SP2>(F.lds, g, S, E);
        SEAM(8);
    }
    if (IN(9)) {
        build_toff(F, A);
        pg8::Gemm g{((bf16*)(A.ws + WS_HID)), ((bf16*)(A.ws + WS_W2)), XS_ROWS, 1024, DEXP}; MoeOrder S{(const LAS int*)F.misc, F.G, vcu, F.misc[NEXP], (const int*)(A.ws + WS_LIST)};
        EpiYs E{((bf16*)(A.ws + WS_YS))};
        pg8::gemm_phase<EpiYs, MoeOrder, PG8_ALIGN, PG8_SP2>(F.lds, g, S, E);
        SEAM(9);
    }
    if (IN(10)) { p10_final(F, A); }
#undef IN
#undef SEAM
}

extern "C" void kernel_launch(void* const* d_in, const int* in_sizes, int n_in, void* d_out, int out_size, void* d_ws, size_t ws_size, hipStream_t stream) {
    static int grid = 0;
    if (grid == 0) {
        if (n_in != 18 || in_sizes[0] != MTOK * DM || out_size != MTOK * DM || ws_size < WS_END) {
            fprintf(stderr, "kernel_launch: unexpected shapes (n_in %d, in0 %d, out %d, ws %zu); nothing launched\n", n_in, n_in > 0 ? in_sizes[0] : -1, out_size, ws_size); grid = -1; return; }
        int dev = 0, cus = 0, per_cu = 0;
        if (hipGetDevice(&dev) != hipSuccess || hipDeviceGetAttribute(&cus, hipDeviceAttributeMultiprocessorCount, dev) != hipSuccess) { grid = -1; return; }
        if (hipFuncSetAttribute((const void*)mega_fwd, hipFuncAttributeMaxDynamicSharedMemorySize, LDS_BYTES) != hipSuccess) { fprintf(stderr, "kernel_launch: hipFuncSetAttribute failed\n"); grid = -1; return; }
        if (hipOccupancyMaxActiveBlocksPerMultiprocessor(&per_cu, (const void*)mega_fwd, NTHREADS, LDS_BYTES) != hipSuccess || per_cu < 1) { fprintf(stderr, "kernel_launch: occupancy query says %d\n", per_cu); per_cu = 1; }
        (void)hipGetLastError();
        grid = cus;
    }
    if (grid < 0) return;
    (void)hipMemsetAsync((char*)d_ws + WS_CTL, 0, CTL_ZERO_BYTES, stream);
    Args a{};
    for (int i = 0; i < 18; ++i) a.in[i] = (const float*)d_in[i];
    a.out = (float*)d_out; a.ws = (unsigned char*)d_ws;
#if MK_LAUNCHES == 1
    a.ph_lo = 0; a.ph_hi = NPHASE;
    void* kargs[] = {&a};
    hipError_t e = hipLaunchCooperativeKernel((const void*)mega_fwd, dim3(grid), dim3(NTHREADS), kargs, LDS_BYTES, stream);
    if (e != hipSuccess) fprintf(stderr, "kernel_launch: cooperative launch failed: %s (grid %d)\n", hipGetErrorString(e), grid);
#else
    for (int p = 0; p < NPHASE; ++p) { a.ph_lo = p; a.ph_hi = p + 1; hipLaunchKernelGGL(mega_fwd, dim3(grid), dim3(NTHREADS), LDS_BYTES, stream, a); }
#endif
}
```
